# Optimizing an MI355X kernel written in HIP

```python
import math
import jax, jax.numpy as jnp
from jax import lax
import numpy as np

D_MODEL = 1024
BATCH = 4
SEQ = 4096
DEPTH = 1

N_META = 16
MIX_WIDTH = D_MODEL
RWKV_WIDTH = MIX_WIDTH // 2
ATT_WIDTH = MIX_WIDTH - RWKV_WIDTH
HEAD_DIM = 64
RWKV_HEADS = RWKV_WIDTH // HEAD_DIM
ATT_HEADS = ATT_WIDTH // HEAD_DIM
DECAY_RANK = 64
ICLR_RANK = 64
GATE_RANK = 128
Q_LORA_RANK = 256
IDX_HEADS = 8
IDX_DIM = 64
IDX_ROPE_DIM = 32
INDEX_TOPK = 256
QBLOCK = 128
ROPE_THETA = 10000.0
N_GROUPS = 4
EXPERTS_PER_GROUP = 8
N_EXPERTS = N_GROUPS * EXPERTS_PER_GROUP
D_EXPERT = 256
TOPK_IN_GROUP = 2
DN_ALPHA = (2.0 * DEPTH) ** 0.25
DN_BETA = (8.0 * DEPTH) ** -0.25
LN_EPS = 1e-5
RMS_EPS = 1e-6
GN_EPS = 64e-5

RWKV_SPLITS = (RWKV_WIDTH, RWKV_WIDTH, RWKV_WIDTH, DECAY_RANK, ICLR_RANK, GATE_RANK)
ATT_SPLITS = (Q_LORA_RANK, ATT_WIDTH, ATT_WIDTH, IDX_DIM, IDX_HEADS)
RWKV_COLS = sum(RWKV_SPLITS)
ATT_COLS = sum(ATT_SPLITS)
IN_COLS = RWKV_COLS + ATT_COLS

kernel_name = "hymba_rwkv7_dsa_hmoe_deepnorm"

F32 = jnp.float32


def split_cols(u, sizes):
    outs, start = [], 0
    for s in sizes:
        outs.append(u[..., start:start + s])
        start += s
    return outs


def layer_norm(x, g, b, eps=LN_EPS):
    xf = x.astype(F32)
    mu = jnp.mean(xf, -1, keepdims=True)
    var = jnp.mean(jnp.square(xf - mu), -1, keepdims=True)
    return ((xf - mu) * lax.rsqrt(var + eps) * g.astype(F32) + b.astype(F32)).astype(x.dtype)


def rms_norm(x, g, eps=RMS_EPS):
    xf = x.astype(F32)
    return (xf * lax.rsqrt(jnp.mean(jnp.square(xf), -1, keepdims=True) + eps) * g.astype(F32)).astype(x.dtype)


def rope(x, positions, rot_dim):
    half = rot_dim // 2
    inv = 1.0 / (ROPE_THETA ** (jnp.arange(half, dtype=F32) / half))
    ang = positions.astype(F32)[:, None] * inv[None, :]
    cos, sin = jnp.cos(ang)[:, None, :], jnp.sin(ang)[:, None, :]
    xr = x[..., :rot_dim].astype(F32)
    x1, x2 = xr[..., :half], xr[..., half:]
    rot = jnp.concatenate([x1 * cos - x2 * sin, x2 * cos + x1 * sin], -1).astype(x.dtype)
    return jnp.concatenate([rot, x[..., rot_dim:]], -1)


def token_shift(u):
    return jnp.pad(u, ((0, 0), (1, 0), (0, 0)))[:, :-1]


def rwkv7_time_mix(u, mu, w0, w2, a0, a2, g2, k_k, k_a, r_k, lnx_g, lnx_b):
    B, L, _ = u.shape
    H, N = RWKV_HEADS, HEAD_DIM
    u = u + (token_shift(u) - u) * mu
    r, k, v, wd, ad, gd = split_cols(u, RWKV_SPLITS)
    w_log = -jax.nn.softplus(-(w0 + jnp.tanh(wd) @ w2).astype(F32)) - 0.5
    decay = jnp.exp(-jnp.exp(w_log))
    a = jax.nn.sigmoid((a0 + ad @ a2).astype(F32))
    g = jax.nn.sigmoid(gd) @ g2
    heads = lambda t: t.astype(F32).reshape(B, L, H, N)
    kk = heads(k * k_k)
    kk = kk / jnp.maximum(jnp.sqrt(jnp.sum(kk * kk, -1, keepdims=True)), 1e-12)
    k_mod = k.astype(F32) * (1.0 + (a - 1.0) * k_a.astype(F32))
    r_h, k_h, v_h, w_h, a_h = heads(r), heads(k_mod), heads(v), heads(decay), heads(a)

    def step(S, inp):
        r_t, w_t, k_t, v_t, kk_t, a_t = inp
        sk = jnp.einsum('bhij,bhj->bhi', S, kk_t)
        S = (S * w_t[:, :, None, :] - sk[..., None] * (kk_t * a_t)[:, :, None, :]
             + v_t[..., None] * k_t[:, :, None, :])
        return S, jnp.einsum('bhij,bhj->bhi', S, r_t)

    tm = lambda t: jnp.moveaxis(t, 1, 0)
    S0 = jnp.zeros((B, H, N, N), F32)
    _, o = lax.scan(step, S0, (tm(r_h), tm(w_h), tm(k_h), tm(v_h), tm(kk), tm(a_h)))
    o = jnp.moveaxis(o, 0, 1)
    mu_o = jnp.mean(o, -1, keepdims=True)
    var_o = jnp.mean(jnp.square(o - mu_o), -1, keepdims=True)
    o = ((o - mu_o) * lax.rsqrt(var_o + GN_EPS)).reshape(B, L, H * N) * lnx_g.astype(F32) + lnx_b.astype(F32)
    bonus = (jnp.sum(r_h * k_h * r_k.astype(F32), -1, keepdims=True) * v_h).reshape(B, L, H * N)
    return ((o + bonus) * g.astype(F32)).astype(u.dtype)


def dsa_attention(u, positions, k_sel, qnorm_g, wuq, idx_wq, idx_kn_g, idx_kn_b):
    B, L, _ = u.shape
    H, Dh, HI, DI = ATT_HEADS, HEAD_DIM, IDX_HEADS, IDX_DIM
    cq, k, v, kidx, widx = split_cols(u, ATT_SPLITS)
    cq = rms_norm(cq, qnorm_g)
    q = rope((cq @ wuq).reshape(B, L, H, Dh), positions, Dh)
    qi = rope((cq @ idx_wq).reshape(B, L, HI, DI), positions, IDX_ROPE_DIM)
    k = rope(k.reshape(B, L, H, Dh), positions, Dh)
    v = v.reshape(B, L, H, Dh)
    kidx = rope(layer_norm(kidx, idx_kn_g, idx_kn_b)[:, :, None, :], positions, IDX_ROPE_DIM)[:, :, 0]
    kidx_f = kidx.astype(F32) * (DI ** -0.5)
    widx = widx * (HI ** -0.5)

    n_blk = -(-L // QBLOCK)
    pad = n_blk * QBLOCK - L
    def to_blocks(t):
        t = jnp.pad(t, ((0, 0), (0, pad)) + ((0, 0),) * (t.ndim - 2))
        return jnp.swapaxes(t.reshape((B, n_blk, QBLOCK) + t.shape[2:]), 0, 1)
    t_blocks = jnp.arange(n_blk * QBLOCK, dtype=jnp.int32).reshape(n_blk, QBLOCK)
    key_pos = jnp.arange(L, dtype=jnp.int32)
    neg = jnp.finfo(F32).min

    def block(args):
        qb, qib, wib, t = args
        s_idx = jnp.einsum('bthd,bsd->bths', qib.astype(F32), kidx_f)
        score = jnp.einsum('bths,bth->bts', jax.nn.relu(s_idx), wib.astype(F32))
        adm = key_pos[None, :] <= t[:, None]
        score = jnp.where(adm[None], score, neg)
        _, sel = lax.top_k(score, k_sel)
        valid = sel <= t[None, :, None]
        kg = jax.vmap(lambda kb, ib: kb[ib])(k, sel)
        vg = jax.vmap(lambda vb, ib: vb[ib])(v, sel)
        logits = jnp.einsum('bthd,btkhd->bhtk', qb.astype(F32), kg.astype(F32)) * (Dh ** -0.5)
        logits = jnp.where(valid[:, None], logits, neg)
        p = jax.nn.softmax(logits, axis=-1)
        return jnp.einsum('bhtk,btkhd->bthd', p, vg.astype(F32)).astype(qb.dtype)

    ob = lax.map(block, (to_blocks(q), to_blocks(qi), to_blocks(widx), t_blocks))
    return jnp.swapaxes(ob, 0, 1).reshape(B, n_blk * QBLOCK, H * Dh)[:, :L]


def hier_moe(h, rgw, rgb, rew, reb, wg, wu, wd):
    B, L, D = h.shape
    t = h.reshape(B * L, D)
    grp_logits = (t @ rgw + rgb).astype(F32)
    grp_prob = jax.nn.softmax(grp_logits, -1)
    gsel = jnp.argmax(grp_logits, -1)
    ggate = jnp.take_along_axis(grp_prob, gsel[:, None], -1)
    exp_logits = (t @ rew + reb).astype(F32).reshape(-1, N_GROUPS, EXPERTS_PER_GROUP)
    in_grp = jnp.take_along_axis(exp_logits, gsel[:, None, None], axis=1)[:, 0]
    top_v, top_i = lax.top_k(in_grp, TOPK_IN_GROUP)
    wts = jax.nn.softmax(top_v, -1) * ggate
    eidx = gsel[:, None] * EXPERTS_PER_GROUP + top_i
    gates = jnp.sum(jax.nn.one_hot(eidx, N_EXPERTS, dtype=F32) * wts[..., None], axis=1)

    def body(acc, xs):
        wg_e, wu_e, wd_e, g_e = xs
        y = (jax.nn.silu(t @ wg_e) * (t @ wu_e)) @ wd_e
        return acc + g_e[:, None].astype(t.dtype) * y, None

    acc, _ = lax.scan(body, jnp.zeros_like(t), (wg, wu, wd, gates.T))
    return acc.reshape(B, L, D)


def setup_inputs(seed: int = 0) -> dict:
    key = jax.random.key(seed)
    ks = iter(jax.random.split(key, 40))
    def nrm(shape, scale):
        return jax.random.normal(next(ks), shape, F32) * scale
    def gain(shape):
        return 1.0 + nrm(shape, 0.02)
    col_scale = jnp.ones((IN_COLS,), F32)
    col_scale = col_scale.at[2 * RWKV_WIDTH:3 * RWKV_WIDTH].set(DN_BETA)
    v_att = RWKV_COLS + Q_LORA_RANK + ATT_WIDTH
    col_scale = col_scale.at[v_att:v_att + ATT_WIDTH].set(DN_BETA)
    return {
        "x": nrm((BATCH, SEQ, D_MODEL), 1.0),
        "meta_tokens": nrm((N_META, D_MODEL), 1.0),
        "ln_emb_g": gain((D_MODEL,)),
        "ln_emb_b": nrm((D_MODEL,), 0.02),
        "w_in": nrm((DEPTH, D_MODEL, IN_COLS), D_MODEL ** -0.5) * col_scale,
        "rw_mu": jax.random.uniform(next(ks), (DEPTH, RWKV_COLS), F32),
        "rw_w0": jax.random.uniform(next(ks), (DEPTH, RWKV_WIDTH), F32, minval=-6.0, maxval=1.0),
        "rw_w2": nrm((DEPTH, DECAY_RANK, RWKV_WIDTH), 0.1 * DECAY_RANK ** -0.5),
        "rw_a0": nrm((DEPTH, RWKV_WIDTH), 0.5),
        "rw_a2": nrm((DEPTH, ICLR_RANK, RWKV_WIDTH), 0.5 * ICLR_RANK ** -0.5),
        "rw_g2": nrm((DEPTH, GATE_RANK, RWKV_WIDTH), GATE_RANK ** -0.5),
        "rw_kk": 0.85 + nrm((DEPTH, RWKV_WIDTH), 0.05),
        "rw_ka": 1.0 + nrm((DEPTH, RWKV_WIDTH), 0.05),
        "rw_rk": nrm((DEPTH, RWKV_HEADS, HEAD_DIM), 0.1),
        "rw_lnx_g": gain((DEPTH, RWKV_WIDTH)),
        "rw_lnx_b": nrm((DEPTH, RWKV_WIDTH), 0.02),
        "att_qnorm_g": gain((DEPTH, Q_LORA_RANK)),
        "att_wuq": nrm((DEPTH, Q_LORA_RANK, ATT_WIDTH), Q_LORA_RANK ** -0.5),
        "idx_wq": nrm((DEPTH, Q_LORA_RANK, IDX_HEADS * IDX_DIM), Q_LORA_RANK ** -0.5),
        "idx_knorm_g": gain((DEPTH, IDX_DIM)),
        "idx_knorm_b": nrm((DEPTH, IDX_DIM), 0.02),
        "w_out": nrm((DEPTH, MIX_WIDTH, D_MODEL), DN_BETA * MIX_WIDTH ** -0.5),
        "ln1_g": gain((DEPTH, D_MODEL)),
        "ln1_b": nrm((DEPTH, D_MODEL), 0.02),
        "rt_grp_w": nrm((DEPTH, D_MODEL, N_GROUPS), D_MODEL ** -0.5),
        "rt_grp_b": nrm((DEPTH, N_GROUPS), 0.01),
        "rt_exp_w": nrm((DEPTH, D_MODEL, N_EXPERTS), D_MODEL ** -0.5),
        "rt_exp_b": nrm((DEPTH, N_EXPERTS), 0.01),
        "ex_w_gate": nrm((DEPTH, N_EXPERTS, D_MODEL, D_EXPERT), D_MODEL ** -0.5),
        "ex_w_up": nrm((DEPTH, N_EXPERTS, D_MODEL, D_EXPERT), D_MODEL ** -0.5),
        "ex_w_down": nrm((DEPTH, N_EXPERTS, D_EXPERT, D_MODEL), DN_BETA * D_EXPERT ** -0.5),
        "ln2_g": gain((DEPTH, D_MODEL)),
        "ln2_b": nrm((DEPTH, D_MODEL), 0.02),
    }


def reference(x, meta_tokens, ln_emb_g, ln_emb_b, w_in, rw_mu, rw_w0, rw_w2, rw_a0, rw_a2, rw_g2,
              rw_kk, rw_ka, rw_rk, rw_lnx_g, rw_lnx_b, att_qnorm_g, att_wuq, idx_wq, idx_knorm_g,
              idx_knorm_b, w_out, ln1_g, ln1_b, rt_grp_w, rt_grp_b, rt_exp_w, rt_exp_b,
              ex_w_gate, ex_w_up, ex_w_down, ln2_g, ln2_b):
    B, S, D = x.shape
    k_sel = min(INDEX_TOPK, S // 4)
    meta = jnp.broadcast_to(meta_tokens[None].astype(x.dtype), (B, N_META, D))
    h = layer_norm(jnp.concatenate([meta, x], axis=1), ln_emb_g, ln_emb_b)
    positions = jnp.arange(N_META + S, dtype=jnp.int32)
    for l in range(DEPTH):
        u = h @ w_in[l]
        y_rwkv = rwkv7_time_mix(u[..., :RWKV_COLS], rw_mu[l], rw_w0[l], rw_w2[l], rw_a0[l], rw_a2[l],
                                rw_g2[l], rw_kk[l], rw_ka[l], rw_rk[l], rw_lnx_g[l], rw_lnx_b[l])
        y_att = dsa_attention(u[..., RWKV_COLS:], positions, k_sel, att_qnorm_g[l], att_wuq[l],
                              idx_wq[l], idx_knorm_g[l], idx_knorm_b[l])
        mix = jnp.concatenate([y_rwkv, y_att], axis=-1) @ w_out[l]
        h = layer_norm(DN_ALPHA * h + mix, ln1_g[l], ln1_b[l])
        ffn = hier_moe(h, rt_grp_w[l], rt_grp_b[l], rt_exp_w[l], rt_exp_b[l],
                       ex_w_gate[l], ex_w_up[l], ex_w_down[l])
        h = layer_norm(DN_ALPHA * h + ffn, ln2_g[l], ln2_b[l])
    return h[:, N_META:]
```

```cpp
#include <hip/hip_runtime.h>
#include <math.h>
#include <stdint.h>
namespace pg8 {
#define PG8_LAS __attribute__((address_space(3)))
typedef unsigned short bf16_t;
typedef short bf16x8 __attribute__((ext_vector_type(8)));
typedef float f32x4 __attribute__((ext_vector_type(4)));
typedef unsigned u32x4 __attribute__((ext_vector_type(4)));
constexpr int BM = 256, BK = 64, HALF = 128, HTB = HALF * BK * 2  , STAGE_BYTES = 8 * HTB, NXCD = 8, WGM = 8;

__host__ __device__ __forceinline__ int lds_byte(int r, int c) { const int st = (r >> 4) * 2 + (c >> 5), rr = r & 15, cc = c & 31, ob = rr * 64 + cc * 2; return st * 1024 + (ob ^ (((ob >> 9) & 1) << 5)); }
__host__ __device__ __forceinline__ void stage_rc(int b, int& R, int& C) { const int st = b / 1024, sb = b % 1024, swz = sb ^ (((sb >> 9) & 1) << 5); R = (st >> 1) * 16 + swz / 64; C = (st & 1) * 32 + (swz % 64) / 2; }
__host__ __device__ __forceinline__ int perm32(int rho) { const int n = rho >> 4, i = rho & 15; return 8 * (i >> 2) + 4 * n + (i & 3); }

struct Unit { int pm, pn; };
struct Gemm { const bf16_t* A; const bf16_t* Bt; int M, N, K, lda; const int* rowidx; };

struct StaticOrder {
    int nM, nN, nwg, G, c;
    __host__ __device__ void init(int M, int N, int G_, int c_) { nM = M / BM; nN = N / BM; nwg = nM * nN; G = G_; c = c_; }
    __host__ __device__ bool next(int i, Unit& u) const {
        const long L = (long)i * G + c; if (L >= nwg) return false;
        int wgid = (int)L; { const int q = nwg / NXCD, r = nwg % NXCD, xcd = wgid % NXCD, off = wgid / NXCD; wgid = (xcd < r ? xcd * (q + 1) : r * (q + 1) + (xcd - r) * q) + off; }
        const int nig = WGM * nN, gid = wgid / nig, fm = gid * WGM, gsz = (nM - fm) < WGM ? (nM - fm) : WGM;
        u.pm = fm + ((wgid % nig) % gsz); u.pn = (wgid % nig) / gsz; return true;
    }
    __device__ __forceinline__ void a_ready(const Unit&) const {}
    __device__ __forceinline__ void done(const Unit&) const {}
};

__device__ __forceinline__ unsigned cvt_pk_bf16(float lo, float hi) { unsigned r; asm volatile("v_cvt_pk_bf16_f32 %0, %1, %2" : "=v"(r) : "v"(lo), "v"(hi)); return r; }
typedef float f32x2 __attribute__((ext_vector_type(2)));
__device__ __forceinline__ f32x2 gelu_pk(f32x2 v) {
    const f32x2 av = __builtin_elementwise_abs(v), d = av * 0.2316418882f + 1.0f;
    f32x2 t; t.x = __builtin_amdgcn_rcpf(d.x); t.y = __builtin_amdgcn_rcpf(d.y);
    f32x2 q = t * 0.5307027145f + (-0.7265760135f); q = q * t + 0.7107068705f; q = q * t + (-0.142248368f); q = q * t + 0.127414796f; q = q * t;
    const f32x2 s = (v * v) * (-0.72134752044f);
    f32x2 e; e.x = __builtin_amdgcn_exp2f(s.x); e.y = __builtin_amdgcn_exp2f(s.y);
    const f32x2 m = v * (q * e), r = v - m;
    f32x2 o; o.x = v.x < 0.f ? m.x : r.x; o.y = v.y < 0.f ? m.y : r.y; return o;
}

template <int ACT  > struct EpiBf16 {
    static constexpr bool PERM = true, AFTER_DRAIN = false; static_assert(ACT == 0 || ACT == 1, "EpiBf16: ACT is 0 (none) or 1 (gelu_pk)");
    bf16_t* O; int ldc; const float* bias; int split_cols; size_t split_stride; float scale0;
    __device__ __forceinline__ void operator()(const f32x4 (&acc)[2][2][4][2], const Unit& u, int wr, int wc, int fr, int fq) const {
        const int row0 = u.pm * BM + wr * 64 + fr; int colt = u.pn * BM; bf16_t* base = O;
        float sc = 1.f; if (split_cols) { const int t = colt / split_cols; base += (size_t)t * split_stride; colt -= t * split_cols; if (t == 0) sc = scale0; }
        const int col0 = colt + wc * 32 + 8 * fq, bcol0 = u.pn * BM + wc * 32 + 8 * fq;
        f32x4 bv[2][2];
#pragma unroll
        for (int bj = 0; bj < 2; ++bj)
#pragma unroll
            for (int n = 0; n < 2; ++n) bv[bj][n] = bias ? *(const f32x4*)(bias + bcol0 + bj * HALF + 4 * n) : (f32x4){0.f, 0.f, 0.f, 0.f};
#pragma unroll
        for (int ai = 0; ai < 2; ++ai)
#pragma unroll
            for (int m = 0; m < 4; ++m) { bf16_t* rowp = base + (size_t)(row0 + ai * HALF + m * 16) * ldc + col0;
#pragma unroll
                for (int bj = 0; bj < 2; ++bj) { f32x4 v0 = acc[ai][bj][m][0] + bv[bj][0], v1 = acc[ai][bj][m][1] + bv[bj][1];
                    if (ACT == 1) { f32x2 a = gelu_pk((f32x2){v0[0], v0[1]}), b = gelu_pk((f32x2){v0[2], v0[3]}), c = gelu_pk((f32x2){v1[0], v1[1]}), d = gelu_pk((f32x2){v1[2], v1[3]});
                        v0 = (f32x4){a.x, a.y, b.x, b.y}; v1 = (f32x4){c.x, c.y, d.x, d.y}; }
                    v0 = v0 * sc; v1 = v1 * sc; u32x4 w; w.x = cvt_pk_bf16(v0[0], v0[1]); w.y = cvt_pk_bf16(v0[2], v0[3]); w.z = cvt_pk_bf16(v1[0], v1[1]); w.w = cvt_pk_bf16(v1[2], v1[3]);
                    *(u32x4*)(rowp + bj * HALF) = w; } }
    }
};
template <class Epi, class Sched, bool ALIGN_EPI = false, bool SP2 = false, bool GATHER = false>
__device__ __forceinline__ void gemm_phase(PG8_LAS unsigned char* lds, const Gemm g, const Sched& S, const Epi& E) {
    const int tid = threadIdx.x, wid = __builtin_amdgcn_readfirstlane(tid >> 6), lane = tid & 63, wr = wid >> 2, wc = wid & 3, fr = lane & 15, fq = lane >> 4;
    const int K = g.K, nt = K / BK;
    unsigned voffA[2], voffA1[2], voffB[2];
#pragma unroll
    for (int i = 0; i < 2; ++i) { int R, C; stage_rc(tid * 16 + i * 8192, R, C); const int Rb = Epi::PERM ? ((R & ~31) + perm32(R & 31)) : R;
        if constexpr (GATHER) { voffA[i] = (unsigned)(g.rowidx[R] * g.lda + C) * 2u; voffA1[i] = (unsigned)(g.rowidx[R + HALF] * g.lda + C) * 2u; }
        else { voffA[i] = (unsigned)(R * g.lda + C) * 2u; voffA1[i] = voffA[i]; }
        voffB[i] = (unsigned)(Rb * K + C) * 2u; }
    const size_t kstep = (size_t)(BK * 2);
    const size_t hstep = (size_t)HALF * K * 2;
    const size_t tstep = 2 * hstep; const size_t hstepA = GATHER ? (size_t)0 : (size_t)HALF * g.lda * 2, tstepA = 2 * hstepA;
    const unsigned ldsw = (unsigned)wid * 1024u;
    const int aoff = lds_byte(wr * 64 + fr, fq * 8), boff = lds_byte(wc * 32 + fr, fq * 8);
#define PG8_SA(b, h) (((b) * 2 + (h)) * HTB)
#define PG8_SB(b, h) ((4 + (b) * 2 + (h)) * HTB)
#define PG8_STAGE(bufoff, gbase, voff) do { _Pragma("unroll") for (int _i = 0; _i < 2; ++_i) \
        __builtin_amdgcn_global_load_lds((const unsigned*)((const char*)(gbase) + (voff)[_i]), (PG8_LAS unsigned*)(lds + (bufoff) + ldsw + _i * 8192), 16, 0, 0); } while (0)
#define PG8_LDA(dst, b, h) do { _Pragma("unroll") for (int m = 0; m < 4; ++m) _Pragma("unroll") for (int k = 0; k < 2; ++k) dst[m][k] = *(const PG8_LAS bf16x8*)(lds + PG8_SA(b, h) + aoff + m * 2048 + k * 1024); } while (0)
#define PG8_LDB(dst, b, h) do { _Pragma("unroll") for (int n = 0; n < 2; ++n) _Pragma("unroll") for (int k = 0; k < 2; ++k) dst[n][k] = *(const PG8_LAS bf16x8*)(lds + PG8_SB(b, h) + boff + n * 2048 + k * 1024); } while (0)
#define PG8_MMA(ai, bj, At, Bt) do { __builtin_amdgcn_s_setprio(1); _Pragma("unroll") for (int m = 0; m < 4; ++m) _Pragma("unroll") for (int n = 0; n < 2; ++n) _Pragma("unroll") for (int k = 0; k < 2; ++k) \
        acc[ai][bj][m][n] = __builtin_amdgcn_mfma_f32_16x16x32_bf16(Bt[n][k], At[m][k], acc[ai][bj][m][n], 0, 0, 0); __builtin_amdgcn_s_setprio(0); } while (0)
#define PG8_WAIT_V(n) asm volatile("s_waitcnt vmcnt(" #n ")" ::: "memory")
#define PG8_WAIT_L(n) asm volatile("s_waitcnt lgkmcnt(" #n ")" ::: "memory")
#define PG8_BAR __builtin_amdgcn_s_barrier()
#define PG8_SCHED __builtin_amdgcn_sched_barrier(0)
    Unit cur, nxt; int ui = 0;
    if (!S.next(0, cur)) return;
    f32x4 acc[2][2][4][2];
#pragma unroll
    for (int a = 0; a < 2; ++a)
#pragma unroll
        for (int b = 0; b < 2; ++b)
#pragma unroll
            for (int m = 0; m < 4; ++m)
#pragma unroll
                for (int n = 0; n < 2; ++n) acc[a][b][m][n] = (f32x4){0.f, 0.f, 0.f, 0.f};
    bf16x8 At[4][2], B0[2][2], B1[2][2];
    const char* cA = (const char*)g.A + (size_t)cur.pm * tstepA; const char* cB = (const char*)g.Bt + (size_t)cur.pn * tstep;
    S.a_ready(cur);
    if constexpr (SP2) {
        PG8_STAGE(PG8_SB(0, 0), cB, voffB); PG8_STAGE(PG8_SB(0, 1), cB + hstep, voffB); PG8_STAGE(PG8_SA(0, 0), cA, voffA); PG8_STAGE(PG8_SA(0, 1), cA + hstepA, voffA1);
        if (wr == 1) PG8_BAR;
        PG8_WAIT_V(2); PG8_BAR;
        PG8_STAGE(PG8_SB(1, 0), cB + kstep, voffB); PG8_STAGE(PG8_SA(1, 0), cA + kstep, voffA); PG8_STAGE(PG8_SB(1, 1), cB + hstep + kstep, voffB);
        PG8_WAIT_V(6); PG8_BAR;
    } else {
        PG8_STAGE(PG8_SB(0, 0), cB, voffB); PG8_STAGE(PG8_SA(0, 0), cA, voffA); PG8_STAGE(PG8_SB(0, 1), cB + hstep, voffB); PG8_STAGE(PG8_SA(0, 1), cA + hstepA, voffA1);
        if (wr == 1) PG8_BAR;
        PG8_WAIT_V(4); PG8_BAR;
        PG8_STAGE(PG8_SB(1, 0), cB + kstep, voffB); PG8_STAGE(PG8_SA(1, 0), cA + kstep, voffA); PG8_STAGE(PG8_SB(1, 1), cB + hstep + kstep, voffB);
        PG8_WAIT_V(6); PG8_BAR;
    }
    for (;;) {
        const bool has_next = S.next(ui + 1, nxt);
        const char* nA = has_next ? (const char*)g.A + (size_t)nxt.pm * tstepA : cA; const char* nB = has_next ? (const char*)g.Bt + (size_t)nxt.pn * tstep : cB;
        for (int t = 0; t < nt; t += 2) {
            const bool last = (t == nt - 2);
            const char* a1 = cA + (size_t)(t + 1) * kstep;
            const char* a2 = last ? nA : cA + (size_t)(t + 2) * kstep; const char* b2 = last ? nB : cB + (size_t)(t + 2) * kstep;
            const char* a3 = a2 + kstep; const char* b3 = b2 + kstep;
            if (last && has_next) S.a_ready(nxt);
            if constexpr (SP2) {
            PG8_LDB(B0, 0, 0); PG8_LDB(B1, 0, 1); PG8_SCHED; PG8_LDA(At, 0, 0); PG8_STAGE(PG8_SA(1, 1), a1 + hstepA, voffA1);
            PG8_WAIT_V(8); PG8_WAIT_L(0); PG8_BAR; PG8_MMA(0, 0, At, B0); PG8_MMA(0, 1, At, B1); PG8_BAR; PG8_SCHED;
            PG8_LDA(At, 0, 1); PG8_STAGE(PG8_SB(0, 0), b2, voffB); PG8_STAGE(PG8_SB(0, 1), b2 + hstep, voffB); PG8_STAGE(PG8_SA(0, 0), a2, voffA);
            PG8_WAIT_V(8); PG8_WAIT_L(0); PG8_BAR; PG8_MMA(1, 0, At, B0); PG8_MMA(1, 1, At, B1); PG8_BAR; PG8_SCHED;
            PG8_LDB(B0, 1, 0); PG8_LDB(B1, 1, 1); PG8_SCHED; PG8_LDA(At, 1, 0); PG8_STAGE(PG8_SA(0, 1), a2 + hstepA, voffA1);
            PG8_WAIT_V(8); PG8_WAIT_L(0); PG8_BAR; PG8_MMA(0, 0, At, B0); PG8_MMA(0, 1, At, B1); PG8_BAR; PG8_SCHED;
            PG8_LDA(At, 1, 1); PG8_STAGE(PG8_SB(1, 0), b3, voffB); PG8_STAGE(PG8_SB(1, 1), b3 + hstep, voffB); PG8_STAGE(PG8_SA(1, 0), a3, voffA);
            PG8_WAIT_V(8); PG8_WAIT_L(0); PG8_BAR; PG8_MMA(1, 0, At, B0); PG8_MMA(1, 1, At, B1); PG8_BAR; PG8_SCHED;
            } else {
            PG8_LDB(B0, 0, 0); PG8_SCHED; PG8_LDA(At, 0, 0); PG8_STAGE(PG8_SA(1, 1), a1 + hstepA, voffA1);
            PG8_WAIT_L(8); PG8_BAR; PG8_WAIT_L(0); PG8_MMA(0, 0, At, B0); PG8_BAR; PG8_SCHED;
            PG8_LDB(B1, 0, 1); PG8_STAGE(PG8_SB(0, 0), b2, voffB);
            PG8_BAR; PG8_WAIT_L(0); PG8_MMA(0, 1, At, B1); PG8_BAR;
            PG8_LDA(At, 0, 1); PG8_STAGE(PG8_SA(0, 0), a2, voffA);
            PG8_BAR; PG8_WAIT_L(0); PG8_MMA(1, 0, At, B0); PG8_BAR; PG8_SCHED;
            PG8_STAGE(PG8_SB(0, 1), b2 + hstep, voffB);
            PG8_WAIT_V(6); PG8_BAR; PG8_MMA(1, 1, At, B1); PG8_BAR;
            PG8_LDB(B0, 1, 0); PG8_SCHED; PG8_LDA(At, 1, 0); PG8_STAGE(PG8_SA(0, 1), a2 + hstepA, voffA1);
            PG8_WAIT_L(8); PG8_BAR; PG8_WAIT_L(0); PG8_MMA(0, 0, At, B0); PG8_BAR; PG8_SCHED;
            PG8_LDB(B1, 1, 1); PG8_STAGE(PG8_SB(1, 0), b3, voffB);
            PG8_BAR; PG8_WAIT_L(0); PG8_MMA(0, 1, At, B1); PG8_BAR;
            PG8_LDA(At, 1, 1); PG8_STAGE(PG8_SA(1, 0), a3, voffA);
            PG8_BAR; PG8_WAIT_L(0); PG8_MMA(1, 0, At, B0); PG8_BAR; PG8_SCHED;
            PG8_STAGE(PG8_SB(1, 1), b3 + hstep, voffB);
            PG8_WAIT_V(6); PG8_BAR; PG8_MMA(1, 1, At, B1); PG8_BAR;
            }
        }
        if constexpr (ALIGN_EPI) { if (wr == 0) PG8_BAR; }
        if constexpr (!Epi::AFTER_DRAIN) { E(acc, cur, wr, wc, fr, fq); S.done(cur); }
        if (!has_next) break;
#pragma unroll
        for (int a = 0; a < 2; ++a)
#pragma unroll
            for (int b = 0; b < 2; ++b)
#pragma unroll
                for (int m = 0; m < 4; ++m)
#pragma unroll
                    for (int n = 0; n < 2; ++n) acc[a][b][m][n] = (f32x4){0.f, 0.f, 0.f, 0.f};
        cur = nxt; cA = nA; cB = nB; ++ui;
        if constexpr (ALIGN_EPI) { if (wr == 1) PG8_BAR; }
    }
    PG8_WAIT_V(0);
    if constexpr (!ALIGN_EPI) { if (wr == 0) PG8_BAR; }
    PG8_BAR;
    if constexpr (Epi::AFTER_DRAIN) { E.fused(acc, cur, wr, wc, fr, fq, lds, wid, lane); S.done(cur); }
#undef PG8_SA
#undef PG8_SB
#undef PG8_STAGE
#undef PG8_LDA
#undef PG8_LDB
#undef PG8_MMA
#undef PG8_WAIT_V
#undef PG8_WAIT_L
#undef PG8_BAR
#undef PG8_SCHED
}
}
namespace pg8 {
struct EpiF32 {
    static constexpr bool PERM = false, AFTER_DRAIN = false;
    float* O; int ldc;
    __device__ __forceinline__ void operator()(const f32x4 (&acc)[2][2][4][2], const Unit& u, int wr, int wc, int fr, int fq) const {
        const int row0 = u.pm * BM + wr * 64 + fr, col0 = u.pn * BM + wc * 32 + 4 * fq;
#pragma unroll
        for (int ai = 0; ai < 2; ++ai)
#pragma unroll
            for (int m = 0; m < 4; ++m) { float* rowp = O + (size_t)(row0 + ai * HALF + m * 16) * ldc + col0;
#pragma unroll
                for (int bj = 0; bj < 2; ++bj)
#pragma unroll
                    for (int n = 0; n < 2; ++n) *(f32x4*)(rowp + bj * HALF + n * 16) = acc[ai][bj][m][n]; }
    }
};
}
namespace pg8 {
struct EpiU {
    static constexpr bool PERM = true, AFTER_DRAIN = false;
    bf16_t* Ur; bf16_t* Ua;
    __device__ __forceinline__ void operator()(const f32x4 (&acc)[2][2][4][2], const Unit& u, int wr, int wc, int fr, int fq) const {
        const int row0 = u.pm * BM + wr * 64 + fr; int colt = u.pn * BM; bf16_t* base = Ur; int ld = 1792;
        if (colt >= 1792) { base = Ua; ld = 1536; colt -= 1792; }
        const int col0 = colt + wc * 32 + 8 * fq;
#pragma unroll
        for (int ai = 0; ai < 2; ++ai)
#pragma unroll
            for (int m = 0; m < 4; ++m) { bf16_t* rowp = base + (size_t)(row0 + ai * HALF + m * 16) * ld + col0;
#pragma unroll
                for (int bj = 0; bj < 2; ++bj) { const f32x4 v0 = acc[ai][bj][m][0], v1 = acc[ai][bj][m][1];
                    u32x4 w; w.x = cvt_pk_bf16(v0[0], v0[1]); w.y = cvt_pk_bf16(v0[2], v0[3]); w.z = cvt_pk_bf16(v1[0], v1[1]); w.w = cvt_pk_bf16(v1[2], v1[3]);
                    *(u32x4*)(rowp + bj * HALF) = w; } }
    }
};
}
namespace pg8 {
struct EpiB16 {
    static constexpr bool PERM = true, AFTER_DRAIN = false;
    bf16_t* O; int ldc;
    __device__ __forceinline__ void operator()(const f32x4 (&acc)[2][2][4][2], const Unit& u, int wr, int wc, int fr, int fq) const {
        const int row0 = u.pm * BM + wr * 64 + fr, col0 = u.pn * BM + wc * 32 + 8 * fq;
#pragma unroll
        for (int ai = 0; ai < 2; ++ai)
#pragma unroll
            for (int m = 0; m < 4; ++m) { bf16_t* rowp = O + (size_t)(row0 + ai * HALF + m * 16) * ldc + col0;
#pragma unroll
                for (int bj = 0; bj < 2; ++bj) { const f32x4 v0 = acc[ai][bj][m][0], v1 = acc[ai][bj][m][1];
                    u32x4 w; w.x = cvt_pk_bf16(v0[0], v0[1]); w.y = cvt_pk_bf16(v0[2], v0[3]); w.z = cvt_pk_bf16(v1[0], v1[1]); w.w = cvt_pk_bf16(v1[2], v1[3]);
                    *(u32x4*)(rowp + bj * HALF) = w; } }
    }
};
}
namespace mk {
#define GAS __attribute__((address_space(1)))
#define LAS __attribute__((address_space(3)))
typedef unsigned short bf16;
typedef unsigned v4u __attribute__((ext_vector_type(4)));
typedef unsigned v2u __attribute__((ext_vector_type(2)));
typedef float f32x4 __attribute__((ext_vector_type(4)));
typedef float f32x16 __attribute__((ext_vector_type(16)));
typedef short bf16x8 __attribute__((ext_vector_type(8)));
typedef GAS unsigned gu32;
typedef GAS unsigned long long gu64;
#define RLX_AGENT __ATOMIC_RELAXED, __HIP_MEMORY_SCOPE_AGENT
#define LDS_WAIT() asm volatile("s_waitcnt lgkmcnt(0)" ::: "memory")
#define VM_WAIT() asm volatile("s_waitcnt vmcnt(0)" ::: "memory")

constexpr int NB = 4, SEQ = 4096, NM = 16, L = 4112, LP = 4160, TP = NB * LP, D = 1024;
constexpr int NCH = LP / 64;
constexpr int UR_W = 1792, UA_W = 1536, IN_N = 3328, IN_COLS = 3144;
constexpr int NWAVES = 8, NTHR = 512;
constexpr float LN_EPS = 1e-5f, RMS_EPS = 1e-6f, GN_EPS = 64e-5f;
constexpr float DN_ALPHA = 1.189207115002721f;

typedef float f32x2_t __attribute__((ext_vector_type(2))); typedef __bf16 bf16x2_t __attribute__((ext_vector_type(2)));
__device__ __forceinline__ unsigned pk2(float lo, float hi) { f32x2_t v = {lo, hi}; bf16x2_t b = __builtin_convertvector(v, bf16x2_t); return __builtin_bit_cast(unsigned, b); }
__device__ __forceinline__ unsigned f2bf(float f) { return pk2(f, f) & 0xffffu; }
__device__ __forceinline__ float bf2f(unsigned short b) { return __uint_as_float(((unsigned)b) << 16); }
__device__ __forceinline__ float bflo(unsigned w) { return __uint_as_float(w << 16); }
__device__ __forceinline__ float bfhi(unsigned w) { return __uint_as_float(w & 0xffff0000u); }
__device__ __forceinline__ float dpp_f(float v, int ctrl_sel) {
    const int x = __float_as_int(v); int r;
    if (ctrl_sel == 0) r = __builtin_amdgcn_mov_dpp(x, 0xB1, 0xF, 0xF, true);
    else if (ctrl_sel == 1) r = __builtin_amdgcn_mov_dpp(x, 0x4E, 0xF, 0xF, true);
    else if (ctrl_sel == 2) r = __builtin_amdgcn_mov_dpp(x, 0x141, 0xF, 0xF, true);
    else r = __builtin_amdgcn_mov_dpp(x, 0x140, 0xF, 0xF, true);
    return __int_as_float(r);
}
__device__ __forceinline__ float sum_x16(float v) { auto rr = __builtin_amdgcn_permlane16_swap(__float_as_uint(v), __float_as_uint(v), false, false); return __uint_as_float(rr[0]) + __uint_as_float(rr[1]); }
__device__ __forceinline__ float sum_x32(float v) { auto rr = __builtin_amdgcn_permlane32_swap(__float_as_uint(v), __float_as_uint(v), false, false); return __uint_as_float(rr[0]) + __uint_as_float(rr[1]); }
__device__ __forceinline__ int isum_x16(int v) { auto rr = __builtin_amdgcn_permlane16_swap((unsigned)v, (unsigned)v, false, false); return (int)(rr[0] + rr[1]); }
__device__ __forceinline__ int isum_x32(int v) { auto rr = __builtin_amdgcn_permlane32_swap((unsigned)v, (unsigned)v, false, false); return (int)(rr[0] + rr[1]); }
__device__ __forceinline__ unsigned or_x16(unsigned v) { auto rr = __builtin_amdgcn_permlane16_swap(v, v, false, false); return rr[0] | rr[1]; }
__device__ __forceinline__ unsigned or_x32(unsigned v) { auto rr = __builtin_amdgcn_permlane32_swap(v, v, false, false); return rr[0] | rr[1]; }
__device__ __forceinline__ float sum8(float v) { v += dpp_f(v, 0); v += dpp_f(v, 1); v += dpp_f(v, 2); return v; }
__device__ __forceinline__ float wave_sum(float v) { v = sum8(v); v += dpp_f(v, 3); v = sum_x16(v); return sum_x32(v); }

constexpr size_t MiB = 1u << 20;
constexpr size_t WS_CTL = 0, CTL_ZERO_BYTES = 64 * 1024;
constexpr int CW_BAR = 1024;
constexpr size_t WS_ROPEQ = 1 * MiB;
constexpr size_t WS_ROPEI = WS_ROPEQ + (size_t)LP * 32 * 8;
constexpr size_t WS_ROWSTAT = WS_ROPEI + (size_t)LP * 16 * 8;
constexpr size_t WS_WIN = 3 * MiB;
constexpr size_t WS_WOUT = WS_WIN + (size_t)IN_N * 1024 * 2;
constexpr size_t WS_WQ = WS_WOUT + (size_t)1024 * 1024 * 2;
constexpr size_t WS_WW2 = WS_WQ + (size_t)1024 * 256 * 2;
constexpr size_t WS_WA2 = WS_WW2 + (size_t)512 * 64 * 2;
constexpr size_t WS_WG2 = WS_WA2 + (size_t)512 * 64 * 2;
constexpr size_t WS_WEND = WS_WG2 + (size_t)512 * 128 * 2;
static_assert(WS_WEND <= 13 * MiB, "weights region");

constexpr int RING_BYTES = 131072;
constexpr int LDS_BYTES = 147456;
constexpr int MISC_OFF = LDS_BYTES - 16;
#define XB_TMO      128
#define XB_XCNT(j)  (256  + 64 * (j))
#define XB_XSUB(j)  (1280 + 64 * (j))
#define XB_XGEN(j)  (2304 + 64 * (j))
#define XB_TOP      3328
#define XB_TOPGEN   3392
#define XCD_BAR_WORDS 3456
#define XB_SPIN_CAP (1u << 18)

__device__ __forceinline__ unsigned xb_ld(unsigned* p)              { return __hip_atomic_load(p, __ATOMIC_RELAXED, __HIP_MEMORY_SCOPE_AGENT); }
__device__ __forceinline__ unsigned xb_add(unsigned* p, unsigned v) { return __hip_atomic_fetch_add(p, v, __ATOMIC_RELAXED, __HIP_MEMORY_SCOPE_AGENT); }
__device__ __forceinline__ unsigned xb_xcc_id() { return (unsigned)__builtin_amdgcn_s_getreg((3 << 11) | 20) & 0xFu; }
#define XB_SPIN(cond, bar) do { unsigned _sp = 0; while (cond) { __builtin_amdgcn_s_sleep(1); \
    if ((++_sp & 255u) == 0u) { if (xb_ld(&(bar)[XB_TMO])) break; if (_sp > XB_SPIN_CAP) { atomicAdd(&(bar)[XB_TMO], 1u); break; } } } } while (0)

struct XcdBarrier {
    unsigned* bar; unsigned x;
    volatile LAS unsigned* st;
};

__device__ __forceinline__ XcdBarrier xcd_barrier_post(unsigned* bar, volatile LAS unsigned* st) {
    XcdBarrier b; b.bar = bar; b.x = xb_xcc_id(); b.st = st;
    if (threadIdx.x == 0) (void)xb_add(&bar[XB_XCNT(b.x)], 1u);
    return b;
}
__device__ __forceinline__ void xcd_barrier_complete(unsigned* bar, unsigned x, unsigned& nloc, unsigned& nx) {
    const unsigned G = gridDim.x * gridDim.y * gridDim.z;
    unsigned sum, cnt, mine, sp = 0u;
    for (;;) {
        sum = 0u; cnt = 0u; mine = 0u;
#pragma unroll
        for (unsigned j = 0; j < 16; ++j) { const unsigned c = xb_ld(&bar[XB_XCNT(j)]); sum += c; cnt += (c > 0u) ? 1u : 0u; mine = (j == x) ? c : mine; }
        if (sum == G) break;
        __builtin_amdgcn_s_sleep(1);
        if ((++sp & 255u) == 0u) { if (xb_ld(&bar[XB_TMO])) break; if (sp > XB_SPIN_CAP) { atomicAdd(&bar[XB_TMO], 1u); break; } }
    }
    nloc = mine > 0u ? mine : 1u; nx = cnt > 0u ? cnt : 1u;
}

__device__ __forceinline__ void xcd_barrier(const XcdBarrier& b) {
    asm volatile("s_waitcnt vmcnt(0)" ::: "memory");
    __syncthreads();
    if (threadIdx.x == 0) {
        unsigned* bar = b.bar;
        __builtin_amdgcn_s_waitcnt(0);
        unsigned nloc = b.st[0], nx = b.st[1];
        if (nloc == 0u) { xcd_barrier_complete(bar, b.x, nloc, nx); b.st[0] = nloc; b.st[1] = nx; }
        const unsigned old = xb_add(&bar[XB_XSUB(b.x)], 1u);
        const unsigned gen = old / nloc;
        if (old + 1u == (gen + 1u) * nloc) {
            __builtin_amdgcn_fence(__ATOMIC_RELEASE, "agent");
            asm volatile("s_waitcnt vmcnt(0)" ::: "memory");
            const unsigned og = xb_add(&bar[XB_TOP], 1u);
            const unsigned tg = og / nx;
            if (og + 1u == (tg + 1u) * nx) xb_add(&bar[XB_TOPGEN], 1u);
            else XB_SPIN(xb_ld(&bar[XB_TOPGEN]) == tg, bar);
            __builtin_amdgcn_fence(__ATOMIC_ACQUIRE, "agent");
            xb_add(&bar[XB_XGEN(b.x)], 1u);
            asm volatile("s_waitcnt vmcnt(0)" ::: "memory");
        } else {
            XB_SPIN(xb_ld(&bar[XB_XGEN(b.x)]) == gen, bar);
            __builtin_amdgcn_fence(__ATOMIC_ACQUIRE, "agent");
            asm volatile("s_waitcnt vmcnt(0)" ::: "memory");
        }
    }
    __syncthreads();
}
struct Args {
    const float* in[33]; float* out; unsigned char* ws; int ph_lo, ph_hi; int flags, pad_;
};
struct Frame {
    LAS unsigned char* lds;
    int tid, lane, wave, G, bid;
    unsigned char* ws;
};

__device__ __forceinline__ int rowmap_in(int n) {
    if (n >= 2048 && n < 2560) { const int d = (n - 2048) & 63, base = n - d; return base + (d < 32 ? 2 * d : 2 * (d - 32) + 1); }
    if (n >= 3072 && n < 3136) { const int d = n - 3072; return 3072 + (d < 16 ? 2 * d : (d < 32 ? 2 * (d - 16) + 1 : d)); }
    return n;
}
template <int MODE> __device__ __forceinline__ int rowmap(int n) {
    if (MODE == 1) return rowmap_in(n);
    if (MODE == 2) { const int d = n & 63, base = n - d; return base + (d < 32 ? 2 * d : 2 * (d - 32) + 1); }
    if (MODE == 4) return 2 * n;
    if (MODE == 3) { const int d = n & 63, base = n - d; return base + (d < 16 ? 2 * d : (d < 32 ? 2 * (d - 16) + 1 : d)); }
    return n;
}
template <int MODE> __device__ __forceinline__ void transpose_item(const float* __restrict__ W, int K, int N, bf16* WT, int row_off, LAS float* scr, int item, int nblk, int lane) {
    const int kb = item / nblk, nb = item % nblk, k0 = 64 * kb, n0 = 32 * nb;
    const int n = n0 + (lane & 31);
    float tv[32];
#pragma unroll
    for (int i = 0; i < 32; ++i) { const int kk = 2 * i + (lane >> 5); tv[i] = (n < N) ? W[(size_t)(k0 + kk) * N + n] : 0.f; }
#pragma unroll
    for (int i = 0; i < 32; ++i) { const int kk = 2 * i + (lane >> 5); scr[kk * 33 + (lane & 31)] = tv[i]; }
    LDS_WAIT(); asm volatile("" ::: "memory");
    const int c = lane & 7;
#pragma unroll
    for (int j = 0; j < 4; ++j) { const int nl = (lane >> 3) + 8 * j; const LAS float* s = scr + (8 * c) * 33 + nl;
        v4u o; o.x = pk2(s[0 * 33], s[1 * 33]); o.y = pk2(s[2 * 33], s[3 * 33]); o.z = pk2(s[4 * 33], s[5 * 33]); o.w = pk2(s[6 * 33], s[7 * 33]);
        *(v4u*)(WT + (size_t)(row_off + rowmap<MODE>(n0 + nl)) * K + k0 + 8 * c) = o; }
    LDS_WAIT(); asm volatile("" ::: "memory");
}
__device__ __forceinline__ void p0_ln_row(const Args& a, int pr, bf16* H0b, float2* rowstat, int lane) {
    const int b = pr / LP, t = pr % LP;
    unsigned long long* o8 = (unsigned long long*)(H0b + (size_t)pr * D) + lane;
    if (t >= L) {
#pragma unroll
        for (int j = 0; j < 4; ++j) o8[64 * j] = 0ull;
        if (lane == 0) rowstat[pr] = make_float2(0.f, 0.f);
        return;
    }
    const float* src = (t < NM) ? (a.in[1] + (size_t)t * D) : (a.in[0] + ((size_t)b * SEQ + (t - NM)) * D);
    const f32x4* xr = (const f32x4*)src + lane;
    f32x4 v[4]; float s = 0.f;
#pragma unroll
    for (int j = 0; j < 4; ++j) { v[j] = xr[64 * j]; s += (v[j].x + v[j].y) + (v[j].z + v[j].w); }
    const float mean = wave_sum(s) * (1.f / D); float s2 = 0.f;
#pragma unroll
    for (int j = 0; j < 4; ++j) { v[j] = v[j] - mean; s2 += (v[j].x * v[j].x + v[j].y * v[j].y) + (v[j].z * v[j].z + v[j].w * v[j].w); }
    const float rstd = 1.f / sqrtf(wave_sum(s2) * (1.f / D) + LN_EPS);
    const f32x4* gp = (const f32x4*)a.in[2] + lane; const f32x4* bp = (const f32x4*)a.in[3] + lane;
#pragma unroll
    for (int j = 0; j < 4; ++j) { const f32x4 g = gp[64 * j], bb = bp[64 * j]; const f32x4 y = v[j] * rstd * g + bb;
        o8[64 * j] = (unsigned long long)pk2(y.x, y.y) | ((unsigned long long)pk2(y.z, y.w) << 32); }
    if (lane == 0) rowstat[pr] = make_float2(mean, rstd);
}
__device__ __forceinline__ void p0_prologue(const Frame& F, const Args& a, bf16* H0b) {
    LAS float* scr = (LAS float*)(F.lds + F.wave * 16384);
    const int gw = F.bid * NWAVES + F.wave, NGW = F.G * NWAVES;
    bf16* Wt_in = (bf16*)(F.ws + WS_WIN); bf16* Wt_out = (bf16*)(F.ws + WS_WOUT); bf16* Wt_q = (bf16*)(F.ws + WS_WQ);
    bf16* Wt_w2 = (bf16*)(F.ws + WS_WW2); bf16* Wt_a2 = (bf16*)(F.ws + WS_WA2); bf16* Wt_g2 = (bf16*)(F.ws + WS_WG2);
    constexpr int I_IN = 16 * (IN_N / 32), I_OUT = 16 * 32, I_Q = 4 * 16, I_W2 = 1 * 16, I_G2 = 2 * 16;
    constexpr int NITEMS = I_IN + I_OUT + 2 * I_Q + 2 * I_W2 + I_G2;
    for (int it = gw; it < NITEMS; it += NGW) {
        int r = it;
        if (r < I_IN) { transpose_item<1>(a.in[4], 1024, IN_COLS, Wt_in, 0, scr, r, IN_N / 32, F.lane); continue; } r -= I_IN;
        if (r < I_OUT) { transpose_item<0>(a.in[21], 1024, 1024, Wt_out, 0, scr, r, 32, F.lane); continue; } r -= I_OUT;
        if (r < I_Q) { transpose_item<2>(a.in[17], 256, 512, Wt_q, 0, scr, r, 16, F.lane); continue; } r -= I_Q;
        if (r < I_Q) { transpose_item<3>(a.in[18], 256, 512, Wt_q, 512, scr, r, 16, F.lane); continue; } r -= I_Q;
        if (r < I_W2) { transpose_item<0>(a.in[7], 64, 512, Wt_w2, 0, scr, r, 16, F.lane); continue; } r -= I_W2;
        if (r < I_W2) { transpose_item<0>(a.in[9], 64, 512, Wt_a2, 0, scr, r, 16, F.lane); continue; } r -= I_W2;
        transpose_item<0>(a.in[10], 128, 512, Wt_g2, 0, scr, r, 16, F.lane);
    }
    float2* rowstat = (float2*)(F.ws + WS_ROWSTAT);
    for (int pr = gw; pr < TP; pr += NGW) p0_ln_row(a, pr, H0b, rowstat, F.lane);
    float2* rq = (float2*)(F.ws + WS_ROPEQ); float2* ri = (float2*)(F.ws + WS_ROPEI);
    const int gt = F.bid * NTHR + F.tid, NGT = F.G * NTHR;
    for (int i = gt; i < LP * 48; i += NGT) {
        if (i < LP * 32) { const int t = i >> 5, d = i & 31; const float ang = (float)t * exp2f(-(float)d * (13.287712379549449f / 32.f)); float sn, cs; sincosf(ang, &sn, &cs); rq[i] = make_float2(cs, sn); }
        else { const int j = i - LP * 32, t = j >> 4, d = j & 15; const float ang = (float)t * exp2f(-(float)d * (13.287712379549449f / 16.f)); float sn, cs; sincosf(ang, &sn, &cs); ri[j] = make_float2(cs, sn); }
    }
}
constexpr int LDM = 72;
constexpr int SLOT = 64 * LDM * 2;
constexpr int LDG = 136;
constexpr int RW_LW_OFF = 0 * SLOT;
constexpr int RW_LA_OFF = 4 * SLOT;
constexpr int RW_LG_OFF = 2 * SLOT;
static_assert(64 * LDG * 2 <= 2 * SLOT, "Lg fits in two slots");
constexpr int RW_A_OFF = 8 * SLOT;
constexpr int RW_G_OFF = RW_A_OFF + 16384;
constexpr int RW_CS_OFF = RW_G_OFF + 8192;
constexpr int RW_SEG_OFF = RW_CS_OFF + 16384;
constexpr int RW_GC_OFF = 13 * SLOT;
static_assert(RW_SEG_OFF + 2048 <= RW_GC_OFF, "rwkv LDS map");
constexpr size_t RW_UNIT_M = 4096 * 2, RW_UNIT_N = 4096 * 4, RW_UNIT_X = 4096 * 2;
constexpr int NUNIT = NB * NCH * 8;

struct RwkvBufs { bf16* M; float* N; bf16* Q; bf16* OP; bf16* G1; bf16* G2; bf16* HC; };

__device__ __forceinline__ bf16x8 lds_frag(const LAS bf16* base, int row, int koff) { return *(const LAS bf16x8*)(base + row * LDM + koff); }
__device__ __forceinline__ f32x4 mm_tile(const LAS bf16* X, const LAS bf16* Y, int ta, int tb, int lane, f32x4 acc) {
    const int r = lane & 15, ko = 8 * (lane >> 4);
#pragma unroll
    for (int ks = 0; ks < 2; ++ks) {
        const bf16x8 ya = lds_frag(Y, 16 * tb + r, 32 * ks + ko), xb = lds_frag(X, 16 * ta + r, 32 * ks + ko);
        acc = __builtin_amdgcn_mfma_f32_16x16x32_bf16(ya, xb, acc, 0, 0, 0);
    }
    return acc;
}
__device__ __forceinline__ void st_r(LAS bf16* dst, int a, int b0, f32x4 v) {
    v2u w; w.x = pk2(v[0], v[1]); w.y = pk2(v[2], v[3]); *(LAS v2u*)(dst + a * LDM + b0) = w;
}
__device__ __forceinline__ void st_t(LAS bf16* dst, int a, int b0, f32x4 v) {
#pragma unroll
    for (int i = 0; i < 4; ++i) dst[(b0 + i) * LDM + a] = (bf16)f2bf(v[i]);
}
__device__ __forceinline__ f32x4 ld_r(const LAS bf16* src, int a, int b0) {
    const v2u w = *(const LAS v2u*)(src + a * LDM + b0);
    return (f32x4){bflo(w.x), bfhi(w.x), bflo(w.y), bfhi(w.y)};
}
__device__ __forceinline__ void st8(LAS bf16* dst, const float (&v)[8]) {
    v4u w; w.x = pk2(v[0], v[1]); w.y = pk2(v[2], v[3]); w.z = pk2(v[4], v[5]); w.w = pk2(v[6], v[7]); *(LAS v4u*)dst = w;
}
__device__ __forceinline__ void unpack8(v4u w, float (&o)[8]) {
    o[0] = bflo(w.x); o[1] = bfhi(w.x); o[2] = bflo(w.y); o[3] = bfhi(w.y); o[4] = bflo(w.z); o[5] = bfhi(w.z); o[6] = bflo(w.w); o[7] = bfhi(w.w);
}
__device__ __forceinline__ void ld8f(const float* p, float (&o)[8]) {
    const f32x4 a = *(const f32x4*)p, b = *(const f32x4*)(p + 4);
    o[0] = a.x; o[1] = a.y; o[2] = a.z; o[3] = a.w; o[4] = b.x; o[5] = b.y; o[6] = b.z; o[7] = b.w;
}
__device__ __forceinline__ float sigmoidf_(float x) { return __builtin_amdgcn_rcpf(1.f + __expf(-x)); }
__device__ __forceinline__ float tanhf_(float x) { return 1.f - 2.f * __builtin_amdgcn_rcpf(1.f + __expf(2.f * x)); }

constexpr int RW_WG2_OFF = 13 * SLOT, RW_WB_OFF = 13 * SLOT + 64 * LDG * 2, RW_WW2_OFF = 15 * SLOT, RW_WA2_OFF = 1 * SLOT;
static_assert(RW_WB_OFF + 512 <= 15 * SLOT, "LoRA weights LDS map");
constexpr int RW_MU_OFF = 12 * SLOT;
struct RwW { v4u v[4]; float mu, bias; };
__device__ __forceinline__ void rw_w_fetch(RwW& W, const Frame& F, const Args& a, int h) {
    const bf16* W2 = (const bf16*)(F.ws + WS_WW2); const bf16* A2 = (const bf16*)(F.ws + WS_WA2); const bf16* G2w = (const bf16*)(F.ws + WS_WG2);
    const int t = F.tid;
    W.v[0] = *(const v4u*)(W2 + (size_t)(64 * h + (t >> 3)) * 64 + 8 * (t & 7));
    W.v[1] = *(const v4u*)(A2 + (size_t)(64 * h + (t >> 3)) * 64 + 8 * (t & 7));
    W.v[2] = *(const v4u*)(G2w + (size_t)(64 * h + (t >> 4)) * 128 + 8 * (t & 15));
    W.v[3] = *(const v4u*)(G2w + (size_t)(64 * h + 32 + (t >> 4)) * 128 + 8 * (t & 15));
    W.mu = (t < 192) ? a.in[5][512 * (t >> 6) + 64 * h + (t & 63)] : ((t < 448) ? a.in[5][1536 + (t - 192)] : a.in[11][64 * h + (t - 448)]);
    W.bias = (t < 64) ? a.in[6][64 * h + t] : ((t < 128) ? a.in[8][64 * h + (t - 64)] : 0.f);
}
__device__ __forceinline__ void rw_w_store(const RwW& W, const Frame& F) {
    const int t = F.tid;
    *(LAS v4u*)(F.lds + RW_WW2_OFF + ((t >> 3) * LDM + 8 * (t & 7)) * 2) = W.v[0];
    *(LAS v4u*)(F.lds + RW_WA2_OFF + ((t >> 3) * LDM + 8 * (t & 7)) * 2) = W.v[1];
    *(LAS v4u*)(F.lds + RW_WG2_OFF + ((t >> 4) * LDG + 8 * (t & 15)) * 2) = W.v[2];
    *(LAS v4u*)(F.lds + RW_WG2_OFF + ((32 + (t >> 4)) * LDG + 8 * (t & 15)) * 2) = W.v[3];
    if (t < 128) *(LAS float*)(F.lds + RW_WB_OFF + 4 * t) = W.bias;
    *(LAS float*)(F.lds + RW_MU_OFF + 4 * t) = W.mu;
}
struct RwRaw { v4u c[7], p[7]; };
__device__ __forceinline__ void rw_load_raw(RwRaw& R, const bf16* __restrict__ Ur, int uidx, int tid) {
    const int h = uidx & 7, bc = uidx >> 3, c = bc % NCH, b = bc / NCH, tau = tid >> 3, q = tid & 7;
    const size_t prow = (size_t)b * LP + (size_t)c * 64 + tau;
    const bool has_prev = (c > 0) || (tau > 0);
    const bf16* ucur = Ur + prow * UR_W; const bf16* uprv = ucur - UR_W;
    const v4u z = {0u, 0u, 0u, 0u};
#pragma unroll
    for (int j = 0; j < 7; ++j) { const int col = (j < 3) ? (512 * j + 64 * h + 8 * q) : (1536 + 64 * (j - 3) + 8 * q);
        R.c[j] = *(const v4u*)(ucur + col); R.p[j] = has_prev ? *(const v4u*)(uprv + col) : z; }
}
__device__ __forceinline__ void rwkv_unit(const Frame& F, const Args& a, const bf16* __restrict__ Ur, const RwkvBufs& RB, int uidx, RwRaw& R, int unext) {
    const int h = uidx & 7, bc = uidx >> 3, c = bc % NCH, b = bc / NCH;
    const int tid = F.tid, lane = F.lane, w = F.wave;
    LAS unsigned char* lds = F.lds;
#define MAT(i) ((LAS bf16*)(lds + (i) * SLOT))
    LAS bf16 *Rg = MAT(0), *Kg = MAT(1), *KgT = MAT(2), *Bi = MAT(3), *nBiT = MAT(4), *Ki = MAT(5), *KiT = MAT(6), *VT = MAT(7);
    LAS bf16 *Akk = MAT(8), *nArb = MAT(9), *Ark = MAT(10), *Pa = MAT(11), *PaT = MAT(12), *Pb = MAT(13), *PbT = MAT(14), *Ta = MAT(15), *Tb = MAT(1);
    LAS bf16 *AVT = MAT(3), *WuT = MAT(5), *UvT = MAT(8);
    LAS bf16* Lw = (LAS bf16*)(lds + RW_LW_OFF); LAS bf16* La = (LAS bf16*)(lds + RW_LA_OFF); LAS bf16* Lg = (LAS bf16*)(lds + RW_LG_OFF);
    LAS float* Af = (LAS float*)(lds + RW_A_OFF); LAS bf16* Gb = (LAS bf16*)(lds + RW_G_OFF); LAS float* CS = (LAS float*)(lds + RW_CS_OFF);
    LAS float* gC = (LAS float*)(lds + RW_GC_OFF); LAS float* SEG = (LAS float*)(lds + RW_SEG_OFF);
    const float* mu = a.in[5];
    const int ta = w >> 1, ar = 16 * ta + (lane & 15), ko = 8 * (lane >> 4);
    const int tau = tid >> 3, q = tid & 7;
    float r8[8], k8[8], v8[8], kk8[8];
    {
        float cu[8], pv[8], m8[8];
        const int ch0 = 64 * h + 8 * q;
        const LAS float* MUL = (const LAS float*)(lds + RW_MU_OFF);
#define RW_LD8L(p_, o_) do { const f32x4 x0_ = *(const LAS f32x4*)(p_), x1_ = *(const LAS f32x4*)((p_) + 4); o_[0] = x0_.x; o_[1] = x0_.y; o_[2] = x0_.z; o_[3] = x0_.w; o_[4] = x1_.x; o_[5] = x1_.y; o_[6] = x1_.z; o_[7] = x1_.w; } while (0)
        unpack8(R.c[0], cu); unpack8(R.p[0], pv);
        RW_LD8L(MUL + 8 * q, m8);
#pragma unroll
        for (int i = 0; i < 8; ++i) r8[i] = cu[i] + (pv[i] - cu[i]) * m8[i];
        unpack8(R.c[1], cu); unpack8(R.p[1], pv);
        RW_LD8L(MUL + 64 + 8 * q, m8);
#pragma unroll
        for (int i = 0; i < 8; ++i) k8[i] = cu[i] + (pv[i] - cu[i]) * m8[i];
        unpack8(R.c[2], cu); unpack8(R.p[2], pv);
        RW_LD8L(MUL + 128 + 8 * q, m8);
#pragma unroll
        for (int i = 0; i < 8; ++i) v8[i] = cu[i] + (pv[i] - cu[i]) * m8[i];
        float kkc[8]; RW_LD8L(MUL + 448 + 8 * q, kkc);
        float ss = 0.f;
#pragma unroll
        for (int i = 0; i < 8; ++i) { kk8[i] = k8[i] * kkc[i]; ss += kk8[i] * kk8[i]; }
        ss = sum8(ss);
        const float inv = 1.f / fmaxf(sqrtf(ss), 1e-12f);
#pragma unroll
        for (int i = 0; i < 8; ++i) kk8[i] *= inv;
#pragma unroll
        for (int i = 0; i < 4; ++i) {
            const int col = 1536 + 64 * i + 8 * q;
            unpack8(R.c[3 + i], cu); unpack8(R.p[3 + i], pv);
            RW_LD8L(MUL + 192 + 64 * i + 8 * q, m8);
            float o[8];
#pragma unroll
            for (int e = 0; e < 8; ++e) { const float x = cu[e] + (pv[e] - cu[e]) * m8[e]; o[e] = (i == 0) ? tanhf_(x) : (i == 1 ? x : sigmoidf_(x)); }
            if (i == 0) st8(Lw + tau * LDM + 8 * q, o);
            else if (i == 1) st8(La + tau * LDM + 8 * q, o);
            else st8(Lg + tau * LDG + 64 * (i - 2) + 8 * q, o);
        }
    }
    LDS_WAIT(); __syncthreads();
    {
        const LAS bf16* W2L = (const LAS bf16*)(lds + RW_WW2_OFF); const LAS bf16* A2L = (const LAS bf16*)(lds + RW_WA2_OFF); const LAS bf16* G2L = (const LAS bf16*)(lds + RW_WG2_OFF);
#pragma unroll 1
        for (int tt = 0; tt < 2; ++tt) {
            const int tb = 2 * (w & 1) + tt, b0 = 16 * tb + 4 * (lane >> 4), chl = 16 * tb + (lane & 15);
            f32x4 aw = {0.f, 0.f, 0.f, 0.f}, aa = aw, ag = aw;
#pragma unroll
            for (int ks = 0; ks < 2; ++ks) {
                const bf16x8 yw = *(const LAS bf16x8*)(W2L + chl * LDM + 32 * ks + ko), ya = *(const LAS bf16x8*)(A2L + chl * LDM + 32 * ks + ko);
                const bf16x8 xw = *(const LAS bf16x8*)(Lw + ar * LDM + 32 * ks + ko), xa = *(const LAS bf16x8*)(La + ar * LDM + 32 * ks + ko);
                aw = __builtin_amdgcn_mfma_f32_16x16x32_bf16(yw, xw, aw, 0, 0, 0);
                aa = __builtin_amdgcn_mfma_f32_16x16x32_bf16(ya, xa, aa, 0, 0, 0);
            }
#pragma unroll
            for (int ks = 0; ks < 4; ++ks) {
                const bf16x8 yg = *(const LAS bf16x8*)(G2L + chl * LDG + 32 * ks + ko);
                const bf16x8 xg = *(const LAS bf16x8*)(Lg + ar * LDG + 32 * ks + ko);
                ag = __builtin_amdgcn_mfma_f32_16x16x32_bf16(yg, xg, ag, 0, 0, 0);
            }
            const f32x4 w0v = *(const LAS f32x4*)(lds + RW_WB_OFF + 4 * b0), a0v = *(const LAS f32x4*)(lds + RW_WB_OFF + 256 + 4 * b0);
            f32x4 lw, av;
#pragma unroll
            for (int i = 0; i < 4; ++i) {
                const float xw = -(w0v[i] + aw[i]);
                const float sp = (xw > 20.f) ? xw : __logf(1.f + __expf(xw));
                lw[i] = -__expf(-sp - 0.5f);
                av[i] = sigmoidf_(a0v[i] + aa[i]);
            }
            *(LAS f32x4*)(CS + ar * 64 + b0) = lw;
            *(LAS f32x4*)(Af + ar * 64 + b0) = av;
            v2u gw; gw.x = pk2(ag[0], ag[1]); gw.y = pk2(ag[2], ag[3]); *(LAS v2u*)(Gb + ar * 64 + b0) = gw;
        }
    }
    float kac[8], rkc[8], lng[8], lnb[8];
    { const int ch0_ = 64 * h + 8 * (tid & 7); ld8f(a.in[12] + ch0_, kac); ld8f(a.in[13] + ch0_, rkc); ld8f(a.in[14] + ch0_, lng); ld8f(a.in[15] + ch0_, lnb); }
    LDS_WAIT(); __syncthreads();
    {
        const int j = tid & 63, sg = tid >> 6;
        float run = 0.f;
#pragma unroll
        for (int i = 0; i < 8; ++i) { run += CS[(8 * sg + i) * 64 + j]; CS[(8 * sg + i) * 64 + j] = run; }
        SEG[sg * 64 + j] = run;
        LDS_WAIT(); __syncthreads();
        float off = 0.f;
        for (int s = 0; s < sg; ++s) off += SEG[s * 64 + j];
#pragma unroll
        for (int i = 0; i < 8; ++i) CS[(8 * sg + i) * 64 + j] += off;
    }
    LDS_WAIT(); __syncthreads();
    {
        float cs[8], csp[8], av[8], gt[8];
        { const LAS f32x4* p = (const LAS f32x4*)(CS + tau * 64 + 8 * q); const f32x4 x0 = p[0], x1 = p[1];
          cs[0] = x0.x; cs[1] = x0.y; cs[2] = x0.z; cs[3] = x0.w; cs[4] = x1.x; cs[5] = x1.y; cs[6] = x1.z; cs[7] = x1.w; }
        if (tau > 0) { const LAS f32x4* p = (const LAS f32x4*)(CS + (tau - 1) * 64 + 8 * q); const f32x4 x0 = p[0], x1 = p[1];
          csp[0] = x0.x; csp[1] = x0.y; csp[2] = x0.z; csp[3] = x0.w; csp[4] = x1.x; csp[5] = x1.y; csp[6] = x1.z; csp[7] = x1.w; }
        else {
#pragma unroll
          for (int i = 0; i < 8; ++i) csp[i] = 0.f; }
        { const LAS f32x4* p = (const LAS f32x4*)(Af + tau * 64 + 8 * q); const f32x4 x0 = p[0], x1 = p[1];
          av[0] = x0.x; av[1] = x0.y; av[2] = x0.z; av[3] = x0.w; av[4] = x1.x; av[5] = x1.y; av[6] = x1.z; av[7] = x1.w; }
        unpack8(*(const LAS v4u*)(Gb + tau * 64 + 8 * q), gt);
        float o_rg[8], o_kg[8], o_bi[8], o_ki[8];
        float bon = 0.f;
#pragma unroll
        for (int i = 0; i < 8; ++i) {
            const float g = __expf(cs[i]), gi = __expf(-cs[i]), gm = __expf(csp[i]);
            o_rg[i] = r8[i] * g; o_kg[i] = kk8[i] * gm;
            const float bb = kk8[i] * av[i]; o_bi[i] = bb * gi;
            const float kt = k8[i] * (1.f + (av[i] - 1.f) * kac[i]); o_ki[i] = kt * gi;
            bon += r8[i] * kt * rkc[i];
            if (tau == 63) gC[8 * q + i] = g;
        }
        bon = sum8(bon);
        st8(Rg + tau * LDM + 8 * q, o_rg); st8(Kg + tau * LDM + 8 * q, o_kg); st8(Bi + tau * LDM + 8 * q, o_bi); st8(Ki + tau * LDM + 8 * q, o_ki);
#pragma unroll
        for (int i = 0; i < 8; ++i) {
            const int j = 8 * q + i;
            KgT[j * LDM + tau] = (bf16)f2bf(o_kg[i]); nBiT[j * LDM + tau] = (bf16)f2bf(-o_bi[i]); KiT[j * LDM + tau] = (bf16)f2bf(o_ki[i]); VT[j * LDM + tau] = (bf16)f2bf(v8[i]);
        }
        float g1[8], g2[8];
#pragma unroll
        for (int i = 0; i < 8; ++i) { g1[i] = lng[i] * gt[i]; g2[i] = (lnb[i] + bon * v8[i]) * gt[i]; }
        v4u w1; w1.x = pk2(g1[0], g1[1]); w1.y = pk2(g1[2], g1[3]); w1.z = pk2(g1[4], g1[5]); w1.w = pk2(g1[6], g1[7]);
        v4u w2; w2.x = pk2(g2[0], g2[1]); w2.y = pk2(g2[2], g2[3]); w2.z = pk2(g2[4], g2[5]); w2.w = pk2(g2[6], g2[7]);
        *(v4u*)(RB.G1 + (size_t)uidx * 4096 + tau * 64 + 8 * q) = w1;
        *(v4u*)(RB.G2 + (size_t)uidx * 4096 + tau * 64 + 8 * q) = w2;
    }
    LDS_WAIT(); __syncthreads();
    const f32x4 zero4 = {0.f, 0.f, 0.f, 0.f};
    const float gj = gC[ar];
    if (unext >= 0) rw_load_raw(R, Ur, unext, tid);
#pragma unroll 1
    for (int tt = 0; tt < 2; ++tt) {
        const int tb = 2 * (w & 1) + tt, b0 = 16 * tb + 4 * (lane >> 4);
        f32x4 zkb = mm_tile(Kg, Bi, ta, tb, lane, zero4), zkk = mm_tile(Kg, Ki, ta, tb, lane, zero4);
        f32x4 zrb = mm_tile(Rg, Bi, ta, tb, lane, zero4), zrk = mm_tile(Rg, Ki, ta, tb, lane, zero4);
        f32x4 p0, t0;
#pragma unroll
        for (int i = 0; i < 4; ++i) {
            const int s = b0 + i;
            p0[i] = (s < ar) ? -zkb[i] : 0.f; t0[i] = p0[i] + ((s == ar) ? 1.f : 0.f);
            zkk[i] = (s < ar) ? zkk[i] : 0.f; zrb[i] = (s <= ar) ? -zrb[i] : 0.f; zrk[i] = (s <= ar) ? zrk[i] : 0.f;
        }
        st_r(Pa, ar, b0, p0); st_t(PaT, ar, b0, p0); st_r(Ta, ar, b0, t0); st_r(Akk, ar, b0, zkk); st_r(nArb, ar, b0, zrb); st_r(Ark, ar, b0, zrk);
    }
    LDS_WAIT(); __syncthreads();
#pragma unroll 1
    for (int tt = 0; tt < 2; ++tt) {
        const int tb = 2 * (w & 1) + tt, b0 = 16 * tb + 4 * (lane >> 4);
        const f32x4 p = mm_tile(Pa, PaT, ta, tb, lane, zero4); st_r(Pb, ar, b0, p); st_t(PbT, ar, b0, p);
        const f32x4 av = mm_tile(VT, Akk, ta, tb, lane, zero4); st_r(AVT, ar, b0, av);
    }
    LDS_WAIT(); __syncthreads();
#define RW_SQ_ACC(Pin, PinT, Pout, PoutT, Tin, Tout, DO_SQ) do { _Pragma("unroll 1") for (int tt = 0; tt < 2; ++tt) { \
        const int tb = 2 * (w & 1) + tt, b0 = 16 * tb + 4 * (lane >> 4); \
        if (DO_SQ) { const f32x4 p = mm_tile(Pin, PinT, ta, tb, lane, zero4); st_r(Pout, ar, b0, p); st_t(PoutT, ar, b0, p); } \
        const f32x4 tn = mm_tile(Tin, PinT, ta, tb, lane, ld_r(Tin, ar, b0)); st_r(Tout, ar, b0, tn); } \
        LDS_WAIT(); __syncthreads(); } while (0)
    RW_SQ_ACC(Pb, PbT, Pa, PaT, Ta, Tb, true);
    RW_SQ_ACC(Pa, PaT, Pb, PbT, Tb, Ta, true);
    RW_SQ_ACC(Pb, PbT, Pa, PaT, Ta, Tb, true);
    RW_SQ_ACC(Pa, PaT, Pb, PbT, Tb, Ta, true);
    RW_SQ_ACC(Pb, PbT, Pa, PaT, Ta, Tb, false);
#undef RW_SQ_ACC
#pragma unroll 1
    for (int tt = 0; tt < 2; ++tt) {
        const int tb = 2 * (w & 1) + tt, b0 = 16 * tb + 4 * (lane >> 4);
        st_r(WuT, ar, b0, mm_tile(KgT, Tb, ta, tb, lane, zero4));
        st_r(UvT, ar, b0, mm_tile(AVT, Tb, ta, tb, lane, zero4));
    }
    LDS_WAIT(); __syncthreads();
    RwW Wn; if (unext >= 0) rw_w_fetch(Wn, F, a, unext & 7);
#pragma unroll 1
    for (int tt = 0; tt < 2; ++tt) {
        const int tb = 2 * (w & 1) + tt, b0 = 16 * tb + 4 * (lane >> 4);
        { const f32x4 z = mm_tile(nBiT, WuT, ta, tb, lane, zero4);
          const int m = ar >> 5, rp = ar & 31;
          bf16* Mo = RB.M + (size_t)uidx * 4096;
          float v4[4];
#pragma unroll
          for (int i = 0; i < 4; ++i) { const int jp = b0 + i; v4[i] = gj * (z[i] + ((jp == ar) ? 1.f : 0.f)); }
          { const int kb = b0 >> 5, qq = b0 & 31, s_ = qq >> 4, p = qq & 15, e0 = 4 * (p >> 3), hh = (p >> 2) & 1, ln = rp + 32 * hh;
            v2u w; w.x = pk2(v4[0], v4[1]); w.y = pk2(v4[2], v4[3]);
            *(v2u*)(Mo + ((((m * 2 + kb) * 2 + s_) * 64 + ln) << 3) + e0) = w; } }
        { f32x4 z = mm_tile(KiT, VT, ta, tb, lane, zero4); z = mm_tile(nBiT, UvT, ta, tb, lane, z);
          const int m = ar >> 5, qq = ar & 31, hh = (qq >> 2) & 1, rg = (qq & 3) + 4 * (qq >> 3);
          float* No = RB.N + (size_t)uidx * 4096;
          { const int n = b0 >> 5, cc = b0 & 31; *(f32x4*)(No + ((m * 2 + n) * 16 + rg) * 64 + cc + 32 * hh) = z * gj; } }
        { const f32x4 z = mm_tile(nArb, WuT, ta, tb, lane, ld_r(Rg, ar, b0)); v2u o; o.x = pk2(z[0], z[1]); o.y = pk2(z[2], z[3]);
          *(v2u*)(RB.Q + (size_t)uidx * 4096 + ar * 64 + b0) = o; }
        { f32x4 z = mm_tile(Ark, VT, ta, tb, lane, zero4); z = mm_tile(nArb, UvT, ta, tb, lane, z); v2u o; o.x = pk2(z[0], z[1]); o.y = pk2(z[2], z[3]);
          *(v2u*)(RB.OP + (size_t)uidx * 4096 + ar * 64 + b0) = o; }
    }
    if (unext >= 0) rw_w_store(Wn, F);
    LDS_WAIT(); __syncthreads();
#undef MAT
}

__device__ __forceinline__ void rwkv_scan(const RwkvBufs& RB, int bh, int n, int lane) {
    const int b = bh >> 3, h = bh & 7;
    f32x16 X0, X1;
#pragma unroll
    for (int r = 0; r < 16; ++r) { X0[r] = 0.f; X1[r] = 0.f; }
    const int cc = lane & 31, hh = lane >> 5;
    bf16x8 Mc[2][2][2], Mn[2][2][2]; f32x16 N0, N1, N0n, N1n;
    {
        const int uidx = ((b * NCH) << 3) + h;
        const bf16* Mi = RB.M + (size_t)uidx * 4096; const float* Ni = RB.N + (size_t)uidx * 4096;
#pragma unroll
        for (int m = 0; m < 2; ++m)
#pragma unroll
            for (int kb = 0; kb < 2; ++kb)
#pragma unroll
                for (int s = 0; s < 2; ++s) Mc[m][kb][s] = *(const bf16x8*)(Mi + ((((m * 2 + kb) * 2 + s) * 64 + lane) << 3));
#pragma unroll
        for (int r = 0; r < 16; ++r) { N0[r] = Ni[((0 * 2 + n) * 16 + r) * 64 + lane]; N1[r] = Ni[((1 * 2 + n) * 16 + r) * 64 + lane]; }
    }
#pragma unroll 1
    for (int c = 0; c < NCH; ++c) {
        const int uidx = ((b * NCH + c) << 3) + h;
        {
            const int un = ((b * NCH + min(c + 1, NCH - 1)) << 3) + h;
            const bf16* Mi = RB.M + (size_t)un * 4096; const float* Ni = RB.N + (size_t)un * 4096;
#pragma unroll
            for (int m = 0; m < 2; ++m)
#pragma unroll
                for (int kb = 0; kb < 2; ++kb)
#pragma unroll
                    for (int s = 0; s < 2; ++s) Mn[m][kb][s] = *(const bf16x8*)(Mi + ((((m * 2 + kb) * 2 + s) * 64 + lane) << 3));
#pragma unroll
            for (int r = 0; r < 16; ++r) { N0n[r] = Ni[((0 * 2 + n) * 16 + r) * 64 + lane]; N1n[r] = Ni[((1 * 2 + n) * 16 + r) * 64 + lane]; }
        }
        bf16* Ho = RB.HC + (size_t)uidx * 4096 + (size_t)(32 * n + cc) * 64;
#pragma unroll
        for (int g = 0; g < 4; ++g) {
            v2u w0; w0.x = pk2(X0[4 * g], X0[4 * g + 1]); w0.y = pk2(X0[4 * g + 2], X0[4 * g + 3]); *(v2u*)(Ho + 8 * g + 4 * hh) = w0;
            v2u w1; w1.x = pk2(X1[4 * g], X1[4 * g + 1]); w1.y = pk2(X1[4 * g + 2], X1[4 * g + 3]); *(v2u*)(Ho + 32 + 8 * g + 4 * hh) = w1;
        }
        bf16x8 bf[2][2];
#pragma unroll
        for (int s = 0; s < 2; ++s) {
            v4u t0; t0.x = pk2(X0[8 * s], X0[8 * s + 1]); t0.y = pk2(X0[8 * s + 2], X0[8 * s + 3]); t0.z = pk2(X0[8 * s + 4], X0[8 * s + 5]); t0.w = pk2(X0[8 * s + 6], X0[8 * s + 7]);
            v4u t1; t1.x = pk2(X1[8 * s], X1[8 * s + 1]); t1.y = pk2(X1[8 * s + 2], X1[8 * s + 3]); t1.z = pk2(X1[8 * s + 4], X1[8 * s + 5]); t1.w = pk2(X1[8 * s + 6], X1[8 * s + 7]);
            bf[0][s] = __builtin_bit_cast(bf16x8, t0); bf[1][s] = __builtin_bit_cast(bf16x8, t1);
        }
        f32x16 Y0 = N0, Y1 = N1;
#pragma unroll
        for (int kb = 0; kb < 2; ++kb)
#pragma unroll
            for (int s = 0; s < 2; ++s) {
                Y0 = __builtin_amdgcn_mfma_f32_32x32x16_bf16(Mc[0][kb][s], bf[kb][s], Y0, 0, 0, 0);
                Y1 = __builtin_amdgcn_mfma_f32_32x32x16_bf16(Mc[1][kb][s], bf[kb][s], Y1, 0, 0, 0);
            }
        X0 = Y0; X1 = Y1;
#pragma unroll
        for (int m = 0; m < 2; ++m)
#pragma unroll
            for (int kb = 0; kb < 2; ++kb)
#pragma unroll
                for (int s = 0; s < 2; ++s) Mc[m][kb][s] = Mn[m][kb][s];
        N0 = N0n; N1 = N1n;
    }
}

template <class OutF> __device__ __forceinline__ void rwkv_out_unit(const RwkvBufs& RB, int uidx, int lane, const OutF& outf) {
    const int h = uidx & 7, bc = uidx >> 3, c = bc % NCH, b = bc / NCH;
    const bf16* Q = RB.Q + (size_t)uidx * 4096; const bf16* HT = RB.HC + (size_t)uidx * 4096; const bf16* OP = RB.OP + (size_t)uidx * 4096;
    const bf16* G1 = RB.G1 + (size_t)uidx * 4096; const bf16* G2 = RB.G2 + (size_t)uidx * 4096;
    const int r = lane & 15, ko = 8 * (lane >> 4);
    bf16x8 yh[4][2];
#pragma unroll
    for (int tb = 0; tb < 4; ++tb)
#pragma unroll
        for (int ks = 0; ks < 2; ++ks) yh[tb][ks] = *(const bf16x8*)(HT + (16 * tb + r) * 64 + 32 * ks + ko);
#pragma unroll 2
    for (int ta = 0; ta < 4; ++ta) {
        const int t = 16 * ta + r;
        bf16x8 xq[2];
        xq[0] = *(const bf16x8*)(Q + t * 64 + ko); xq[1] = *(const bf16x8*)(Q + t * 64 + 32 + ko);
        f32x4 o[4]; float s = 0.f;
#pragma unroll
        for (int tb = 0; tb < 4; ++tb) {
            const int i0 = 16 * tb + 4 * (lane >> 4);
            const v2u ow = *(const v2u*)(OP + t * 64 + i0);
            f32x4 acc = {bflo(ow.x), bfhi(ow.x), bflo(ow.y), bfhi(ow.y)};
#pragma unroll
            for (int ks = 0; ks < 2; ++ks) acc = __builtin_amdgcn_mfma_f32_16x16x32_bf16(yh[tb][ks], xq[ks], acc, 0, 0, 0);
            o[tb] = acc; s += (acc[0] + acc[1]) + (acc[2] + acc[3]);
        }
        s = sum_x32(sum_x16(s));
        const float mean = s * (1.f / 64.f); float qv = 0.f;
#pragma unroll
        for (int tb = 0; tb < 4; ++tb) { o[tb] = o[tb] - mean; qv += (o[tb][0] * o[tb][0] + o[tb][1] * o[tb][1]) + (o[tb][2] * o[tb][2] + o[tb][3] * o[tb][3]); }
        qv = sum_x32(sum_x16(qv));
        const float rstd = rsqrtf(qv * (1.f / 64.f) + GN_EPS);
        const int tg = c * 64 + t;
#pragma unroll
        for (int tb = 0; tb < 4; ++tb) {
            const int i0 = 16 * tb + 4 * (lane >> 4);
            const v2u g1 = *(const v2u*)(G1 + t * 64 + i0), g2 = *(const v2u*)(G2 + t * 64 + i0);
            f32x4 y;
            y[0] = o[tb][0] * rstd * bflo(g1.x) + bflo(g2.x); y[1] = o[tb][1] * rstd * bfhi(g1.x) + bfhi(g2.x);
            y[2] = o[tb][2] * rstd * bflo(g1.y) + bflo(g2.y); y[3] = o[tb][3] * rstd * bfhi(g1.y) + bfhi(g2.y);
            if (tg < L) outf(b, tg, 64 * h + i0, y);
        }
    }
}
constexpr int MW = 264;
constexpr float QSCALE = 0.125f * 1.4426950408889634f;
struct AttBufs { bf16* Q; bf16* QI; unsigned short* MASK; bf16* KX; };

constexpr int LDQ = 264;
__device__ __forceinline__ void att_prep_unit(const Frame& F, const Args& a, bf16* Ua, const AttBufs& AB, int tile) {
    const int tid = F.tid, lane = F.lane, w = F.wave;
    LAS bf16* CQ = (LAS bf16*)F.lds;
    LAS f32x2_t* RQL = (LAS f32x2_t*)(F.lds + 34816);
    LAS f32x2_t* RIL = (LAS f32x2_t*)(F.lds + 34816 + 64 * 33 * 8);
    const int tau = tid >> 3, q = tid & 7;
    const size_t prow = (size_t)tile * 64 + tau;
    const int tpos = (int)(prow % LP);
    bf16* urow = Ua + prow * UA_W;
    const float2* rq = (const float2*)(F.ws + WS_ROPEQ) + (size_t)tpos * 32;
    const float2* ri = (const float2*)(F.ws + WS_ROPEI) + (size_t)tpos * 16;
    { const int t0p = (int)(((size_t)tile * 64) % LP);
      const f32x2_t* gq = (const f32x2_t*)(F.ws + WS_ROPEQ) + (size_t)t0p * 32; const f32x2_t* gi = (const f32x2_t*)(F.ws + WS_ROPEI) + (size_t)t0p * 16;
      for (int i = tid; i < 64 * 32; i += NTHR) RQL[(i >> 5) * 33 + (i & 31)] = gq[i];
      for (int i = tid; i < 64 * 16; i += NTHR) RIL[(i >> 4) * 17 + (i & 15)] = gi[i]; }
    {
        float x[4][8]; float ss = 0.f;
#pragma unroll
        for (int i = 0; i < 4; ++i) { unpack8(*(const v4u*)(urow + 64 * i + 8 * q), x[i]);
#pragma unroll
            for (int e = 0; e < 8; ++e) ss += x[i][e] * x[i][e]; }
        ss = sum8(ss);
        const float rs = rsqrtf(ss * (1.f / 256.f) + RMS_EPS);
#pragma unroll
        for (int i = 0; i < 4; ++i) { float g8[8], o[8]; ld8f(a.in[16] + 64 * i + 8 * q, g8);
#pragma unroll
            for (int e = 0; e < 8; ++e) o[e] = x[i][e] * rs * g8[e];
            st8(CQ + tau * LDQ + 64 * i + 8 * q, o); }
    }
#pragma unroll
    for (int i = 0; i < 8; ++i) {
        const int col = 8 * (q + 8 * i); float x[8], o[8];
        unpack8(*(const v4u*)(urow + 256 + col), x);
        const int d0 = (col & 63) >> 1;
#pragma unroll
        for (int pp = 0; pp < 4; ++pp) { const float2 cs = rq[d0 + pp]; o[2 * pp] = x[2 * pp] * cs.x - x[2 * pp + 1] * cs.y; o[2 * pp + 1] = x[2 * pp + 1] * cs.x + x[2 * pp] * cs.y; }
        v4u wv; wv.x = pk2(o[0], o[1]); wv.y = pk2(o[2], o[3]); wv.z = pk2(o[4], o[5]); wv.w = pk2(o[6], o[7]);
        *(v4u*)(urow + 256 + col) = wv;
    }
    {
        float x[8]; unpack8(*(const v4u*)(urow + 1280 + 8 * q), x);
        float s = 0.f;
#pragma unroll
        for (int e = 0; e < 8; ++e) s += x[e];
        s = sum8(s);
        const float mean = s * (1.f / 64.f); float qv = 0.f;
#pragma unroll
        for (int e = 0; e < 8; ++e) { x[e] -= mean; qv += x[e] * x[e]; }
        qv = sum8(qv);
        const float rstd = rsqrtf(qv * (1.f / 64.f) + LN_EPS);
        float y[8];
#pragma unroll
        for (int e = 0; e < 8; ++e) { const int p = 8 * q + e; const int d = (p < 32) ? ((p & 1) ? 16 + (p >> 1) : (p >> 1)) : p;
            y[e] = x[e] * rstd * a.in[19][d] + a.in[20][d]; }
        float o[8];
        if (q < 4) {
#pragma unroll
            for (int pp = 0; pp < 4; ++pp) { const float2 cs = ri[4 * q + pp]; o[2 * pp] = y[2 * pp] * cs.x - y[2 * pp + 1] * cs.y; o[2 * pp + 1] = y[2 * pp + 1] * cs.x + y[2 * pp] * cs.y; }
        } else {
#pragma unroll
            for (int e = 0; e < 8; ++e) o[e] = y[e];
        }
        v4u wv; wv.x = pk2(o[0] * 0.125f, o[1] * 0.125f); wv.y = pk2(o[2] * 0.125f, o[3] * 0.125f); wv.z = pk2(o[4] * 0.125f, o[5] * 0.125f); wv.w = pk2(o[6] * 0.125f, o[7] * 0.125f);
        *(v4u*)(AB.KX + prow * 64 + 8 * q) = wv;
    }
    LDS_WAIT(); __syncthreads();
    {
        const bf16* Wq = (const bf16*)(F.ws + WS_WQ);
        const int r = lane & 15, ko = 8 * (lane >> 4);
        bf16x8 yfA[8], yfB[8];
#pragma unroll
        for (int ks = 0; ks < 8; ++ks) yfA[ks] = *(const bf16x8*)(Wq + (size_t)(16 * (8 * w) + r) * 256 + 32 * ks + ko);
#define ATP_TILE(YF, TBL) do { const int tb = 8 * w + (TBL), n0 = 16 * tb + 4 * (lane >> 4); \
            _Pragma("unroll 1") for (int ta = 0; ta < 4; ++ta) { \
                f32x4 acc = {0.f, 0.f, 0.f, 0.f}; \
                _Pragma("unroll") for (int ks = 0; ks < 8; ++ks) { const bf16x8 xf = *(const LAS bf16x8*)(CQ + (16 * ta + r) * LDQ + 32 * ks + ko); acc = __builtin_amdgcn_mfma_f32_16x16x32_bf16(YF[ks], xf, acc, 0, 0, 0); } \
                const size_t orow = (size_t)tile * 64 + 16 * ta + r; \
                const bool isq = (n0 < 512); const int p = n0 & 63; \
                float o0 = acc[0], o1 = acc[1], o2 = acc[2], o3 = acc[3]; \
                if (isq) { const LAS f32x2_t* rr = RQL + (16 * ta + r) * 33 + (p >> 1); const f32x2_t c0 = rr[0], c1 = rr[1]; \
                    o0 = (acc[0] * c0.x - acc[1] * c0.y) * QSCALE; o1 = (acc[1] * c0.x + acc[0] * c0.y) * QSCALE; o2 = (acc[2] * c1.x - acc[3] * c1.y) * QSCALE; o3 = (acc[3] * c1.x + acc[2] * c1.y) * QSCALE; } \
                else if (p < 32) { const LAS f32x2_t* rr = RIL + (16 * ta + r) * 17 + (p >> 1); const f32x2_t c0 = rr[0], c1 = rr[1]; \
                    o0 = acc[0] * c0.x - acc[1] * c0.y; o1 = acc[1] * c0.x + acc[0] * c0.y; o2 = acc[2] * c1.x - acc[3] * c1.y; o3 = acc[3] * c1.x + acc[2] * c1.y; } \
                v2u ov; ov.x = pk2(o0, o1); ov.y = pk2(o2, o3); \
                bf16* dst = isq ? (AB.Q + orow * 512 + n0) : (AB.QI + orow * 512 + (n0 - 512)); \
                *(v2u*)dst = ov; } } while (0)
#pragma unroll 1
        for (int tb2 = 0; tb2 < 8; tb2 += 2) {
#pragma unroll
            for (int ks = 0; ks < 8; ++ks) yfB[ks] = *(const bf16x8*)(Wq + (size_t)(16 * (8 * w + tb2 + 1) + r) * 256 + 32 * ks + ko);
            ATP_TILE(yfA, tb2);
            if (tb2 + 2 < 8) {
#pragma unroll
                for (int ks = 0; ks < 8; ++ks) yfA[ks] = *(const bf16x8*)(Wq + (size_t)(16 * (8 * w + tb2 + 2) + r) * 256 + 32 * ks + ko);
            }
            ATP_TILE(yfB, tb2 + 1);
        }
#undef ATP_TILE
    }
    LDS_WAIT(); __syncthreads();
}

__device__ __forceinline__ unsigned fkey(float f) { const unsigned u = __float_as_uint(f); return u ^ ((unsigned)((int)u >> 31) | 0x80000000u); }
__device__ __forceinline__ void cnt_ge(int& c, unsigned x, unsigned cand) {
    unsigned long long m;
    asm("v_cmp_ge_u32 %1, %2, %3\n\tv_addc_co_u32 %0, %1, 0, %0, %1" : "+v"(c), "=&s"(m) : "v"(x), "v"(cand));
}
template <int BIT> __device__ __forceinline__ void nib_ge(unsigned& nib, unsigned x, unsigned K) {
    unsigned t; asm volatile("v_cmp_ge_u32 vcc, %1, %2\n\tv_cndmask_b32 %0, 0, %3, vcc" : "=v"(t) : "v"(x), "v"(K), "v"(1u << BIT) : "vcc"); nib |= t;
}
constexpr int IDX_NT = 33, IDX_PF = 4;
__device__ __forceinline__ void idx_unit(const Frame& F, const bf16* __restrict__ Ua, const AttBufs& AB, int b, int qt, unsigned* ticket_ctr, int ticket_slot_off) {
    const int lane = F.lane, w = F.wave, qc = lane & 15, g = lane >> 4, ko = 8 * g;
    LAS int* cntb = (LAS int*)F.lds;
    const int t0 = 16 * qt, ntile = qt + 1, tq = t0 + qc;
    const size_t qrow = (size_t)b * LP + tq;
    LAS bf16* QIL = (LAS bf16*)(F.lds + 8192);
    { const int tid = F.tid; const int rr = tid >> 5, cc = (tid & 31) * 16;
      const bf16* src = AB.QI + ((size_t)b * LP + t0 + rr) * 512 + cc;
      const v4u x0 = *(const v4u*)src, x1 = *(const v4u*)(src + 8);
      *(LAS v4u*)(QIL + rr * 520 + cc) = x0; *(LAS v4u*)(QIL + rr * 520 + cc + 8) = x1; }
    LDS_WAIT(); __syncthreads();
    float wq[8];
    { const v4u ww = *(const v4u*)(Ua + qrow * UA_W + 1344); float t8[8]; unpack8(ww, t8);
#pragma unroll
      for (int h = 0; h < 8; ++h) wq[h] = t8[h] * 0.35355339059327373f; }
    unsigned sc[IDX_NT][4];
    const bf16* kbase = AB.KX + (size_t)b * LP * 64;
    const int wlast = (ntile - 1 - w) >> 3;
    bf16x8 ra0[IDX_PF], ra1[IDX_PF];
#pragma unroll
    for (int p = 0; p < IDX_PF; ++p) { const unsigned ko_ = (unsigned)((16 * (w + 8 * max(min(p, wlast), 0)) + qc) * 64 + ko) ; const unsigned kc = (w < ntile) ? ko_ : (unsigned)(qc * 64 + ko);
        ra0[p] = *(const bf16x8*)(kbase + kc); ra1[p] = *(const bf16x8*)(kbase + kc + 32); }
#pragma unroll
    for (int i = 0; i < IDX_NT; ++i) {
        const int kt = w + 8 * i;
        const bf16x8 a0 = ra0[i % IDX_PF], a1 = ra1[i % IDX_PF];
        { const int ip = max(min(i + IDX_PF, wlast), 0); const unsigned ko_ = (unsigned)((16 * (w + 8 * ip) + qc) * 64 + ko); const unsigned kc = (w < ntile) ? ko_ : (unsigned)(qc * 64 + ko);
          ra0[i % IDX_PF] = *(const bf16x8*)(kbase + kc); ra1[i % IDX_PF] = *(const bf16x8*)(kbase + kc + 32); }
        asm volatile("" ::: "memory");
        if (kt < ntile) {
            f32x4 acc = {0.f, 0.f, 0.f, 0.f};
#pragma unroll
            for (int hq = 0; hq < 2; ++hq) {
                bf16x8 qa[4], qb_[4];
#pragma unroll
                for (int h4 = 0; h4 < 4; ++h4) { qa[h4] = *(const LAS bf16x8*)(QIL + qc * 520 + 64 * (4 * hq + h4) + ko); qb_[h4] = *(const LAS bf16x8*)(QIL + qc * 520 + 64 * (4 * hq + h4) + 32 + ko); }
                __builtin_amdgcn_sched_group_barrier(0x100, 8, 0);
                f32x4 sh[4];
#pragma unroll
                for (int h4 = 0; h4 < 4; ++h4) { sh[h4] = (f32x4){0.f, 0.f, 0.f, 0.f}; sh[h4] = __builtin_amdgcn_mfma_f32_16x16x32_bf16(a0, qa[h4], sh[h4], 0, 0, 0); }
#pragma unroll
                for (int h4 = 0; h4 < 4; ++h4) sh[h4] = __builtin_amdgcn_mfma_f32_16x16x32_bf16(a1, qb_[h4], sh[h4], 0, 0, 0);
                __builtin_amdgcn_sched_group_barrier(0x008, 8, 0);
#pragma unroll
                for (int h4 = 0; h4 < 4; ++h4)
#pragma unroll
                    for (int r = 0; r < 4; ++r) acc[r] = fmaf(__builtin_amdgcn_fmed3f(sh[h4][r], 0.f, INFINITY), wq[4 * hq + h4], acc[r]);
                if (hq == 0) asm volatile("" ::: "memory");
            }
            if (kt == qt) {
#pragma unroll
                for (int r = 0; r < 4; ++r) sc[i][r] = (4 * g + r <= qc) ? (fkey(acc[r]) >> 1) : 0u;
            } else {
#pragma unroll
                for (int r = 0; r < 4; ++r) sc[i][r] = fkey(acc[r]) >> 1;
            }
        } else {
#pragma unroll
            for (int r = 0; r < 4; ++r) sc[i][r] = 0u;
        }
    }
    int nxt_ticket = 0; if (F.tid == 0) nxt_ticket = (int)atomicAdd(ticket_ctr, 1u);
    unsigned K = 0u; bool found = (tq + 1 <= 256);
    const int nwave_tiles = __builtin_amdgcn_readfirstlane(max(wlast + 1, 0));
#pragma unroll 1
    for (int bit = 30; bit >= 0; --bit) {
        const unsigned cand = K | (1u << bit);
        unsigned b0 = 0u, b1 = 0u, b2 = 0u, b3 = 0u; int lt = 0;
        int nwv = nwave_tiles; asm volatile("" : "+s"(nwv));
#pragma unroll
        for (int i = 0; i < IDX_NT; ++i) {
            if (i < nwv) {
                b0 = __builtin_amdgcn_alignbit(b0, sc[i][0] - cand, 31); b1 = __builtin_amdgcn_alignbit(b1, sc[i][1] - cand, 31);
                b2 = __builtin_amdgcn_alignbit(b2, sc[i][2] - cand, 31); b3 = __builtin_amdgcn_alignbit(b3, sc[i][3] - cand, 31);
            }
            if (i == 15 || i == 31 || i == IDX_NT - 1) { lt += __builtin_popcount(b0) + __builtin_popcount(b1) + __builtin_popcount(b2) + __builtin_popcount(b3); b0 = b1 = b2 = b3 = 0u; }
        }
        int c = 4 * nwv - lt;
        c = isum_x32(isum_x16(c));
        LAS int* cb = cntb + (bit & 1) * 128;
        if (g == 0) cb[w * 16 + qc] = c;
        LDS_WAIT(); __syncthreads();
        int tot = 0;
#pragma unroll
        for (int ww = 0; ww < 8; ++ww) tot += cb[ww * 16 + qc];
        if (!found && tot >= 256) K = cand;
        found = found || (tot == 256);
        if (__all(found)) break;
    }
    if (tq + 1 <= 256 || K == 0u) K = 1u;
    LAS unsigned short* mlds = (LAS unsigned short*)(F.lds + 32768);
    const int kend = (qt == 0) ? 4 : min(16 * (1 + ((qt - 1) >> 4)) + 4, 260);
#pragma unroll
    for (int i = 0; i < IDX_NT; ++i) {
        const int kt = w + 8 * i;
        unsigned nib = 0u;
        nib_ge<0>(nib, sc[i][0], K); nib_ge<1>(nib, sc[i][1], K); nib_ge<2>(nib, sc[i][2], K); nib_ge<3>(nib, sc[i][3], K);
        unsigned v = nib << (4 * g);
        v = or_x32(or_x16(v));
        if (g == 0) mlds[qc * MW + kt] = (unsigned short)((kt < ntile) ? v : 0u);
    }
    LDS_WAIT(); __syncthreads();
    {
        const int npiece = kend >> 2;
        for (int p = F.tid; p < 16 * npiece; p += NTHR) { const int q_ = p / npiece, c = p % npiece;
            const v2u val = *(const LAS v2u*)(mlds + q_ * MW + 4 * c);
            *(v2u*)(AB.MASK + ((size_t)b * LP + t0 + q_) * MW + 4 * c) = val; }
    }
    if (F.tid == 0) *(LAS int*)(F.lds + ticket_slot_off) = nxt_ticket;
    LDS_WAIT(); __syncthreads();
}

__device__ __forceinline__ int crow(int r, int hi) { return (r & 3) + 8 * (r >> 2) + 4 * hi; }
constexpr int AT_K = 0, AT_V = 2 * 8192, AT_WS = 4 * 8192;
__device__ __forceinline__ void at_qkt(f32x16& p0, f32x16& p1, const LAS unsigned char* Kslot, const bf16x8* qr, const f32x16& negm, int r32, int hi) {
    const LAS unsigned char* kb = Kslot + hi * 1024 + r32 * 16;
    p0 = negm; p1 = negm;
#pragma unroll
    for (int d0 = 0; d0 < 4; ++d0) {
        const bf16x8 b0 = *(const LAS bf16x8*)(kb + d0 * 2048), b1 = *(const LAS bf16x8*)(kb + d0 * 2048 + 512);
        p0 = __builtin_amdgcn_mfma_f32_32x32x16_bf16(b0, qr[d0], p0, 0, 0, 0);
        p1 = __builtin_amdgcn_mfma_f32_32x32x16_bf16(b1, qr[d0], p1, 0, 0, 0);
    }
}
__device__ __forceinline__ float at_max3(float a, float b, float c) { float r; asm("v_max3_f32 %0, %1, %2, %3" : "=v"(r) : "v"(a), "v"(b), "v"(c)); return r; }
typedef short s16x4 __attribute__((ext_vector_type(4)));
__device__ __forceinline__ s16x4 at_vtr(const LAS unsigned char* p) { return __builtin_bit_cast(s16x4, __builtin_amdgcn_ds_read_tr16_b64_v4i16((LAS s16x4*)p)); }
__device__ __forceinline__ void at_pv(f32x16* o, const LAS unsigned char* vb, bf16x8 pa0, bf16x8 pa1, bf16x8 pa2, bf16x8 pa3) {
#pragma unroll
    for (int d0 = 0; d0 < 2; ++d0) {
        s16x4 lo[4], hi[4];
#pragma unroll
        for (int ks = 0; ks < 4; ++ks) { lo[ks] = at_vtr(vb + d0 * 4096 + ks * 1024); hi[ks] = at_vtr(vb + d0 * 4096 + ks * 1024 + 512); }
#define AT_PK(k) (bf16x8){lo[k][0], lo[k][1], lo[k][2], lo[k][3], hi[k][0], hi[k][1], hi[k][2], hi[k][3]}
        o[d0] = __builtin_amdgcn_mfma_f32_32x32x16_bf16(pa0, AT_PK(0), o[d0], 0, 0, 0);
        o[d0] = __builtin_amdgcn_mfma_f32_32x32x16_bf16(pa1, AT_PK(1), o[d0], 0, 0, 0);
        o[d0] = __builtin_amdgcn_mfma_f32_32x32x16_bf16(pa2, AT_PK(2), o[d0], 0, 0, 0);
        o[d0] = __builtin_amdgcn_mfma_f32_32x32x16_bf16(pa3, AT_PK(3), o[d0], 0, 0, 0);
#undef AT_PK
    }
}
template <class OutF> __device__ __forceinline__ void attn_unit(const Frame& F, const bf16* __restrict__ Ua, const AttBufs& AB, int b, int h, int qb, const OutF& outf) {
    const int lane = F.lane, wid = F.wave, r32 = lane & 31, hi = lane >> 5;
    const LAS unsigned char* lds = F.lds;
    LAS float* wsf = (LAS float*)(F.lds + AT_WS) + wid * 64;
    const size_t rowbase = (size_t)b * LP; const int q0 = (qb == 0) ? 0 : 16 + 256 * (qb - 1), qend = (qb == 0) ? 16 : q0 + 256;
    const int tq = q0 + wid * 32 + r32;
    const int NT = (qend + 63) / 64;
    bf16x8 qr[4];
    { const bf16* Qw = AB.Q + (rowbase + min(tq, LP - 1)) * 512 + 64 * h;
#pragma unroll
      for (int d0 = 0; d0 < 4; ++d0) qr[d0] = *(const bf16x8*)(Qw + 16 * d0 + 8 * hi); }
    const unsigned short* mrow = AB.MASK + (rowbase + min(tq, LP - 1)) * MW;
    const bf16* ksrc = Ua + (rowbase + lane) * UA_W + 256 + 64 * h + 8 * wid;
    const bf16* vsrc = Ua + (rowbase + 16 * (wid & 3) + (lane >> 2)) * UA_W + 768 + 64 * h + (wid >> 2) * 32 + (lane & 3) * 8;
    const int sdst = wid * 1024 + lane * 16;
    const int vb0 = ((lane >> 4) & 1) * 32 + (lane & 3) * 8 + (4 * hi + ((lane & 15) >> 2)) * 64;
    float m_run = 0.f, l_run = 0.f;
    f32x16 negm;
#pragma unroll
    for (int r = 0; r < 16; ++r) negm[r] = 0.f;
    f32x16 o[2];
#pragma unroll
    for (int r = 0; r < 16; ++r) { o[0][r] = 0.f; o[1][r] = 0.f; }
    v4u kreg = *(const v4u*)ksrc, vreg = *(const v4u*)vsrc;
    v2u mk_next = *(const v2u*)mrow;
    __syncthreads();
    *(LAS v4u*)(lds + AT_K + sdst) = kreg; *(LAS v4u*)(lds + AT_V + sdst) = vreg;
    for (int j = 0; j < NT; ++j) {
        const int cur = j & 1;
        if (j + 1 < NT) { kreg = *(const v4u*)(ksrc + (size_t)(j + 1) * 64 * UA_W); vreg = *(const v4u*)(vsrc + (size_t)(j + 1) * 64 * UA_W); }
        const v2u mk = mk_next;
        if (j + 1 < NT) mk_next = *(const v2u*)(mrow + 4 * (j + 1));
        LDS_WAIT(); __syncthreads();
        if (64 * j <= q0 + wid * 32 + 31 && q0 + wid * 32 < qend) {
        f32x16 p0, p1;
        at_qkt(p0, p1, lds + AT_K + cur * 8192, qr, negm, r32, hi);
        float mx;
        { float a0 = at_max3(p0[0], p0[1], p1[0]), a1 = at_max3(p0[2], p0[3], p1[1]); a0 = at_max3(a0, p1[2], p1[3]);
#pragma unroll
          for (int r = 4; r < 16; r += 4) { a0 = at_max3(a0, p0[r], p0[r + 1]); a1 = at_max3(a1, p0[r + 2], p0[r + 3]); a0 = at_max3(a0, p1[r], p1[r + 1]); a1 = at_max3(a1, p1[r + 2], p1[r + 3]); }
          mx = at_max3(a0, a1, a1); }
        { auto rr = __builtin_amdgcn_permlane32_swap(__float_as_uint(mx), __float_as_uint(mx), false, false); mx = fmaxf(__uint_as_float(rr[0]), __uint_as_float(rr[1])); }
        if (__any(mx > 4.f)) {
            const float dl = fmaxf(mx, 0.f);
            const float f = __builtin_amdgcn_exp2f(-dl);
            m_run += dl; l_run *= f;
#pragma unroll
            for (int r = 0; r < 16; ++r) { p0[r] -= dl; p1[r] -= dl; negm[r] = -m_run; }
            if (hi == 0) wsf[r32] = f;
            LDS_WAIT();
#pragma unroll
            for (int r = 0; r < 16; ++r) { const float fr = wsf[crow(r, hi)]; o[0][r] *= fr; o[1][r] *= fr; }
        }
        const int mlo = (int)(mk.x >> (4 * hi)), mhi = (int)(mk.y >> (4 * hi));
        float s = 0.f;
#pragma unroll
        for (int r = 0; r < 16; ++r) {
            int b0_, b1_;
            asm("v_bfe_i32 %0, %1, %2, 1" : "=v"(b0_) : "v"(mlo), "n"((r & 3) + 8 * (r >> 2)));
            asm("v_bfe_i32 %0, %1, %2, 1" : "=v"(b1_) : "v"(mhi), "n"((r & 3) + 8 * (r >> 2)));
            p0[r] = __uint_as_float(__float_as_uint(__builtin_amdgcn_exp2f(p0[r])) & (unsigned)b0_);
            p1[r] = __uint_as_float(__float_as_uint(__builtin_amdgcn_exp2f(p1[r])) & (unsigned)b1_);
            s += p0[r] + p1[r];
        }
        l_run += s;
        v4u pw0, pw1, pw2, pw3;
        pw0.x = pk2(p0[0], p0[1]); pw0.y = pk2(p0[2], p0[3]); pw0.z = pk2(p0[4], p0[5]); pw0.w = pk2(p0[6], p0[7]);
        pw1.x = pk2(p0[8], p0[9]); pw1.y = pk2(p0[10], p0[11]); pw1.z = pk2(p0[12], p0[13]); pw1.w = pk2(p0[14], p0[15]);
        pw2.x = pk2(p1[0], p1[1]); pw2.y = pk2(p1[2], p1[3]); pw2.z = pk2(p1[4], p1[5]); pw2.w = pk2(p1[6], p1[7]);
        pw3.x = pk2(p1[8], p1[9]); pw3.y = pk2(p1[10], p1[11]); pw3.z = pk2(p1[12], p1[13]); pw3.w = pk2(p1[14], p1[15]);
        at_pv(o, lds + AT_V + cur * 8192 + vb0, __builtin_bit_cast(bf16x8, pw0), __builtin_bit_cast(bf16x8, pw1), __builtin_bit_cast(bf16x8, pw2), __builtin_bit_cast(bf16x8, pw3));
        }
        if (j + 1 < NT) { *(LAS v4u*)(lds + AT_K + (cur ^ 1) * 8192 + sdst) = kreg; *(LAS v4u*)(lds + AT_V + (cur ^ 1) * 8192 + sdst) = vreg; }
    }
    { auto rr = __builtin_amdgcn_permlane32_swap(__float_as_uint(l_run), __float_as_uint(l_run), false, false); l_run = __uint_as_float(rr[0]) + __uint_as_float(rr[1]); }
    LDS_WAIT();
    if (hi == 0) wsf[32 + r32] = 1.f / l_run;
    LDS_WAIT();
#pragma unroll
    for (int r = 0; r < 16; ++r) {
        const int qloc = crow(r, hi), t = q0 + wid * 32 + qloc; const float li = wsf[32 + qloc];
        if (t < qend) { outf(b, t, 512 + 64 * h + r32, o[0][r] * li); outf(b, t, 512 + 64 * h + 32 + r32, o[1][r] * li); }
    }
}
constexpr int NEXP = 32, LISTCAP = 32896;
constexpr int CW_CNT = 256;
constexpr size_t WS_LIST = 236 * MiB;
constexpr size_t WS_WT = 241 * MiB;
constexpr size_t WS_PINFO = 242 * MiB;
constexpr size_t EW_GU = (size_t)512 * 1024 * 2, EW_D = (size_t)1024 * 256 * 2;
struct MoeBufs { float* MIX; float* H1; bf16* H1b; bf16* HID; bf16* F; bf16* WGU; bf16* WD; };

__device__ __forceinline__ void convert_experts(const Frame& F, const Args& a, const MoeBufs& MB, int part, int first_wg = 0) {
    LAS float* scr = (LAS float*)(F.lds + F.wave * 16384);
    if (F.bid < first_wg) return;
    const int gw = (F.bid - first_wg) * NWAVES + F.wave, NGW = (F.G - first_wg) * NWAVES;
    if (part == 0) {
        for (int it = gw; it < NEXP * 256; it += NGW) {
            const int e = it >> 8, r = it & 255;
            if (r < 128) transpose_item<4>(a.in[28] + (size_t)e * 1024 * 256, 1024, 256, MB.WGU + (size_t)e * 512 * 1024, 0, scr, r, 8, F.lane);
            else transpose_item<4>(a.in[29] + (size_t)e * 1024 * 256, 1024, 256, MB.WGU + (size_t)e * 512 * 1024, 1, scr, r - 128, 8, F.lane);
        }
    } else {
        for (int it = gw; it < NEXP * 128; it += NGW) {
            const int e = it >> 7, r = it & 127;
            transpose_item<0>(a.in[30] + (size_t)e * 256 * 1024, 256, 1024, MB.WD + (size_t)e * 1024 * 256, 0, scr, r, 32, F.lane);
        }
    }
}

constexpr int P6_HROW = 4096, P6_RGW = P6_HROW + 8 * 4096, P6_REW = P6_RGW + 16384;
static_assert(P6_REW + 65536 <= RING_BYTES, "P6 LDS map");
__device__ __forceinline__ void p6_ln1_router(const Frame& F, const Args& a, const MoeBufs& MB) {
    LAS int* lcount = (LAS int*)F.lds;
    LAS int* lbase = lcount + 32;
    LAS int* ent = lbase + 32;
    LAS float* entw = (LAS float*)(ent + 65 * 4);
    unsigned* ctl = (unsigned*)(F.ws + WS_CTL);
    const float2* rowstat = (const float2*)(F.ws + WS_ROWSTAT);
    const int lane = F.lane;
    for (int i = F.tid; i < 1024; i += NTHR) *(LAS f32x4*)(F.lds + P6_RGW + i * 16) = *(const f32x4*)(a.in[24] + (size_t)i * 4);
    for (int i = F.tid; i < 4096; i += NTHR) { const int k = i >> 2, g = i & 3; float w8[8]; ld8f(a.in[26] + (size_t)k * 32 + 8 * g, w8); st8((LAS bf16*)(F.lds + P6_REW + g * 16384 + k * 16), w8); }
    for (int blk = F.bid; blk < 256; blk += F.G) {
    if (F.tid < 32) lcount[F.tid] = 0;
    LDS_WAIT(); __syncthreads();
    f32x4 nx[4]; v2u nm[4];
    { const int pr = 65 * blk + F.wave, b = pr / LP, t = pr % LP; const int tc = (t < L) ? t : 0;
      const float* src = (tc < NM) ? (a.in[1] + (size_t)tc * D) : (a.in[0] + ((size_t)b * SEQ + (tc - NM)) * D);
#pragma unroll
      for (int j = 0; j < 4; ++j) { nx[j] = ((const f32x4*)src)[lane + 64 * j]; nm[j] = ((const v2u*)((const bf16*)MB.MIX + (size_t)pr * D))[lane + 64 * j]; } }
    for (int i = F.wave; i < 65; i += NWAVES) {
        const int pr = 65 * blk + i, t = pr % LP;
        f32x4 cx[4]; v2u cm[4];
#pragma unroll
        for (int j = 0; j < 4; ++j) { cx[j] = nx[j]; cm[j] = nm[j]; }
        if (i + NWAVES < 65) { const int pn = pr + NWAVES, bn = pn / LP, tn = pn % LP; const int tc = (tn < L) ? tn : 0;
            const float* src = (tc < NM) ? (a.in[1] + (size_t)tc * D) : (a.in[0] + ((size_t)bn * SEQ + (tc - NM)) * D);
#pragma unroll
            for (int j = 0; j < 4; ++j) { nx[j] = ((const f32x4*)src)[lane + 64 * j]; nm[j] = ((const v2u*)((const bf16*)MB.MIX + (size_t)pn * D))[lane + 64 * j]; } }
        if (t >= L) { if (lane == 0) ent[i * 4] = -1; continue; }
        const float2 st = rowstat[pr];
        f32x4 v[4]; float s = 0.f;
#pragma unroll
        for (int j = 0; j < 4; ++j) {
            const f32x4 g0 = ((const f32x4*)a.in[2])[lane + 64 * j], b0 = ((const f32x4*)a.in[3])[lane + 64 * j];
            const f32x4 mxv = {bflo(cm[j].x), bfhi(cm[j].x), bflo(cm[j].y), bfhi(cm[j].y)};
            v[j] = ((cx[j] - st.x) * st.y * g0 + b0) * DN_ALPHA + mxv;
            s += (v[j].x + v[j].y) + (v[j].z + v[j].w);
        }
        const float mean = wave_sum(s) * (1.f / D); float s2 = 0.f;
#pragma unroll
        for (int j = 0; j < 4; ++j) { v[j] = v[j] - mean; s2 += (v[j].x * v[j].x + v[j].y * v[j].y) + (v[j].z * v[j].z + v[j].w * v[j].w); }
        const float rstd = rsqrtf(wave_sum(s2) * (1.f / D) + LN_EPS);
        LAS float* hrow = (LAS float*)(F.lds + P6_HROW + F.wave * 4096);
#pragma unroll
        for (int j = 0; j < 4; ++j) {
            const f32x4 g1 = ((const f32x4*)a.in[22])[lane + 64 * j], b1 = ((const f32x4*)a.in[23])[lane + 64 * j];
            v[j] = v[j] * rstd * g1 + b1;
            ((f32x4*)(MB.H1 + (size_t)pr * D))[lane + 64 * j] = v[j];
            v2u hb; hb.x = pk2(v[j].x, v[j].y); hb.y = pk2(v[j].z, v[j].w);
            ((v2u*)(MB.H1b + (size_t)pr * D))[lane + 64 * j] = hb;
            *(LAS f32x4*)(hrow + 4 * (lane + 64 * j)) = v[j];
        }
        LDS_WAIT();
        float hk[16];
#pragma unroll
        for (int kk = 0; kk < 16; ++kk) hk[kk] = hrow[lane + 64 * kk];
        f32x4 ga = {0.f, 0.f, 0.f, 0.f};
#pragma unroll
        for (int kk = 0; kk < 16; ++kk) { const f32x4 wg = *(const LAS f32x4*)(F.lds + P6_RGW + (lane + 64 * kk) * 16); ga = ga + wg * hk[kk]; }
        float lgp[4];
#pragma unroll
        for (int g = 0; g < 4; ++g) lgp[g] = wave_sum(ga[g]) + a.in[25][g];
        int gs = 0; float gm = lgp[0];
#pragma unroll
        for (int g = 1; g < 4; ++g) if (lgp[g] > gm) { gm = lgp[g]; gs = g; }
        float den = 0.f;
#pragma unroll
        for (int g = 0; g < 4; ++g) den += __expf(lgp[g] - gm);
        const float ggate = 1.f / den;
        float el[8];
#pragma unroll
        for (int q8 = 0; q8 < 8; ++q8) el[q8] = 0.f;
#pragma unroll
        for (int kk = 0; kk < 16; ++kk) { float w8[8]; unpack8(*(const LAS v4u*)(F.lds + P6_REW + gs * 16384 + (lane + 64 * kk) * 16), w8);
#pragma unroll
            for (int q8 = 0; q8 < 8; ++q8) el[q8] = fmaf(hk[kk], w8[q8], el[q8]); }
#pragma unroll
        for (int q8 = 0; q8 < 8; ++q8) el[q8] = wave_sum(el[q8]) + a.in[27][gs * 8 + q8];
        int i1 = 0; float v1 = el[0];
#pragma unroll
        for (int q8 = 1; q8 < 8; ++q8) if (el[q8] > v1) { v1 = el[q8]; i1 = q8; }
        int i2 = 0; float v2 = -INFINITY;
#pragma unroll
        for (int q8 = 0; q8 < 8; ++q8) if (q8 != i1 && el[q8] > v2) { v2 = el[q8]; i2 = q8; }
        const float e2 = __expf(v2 - v1);
        const float w1 = ggate / (1.f + e2), w2 = ggate * e2 / (1.f + e2);
        if (lane == 0) {
            const int e0 = gs * 8 + i1, e1 = gs * 8 + i2;
            ent[i * 4] = e0; ent[i * 4 + 1] = e1;
            ent[i * 4 + 2] = atomicAdd((int*)(lcount + e0), 1); ent[i * 4 + 3] = atomicAdd((int*)(lcount + e1), 1);
            entw[i * 2] = w1; entw[i * 2 + 1] = w2;
        }
    }
    LDS_WAIT(); __syncthreads();
    if (F.tid < 32) lbase[F.tid] = (int)atomicAdd(ctl + CW_CNT + F.tid, (unsigned)lcount[F.tid]);
    LDS_WAIT(); __syncthreads();
    if (F.tid < 65) {
        const int i = F.tid, e0 = ent[i * 4];
        if (e0 >= 0) {
            const int pr = 65 * blk + i, e1 = ent[i * 4 + 1];
            int* list = (int*)(F.ws + WS_LIST); float* wt = (float*)(F.ws + WS_WT);
            list[(size_t)e0 * LISTCAP + lbase[e0] + ent[i * 4 + 2]] = pr * 2;
            list[(size_t)e1 * LISTCAP + lbase[e1] + ent[i * 4 + 3]] = pr * 2 + 1;
            wt[pr * 2] = entw[i * 2]; wt[pr * 2 + 1] = entw[i * 2 + 1];
            unsigned* pinfo = (unsigned*)(F.ws + WS_PINFO);
            pinfo[pr * 2] = ((unsigned)e0 << 16) | (unsigned)(lbase[e0] + ent[i * 4 + 2]); pinfo[pr * 2 + 1] = ((unsigned)e1 << 16) | (unsigned)(lbase[e1] + ent[i * 4 + 3]);
        }
    }
    LDS_WAIT(); __syncthreads();
    }
}
}

namespace pg8 {
struct OneUnit { int pm, pn;
    __device__ __forceinline__ bool next(int i, Unit& u) const { if (i) return false; u.pm = pm; u.pn = pn; return true; }
    __device__ __forceinline__ void a_ready(const Unit&) const {}
    __device__ __forceinline__ void done(const Unit&) const {} };
struct EpiMoeUp {
    static constexpr bool PERM = true, AFTER_DRAIN = false;
    bf16_t* HID;
    __device__ __forceinline__ void operator()(const f32x4 (&acc)[2][2][4][2], const Unit& u, int wr, int wc, int fr, int fq) const {
        const int j0 = 128 * u.pn + 16 * wc + 4 * fq;
#pragma unroll
        for (int ai = 0; ai < 2; ++ai)
#pragma unroll
            for (int m = 0; m < 4; ++m) { bf16_t* rowp = HID + (size_t)(ai * HALF + wr * 64 + m * 16 + fr) * 256 + j0;
#pragma unroll
                for (int bj = 0; bj < 2; ++bj) { const f32x4 v0 = acc[ai][bj][m][0], v1 = acc[ai][bj][m][1];
                    const float h0 = v0[0] / (1.f + __expf(-v0[0])) * v0[1], h1 = v0[2] / (1.f + __expf(-v0[2])) * v0[3];
                    const float h2 = v1[0] / (1.f + __expf(-v1[0])) * v1[1], h3 = v1[2] / (1.f + __expf(-v1[2])) * v1[3];
                    unsigned w0 = cvt_pk_bf16(h0, h1), w1 = cvt_pk_bf16(h2, h3);
                    typedef unsigned u32x2_ __attribute__((ext_vector_type(2))); u32x2_ wv; wv.x = w0; wv.y = w1;
                    *(u32x2_*)(rowp + 64 * bj) = wv; } }
    }
};
struct EpiMoeDown {
    static constexpr bool PERM = true, AFTER_DRAIN = false;
    bf16_t* O;
    __device__ __forceinline__ void operator()(const f32x4 (&acc)[2][2][4][2], const Unit& u, int wr, int wc, int fr, int fq) const {
        const int col0 = u.pn * BM + wc * 32 + 8 * fq;
#pragma unroll
        for (int ai = 0; ai < 2; ++ai)
#pragma unroll
            for (int m = 0; m < 4; ++m) { bf16_t* rowp = O + (size_t)(ai * HALF + wr * 64 + m * 16 + fr) * 1024 + col0;
#pragma unroll
                for (int bj = 0; bj < 2; ++bj) { const f32x4 v0 = acc[ai][bj][m][0], v1 = acc[ai][bj][m][1];
                    u32x4 w; w.x = cvt_pk_bf16(v0[0], v0[1]); w.y = cvt_pk_bf16(v0[2], v0[3]); w.z = cvt_pk_bf16(v1[0], v1[1]); w.w = cvt_pk_bf16(v1[2], v1[3]);
                    *(u32x4*)(rowp + bj * HALF) = w; } }
    }
};
}

namespace mk {
struct MoeTiles { int total; };
__device__ __forceinline__ int moe_find(const unsigned* cnt, int ti, int& e_out, int& i_out, int& hb_out, int& total) {
    int acc = 0, e_f = -1, i_f = 0, hb = 0;
    for (int e = 0; e < NEXP; ++e) { const int nt = ((int)cnt[e] + 255) >> 8; if (e_f < 0 && ti < acc + nt) { e_f = e; i_f = ti - acc; hb = acc; } acc += nt; }
    total = acc; e_out = e_f; i_out = i_f; hb_out = hb; return e_f;
}
constexpr int MOE_LDS_IDX = RING_BYTES;
__device__ __forceinline__ void p7_moe(const Frame& F, const MoeBufs& MB, bool down) {
    const unsigned* cnt = (const unsigned*)(F.ws + WS_CTL) + CW_CNT;
    const int* list = (const int*)(F.ws + WS_LIST);
    LAS int* lidx = (LAS int*)(F.lds + MOE_LDS_IDX);
    const int ncol = down ? 4 : 2;
    for (int u = F.bid;; u += F.G) {
        int e, i, hb, total; moe_find(cnt, u / ncol, e, i, hb, total);
        e = __builtin_amdgcn_readfirstlane(e); i = __builtin_amdgcn_readfirstlane(i); hb = __builtin_amdgcn_readfirstlane(hb); total = __builtin_amdgcn_readfirstlane(total);
        if (u >= total * ncol) break;
        const int pn = __builtin_amdgcn_readfirstlane(u % ncol), n_e = __builtin_amdgcn_readfirstlane((int)cnt[e]), base = 256 * i;
        if (!down) {
            __syncthreads();
            if (F.tid < 256) lidx[F.tid] = list[(size_t)e * LISTCAP + min(base + F.tid, n_e - 1)] >> 1;
            LDS_WAIT(); __syncthreads();
        }
        if (!down) {
            pg8::Gemm g{MB.H1b, MB.WGU + (size_t)e * 512 * 1024, 256, 512, 1024, 1024, (const int*)(F.lds + MOE_LDS_IDX)};
            pg8::OneUnit S{0, pn};
            pg8::EpiMoeUp E{MB.HID + (size_t)(hb + i) * 256 * 256};
            pg8::gemm_phase<pg8::EpiMoeUp, pg8::OneUnit, true, true, true>(F.lds, g, S, E);
        } else {
            pg8::Gemm g{MB.HID + (size_t)(hb + i) * 256 * 256, MB.WD + (size_t)e * 1024 * 256, 256, 1024, 256, 256, nullptr};
            pg8::OneUnit S{0, pn};
            pg8::EpiMoeDown E{MB.F + (size_t)(hb + i) * 256 * 1024};
            pg8::gemm_phase<pg8::EpiMoeDown, pg8::OneUnit, true, true, false>(F.lds, g, S, E);
        }
    }
}
__device__ __forceinline__ int moe_total_tiles(const unsigned* cnt) { int acc = 0; for (int e = 0; e < NEXP; ++e) acc += ((int)cnt[e] + 255) >> 8; return acc; }
__device__ __forceinline__ void p8_final(const Frame& F, const Args& a, const MoeBufs& MB) {
    const int gw = F.bid * NWAVES + F.wave, NGW = F.G * NWAVES, lane = F.lane;
    const unsigned* cnt = (const unsigned*)(F.ws + WS_CTL) + CW_CNT;
    const unsigned* pinfo = (const unsigned*)(F.ws + WS_PINFO); const float* wt = (const float*)(F.ws + WS_WT);
    int tb = 0;
    { const int nt = (lane < NEXP) ? (((int)cnt[lane & 31] + 255) >> 8) : 0; int inc = nt;
#pragma unroll
      for (int o = 1; o < 32; o <<= 1) { const int t = __shfl_up(inc, o); if ((lane & 31) >= o) inc += t; }
      tb = inc - nt; }
    const int NR = NB * SEQ;
    for (int orow = gw; orow < NR; orow += 2 * NGW) {
        f32x4 hv[2][4]; v2u fa[2][4], fb[2][4]; float w0[2], w1[2]; bool ok[2];
#pragma unroll
        for (int u = 0; u < 2; ++u) {
            const int o = orow + u * NGW; ok[u] = o < NR; const int oc = ok[u] ? o : orow;
            const size_t pr = (size_t)(oc / SEQ) * LP + NM + (oc % SEQ);
            const unsigned p0 = pinfo[pr * 2], p1 = pinfo[pr * 2 + 1]; w0[u] = wt[pr * 2]; w1[u] = wt[pr * 2 + 1];
            const size_t r0 = (size_t)__shfl(tb, (int)(p0 >> 16)) * 256 + (p0 & 0xffffu), r1 = (size_t)__shfl(tb, (int)(p1 >> 16)) * 256 + (p1 & 0xffffu);
#pragma unroll
            for (int j = 0; j < 4; ++j) { hv[u][j] = ((const f32x4*)(MB.H1 + pr * D))[lane + 64 * j]; fa[u][j] = ((const v2u*)(MB.F + r0 * D))[lane + 64 * j]; fb[u][j] = ((const v2u*)(MB.F + r1 * D))[lane + 64 * j]; }
        }
#pragma unroll
        for (int u = 0; u < 2; ++u) {
            f32x4 v[4]; float sm = 0.f;
#pragma unroll
            for (int j = 0; j < 4; ++j) {
                const f32x4 h = hv[u][j]; const v2u f0 = fa[u][j], f1 = fb[u][j];
                v[j].x = DN_ALPHA * h.x + w0[u] * bflo(f0.x) + w1[u] * bflo(f1.x); v[j].y = DN_ALPHA * h.y + w0[u] * bfhi(f0.x) + w1[u] * bfhi(f1.x);
                v[j].z = DN_ALPHA * h.z + w0[u] * bflo(f0.y) + w1[u] * bflo(f1.y); v[j].w = DN_ALPHA * h.w + w0[u] * bfhi(f0.y) + w1[u] * bfhi(f1.y);
                sm += (v[j].x + v[j].y) + (v[j].z + v[j].w);
            }
            const float mean = wave_sum(sm) * (1.f / D); float s2 = 0.f;
#pragma unroll
            for (int j = 0; j < 4; ++j) { v[j] = v[j] - mean; s2 += (v[j].x * v[j].x + v[j].y * v[j].y) + (v[j].z * v[j].z + v[j].w * v[j].w); }
            const float rstd = rsqrtf(wave_sum(s2) * (1.f / D) + LN_EPS);
            if (ok[u]) {
                const int o = orow + u * NGW;
#pragma unroll
                for (int j = 0; j < 4; ++j) { const f32x4 g2 = ((const f32x4*)a.in[31])[lane + 64 * j], b2 = ((const f32x4*)a.in[32])[lane + 64 * j];
                    ((f32x4*)(a.out + (size_t)o * D))[lane + 64 * j] = v[j] * rstd * g2 + b2; }
            }
        }
    }
}
struct OutY {
    bf16* Ur;
    __device__ __forceinline__ void operator()(int b, int t, int col, f32x4 y) const { v2u o; o.x = pk2(y[0], y[1]); o.y = pk2(y[2], y[3]); *(v2u*)(Ur + ((size_t)b * LP + t) * UR_W + col) = o; }
    __device__ __forceinline__ void operator()(int b, int t, int col, float y) const { Ur[((size_t)b * LP + t) * UR_W + col] = (bf16)f2bf(y); }
};
constexpr int CW_W3 = 16, CW_W4 = 80;
constexpr int TICKET_OFF = 15 * 9216 + 62 * 144 + 128;
__device__ __forceinline__ int next_ticket(const Frame& F, unsigned* ctr) {
    LAS int* slot = (LAS int*)(F.lds + TICKET_OFF);
    if (F.tid == 0) *slot = (int)atomicAdd(ctr, 1u);
    LDS_WAIT(); __syncthreads();
    const int t = *slot;
    LDS_WAIT(); __syncthreads();
    return t;
}
__device__ __forceinline__ int bcast_ticket(const Frame& F, int mine) {
    LAS int* slot = (LAS int*)(F.lds + TICKET_OFF);
    if (F.tid == 0) *slot = mine;
    LDS_WAIT(); __syncthreads();
    const int t = *slot;
    LDS_WAIT(); __syncthreads();
    return t;
}
constexpr size_t W_UR = 16 * MiB;
constexpr size_t W_UA = W_UR + (size_t)TP * UR_W * 2;
constexpr size_t W_RW = W_UA + (size_t)TP * UA_W * 2;
constexpr size_t W_H0B = W_RW;
constexpr size_t W_RW_M = W_RW, W_RW_N = W_RW_M + (size_t)NUNIT * 8192, W_RW_Q = W_RW_N + (size_t)NUNIT * 16384, W_RW_OP = W_RW_Q + (size_t)NUNIT * 8192,
                 W_RW_G1 = W_RW_OP + (size_t)NUNIT * 8192, W_RW_G2 = W_RW_G1 + (size_t)NUNIT * 8192, W_RW_END = W_RW_G2 + (size_t)NUNIT * 8192;
static_assert(W_RW_END <= WS_LIST, "RWKV data below the token lists");
constexpr size_t W_MIX = W_RW;
constexpr size_t W_F = W_RW;
constexpr size_t W_H1B = W_RW + 81 * MiB;
constexpr size_t W_H1 = W_UR;
constexpr size_t W_HID = 81 * MiB;
static_assert(W_H1 + (size_t)TP * 4096 <= W_HID && W_HID + (size_t)41216 * 512 <= W_RW && W_H1B + (size_t)TP * 2048 <= WS_LIST && W_F + (size_t)41216 * 2048 <= W_H1B, "late-phase overlays");
constexpr size_t O_Q = 0, O_QI = O_Q + (size_t)TP * 1024, O_HC = O_QI + (size_t)TP * 1024, O_MASK = O_HC + (size_t)NUNIT * 8192, O_KX = O_MASK + (size_t)TP * MW * 2, O_END = O_KX + (size_t)TP * 128;
constexpr size_t O_WGU = 0, O_WD = 32 * MiB;
static_assert(O_END <= 64 * MiB && O_WD + (size_t)NEXP * EW_D <= 64 * MiB, "d_out scratch");

__global__ void __launch_bounds__(NTHR, 2) mega(Args a) {
    unsigned char* const wsb_ = a.ws; unsigned char* const ob_ = (unsigned char*)a.out;
    bf16* const H0b = (bf16*)(wsb_ + W_H0B); bf16* const Ur = (bf16*)(wsb_ + W_UR); bf16* const Ua = (bf16*)(wsb_ + W_UA);
    const RwkvBufs RB{(bf16*)(wsb_ + W_RW_M), (float*)(wsb_ + W_RW_N), (bf16*)(wsb_ + W_RW_Q), (bf16*)(wsb_ + W_RW_OP), (bf16*)(wsb_ + W_RW_G1), (bf16*)(wsb_ + W_RW_G2), (bf16*)(ob_ + O_HC)};
    const AttBufs AB{(bf16*)(ob_ + O_Q), (bf16*)(ob_ + O_QI), (unsigned short*)(ob_ + O_MASK), (bf16*)(ob_ + O_KX)};
    const MoeBufs MB{(float*)(wsb_ + W_MIX), (float*)(wsb_ + W_H1), (bf16*)(wsb_ + W_H1B), (bf16*)(wsb_ + W_HID), (bf16*)(wsb_ + W_F), (bf16*)(ob_ + O_WGU), (bf16*)(ob_ + O_WD)};
    extern __shared__ __attribute__((aligned(16))) unsigned char lds[];
    Frame F;
    F.lds = (LAS unsigned char*)lds;
    F.tid = threadIdx.x; F.lane = F.tid & 63; F.wave = __builtin_amdgcn_readfirstlane(F.tid >> 6);
    F.G = gridDim.x; F.bid = blockIdx.x; F.ws = a.ws;
    unsigned* ctl = (unsigned*)(a.ws + WS_CTL);
    const int lo = a.ph_lo, hi = a.ph_hi;
    volatile LAS unsigned* MISC = (volatile LAS unsigned*)(F.lds + MISC_OFF);
    if (F.tid < 4) MISC[F.tid] = 0u;
    LDS_WAIT(); __syncthreads();
    XcdBarrier bar; bar.bar = ctl + CW_BAR; bar.x = 0; bar.st = MISC;
    if (hi - lo > 1) bar = xcd_barrier_post(ctl + CW_BAR, MISC);
#define SEAM(k) do { if (IN(k) && IN((k) + 1)) xcd_barrier(bar); } while (0)
#define IN(k) (lo <= (k) && (k) < hi)
    if (IN(0)) { p0_prologue(F, a, H0b); }
    SEAM(0);
    if (IN(1)) {
        pg8::Gemm g{H0b, (const bf16*)(F.ws + WS_WIN), TP, IN_N, 1024, 1024, nullptr};
        pg8::StaticOrder S; S.init(TP, IN_N, F.G, (int)blockIdx.x);
        pg8::EpiU E{Ur, Ua};
        pg8::gemm_phase<pg8::EpiU, pg8::StaticOrder, true, true>(F.lds, g, S, E);
    }
    SEAM(1);
    if (IN(2)) {
        {
            if (F.G == 256) { att_prep_unit(F, a, Ua, AB, F.bid); if (F.bid >= 32 && F.bid < 36) att_prep_unit(F, a, Ua, AB, 256 + F.bid - 32); }
            else for (int u = F.bid; u < TP / 64; u += F.G) att_prep_unit(F, a, Ua, AB, u);
        }
        {
            if (F.G == 256) {
                const int nk = (F.bid >= 32 && F.bid < 36) ? 7 : ((F.bid < 32 || (F.bid >= 36 && F.bid < 40)) ? 9 : 8);
#define PB(x) (32 * ((x) & 7) + ((x) >> 3))
                RwRaw R; rw_load_raw(R, Ur, PB(F.bid), F.tid);
                { RwW W0; rw_w_fetch(W0, F, a, PB(F.bid) & 7); __syncthreads(); rw_w_store(W0, F); LDS_WAIT(); __syncthreads(); }
#pragma unroll 1
                for (int kq = 0; kq < nk; ++kq) {
                    const int u = (kq < 8) ? PB(F.bid) + 256 * kq : (F.bid < 32 ? 2048 + F.bid : PB(F.bid - 4) + 256 * 7);
                    const int kn = kq + 1; const int un = (kn >= nk) ? -1 : ((kn < 8) ? PB(F.bid) + 256 * kn : (F.bid < 32 ? 2048 + F.bid : PB(F.bid - 4) + 256 * 7));
                    rwkv_unit(F, a, Ur, RB, u, R, un);
                }
            } else { RwRaw R; for (int u = F.bid; u < NUNIT; u += F.G) { rw_load_raw(R, Ur, u, F.tid); { RwW W0; rw_w_fetch(W0, F, a, u & 7); __syncthreads(); rw_w_store(W0, F); LDS_WAIT(); __syncthreads(); } rwkv_unit(F, a, Ur, RB, u, R, -1); } }
        }
    }
    SEAM(2);
    if (IN(3)) {
        if (F.bid < 32 && F.wave < 2) rwkv_scan(RB, F.bid, F.wave, F.lane);
        for (int i = next_ticket(F, ctl + CW_W3); i < 4 * 257;) {
            idx_unit(F, Ua, AB, i & 3, 256 - (i >> 2), ctl + CW_W3, TICKET_OFF);
            i = *(LAS int*)(F.lds + TICKET_OFF);
            LDS_WAIT(); __syncthreads();
        }
    }
    SEAM(3);
    if (IN(4)) {
        const OutY of{Ur};
        for (int u = F.bid * NWAVES + F.wave; u < NUNIT; u += F.G * NWAVES) rwkv_out_unit(RB, u, F.lane, of);
        for (int i = next_ticket(F, ctl + CW_W4); i < 17 * 32;) {
            attn_unit(F, Ua, AB, (i & 31) >> 3, i & 7, 16 - (i >> 5), of);
            i = next_ticket(F, ctl + CW_W4);
        }
    }
    SEAM(4);
    if (IN(5)) {
        pg8::Gemm g{Ur, (const bf16*)(F.ws + WS_WOUT), TP, 1024, 1024, UR_W, nullptr};
        pg8::StaticOrder S; S.init(TP, 1024, F.G, (int)blockIdx.x);
        pg8::EpiB16 E{(bf16*)MB.MIX, 1024};
        pg8::gemm_phase<pg8::EpiB16, pg8::StaticOrder, true, true>(F.lds, g, S, E);
        convert_experts(F, a, MB, 0, (TP / 256) * 4 - F.G > 0 ? (TP / 256) * 4 - F.G : 0);
    }
    SEAM(5);
    if (IN(6)) { p6_ln1_router(F, a, MB); }
    SEAM(6);
    if (IN(7)) { p7_moe(F, MB, false);
        { const int nu = 2 * moe_total_tiles((const unsigned*)(F.ws + WS_CTL) + CW_CNT); const int fw = nu - F.G; convert_experts(F, a, MB, 1, (fw > 0 && fw < F.G) ? fw : 0); } }
    SEAM(7);
    if (IN(8)) { p7_moe(F, MB, true); }
    SEAM(8);
    if (IN(9)) { p8_final(F, a, MB); }
#undef IN
#undef SEAM
}

}
extern "C" void kernel_launch(void* const* d_in, const int* in_sizes, int n_in, void* d_out, int out_size, void* d_ws, size_t ws_size, hipStream_t stream) {
    static int inited = 0;
    if (!inited) { (void)hipFuncSetAttribute((const void*)mk::mega, hipFuncAttributeMaxDynamicSharedMemorySize, mk::LDS_BYTES); inited = 1; }
    unsigned char* wsb = (unsigned char*)d_ws;
    (void)hipMemsetAsync(wsb + mk::WS_CTL, 0, mk::CTL_ZERO_BYTES, stream);
    mk::Args a{};
    for (int i = 0; i < 33; ++i) a.in[i] = (const float*)d_in[i];
    a.out = (float*)d_out; a.ws = wsb;
    static int grid = 0;
    if (!grid) { int dev = 0, cus = 0, per_cu = 0; (void)hipGetDevice(&dev); (void)hipDeviceGetAttribute(&cus, hipDeviceAttributeMultiprocessorCount, dev);
        (void)hipOccupancyMaxActiveBlocksPerMultiprocessor(&per_cu, (const void*)mk::mega, mk::NTHR, mk::LDS_BYTES); (void)hipGetLastError();
        if (per_cu < 1) per_cu = 1; if (cus < 1) cus = 256; grid = cus * per_cu; if (grid > 256) grid = 256; }
    a.ph_lo = 0; a.ph_hi = 10;
    { void* kargs[] = {(void*)&a};
      if (hipLaunchCooperativeKernel((const void*)mk::mega, dim3(grid), dim3(mk::NTHR), kargs, mk::LDS_BYTES, stream) != hipSuccess) {
          (void)hipGetLastError();
          hipLaunchKernelGGL(mk::mega, dim3(grid), dim3(mk::NTHR), mk::LDS_BYTES, stream, a);
      } }
}
```

```cpp
#include <hip/hip_runtime.h>
#include <math.h>
#include <stdint.h>
namespace pg8 {
#define PG8_LAS __attribute__((address_space(3)))
typedef unsigned short bf16_t;
typedef short bf16x8 __attribute__((ext_vector_type(8)));
typedef float f32x4 __attribute__((ext_vector_type(4)));
typedef unsigned u32x4 __attribute__((ext_vector_type(4)));
constexpr int BM = 256, BK = 64, HALF = 128, HTB = HALF * BK * 2  , STAGE_BYTES = 8 * HTB, NXCD = 8, WGM = 8;

__host__ __device__ __forceinline__ int lds_byte(int r, int c) { const int st = (r >> 4) * 2 + (c >> 5), rr = r & 15, cc = c & 31, ob = rr * 64 + cc * 2; return st * 1024 + (ob ^ (((ob >> 9) & 1) << 5)); }
__host__ __device__ __forceinline__ void stage_rc(int b, int& R, int& C) { const int st = b / 1024, sb = b % 1024, swz = sb ^ (((sb >> 9) & 1) << 5); R = (st >> 1) * 16 + swz / 64; C = (st & 1) * 32 + (swz % 64) / 2; }
__host__ __device__ __forceinline__ int perm32(int rho) { const int n = rho >> 4, i = rho & 15; return 8 * (i >> 2) + 4 * n + (i & 3); }

struct Unit { int pm, pn; };
struct Gemm { const bf16_t* A; const bf16_t* Bt; int M, N, K, lda; const int* rowidx; };

struct StaticOrder {
    int nM, nN, nwg, G, c;
    __host__ __device__ void init(int M, int N, int G_, int c_) { nM = M / BM; nN = N / BM; nwg = nM * nN; G = G_; c = c_; }
    __host__ __device__ bool next(int i, Unit& u) const {
        const long L = (long)i * G + c; if (L >= nwg) return false;
        int wgid = (int)L; { const int q = nwg / NXCD, r = nwg % NXCD, xcd = wgid % NXCD, off = wgid / NXCD; wgid = (xcd < r ? xcd * (q + 1) : r * (q + 1) + (xcd - r) * q) + off; }
        const int nig = WGM * nN, gid = wgid / nig, fm = gid * WGM, gsz = (nM - fm) < WGM ? (nM - fm) : WGM;
        u.pm = fm + ((wgid % nig) % gsz); u.pn = (wgid % nig) / gsz; return true;
    }
    __device__ __forceinline__ void a_ready(const Unit&) const {}
    __device__ __forceinline__ void done(const Unit&) const {}
};

__device__ __forceinline__ unsigned cvt_pk_bf16(float lo, float hi) { unsigned r; asm volatile("v_cvt_pk_bf16_f32 %0, %1, %2" : "=v"(r) : "v"(lo), "v"(hi)); return r; }
typedef float f32x2 __attribute__((ext_vector_type(2)));
__device__ __forceinline__ f32x2 gelu_pk(f32x2 v) {
    const f32x2 av = __builtin_elementwise_abs(v), d = av * 0.2316418882f + 1.0f;
    f32x2 t; t.x = __builtin_amdgcn_rcpf(d.x); t.y = __builtin_amdgcn_rcpf(d.y);
    f32x2 q = t * 0.5307027145f + (-0.7265760135f); q = q * t + 0.7107068705f; q = q * t + (-0.142248368f); q = q * t + 0.127414796f; q = q * t;
    const f32x2 s = (v * v) * (-0.72134752044f);
    f32x2 e; e.x = __builtin_amdgcn_exp2f(s.x); e.y = __builtin_amdgcn_exp2f(s.y);
    const f32x2 m = v * (q * e), r = v - m;
    f32x2 o; o.x = v.x < 0.f ? m.x : r.x; o.y = v.y < 0.f ? m.y : r.y; return o;
}

template <int ACT  > struct EpiBf16 {
    static constexpr bool PERM = true, AFTER_DRAIN = false; static_assert(ACT == 0 || ACT == 1, "EpiBf16: ACT is 0 (none) or 1 (gelu_pk)");
    bf16_t* O; int ldc; const float* bias; int split_cols; size_t split_stride; float scale0;
    __device__ __forceinline__ void operator()(const f32x4 (&acc)[2][2][4][2], const Unit& u, int wr, int wc, int fr, int fq) const {
        const int row0 = u.pm * BM + wr * 64 + fr; int colt = u.pn * BM; bf16_t* base = O;
        float sc = 1.f; if (split_cols) { const int t = colt / split_cols; base += (size_t)t * split_stride; colt -= t * split_cols; if (t == 0) sc = scale0; }
        const int col0 = colt + wc * 32 + 8 * fq, bcol0 = u.pn * BM + wc * 32 + 8 * fq;
        f32x4 bv[2][2];
#pragma unroll
        for (int bj = 0; bj < 2; ++bj)
#pragma unroll
            for (int n = 0; n < 2; ++n) bv[bj][n] = bias ? *(const f32x4*)(bias + bcol0 + bj * HALF + 4 * n) : (f32x4){0.f, 0.f, 0.f, 0.f};
#pragma unroll
        for (int ai = 0; ai < 2; ++ai)
#pragma unroll
            for (int m = 0; m < 4; ++m) { bf16_t* rowp = base + (size_t)(row0 + ai * HALF + m * 16) * ldc + col0;
#pragma unroll
                for (int bj = 0; bj < 2; ++bj) { f32x4 v0 = acc[ai][bj][m][0] + bv[bj][0], v1 = acc[ai][bj][m][1] + bv[bj][1];
                    if (ACT == 1) { f32x2 a = gelu_pk((f32x2){v0[0], v0[1]}), b = gelu_pk((f32x2){v0[2], v0[3]}), c = gelu_pk((f32x2){v1[0], v1[1]}), d = gelu_pk((f32x2){v1[2], v1[3]});
                        v0 = (f32x4){a.x, a.y, b.x, b.y}; v1 = (f32x4){c.x, c.y, d.x, d.y}; }
                    v0 = v0 * sc; v1 = v1 * sc; u32x4 w; w.x = cvt_pk_bf16(v0[0], v0[1]); w.y = cvt_pk_bf16(v0[2], v0[3]); w.z = cvt_pk_bf16(v1[0], v1[1]); w.w = cvt_pk_bf16(v1[2], v1[3]);
                    *(u32x4*)(rowp + bj * HALF) = w; } }
    }
};
template <class Epi, class Sched, bool ALIGN_EPI = false, bool SP2 = false, bool GATHER = false>
__device__ __forceinline__ void gemm_phase(PG8_LAS unsigned char* lds, const Gemm g, const Sched& S, const Epi& E) {
    const int tid = threadIdx.x, wid = __builtin_amdgcn_readfirstlane(tid >> 6), lane = tid & 63, wr = wid >> 2, wc = wid & 3, fr = lane & 15, fq = lane >> 4;
    const int K = g.K, nt = K / BK;
    unsigned voffA[2], voffA1[2], voffB[2];
#pragma unroll
    for (int i = 0; i < 2; ++i) { int R, C; stage_rc(tid * 16 + i * 8192, R, C); const int Rb = Epi::PERM ? ((R & ~31) + perm32(R & 31)) : R;
        if constexpr (GATHER) { voffA[i] = (unsigned)(g.rowidx[R] * g.lda + C) * 2u; voffA1[i] = (unsigned)(g.rowidx[R + HALF] * g.lda + C) * 2u; }
        else { voffA[i] = (unsigned)(R * g.lda + C) * 2u; voffA1[i] = voffA[i]; }
        voffB[i] = (unsigned)(Rb * K + C) * 2u; }
    const size_t kstep = (size_t)(BK * 2);
    const size_t hstep = (size_t)HALF * K * 2;
    const size_t tstep = 2 * hstep; const size_t hstepA = GATHER ? (size_t)0 : (size_t)HALF * g.lda * 2, tstepA = 2 * hstepA;
    const unsigned ldsw = (unsigned)wid * 1024u;
    const int aoff = lds_byte(wr * 64 + fr, fq * 8), boff = lds_byte(wc * 32 + fr, fq * 8);
#define PG8_SA(b, h) (((b) * 2 + (h)) * HTB)
#define PG8_SB(b, h) ((4 + (b) * 2 + (h)) * HTB)
#define PG8_STAGE(bufoff, gbase, voff) do { _Pragma("unroll") for (int _i = 0; _i < 2; ++_i) \
        __builtin_amdgcn_global_load_lds((const unsigned*)((const char*)(gbase) + (voff)[_i]), (PG8_LAS unsigned*)(lds + (bufoff) + ldsw + _i * 8192), 16, 0, 0); } while (0)
#define PG8_LDA(dst, b, h) do { _Pragma("unroll") for (int m = 0; m < 4; ++m) _Pragma("unroll") for (int k = 0; k < 2; ++k) dst[m][k] = *(const PG8_LAS bf16x8*)(lds + PG8_SA(b, h) + aoff + m * 2048 + k * 1024); } while (0)
#define PG8_LDB(dst, b, h) do { _Pragma("unroll") for (int n = 0; n < 2; ++n) _Pragma("unroll") for (int k = 0; k < 2; ++k) dst[n][k] = *(const PG8_LAS bf16x8*)(lds + PG8_SB(b, h) + boff + n * 2048 + k * 1024); } while (0)
#define PG8_MMA(ai, bj, At, Bt) do { __builtin_amdgcn_s_setprio(1); _Pragma("unroll") for (int m = 0; m < 4; ++m) _Pragma("unroll") for (int n = 0; n < 2; ++n) _Pragma("unroll") for (int k = 0; k < 2; ++k) \
        acc[ai][bj][m][n] = __builtin_amdgcn_mfma_f32_16x16x32_bf16(Bt[n][k], At[m][k], acc[ai][bj][m][n], 0, 0, 0); __builtin_amdgcn_s_setprio(0); } while (0)
#define PG8_WAIT_V(n) asm volatile("s_waitcnt vmcnt(" #n ")" ::: "memory")
#define PG8_WAIT_L(n) asm volatile("s_waitcnt lgkmcnt(" #n ")" ::: "memory")
#define PG8_BAR __builtin_amdgcn_s_barrier()
#define PG8_SCHED __builtin_amdgcn_sched_barrier(0)
    Unit cur, nxt; int ui = 0;
    if (!S.next(0, cur)) return;
    f32x4 acc[2][2][4][2];
#pragma unroll
    for (int a = 0; a < 2; ++a)
#pragma unroll
        for (int b = 0; b < 2; ++b)
#pragma unroll
            for (int m = 0; m < 4; ++m)
#pragma unroll
                for (int n = 0; n < 2; ++n) acc[a][b][m][n] = (f32x4){0.f, 0.f, 0.f, 0.f};
    bf16x8 At[4][2], B0[2][2], B1[2][2];
    const char* cA = (const char*)g.A + (size_t)cur.pm * tstepA; const char* cB = (const char*)g.Bt + (size_t)cur.pn * tstep;
    S.a_ready(cur);
    if constexpr (SP2) {
        PG8_STAGE(PG8_SB(0, 0), cB, voffB); PG8_STAGE(PG8_SB(0, 1), cB + hstep, voffB); PG8_STAGE(PG8_SA(0, 0), cA, voffA); PG8_STAGE(PG8_SA(0, 1), cA + hstepA, voffA1);
        if (wr == 1) PG8_BAR;
        PG8_WAIT_V(2); PG8_BAR;
        PG8_STAGE(PG8_SB(1, 0), cB + kstep, voffB); PG8_STAGE(PG8_SA(1, 0), cA + kstep, voffA); PG8_STAGE(PG8_SB(1, 1), cB + hstep + kstep, voffB);
        PG8_WAIT_V(6); PG8_BAR;
    } else {
        PG8_STAGE(PG8_SB(0, 0), cB, voffB); PG8_STAGE(PG8_SA(0, 0), cA, voffA); PG8_STAGE(PG8_SB(0, 1), cB + hstep, voffB); PG8_STAGE(PG8_SA(0, 1), cA + hstepA, voffA1);
        if (wr == 1) PG8_BAR;
        PG8_WAIT_V(4); PG8_BAR;
        PG8_STAGE(PG8_SB(1, 0), cB + kstep, voffB); PG8_STAGE(PG8_SA(1, 0), cA + kstep, voffA); PG8_STAGE(PG8_SB(1, 1), cB + hstep + kstep, voffB);
        PG8_WAIT_V(6); PG8_BAR;
    }
    for (;;) {
        const bool has_next = S.next(ui + 1, nxt);
        const char* nA = has_next ? (const char*)g.A + (size_t)nxt.pm * tstepA : cA; const char* nB = has_next ? (const char*)g.Bt + (size_t)nxt.pn * tstep : cB;
        for (int t = 0; t < nt; t += 2) {
            const bool last = (t == nt - 2);
            const char* a1 = cA + (size_t)(t + 1) * kstep;
            const char* a2 = last ? nA : cA + (size_t)(t + 2) * kstep; const char* b2 = last ? nB : cB + (size_t)(t + 2) * kstep;
            const char* a3 = a2 + kstep; const char* b3 = b2 + kstep;
            if (last && has_next) S.a_ready(nxt);
            if constexpr (SP2) {
            PG8_LDB(B0, 0, 0); PG8_LDB(B1, 0, 1); PG8_SCHED; PG8_LDA(At, 0, 0); PG8_STAGE(PG8_SA(1, 1), a1 + hstepA, voffA1);
            PG8_WAIT_V(8); PG8_WAIT_L(0); PG8_BAR; PG8_MMA(0, 0, At, B0); PG8_MMA(0, 1, At, B1); PG8_BAR; PG8_SCHED;
            PG8_LDA(At, 0, 1); PG8_STAGE(PG8_SB(0, 0), b2, voffB); PG8_STAGE(PG8_SB(0, 1), b2 + hstep, voffB); PG8_STAGE(PG8_SA(0, 0), a2, voffA);
            PG8_WAIT_V(8); PG8_WAIT_L(0); PG8_BAR; PG8_MMA(1, 0, At, B0); PG8_MMA(1, 1, At, B1); PG8_BAR; PG8_SCHED;
            PG8_LDB(B0, 1, 0); PG8_LDB(B1, 1, 1); PG8_SCHED; PG8_LDA(At, 1, 0); PG8_STAGE(PG8_SA(0, 1), a2 + hstepA, voffA1);
            PG8_WAIT_V(8); PG8_WAIT_L(0); PG8_BAR; PG8_MMA(0, 0, At, B0); PG8_MMA(0, 1, At, B1); PG8_BAR; PG8_SCHED;
            PG8_LDA(At, 1, 1); PG8_STAGE(PG8_SB(1, 0), b3, voffB); PG8_STAGE(PG8_SB(1, 1), b3 + hstep, voffB); PG8_STAGE(PG8_SA(1, 0), a3, voffA);
            PG8_WAIT_V(8); PG8_WAIT_L(0); PG8_BAR; PG8_MMA(1, 0, At, B0); PG8_MMA(1, 1, At, B1); PG8_BAR; PG8_SCHED;
            } else {
            PG8_LDB(B0, 0, 0); PG8_SCHED; PG8_LDA(At, 0, 0); PG8_STAGE(PG8_SA(1, 1), a1 + hstepA, voffA1);
            PG8_WAIT_L(8); PG8_BAR; PG8_WAIT_L(0); PG8_MMA(0, 0, At, B0); PG8_BAR; PG8_SCHED;
            PG8_LDB(B1, 0, 1); PG8_STAGE(PG8_SB(0, 0), b2, voffB);
            PG8_BAR; PG8_WAIT_L(0); PG8_MMA(0, 1, At, B1); PG8_BAR;
            PG8_LDA(At, 0, 1); PG8_STAGE(PG8_SA(0, 0), a2, voffA);
            PG8_BAR; PG8_WAIT_L(0); PG8_MMA(1, 0, At, B0); PG8_BAR; PG8_SCHED;
            PG8_STAGE(PG8_SB(0, 1), b2 + hstep, voffB);
            PG8_WAIT_V(6); PG8_BAR; PG8_MMA(1, 1, At, B1); PG8_BAR;
            PG8_LDB(B0, 1, 0); PG8_SCHED; PG8_LDA(At, 1, 0); PG8_STAGE(PG8_SA(0, 1), a2 + hstepA, voffA1);
            PG8_WAIT_L(8); PG8_BAR; PG8_WAIT_L(0); PG8_MMA(0, 0, At, B0); PG8_BAR; PG8_SCHED;
            PG8_LDB(B1, 1, 1); PG8_STAGE(PG8_SB(1, 0), b3, voffB);
            PG8_BAR; PG8_WAIT_L(0); PG8_MMA(0, 1, At, B1); PG8_BAR;
            PG8_LDA(At, 1, 1); PG8_STAGE(PG8_SA(1, 0), a3, voffA);
            PG8_BAR; PG8_WAIT_L(0); PG8_MMA(1, 0, At, B0); PG8_BAR; PG8_SCHED;
            PG8_STAGE(PG8_SB(1, 1), b3 + hstep, voffB);
            PG8_WAIT_V(6); PG8_BAR; PG8_MMA(1, 1, At, B1); PG8_BAR;
            }
        }
        if constexpr (ALIGN_EPI) { if (wr == 0) PG8_BAR; }
        if constexpr (!Epi::AFTER_DRAIN) { E(acc, cur, wr, wc, fr, fq); S.done(cur); }
        if (!has_next) break;
#pragma unroll
        for (int a = 0; a < 2; ++a)
#pragma unroll
            for (int b = 0; b < 2; ++b)
#pragma unroll
                for (int m = 0; m < 4; ++m)
#pragma unroll
                    for (int n = 0; n < 2; ++n) acc[a][b][m][n] = (f32x4){0.f, 0.f, 0.f, 0.f};
        cur = nxt; cA = nA; cB = nB; ++ui;
        if constexpr (ALIGN_EPI) { if (wr == 1) PG8_BAR; }
    }
    PG8_WAIT_V(0);
    if constexpr (!ALIGN_EPI) { if (wr == 0) PG8_BAR; }
    PG8_BAR;
    if constexpr (Epi::AFTER_DRAIN) { E.fused(acc, cur, wr, wc, fr, fq, lds, wid, lane); S.done(cur); }
#undef PG8_SA
#undef PG8_SB
#undef PG8_STAGE
#undef PG8_LDA
#undef PG8_LDB
#undef PG8_MMA
#undef PG8_WAIT_V
#undef PG8_WAIT_L
#undef PG8_BAR
#undef PG8_SCHED
}
}
namespace pg8 {
struct EpiF32 {
    static constexpr bool PERM = false, AFTER_DRAIN = false;
    float* O; int ldc;
    __device__ __forceinline__ void operator()(const f32x4 (&acc)[2][2][4][2], const Unit& u, int wr, int wc, int fr, int fq) const {
        const int row0 = u.pm * BM + wr * 64 + fr, col0 = u.pn * BM + wc * 32 + 4 * fq;
#pragma unroll
        for (int ai = 0; ai < 2; ++ai)
#pragma unroll
            for (int m = 0; m < 4; ++m) { float* rowp = O + (size_t)(row0 + ai * HALF + m * 16) * ldc + col0;
#pragma unroll
                for (int bj = 0; bj < 2; ++bj)
#pragma unroll
                    for (int n = 0; n < 2; ++n) *(f32x4*)(rowp + bj * HALF + n * 16) = acc[ai][bj][m][n]; }
    }
};
}
namespace pg8 {
struct EpiU {
    static constexpr bool PERM = true, AFTER_DRAIN = false;
    bf16_t* Ur; bf16_t* Ua;
    __device__ __forceinline__ void operator()(const f32x4 (&acc)[2][2][4][2], const Unit& u, int wr, int wc, int fr, int fq) const {
        const int row0 = u.pm * BM + wr * 64 + fr; int colt = u.pn * BM; bf16_t* base = Ur; int ld = 1792;
        if (colt >= 1792) { base = Ua; ld = 1536; colt -= 1792; }
        const int col0 = colt + wc * 32 + 8 * fq;
#pragma unroll
        for (int ai = 0; ai < 2; ++ai)
#pragma unroll
            for (int m = 0; m < 4; ++m) { bf16_t* rowp = base + (size_t)(row0 + ai * HALF + m * 16) * ld + col0;
#pragma unroll
                for (int bj = 0; bj < 2; ++bj) { const f32x4 v0 = acc[ai][bj][m][0], v1 = acc[ai][bj][m][1];
                    u32x4 w; w.x = cvt_pk_bf16(v0[0], v0[1]); w.y = cvt_pk_bf16(v0[2], v0[3]); w.z = cvt_pk_bf16(v1[0], v1[1]); w.w = cvt_pk_bf16(v1[2], v1[3]);
                    *(u32x4*)(rowp + bj * HALF) = w; } }
    }
};
}
namespace pg8 {
struct EpiB16 {
    static constexpr bool PERM = true, AFTER_DRAIN = false;
    bf16_t* O; int ldc;
    __device__ __forceinline__ void operator()(const f32x4 (&acc)[2][2][4][2], const Unit& u, int wr, int wc, int fr, int fq) const {
        const int row0 = u.pm * BM + wr * 64 + fr, col0 = u.pn * BM + wc * 32 + 8 * fq;
#pragma unroll
        for (int ai = 0; ai < 2; ++ai)
#pragma unroll
            for (int m = 0; m < 4; ++m) { bf16_t* rowp = O + (size_t)(row0 + ai * HALF + m * 16) * ldc + col0;
#pragma unroll
                for (int bj = 0; bj < 2; ++bj) { const f32x4 v0 = acc[ai][bj][m][0], v1 = acc[ai][bj][m][1];
                    u32x4 w; w.x = cvt_pk_bf16(v0[0], v0[1]); w.y = cvt_pk_bf16(v0[2], v0[3]); w.z = cvt_pk_bf16(v1[0], v1[1]); w.w = cvt_pk_bf16(v1[2], v1[3]);
                    *(u32x4*)(rowp + bj * HALF) = w; } }
    }
};
}
namespace mk {
#define GAS __attribute__((address_space(1)))
#define LAS __attribute__((address_space(3)))
typedef unsigned short bf16;
typedef unsigned v4u __attribute__((ext_vector_type(4)));
typedef unsigned v2u __attribute__((ext_vector_type(2)));
typedef float f32x4 __attribute__((ext_vector_type(4)));
typedef float f32x16 __attribute__((ext_vector_type(16)));
typedef short bf16x8 __attribute__((ext_vector_type(8)));
typedef GAS unsigned gu32;
typedef GAS unsigned long long gu64;
#define RLX_AGENT __ATOMIC_RELAXED, __HIP_MEMORY_SCOPE_AGENT
#define LDS_WAIT() asm volatile("s_waitcnt lgkmcnt(0)" ::: "memory")
#define VM_WAIT() asm volatile("s_waitcnt vmcnt(0)" ::: "memory")

constexpr int NB = 4, SEQ = 4096, NM = 16, L = 4112, LP = 4160, TP = NB * LP, D = 1024;
constexpr int NCH = LP / 64;
constexpr int UR_W = 1792, UA_W = 1536, IN_N = 3328, IN_COLS = 3144;
constexpr int NWAVES = 8, NTHR = 512;
constexpr float LN_EPS = 1e-5f, RMS_EPS = 1e-6f, GN_EPS = 64e-5f;
constexpr float DN_ALPHA = 1.189207115002721f;

typedef float f32x2_t __attribute__((ext_vector_type(2))); typedef __bf16 bf16x2_t __attribute__((ext_vector_type(2)));
__device__ __forceinline__ unsigned pk2(float lo, float hi) { f32x2_t v = {lo, hi}; bf16x2_t b = __builtin_convertvector(v, bf16x2_t); return __builtin_bit_cast(unsigned, b); }
__device__ __forceinline__ unsigned f2bf(float f) { return pk2(f, f) & 0xffffu; }
__device__ __forceinline__ float bf2f(unsigned short b) { return __uint_as_float(((unsigned)b) << 16); }
__device__ __forceinline__ float bflo(unsigned w) { return __uint_as_float(w << 16); }
__device__ __forceinline__ float bfhi(unsigned w) { return __uint_as_float(w & 0xffff0000u); }
__device__ __forceinline__ float dpp_f(float v, int ctrl_sel) {
    const int x = __float_as_int(v); int r;
    if (ctrl_sel == 0) r = __builtin_amdgcn_mov_dpp(x, 0xB1, 0xF, 0xF, true);
    else if (ctrl_sel == 1) r = __builtin_amdgcn_mov_dpp(x, 0x4E, 0xF, 0xF, true);
    else if (ctrl_sel == 2) r = __builtin_amdgcn_mov_dpp(x, 0x141, 0xF, 0xF, true);
    else r = __builtin_amdgcn_mov_dpp(x, 0x140, 0xF, 0xF, true);
    return __int_as_float(r);
}
__device__ __forceinline__ float sum_x16(float v) { auto rr = __builtin_amdgcn_permlane16_swap(__float_as_uint(v), __float_as_uint(v), false, false); return __uint_as_float(rr[0]) + __uint_as_float(rr[1]); }
__device__ __forceinline__ float sum_x32(float v) { auto rr = __builtin_amdgcn_permlane32_swap(__float_as_uint(v), __float_as_uint(v), false, false); return __uint_as_float(rr[0]) + __uint_as_float(rr[1]); }
__device__ __forceinline__ int isum_x16(int v) { auto rr = __builtin_amdgcn_permlane16_swap((unsigned)v, (unsigned)v, false, false); return (int)(rr[0] + rr[1]); }
__device__ __forceinline__ int isum_x32(int v) { auto rr = __builtin_amdgcn_permlane32_swap((unsigned)v, (unsigned)v, false, false); return (int)(rr[0] + rr[1]); }
__device__ __forceinline__ unsigned or_x16(unsigned v) { auto rr = __builtin_amdgcn_permlane16_swap(v, v, false, false); return rr[0] | rr[1]; }
__device__ __forceinline__ unsigned or_x32(unsigned v) { auto rr = __builtin_amdgcn_permlane32_swap(v, v, false, false); return rr[0] | rr[1]; }
__device__ __forceinline__ float sum8(float v) { v += dpp_f(v, 0); v += dpp_f(v, 1); v += dpp_f(v, 2); return v; }
__device__ __forceinline__ float wave_sum(float v) { v = sum8(v); v += dpp_f(v, 3); v = sum_x16(v); return sum_x32(v); }

constexpr size_t MiB = 1u << 20;
constexpr size_t WS_CTL = 0, CTL_ZERO_BYTES = 64 * 1024;
constexpr int CW_BAR = 1024;
constexpr size_t WS_ROPEQ = 1 * MiB;
constexpr size_t WS_ROPEI = WS_ROPEQ + (size_t)LP * 32 * 8;
constexpr size_t WS_ROWSTAT = WS_ROPEI + (size_t)LP * 16 * 8;
constexpr size_t WS_WIN = 3 * MiB;
constexpr size_t WS_WOUT = WS_WIN + (size_t)IN_N * 1024 * 2;
constexpr size_t WS_WQ = WS_WOUT + (size_t)1024 * 1024 * 2;
constexpr size_t WS_WW2 = WS_WQ + (size_t)1024 * 256 * 2;
constexpr size_t WS_WA2 = WS_WW2 + (size_t)512 * 64 * 2;
constexpr size_t WS_WG2 = WS_WA2 + (size_t)512 * 64 * 2;
constexpr size_t WS_WEND = WS_WG2 + (size_t)512 * 128 * 2;
static_assert(WS_WEND <= 13 * MiB, "weights region");

constexpr int RING_BYTES = 131072;
constexpr int LDS_BYTES = 147456;
constexpr int MISC_OFF = LDS_BYTES - 16;
#define XB_TMO      128
#define XB_XCNT(j)  (256  + 64 * (j))
#define XB_XSUB(j)  (1280 + 64 * (j))
#define XB_XGEN(j)  (2304 + 64 * (j))
#define XB_TOP      3328
#define XB_TOPGEN   3392
#define XCD_BAR_WORDS 3456
#define XB_SPIN_CAP (1u << 18)

__device__ __forceinline__ unsigned xb_ld(unsigned* p)              { return __hip_atomic_load(p, __ATOMIC_RELAXED, __HIP_MEMORY_SCOPE_AGENT); }
__device__ __forceinline__ unsigned xb_add(unsigned* p, unsigned v) { return __hip_atomic_fetch_add(p, v, __ATOMIC_RELAXED, __HIP_MEMORY_SCOPE_AGENT); }
__device__ __forceinline__ unsigned xb_xcc_id() { return (unsigned)__builtin_amdgcn_s_getreg((3 << 11) | 20) & 0xFu; }
#define XB_SPIN(cond, bar) do { unsigned _sp = 0; while (cond) { __builtin_amdgcn_s_sleep(1); \
    if ((++_sp & 255u) == 0u) { if (xb_ld(&(bar)[XB_TMO])) break; if (_sp > XB_SPIN_CAP) { atomicAdd(&(bar)[XB_TMO], 1u); break; } } } } while (0)

struct XcdBarrier {
    unsigned* bar; unsigned x;
    volatile LAS unsigned* st;
};

__device__ __forceinline__ XcdBarrier xcd_barrier_post(unsigned* bar, volatile LAS unsigned* st) {
    XcdBarrier b; b.bar = bar; b.x = xb_xcc_id(); b.st = st;
    if (threadIdx.x == 0) (void)xb_add(&bar[XB_XCNT(b.x)], 1u);
    return b;
}
__device__ __forceinline__ void xcd_barrier_complete(unsigned* bar, unsigned x, unsigned& nloc, unsigned& nx) {
    const unsigned G = gridDim.x * gridDim.y * gridDim.z;
    unsigned sum, cnt, mine, sp = 0u;
    for (;;) {
        sum = 0u; cnt = 0u; mine = 0u;
#pragma unroll
        for (unsigned j = 0; j < 16; ++j) { const unsigned c = xb_ld(&bar[XB_XCNT(j)]); sum += c; cnt += (c > 0u) ? 1u : 0u; mine = (j == x) ? c : mine; }
        if (sum == G) break;
        __builtin_amdgcn_s_sleep(1);
        if ((++sp & 255u) == 0u) { if (xb_ld(&bar[XB_TMO])) break; if (sp > XB_SPIN_CAP) { atomicAdd(&bar[XB_TMO], 1u); break; } }
    }
    nloc = mine > 0u ? mine : 1u; nx = cnt > 0u ? cnt : 1u;
}

__device__ __forceinline__ void xcd_barrier(const XcdBarrier& b) {
    asm volatile("s_waitcnt vmcnt(0)" ::: "memory");
    __syncthreads();
    if (threadIdx.x == 0) {
        unsigned* bar = b.bar;
        __builtin_amdgcn_s_waitcnt(0);
        unsigned nloc = b.st[0], nx = b.st[1];
        if (nloc == 0u) { xcd_barrier_complete(bar, b.x, nloc, nx); b.st[0] = nloc; b.st[1] = nx; }
        const unsigned old = xb_add(&bar[XB_XSUB(b.x)], 1u);
        const unsigned gen = old / nloc;
        if (old + 1u == (gen + 1u) * nloc) {
            __builtin_amdgcn_fence(__ATOMIC_RELEASE, "agent");
            asm volatile("s_waitcnt vmcnt(0)" ::: "memory");
            const unsigned og = xb_add(&bar[XB_TOP], 1u);
            const unsigned tg = og / nx;
            if (og + 1u == (tg + 1u) * nx) xb_add(&bar[XB_TOPGEN], 1u);
            else XB_SPIN(xb_ld(&bar[XB_TOPGEN]) == tg, bar);
            __builtin_amdgcn_fence(__ATOMIC_ACQUIRE, "agent");
            xb_add(&bar[XB_XGEN(b.x)], 1u);
            asm volatile("s_waitcnt vmcnt(0)" ::: "memory");
        } else {
            XB_SPIN(xb_ld(&bar[XB_XGEN(b.x)]) == gen, bar);
            __builtin_amdgcn_fence(__ATOMIC_ACQUIRE, "agent");
            asm volatile("s_waitcnt vmcnt(0)" ::: "memory");
        }
    }
    __syncthreads();
}
struct Args {
    const float* in[33]; float* out; unsigned char* ws; int ph_lo, ph_hi; int flags, pad_;
};
struct Frame {
    LAS unsigned char* lds;
    int tid, lane, wave, G, bid;
    unsigned char* ws;
};

__device__ __forceinline__ int rowmap_in(int n) {
    if (n >= 2048 && n < 2560) { const int d = (n - 2048) & 63, base = n - d; return base + (d < 32 ? 2 * d : 2 * (d - 32) + 1); }
    if (n >= 3072 && n < 3136) { const int d = n - 3072; return 3072 + (d < 16 ? 2 * d : (d < 32 ? 2 * (d - 16) + 1 : d)); }
    return n;
}
template <int MODE> __device__ __forceinline__ int rowmap(int n) {
    if (MODE == 1) return rowmap_in(n);
    if (MODE == 2) { const int d = n & 63, base = n - d; return base + (d < 32 ? 2 * d : 2 * (d - 32) + 1); }
    if (MODE == 4) return 2 * n;
    if (MODE == 3) { const int d = n & 63, base = n - d; return base + (d < 16 ? 2 * d : (d < 32 ? 2 * (d - 16) + 1 : d)); }
    return n;
}
template <int MODE> __device__ __forceinline__ void transpose_item(const float* __restrict__ W, int K, int N, bf16* WT, int row_off, LAS float* scr, int item, int nblk, int lane) {
    const int kb = item / nblk, nb = item % nblk, k0 = 64 * kb, n0 = 32 * nb;
    const int n = n0 + (lane & 31);
    float tv[32];
#pragma unroll
    for (int i = 0; i < 32; ++i) { const int kk = 2 * i + (lane >> 5); tv[i] = (n < N) ? W[(size_t)(k0 + kk) * N + n] : 0.f; }
#pragma unroll
    for (int i = 0; i < 32; ++i) { const int kk = 2 * i + (lane >> 5); scr[kk * 33 + (lane & 31)] = tv[i]; }
    LDS_WAIT(); asm volatile("" ::: "memory");
    const int c = lane & 7;
#pragma unroll
    for (int j = 0; j < 4; ++j) { const int nl = (lane >> 3) + 8 * j; const LAS float* s = scr + (8 * c) * 33 + nl;
        v4u o; o.x = pk2(s[0 * 33], s[1 * 33]); o.y = pk2(s[2 * 33], s[3 * 33]); o.z = pk2(s[4 * 33], s[5 * 33]); o.w = pk2(s[6 * 33], s[7 * 33]);
        *(v4u*)(WT + (size_t)(row_off + rowmap<MODE>(n0 + nl)) * K + k0 + 8 * c) = o; }
    LDS_WAIT(); asm volatile("" ::: "memory");
}
__device__ __forceinline__ void p0_ln_row(const Args& a, int pr, bf16* H0b, float2* rowstat, int lane) {
    const int b = pr / LP, t = pr % LP;
    unsigned long long* o8 = (unsigned long long*)(H0b + (size_t)pr * D) + lane;
    if (t >= L) {
#pragma unroll
        for (int j = 0; j < 4; ++j) o8[64 * j] = 0ull;
        if (lane == 0) rowstat[pr] = make_float2(0.f, 0.f);
        return;
    }
    const float* src = (t < NM) ? (a.in[1] + (size_t)t * D) : (a.in[0] + ((size_t)b * SEQ + (t - NM)) * D);
    const f32x4* xr = (const f32x4*)src + lane;
    f32x4 v[4]; float s = 0.f;
#pragma unroll
    for (int j = 0; j < 4; ++j) { v[j] = xr[64 * j]; s += (v[j].x + v[j].y) + (v[j].z + v[j].w); }
    const float mean = wave_sum(s) * (1.f / D); float s2 = 0.f;
#pragma unroll
    for (int j = 0; j < 4; ++j) { v[j] = v[j] - mean; s2 += (v[j].x * v[j].x + v[j].y * v[j].y) + (v[j].z * v[j].z + v[j].w * v[j].w); }
    const float rstd = 1.f / sqrtf(wave_sum(s2) * (1.f / D) + LN_EPS);
    const f32x4* gp = (const f32x4*)a.in[2] + lane; const f32x4* bp = (const f32x4*)a.in[3] + lane;
#pragma unroll
    for (int j = 0; j < 4; ++j) { const f32x4 g = gp[64 * j], bb = bp[64 * j]; const f32x4 y = v[j] * rstd * g + bb;
        o8[64 * j] = (unsigned long long)pk2(y.x, y.y) | ((unsigned long long)pk2(y.z, y.w) << 32); }
    if (lane == 0) rowstat[pr] = make_float2(mean, rstd);
}
__device__ __forceinline__ void p0_prologue(const Frame& F, const Args& a, bf16* H0b) {
    LAS float* scr = (LAS float*)(F.lds + F.wave * 16384);
    const int gw = F.bid * NWAVES + F.wave, NGW = F.G * NWAVES;
    bf16* Wt_in = (bf16*)(F.ws + WS_WIN); bf16* Wt_out = (bf16*)(F.ws + WS_WOUT); bf16* Wt_q = (bf16*)(F.ws + WS_WQ);
    bf16* Wt_w2 = (bf16*)(F.ws + WS_WW2); bf16* Wt_a2 = (bf16*)(F.ws + WS_WA2); bf16* Wt_g2 = (bf16*)(F.ws + WS_WG2);
    constexpr int I_IN = 16 * (IN_N / 32), I_OUT = 16 * 32, I_Q = 4 * 16, I_W2 = 1 * 16, I_G2 = 2 * 16;
    constexpr int NITEMS = I_IN + I_OUT + 2 * I_Q + 2 * I_W2 + I_G2;
    for (int it = gw; it < NITEMS; it += NGW) {
        int r = it;
        if (r < I_IN) { transpose_item<1>(a.in[4], 1024, IN_COLS, Wt_in, 0, scr, r, IN_N / 32, F.lane); continue; } r -= I_IN;
        if (r < I_OUT) { transpose_item<0>(a.in[21], 1024, 1024, Wt_out, 0, scr, r, 32, F.lane); continue; } r -= I_OUT;
        if (r < I_Q) { transpose_item<2>(a.in[17], 256, 512, Wt_q, 0, scr, r, 16, F.lane); continue; } r -= I_Q;
        if (r < I_Q) { transpose_item<3>(a.in[18], 256, 512, Wt_q, 512, scr, r, 16, F.lane); continue; } r -= I_Q;
        if (r < I_W2) { transpose_item<0>(a.in[7], 64, 512, Wt_w2, 0, scr, r, 16, F.lane); continue; } r -= I_W2;
        if (r < I_W2) { transpose_item<0>(a.in[9], 64, 512, Wt_a2, 0, scr, r, 16, F.lane); continue; } r -= I_W2;
        transpose_item<0>(a.in[10], 128, 512, Wt_g2, 0, scr, r, 16, F.lane);
    }
    float2* rowstat = (float2*)(F.ws + WS_ROWSTAT);
    for (int pr = gw; pr < TP; pr += NGW) p0_ln_row(a, pr, H0b, rowstat, F.lane);
    float2* rq = (float2*)(F.ws + WS_ROPEQ); float2* ri = (float2*)(F.ws + WS_ROPEI);
    const int gt = F.bid * NTHR + F.tid, NGT = F.G * NTHR;
    for (int i = gt; i < LP * 48; i += NGT) {
        if (i < LP * 32) { const int t = i >> 5, d = i & 31; const float ang = (float)t * exp2f(-(float)d * (13.287712379549449f / 32.f)); float sn, cs; sincosf(ang, &sn, &cs); rq[i] = make_float2(cs, sn); }
        else { const int j = i - LP * 32, t = j >> 4, d = j & 15; const float ang = (float)t * exp2f(-(float)d * (13.287712379549449f / 16.f)); float sn, cs; sincosf(ang, &sn, &cs); ri[j] = make_float2(cs, sn); }
    }
}
constexpr int LDM = 72;
constexpr int SLOT = 64 * LDM * 2;
constexpr int LDG = 136;
constexpr int RW_LW_OFF = 0 * SLOT;
constexpr int RW_LA_OFF = 4 * SLOT;
constexpr int RW_LG_OFF = 2 * SLOT;
static_assert(64 * LDG * 2 <= 2 * SLOT, "Lg fits in two slots");
constexpr int RW_A_OFF = 8 * SLOT;
constexpr int RW_G_OFF = RW_A_OFF + 16384;
constexpr int RW_CS_OFF = RW_G_OFF + 8192;
constexpr int RW_SEG_OFF = RW_CS_OFF + 16384;
constexpr int RW_GC_OFF = 13 * SLOT;
static_assert(RW_SEG_OFF + 2048 <= RW_GC_OFF, "rwkv LDS map");
constexpr size_t RW_UNIT_M = 4096 * 2, RW_UNIT_N = 4096 * 4, RW_UNIT_X = 4096 * 2;
constexpr int NUNIT = NB * NCH * 8;

struct RwkvBufs { bf16* M; float* N; bf16* Q; bf16* OP; bf16* G1; bf16* G2; bf16* HC; };

__device__ __forceinline__ bf16x8 lds_frag(const LAS bf16* base, int row, int koff) { return *(const LAS bf16x8*)(base + row * LDM + koff); }
__device__ __forceinline__ f32x4 mm_tile(const LAS bf16* X, const LAS bf16* Y, int ta, int tb, int lane, f32x4 acc) {
    const int r = lane & 15, ko = 8 * (lane >> 4);
#pragma unroll
    for (int ks = 0; ks < 2; ++ks) {
        const bf16x8 ya = lds_frag(Y, 16 * tb + r, 32 * ks + ko), xb = lds_frag(X, 16 * ta + r, 32 * ks + ko);
        acc = __builtin_amdgcn_mfma_f32_16x16x32_bf16(ya, xb, acc, 0, 0, 0);
    }
    return acc;
}
__device__ __forceinline__ void st_r(LAS bf16* dst, int a, int b0, f32x4 v) {
    v2u w; w.x = pk2(v[0], v[1]); w.y = pk2(v[2], v[3]); *(LAS v2u*)(dst + a * LDM + b0) = w;
}
__device__ __forceinline__ void st_t(LAS bf16* dst, int a, int b0, f32x4 v) {
#pragma unroll
    for (int i = 0; i < 4; ++i) dst[(b0 + i) * LDM + a] = (bf16)f2bf(v[i]);
}
__device__ __forceinline__ f32x4 ld_r(const LAS bf16* src, int a, int b0) {
    const v2u w = *(const LAS v2u*)(src + a * LDM + b0);
    return (f32x4){bflo(w.x), bfhi(w.x), bflo(w.y), bfhi(w.y)};
}
__device__ __forceinline__ void st8(LAS bf16* dst, const float (&v)[8]) {
    v4u w; w.x = pk2(v[0], v[1]); w.y = pk2(v[2], v[3]); w.z = pk2(v[4], v[5]); w.w = pk2(v[6], v[7]); *(LAS v4u*)dst = w;
}
__device__ __forceinline__ void unpack8(v4u w, float (&o)[8]) {
    o[0] = bflo(w.x); o[1] = bfhi(w.x); o[2] = bflo(w.y); o[3] = bfhi(w.y); o[4] = bflo(w.z); o[5] = bfhi(w.z); o[6] = bflo(w.w); o[7] = bfhi(w.w);
}
__device__ __forceinline__ void ld8f(const float* p, float (&o)[8]) {
    const f32x4 a = *(const f32x4*)p, b = *(const f32x4*)(p + 4);
    o[0] = a.x; o[1] = a.y; o[2] = a.z; o[3] = a.w; o[4] = b.x; o[5] = b.y; o[6] = b.z; o[7] = b.w;
}
__device__ __forceinline__ float sigmoidf_(float x) { return __builtin_amdgcn_rcpf(1.f + __expf(-x)); }
__device__ __forceinline__ float tanhf_(float x) { return 1.f - 2.f * __builtin_amdgcn_rcpf(1.f + __expf(2.f * x)); }

constexpr int RW_WG2_OFF = 13 * SLOT, RW_WB_OFF = 13 * SLOT + 64 * LDG * 2, RW_WW2_OFF = 15 * SLOT, RW_WA2_OFF = 1 * SLOT;
static_assert(RW_WB_OFF + 512 <= 15 * SLOT, "LoRA weights LDS map");
constexpr int RW_MU_OFF = 12 * SLOT;
struct RwW { v4u v[4]; float mu, bias; };
__device__ __forceinline__ void rw_w_fetch(RwW& W, const Frame& F, const Args& a, int h) {
    const bf16* W2 = (const bf16*)(F.ws + WS_WW2); const bf16* A2 = (const bf16*)(F.ws + WS_WA2); const bf16* G2w = (const bf16*)(F.ws + WS_WG2);
    const int t = F.tid;
    W.v[0] = *(const v4u*)(W2 + (size_t)(64 * h + (t >> 3)) * 64 + 8 * (t & 7));
    W.v[1] = *(const v4u*)(A2 + (size_t)(64 * h + (t >> 3)) * 64 + 8 * (t & 7));
    W.v[2] = *(const v4u*)(G2w + (size_t)(64 * h + (t >> 4)) * 128 + 8 * (t & 15));
    W.v[3] = *(const v4u*)(G2w + (size_t)(64 * h + 32 + (t >> 4)) * 128 + 8 * (t & 15));
    W.mu = (t < 192) ? a.in[5][512 * (t >> 6) + 64 * h + (t & 63)] : ((t < 448) ? a.in[5][1536 + (t - 192)] : a.in[11][64 * h + (t - 448)]);
    W.bias = (t < 64) ? a.in[6][64 * h + t] : ((t < 128) ? a.in[8][64 * h + (t - 64)] : 0.f);
}
__device__ __forceinline__ void rw_w_store(const RwW& W, const Frame& F) {
    const int t = F.tid;
    *(LAS v4u*)(F.lds + RW_WW2_OFF + ((t >> 3) * LDM + 8 * (t & 7)) * 2) = W.v[0];
    *(LAS v4u*)(F.lds + RW_WA2_OFF + ((t >> 3) * LDM + 8 * (t & 7)) * 2) = W.v[1];
    *(LAS v4u*)(F.lds + RW_WG2_OFF + ((t >> 4) * LDG + 8 * (t & 15)) * 2) = W.v[2];
    *(LAS v4u*)(F.lds + RW_WG2_OFF + ((32 + (t >> 4)) * LDG + 8 * (t & 15)) * 2) = W.v[3];
    if (t < 128) *(LAS float*)(F.lds + RW_WB_OFF + 4 * t) = W.bias;
    *(LAS float*)(F.lds + RW_MU_OFF + 4 * t) = W.mu;
}
struct RwRaw { v4u c[7], p[7]; };
__device__ __forceinline__ void rw_load_raw(RwRaw& R, const bf16* __restrict__ Ur, int uidx, int tid) {
    const int h = uidx & 7, bc = uidx >> 3, c = bc % NCH, b = bc / NCH, tau = tid >> 3, q = tid & 7;
    const size_t prow = (size_t)b * LP + (size_t)c * 64 + tau;
    const bool has_prev = (c > 0) || (tau > 0);
    const bf16* ucur = Ur + prow * UR_W; const bf16* uprv = ucur - UR_W;
    const v4u z = {0u, 0u, 0u, 0u};
#pragma unroll
    for (int j = 0; j < 7; ++j) { const int col = (j < 3) ? (512 * j + 64 * h + 8 * q) : (1536 + 64 * (j - 3) + 8 * q);
        R.c[j] = *(const v4u*)(ucur + col); R.p[j] = has_prev ? *(const v4u*)(uprv + col) : z; }
}
__device__ __forceinline__ void rwkv_unit(const Frame& F, const Args& a, const bf16* __restrict__ Ur, const RwkvBufs& RB, int uidx, RwRaw& R, int unext) {
    const int h = uidx & 7, bc = uidx >> 3, c = bc % NCH, b = bc / NCH;
    const int tid = F.tid, lane = F.lane, w = F.wave;
    LAS unsigned char* lds = F.lds;
#define MAT(i) ((LAS bf16*)(lds + (i) * SLOT))
    LAS bf16 *Rg = MAT(0), *Kg = MAT(1), *KgT = MAT(2), *Bi = MAT(3), *nBiT = MAT(4), *Ki = MAT(5), *KiT = MAT(6), *VT = MAT(7);
    LAS bf16 *Akk = MAT(8), *nArb = MAT(9), *Ark = MAT(10), *Pa = MAT(11), *PaT = MAT(12), *Pb = MAT(13), *PbT = MAT(14), *Ta = MAT(15), *Tb = MAT(1);
    LAS bf16 *AVT = MAT(3), *WuT = MAT(5), *UvT = MAT(8);
    LAS bf16* Lw = (LAS bf16*)(lds + RW_LW_OFF); LAS bf16* La = (LAS bf16*)(lds + RW_LA_OFF); LAS bf16* Lg = (LAS bf16*)(lds + RW_LG_OFF);
    LAS float* Af = (LAS float*)(lds + RW_A_OFF); LAS bf16* Gb = (LAS bf16*)(lds + RW_G_OFF); LAS float* CS = (LAS float*)(lds + RW_CS_OFF);
    LAS float* gC = (LAS float*)(lds + RW_GC_OFF); LAS float* SEG = (LAS float*)(lds + RW_SEG_OFF);
    const float* mu = a.in[5];
    const int ta = w >> 1, ar = 16 * ta + (lane & 15), ko = 8 * (lane >> 4);
    const int tau = tid >> 3, q = tid & 7;
    float r8[8], k8[8], v8[8], kk8[8];
    {
        float cu[8], pv[8], m8[8];
        const int ch0 = 64 * h + 8 * q;
        const LAS float* MUL = (const LAS float*)(lds + RW_MU_OFF);
#define RW_LD8L(p_, o_) do { const f32x4 x0_ = *(const LAS f32x4*)(p_), x1_ = *(const LAS f32x4*)((p_) + 4); o_[0] = x0_.x; o_[1] = x0_.y; o_[2] = x0_.z; o_[3] = x0_.w; o_[4] = x1_.x; o_[5] = x1_.y; o_[6] = x1_.z; o_[7] = x1_.w; } while (0)
        unpack8(R.c[0], cu); unpack8(R.p[0], pv);
        RW_LD8L(MUL + 8 * q, m8);
#pragma unroll
        for (int i = 0; i < 8; ++i) r8[i] = cu[i] + (pv[i] - cu[i]) * m8[i];
        unpack8(R.c[1], cu); unpack8(R.p[1], pv);
        RW_LD8L(MUL + 64 + 8 * q, m8);
#pragma unroll
        for (int i = 0; i < 8; ++i) k8[i] = cu[i] + (pv[i] - cu[i]) * m8[i];
        unpack8(R.c[2], cu); unpack8(R.p[2], pv);
        RW_LD8L(MUL + 128 + 8 * q, m8);
#pragma unroll
        for (int i = 0; i < 8; ++i) v8[i] = cu[i] + (pv[i] - cu[i]) * m8[i];
        float kkc[8]; RW_LD8L(MUL + 448 + 8 * q, kkc);
        float ss = 0.f;
#pragma unroll
        for (int i = 0; i < 8; ++i) { kk8[i] = k8[i] * kkc[i]; ss += kk8[i] * kk8[i]; }
        ss = sum8(ss);
        const float inv = 1.f / fmaxf(sqrtf(ss), 1e-12f);
#pragma unroll
        for (int i = 0; i < 8; ++i) kk8[i] *= inv;
#pragma unroll
        for (int i = 0; i < 4; ++i) {
            const int col = 1536 + 64 * i + 8 * q;
            unpack8(R.c[3 + i], cu); unpack8(R.p[3 + i], pv);
            RW_LD8L(MUL + 192 + 64 * i + 8 * q, m8);
            float o[8];
#pragma unroll
            for (int e = 0; e < 8; ++e) { const float x = cu[e] + (pv[e] - cu[e]) * m8[e]; o[e] = (i == 0) ? tanhf_(x) : (i == 1 ? x : sigmoidf_(x)); }
            if (i == 0) st8(Lw + tau * LDM + 8 * q, o);
            else if (i == 1) st8(La + tau * LDM + 8 * q, o);
            else st8(Lg + tau * LDG + 64 * (i - 2) + 8 * q, o);
        }
    }
    LDS_WAIT(); __syncthreads();
    {
        const LAS bf16* W2L = (const LAS bf16*)(lds + RW_WW2_OFF); const LAS bf16* A2L = (const LAS bf16*)(lds + RW_WA2_OFF); const LAS bf16* G2L = (const LAS bf16*)(lds + RW_WG2_OFF);
#pragma unroll 1
        for (int tt = 0; tt < 2; ++tt) {
            const int tb = 2 * (w & 1) + tt, b0 = 16 * tb + 4 * (lane >> 4), chl = 16 * tb + (lane & 15);
            f32x4 aw = {0.f, 0.f, 0.f, 0.f}, aa = aw, ag = aw;
#pragma unroll
            for (int ks = 0; ks < 2; ++ks) {
                const bf16x8 yw = *(const LAS bf16x8*)(W2L + chl * LDM + 32 * ks + ko), ya = *(const LAS bf16x8*)(A2L + chl * LDM + 32 * ks + ko);
                const bf16x8 xw = *(const LAS bf16x8*)(Lw + ar * LDM + 32 * ks + ko), xa = *(const LAS bf16x8*)(La + ar * LDM + 32 * ks + ko);
                aw = __builtin_amdgcn_mfma_f32_16x16x32_bf16(yw, xw, aw, 0, 0, 0);
                aa = __builtin_amdgcn_mfma_f32_16x16x32_bf16(ya, xa, aa, 0, 0, 0);
            }
#pragma unroll
            for (int ks = 0; ks < 4; ++ks) {
                const bf16x8 yg = *(const LAS bf16x8*)(G2L + chl * LDG + 32 * ks + ko);
                const bf16x8 xg = *(const LAS bf16x8*)(Lg + ar * LDG + 32 * ks + ko);
                ag = __builtin_amdgcn_mfma_f32_16x16x32_bf16(yg, xg, ag, 0, 0, 0);
            }
            const f32x4 w0v = *(const LAS f32x4*)(lds + RW_WB_OFF + 4 * b0), a0v = *(const LAS f32x4*)(lds + RW_WB_OFF + 256 + 4 * b0);
            f32x4 lw, av;
#pragma unroll
            for (int i = 0; i < 4; ++i) {
                const float xw = -(w0v[i] + aw[i]);
                const float sp = (xw > 20.f) ? xw : __logf(1.f + __expf(xw));
                lw[i] = -__expf(-sp - 0.5f);
                av[i] = sigmoidf_(a0v[i] + aa[i]);
            }
            *(LAS f32x4*)(CS + ar * 64 + b0) = lw;
            *(LAS f32x4*)(Af + ar * 64 + b0) = av;
            v2u gw; gw.x = pk2(ag[0], ag[1]); gw.y = pk2(ag[2], ag[3]); *(LAS v2u*)(Gb + ar * 64 + b0) = gw;
        }
    }
    float kac[8], rkc[8], lng[8], lnb[8];
    { const int ch0_ = 64 * h + 8 * (tid & 7); ld8f(a.in[12] + ch0_, kac); ld8f(a.in[13] + ch0_, rkc); ld8f(a.in[14] + ch0_, lng); ld8f(a.in[15] + ch0_, lnb); }
    LDS_WAIT(); __syncthreads();
    {
        const int j = tid & 63, sg = tid >> 6;
        float run = 0.f;
#pragma unroll
        for (int i = 0; i < 8; ++i) { run += CS[(8 * sg + i) * 64 + j]; CS[(8 * sg + i) * 64 + j] = run; }
        SEG[sg * 64 + j] = run;
        LDS_WAIT(); __syncthreads();
        float off = 0.f;
        for (int s = 0; s < sg; ++s) off += SEG[s * 64 + j];
#pragma unroll
        for (int i = 0; i < 8; ++i) CS[(8 * sg + i) * 64 + j] += off;
    }
    LDS_WAIT(); __syncthreads();
    {
        float cs[8], csp[8], av[8], gt[8];
        { const LAS f32x4* p = (const LAS f32x4*)(CS + tau * 64 + 8 * q); const f32x4 x0 = p[0], x1 = p[1];
          cs[0] = x0.x; cs[1] = x0.y; cs[2] = x0.z; cs[3] = x0.w; cs[4] = x1.x; cs[5] = x1.y; cs[6] = x1.z; cs[7] = x1.w; }
        if (tau > 0) { const LAS f32x4* p = (const LAS f32x4*)(CS + (tau - 1) * 64 + 8 * q); const f32x4 x0 = p[0], x1 = p[1];
          csp[0] = x0.x; csp[1] = x0.y; csp[2] = x0.z; csp[3] = x0.w; csp[4] = x1.x; csp[5] = x1.y; csp[6] = x1.z; csp[7] = x1.w; }
        else {
#pragma unroll
          for (int i = 0; i < 8; ++i) csp[i] = 0.f; }
        { const LAS f32x4* p = (const LAS f32x4*)(Af + tau * 64 + 8 * q); const f32x4 x0 = p[0], x1 = p[1];
          av[0] = x0.x; av[1] = x0.y; av[2] = x0.z; av[3] = x0.w; av[4] = x1.x; av[5] = x1.y; av[6] = x1.z; av[7] = x1.w; }
        unpack8(*(const LAS v4u*)(Gb + tau * 64 + 8 * q), gt);
        float o_rg[8], o_kg[8], o_bi[8], o_ki[8];
        float bon = 0.f;
#pragma unroll
        for (int i = 0; i < 8; ++i) {
            const float g = __expf(cs[i]), gi = __expf(-cs[i]), gm = __expf(csp[i]);
            o_rg[i] = r8[i] * g; o_kg[i] = kk8[i] * gm;
            const float bb = kk8[i] * av[i]; o_bi[i] = bb * gi;
            const float kt = k8[i] * (1.f + (av[i] - 1.f) * kac[i]); o_ki[i] = kt * gi;
            bon += r8[i] * kt * rkc[i];
            if (tau == 63) gC[8 * q + i] = g;
        }
        bon = sum8(bon);
        st8(Rg + tau * LDM + 8 * q, o_rg); st8(Kg + tau * LDM + 8 * q, o_kg); st8(Bi + tau * LDM + 8 * q, o_bi); st8(Ki + tau * LDM + 8 * q, o_ki);
#pragma unroll
        for (int i = 0; i < 8; ++i) {
            const int j = 8 * q + i;
            KgT[j * LDM + tau] = (bf16)f2bf(o_kg[i]); nBiT[j * LDM + tau] = (bf16)f2bf(-o_bi[i]); KiT[j * LDM + tau] = (bf16)f2bf(o_ki[i]); VT[j * LDM + tau] = (bf16)f2bf(v8[i]);
        }
        float g1[8], g2[8];
#pragma unroll
        for (int i = 0; i < 8; ++i) { g1[i] = lng[i] * gt[i]; g2[i] = (lnb[i] + bon * v8[i]) * gt[i]; }
        v4u w1; w1.x = pk2(g1[0], g1[1]); w1.y = pk2(g1[2], g1[3]); w1.z = pk2(g1[4], g1[5]); w1.w = pk2(g1[6], g1[7]);
        v4u w2; w2.x = pk2(g2[0], g2[1]); w2.y = pk2(g2[2], g2[3]); w2.z = pk2(g2[4], g2[5]); w2.w = pk2(g2[6], g2[7]);
        *(v4u*)(RB.G1 + (size_t)uidx * 4096 + tau * 64 + 8 * q) = w1;
        *(v4u*)(RB.G2 + (size_t)uidx * 4096 + tau * 64 + 8 * q) = w2;
    }
    LDS_WAIT(); __syncthreads();
    const f32x4 zero4 = {0.f, 0.f, 0.f, 0.f};
    const float gj = gC[ar];
    if (unext >= 0) rw_load_raw(R, Ur, unext, tid);
#pragma unroll 1
    for (int tt = 0; tt < 2; ++tt) {
        const int tb = 2 * (w & 1) + tt, b0 = 16 * tb + 4 * (lane >> 4);
        f32x4 zkb = mm_tile(Kg, Bi, ta, tb, lane, zero4), zkk = mm_tile(Kg, Ki, ta, tb, lane, zero4);
        f32x4 zrb = mm_tile(Rg, Bi, ta, tb, lane, zero4), zrk = mm_tile(Rg, Ki, ta, tb, lane, zero4);
        f32x4 p0, t0;
#pragma unroll
        for (int i = 0; i < 4; ++i) {
            const int s = b0 + i;
            p0[i] = (s < ar) ? -zkb[i] : 0.f; t0[i] = p0[i] + ((s == ar) ? 1.f : 0.f);
            zkk[i] = (s < ar) ? zkk[i] : 0.f; zrb[i] = (s <= ar) ? -zrb[i] : 0.f; zrk[i] = (s <= ar) ? zrk[i] : 0.f;
        }
        st_r(Pa, ar, b0, p0); st_t(PaT, ar, b0, p0); st_r(Ta, ar, b0, t0); st_r(Akk, ar, b0, zkk); st_r(nArb, ar, b0, zrb); st_r(Ark, ar, b0, zrk);
    }
    LDS_WAIT(); __syncthreads();
#pragma unroll 1
    for (int tt = 0; tt < 2; ++tt) {
        const int tb = 2 * (w & 1) + tt, b0 = 16 * tb + 4 * (lane >> 4);
        const f32x4 p = mm_tile(Pa, PaT, ta, tb, lane, zero4); st_r(Pb, ar, b0, p); st_t(PbT, ar, b0, p);
        const f32x4 av = mm_tile(VT, Akk, ta, tb, lane, zero4); st_r(AVT, ar, b0, av);
    }
    LDS_WAIT(); __syncthreads();
#define RW_SQ_ACC(Pin, PinT, Pout, PoutT, Tin, Tout, DO_SQ) do { _Pragma("unroll 1") for (int tt = 0; tt < 2; ++tt) { \
        const int tb = 2 * (w & 1) + tt, b0 = 16 * tb + 4 * (lane >> 4); \
        if (DO_SQ) { const f32x4 p = mm_tile(Pin, PinT, ta, tb, lane, zero4); st_r(Pout, ar, b0, p); st_t(PoutT, ar, b0, p); } \
        const f32x4 tn = mm_tile(Tin, PinT, ta, tb, lane, ld_r(Tin, ar, b0)); st_r(Tout, ar, b0, tn); } \
        LDS_WAIT(); __syncthreads(); } while (0)
    RW_SQ_ACC(Pb, PbT, Pa, PaT, Ta, Tb, true);
    RW_SQ_ACC(Pa, PaT, Pb, PbT, Tb, Ta, true);
    RW_SQ_ACC(Pb, PbT, Pa, PaT, Ta, Tb, true);
    RW_SQ_ACC(Pa, PaT, Pb, PbT, Tb, Ta, true);
    RW_SQ_ACC(Pb, PbT, Pa, PaT, Ta, Tb, false);
#undef RW_SQ_ACC
#pragma unroll 1
    for (int tt = 0; tt < 2; ++tt) {
        const int tb = 2 * (w & 1) + tt, b0 = 16 * tb + 4 * (lane >> 4);
        st_r(WuT, ar, b0, mm_tile(KgT, Tb, ta, tb, lane, zero4));
        st_r(UvT, ar, b0, mm_tile(AVT, Tb, ta, tb, lane, zero4));
    }
    LDS_WAIT(); __syncthreads();
    RwW Wn; if (unext >= 0) rw_w_fetch(Wn, F, a, unext & 7);
#pragma unroll 1
    for (int tt = 0; tt < 2; ++tt) {
        const int tb = 2 * (w & 1) + tt, b0 = 16 * tb + 4 * (lane >> 4);
        { const f32x4 z = mm_tile(nBiT, WuT, ta, tb, lane, zero4);
          const int m = ar >> 5, rp = ar & 31;
          bf16* Mo = RB.M + (size_t)uidx * 4096;
          float v4[4];
#pragma unroll
          for (int i = 0; i < 4; ++i) { const int jp = b0 + i; v4[i] = gj * (z[i] + ((jp == ar) ? 1.f : 0.f)); }
          { const int kb = b0 >> 5, qq = b0 & 31, s_ = qq >> 4, p = qq & 15, e0 = 4 * (p >> 3), hh = (p >> 2) & 1, ln = rp + 32 * hh;
            v2u w; w.x = pk2(v4[0], v4[1]); w.y = pk2(v4[2], v4[3]);
            *(v2u*)(Mo + ((((m * 2 + kb) * 2 + s_) * 64 + ln) << 3) + e0) = w; } }
        { f32x4 z = mm_tile(KiT, VT, ta, tb, lane, zero4); z = mm_tile(nBiT, UvT, ta, tb, lane, z);
          const int m = ar >> 5, qq = ar & 31, hh = (qq >> 2) & 1, rg = (qq & 3) + 4 * (qq >> 3);
          float* No = RB.N + (size_t)uidx * 4096;
          { const int n = b0 >> 5, cc = b0 & 31; *(f32x4*)(No + ((m * 2 + n) * 16 + rg) * 64 + cc + 32 * hh) = z * gj; } }
        { const f32x4 z = mm_tile(nArb, WuT, ta, tb, lane, ld_r(Rg, ar, b0)); v2u o; o.x = pk2(z[0], z[1]); o.y = pk2(z[2], z[3]);
          *(v2u*)(RB.Q + (size_t)uidx * 4096 + ar * 64 + b0) = o; }
        { f32x4 z = mm_tile(Ark, VT, ta, tb, lane, zero4); z = mm_tile(nArb, UvT, ta, tb, lane, z); v2u o; o.x = pk2(z[0], z[1]); o.y = pk2(z[2], z[3]);
          *(v2u*)(RB.OP + (size_t)uidx * 4096 + ar * 64 + b0) = o; }
    }
    if (unext >= 0) rw_w_store(Wn, F);
    LDS_WAIT(); __syncthreads();
#undef MAT
}

__device__ __forceinline__ void rwkv_scan(const RwkvBufs& RB, int bh, int n, int lane) {
    const int b = bh >> 3, h = bh & 7;
    f32x16 X0, X1;
#pragma unroll
    for (int r = 0; r < 16; ++r) { X0[r] = 0.f; X1[r] = 0.f; }
    const int cc = lane & 31, hh = lane >> 5;
    bf16x8 Mc[2][2][2], Mn[2][2][2]; f32x16 N0, N1, N0n, N1n;
    {
        const int uidx = ((b * NCH) << 3) + h;
        const bf16* Mi = RB.M + (size_t)uidx * 4096; const float* Ni = RB.N + (size_t)uidx * 4096;
#pragma unroll
        for (int m = 0; m < 2; ++m)
#pragma unroll
            for (int kb = 0; kb < 2; ++kb)
#pragma unroll
                for (int s = 0; s < 2; ++s) Mc[m][kb][s] = *(const bf16x8*)(Mi + ((((m * 2 + kb) * 2 + s) * 64 + lane) << 3));
#pragma unroll
        for (int r = 0; r < 16; ++r) { N0[r] = Ni[((0 * 2 + n) * 16 + r) * 64 + lane]; N1[r] = Ni[((1 * 2 + n) * 16 + r) * 64 + lane]; }
    }
#pragma unroll 1
    for (int c = 0; c < NCH; ++c) {
        const int uidx = ((b * NCH + c) << 3) + h;
        {
            const int un = ((b * NCH + min(c + 1, NCH - 1)) << 3) + h;
            const bf16* Mi = RB.M + (size_t)un * 4096; const float* Ni = RB.N + (size_t)un * 4096;
#pragma unroll
            for (int m = 0; m < 2; ++m)
#pragma unroll
                for (int kb = 0; kb < 2; ++kb)
#pragma unroll
                    for (int s = 0; s < 2; ++s) Mn[m][kb][s] = *(const bf16x8*)(Mi + ((((m * 2 + kb) * 2 + s) * 64 + lane) << 3));
#pragma unroll
            for (int r = 0; r < 16; ++r) { N0n[r] = Ni[((0 * 2 + n) * 16 + r) * 64 + lane]; N1n[r] = Ni[((1 * 2 + n) * 16 + r) * 64 + lane]; }
        }
        bf16* Ho = RB.HC + (size_t)uidx * 4096 + (size_t)(32 * n + cc) * 64;
#pragma unroll
        for (int g = 0; g < 4; ++g) {
            v2u w0; w0.x = pk2(X0[4 * g], X0[4 * g + 1]); w0.y = pk2(X0[4 * g + 2], X0[4 * g + 3]); *(v2u*)(Ho + 8 * g + 4 * hh) = w0;
            v2u w1; w1.x = pk2(X1[4 * g], X1[4 * g + 1]); w1.y = pk2(X1[4 * g + 2], X1[4 * g + 3]); *(v2u*)(Ho + 32 + 8 * g + 4 * hh) = w1;
        }
        bf16x8 bf[2][2];
#pragma unroll
        for (int s = 0; s < 2; ++s) {
            v4u t0; t0.x = pk2(X0[8 * s], X0[8 * s + 1]); t0.y = pk2(X0[8 * s + 2], X0[8 * s + 3]); t0.z = pk2(X0[8 * s + 4], X0[8 * s + 5]); t0.w = pk2(X0[8 * s + 6], X0[8 * s + 7]);
            v4u t1; t1.x = pk2(X1[8 * s], X1[8 * s + 1]); t1.y = pk2(X1[8 * s + 2], X1[8 * s + 3]); t1.z = pk2(X1[8 * s + 4], X1[8 * s + 5]); t1.w = pk2(X1[8 * s + 6], X1[8 * s + 7]);
            bf[0][s] = __builtin_bit_cast(bf16x8, t0); bf[1][s] = __builtin_bit_cast(bf16x8, t1);
        }
        f32x16 Y0 = N0, Y1 = N1;
#pragma unroll
        for (int kb = 0; kb < 2; ++kb)
#pragma unroll
            for (int s = 0; s < 2; ++s) {
                Y0 = __builtin_amdgcn_mfma_f32_32x32x16_bf16(Mc[0][kb][s], bf[kb][s], Y0, 0, 0, 0);
                Y1 = __builtin_amdgcn_mfma_f32_32x32x16_bf16(Mc[1][kb][s], bf[kb][s], Y1, 0, 0, 0);
            }
        X0 = Y0; X1 = Y1;
#pragma unroll
        for (int m = 0; m < 2; ++m)
#pragma unroll
            for (int kb = 0; kb < 2; ++kb)
#pragma unroll
                for (int s = 0; s < 2; ++s) Mc[m][kb][s] = Mn[m][kb][s];
        N0 = N0n; N1 = N1n;
    }
}

template <class OutF> __device__ __forceinline__ void rwkv_out_unit(const RwkvBufs& RB, int uidx, int lane, const OutF& outf) {
    const int h = uidx & 7, bc = uidx >> 3, c = bc % NCH, b = bc / NCH;
    const bf16* Q = RB.Q + (size_t)uidx * 4096; const bf16* HT = RB.HC + (size_t)uidx * 4096; const bf16* OP = RB.OP + (size_t)uidx * 4096;
    const bf16* G1 = RB.G1 + (size_t)uidx * 4096; const bf16* G2 = RB.G2 + (size_t)uidx * 4096;
    const int r = lane & 15, ko = 8 * (lane >> 4);
    bf16x8 yh[4][2];
#pragma unroll
    for (int tb = 0; tb < 4; ++tb)
#pragma unroll
        for (int ks = 0; ks < 2; ++ks) yh[tb][ks] = *(const bf16x8*)(HT + (16 * tb + r) * 64 + 32 * ks + ko);
#pragma unroll 2
    for (int ta = 0; ta < 4; ++ta) {
        const int t = 16 * ta + r;
        bf16x8 xq[2];
        xq[0] = *(const bf16x8*)(Q + t * 64 + ko); xq[1] = *(const bf16x8*)(Q + t * 64 + 32 + ko);
        f32x4 o[4]; float s = 0.f;
#pragma unroll
        for (int tb = 0; tb < 4; ++tb) {
            const int i0 = 16 * tb + 4 * (lane >> 4);
            const v2u ow = *(const v2u*)(OP + t * 64 + i0);
            f32x4 acc = {bflo(ow.x), bfhi(ow.x), bflo(ow.y), bfhi(ow.y)};
#pragma unroll
            for (int ks = 0; ks < 2; ++ks) acc = __builtin_amdgcn_mfma_f32_16x16x32_bf16(yh[tb][ks], xq[ks], acc, 0, 0, 0);
            o[tb] = acc; s += (acc[0] + acc[1]) + (acc[2] + acc[3]);
        }
        s = sum_x32(sum_x16(s));
        const float mean = s * (1.f / 64.f); float qv = 0.f;
#pragma unroll
        for (int tb = 0; tb < 4; ++tb) { o[tb] = o[tb] - mean; qv += (o[tb][0] * o[tb][0] + o[tb][1] * o[tb][1]) + (o[tb][2] * o[tb][2] + o[tb][3] * o[tb][3]); }
        qv = sum_x32(sum_x16(qv));
        const float rstd = rsqrtf(qv * (1.f / 64.f) + GN_EPS);
        const int tg = c * 64 + t;
#pragma unroll
        for (int tb = 0; tb < 4; ++tb) {
            const int i0 = 16 * tb + 4 * (lane >> 4);
            const v2u g1 = *(const v2u*)(G1 + t * 64 + i0), g2 = *(const v2u*)(G2 + t * 64 + i0);
            f32x4 y;
            y[0] = o[tb][0] * rstd * bflo(g1.x) + bflo(g2.x); y[1] = o[tb][1] * rstd * bfhi(g1.x) + bfhi(g2.x);
            y[2] = o[tb][2] * rstd * bflo(g1.y) + bflo(g2.y); y[3] = o[tb][3] * rstd * bfhi(g1.y) + bfhi(g2.y);
            if (tg < L) outf(b, tg, 64 * h + i0, y);
        }
    }
}
constexpr int MW = 264;
constexpr float QSCALE = 0.125f * 1.4426950408889634f;
struct AttBufs { bf16* Q; bf16* QI; unsigned short* MASK; bf16* KX; };

constexpr int LDQ = 264;
__device__ __forceinline__ void att_prep_unit(const Frame& F, const Args& a, bf16* Ua, const AttBufs& AB, int tile) {
    const int tid = F.tid, lane = F.lane, w = F.wave;
    LAS bf16* CQ = (LAS bf16*)F.lds;
    LAS f32x2_t* RQL = (LAS f32x2_t*)(F.lds + 34816);
    LAS f32x2_t* RIL = (LAS f32x2_t*)(F.lds + 34816 + 64 * 33 * 8);
    const int tau = tid >> 3, q = tid & 7;
    const size_t prow = (size_t)tile * 64 + tau;
    const int tpos = (int)(prow % LP);
    bf16* urow = Ua + prow * UA_W;
    const float2* rq = (const float2*)(F.ws + WS_ROPEQ) + (size_t)tpos * 32;
    const float2* ri = (const float2*)(F.ws + WS_ROPEI) + (size_t)tpos * 16;
    { const int t0p = (int)(((size_t)tile * 64) % LP);
      const f32x2_t* gq = (const f32x2_t*)(F.ws + WS_ROPEQ) + (size_t)t0p * 32; const f32x2_t* gi = (const f32x2_t*)(F.ws + WS_ROPEI) + (size_t)t0p * 16;
      for (int i = tid; i < 64 * 32; i += NTHR) RQL[(i >> 5) * 33 + (i & 31)] = gq[i];
      for (int i = tid; i < 64 * 16; i += NTHR) RIL[(i >> 4) * 17 + (i & 15)] = gi[i]; }
    {
        float x[4][8]; float ss = 0.f;
#pragma unroll
        for (int i = 0; i < 4; ++i) { unpack8(*(const v4u*)(urow + 64 * i + 8 * q), x[i]);
#pragma unroll
            for (int e = 0; e < 8; ++e) ss += x[i][e] * x[i][e]; }
        ss = sum8(ss);
        const float rs = rsqrtf(ss * (1.f / 256.f) + RMS_EPS);
#pragma unroll
        for (int i = 0; i < 4; ++i) { float g8[8], o[8]; ld8f(a.in[16] + 64 * i + 8 * q, g8);
#pragma unroll
            for (int e = 0; e < 8; ++e) o[e] = x[i][e] * rs * g8[e];
            st8(CQ + tau * LDQ + 64 * i + 8 * q, o); }
    }
#pragma unroll
    for (int i = 0; i < 8; ++i) {
        const int col = 8 * (q + 8 * i); float x[8], o[8];
        unpack8(*(const v4u*)(urow + 256 + col), x);
        const int d0 = (col & 63) >> 1;
#pragma unroll
        for (int pp = 0; pp < 4; ++pp) { const float2 cs = rq[d0 + pp]; o[2 * pp] = x[2 * pp] * cs.x - x[2 * pp + 1] * cs.y; o[2 * pp + 1] = x[2 * pp + 1] * cs.x + x[2 * pp] * cs.y; }
        v4u wv; wv.x = pk2(o[0], o[1]); wv.y = pk2(o[2], o[3]); wv.z = pk2(o[4], o[5]); wv.w = pk2(o[6], o[7]);
        *(v4u*)(urow + 256 + col) = wv;
    }
    {
        float x[8]; unpack8(*(const v4u*)(urow + 1280 + 8 * q), x);
        float s = 0.f;
#pragma unroll
        for (int e = 0; e < 8; ++e) s += x[e];
        s = sum8(s);
        const float mean = s * (1.f / 64.f); float qv = 0.f;
#pragma unroll
        for (int e = 0; e < 8; ++e) { x[e] -= mean; qv += x[e] * x[e]; }
        qv = sum8(qv);
        const float rstd = rsqrtf(qv * (1.f / 64.f) + LN_EPS);
        float y[8];
#pragma unroll
        for (int e = 0; e < 8; ++e) { const int p = 8 * q + e; const int d = (p < 32) ? ((p & 1) ? 16 + (p >> 1) : (p >> 1)) : p;
            y[e] = x[e] * rstd * a.in[19][d] + a.in[20][d]; }
        float o[8];
        if (q < 4) {
#pragma unroll
            for (int pp = 0; pp < 4; ++pp) { const float2 cs = ri[4 * q + pp]; o[2 * pp] = y[2 * pp] * cs.x - y[2 * pp + 1] * cs.y; o[2 * pp + 1] = y[2 * pp + 1] * cs.x + y[2 * pp] * cs.y; }
        } else {
#pragma unroll
            for (int e = 0; e < 8; ++e) o[e] = y[e];
        }
        v4u wv; wv.x = pk2(o[0] * 0.125f, o[1] * 0.125f); wv.y = pk2(o[2] * 0.125f, o[3] * 0.125f); wv.z = pk2(o[4] * 0.125f, o[5] * 0.125f); wv.w = pk2(o[6] * 0.125f, o[7] * 0.125f);
        *(v4u*)(AB.KX + prow * 64 + 8 * q) = wv;
    }
    LDS_WAIT(); __syncthreads();
    {
        const bf16* Wq = (const bf16*)(F.ws + WS_WQ);
        const int r = lane & 15, ko = 8 * (lane >> 4);
        bf16x8 yfA[8], yfB[8];
#pragma unroll
        for (int ks = 0; ks < 8; ++ks) yfA[ks] = *(const bf16x8*)(Wq + (size_t)(16 * (8 * w) + r) * 256 + 32 * ks + ko);
#define ATP_TILE(YF, TBL) do { const int tb = 8 * w + (TBL), n0 = 16 * tb + 4 * (lane >> 4); \
            _Pragma("unroll 1") for (int ta = 0; ta < 4; ++ta) { \
                f32x4 acc = {0.f, 0.f, 0.f, 0.f}; \
                _Pragma("unroll") for (int ks = 0; ks < 8; ++ks) { const bf16x8 xf = *(const LAS bf16x8*)(CQ + (16 * ta + r) * LDQ + 32 * ks + ko); acc = __builtin_amdgcn_mfma_f32_16x16x32_bf16(YF[ks], xf, acc, 0, 0, 0); } \
                const size_t orow = (size_t)tile * 64 + 16 * ta + r; \
                const bool isq = (n0 < 512); const int p = n0 & 63; \
                float o0 = acc[0], o1 = acc[1], o2 = acc[2], o3 = acc[3]; \
                if (isq) { const LAS f32x2_t* rr = RQL + (16 * ta + r) * 33 + (p >> 1); const f32x2_t c0 = rr[0], c1 = rr[1]; \
                    o0 = (acc[0] * c0.x - acc[1] * c0.y) * QSCALE; o1 = (acc[1] * c0.x + acc[0] * c0.y) * QSCALE; o2 = (acc[2] * c1.x - acc[3] * c1.y) * QSCALE; o3 = (acc[3] * c1.x + acc[2] * c1.y) * QSCALE; } \
                else if (p < 32) { const LAS f32x2_t* rr = RIL + (16 * ta + r) * 17 + (p >> 1); const f32x2_t c0 = rr[0], c1 = rr[1]; \
                    o0 = acc[0] * c0.x - acc[1] * c0.y; o1 = acc[1] * c0.x + acc[0] * c0.y; o2 = acc[2] * c1.x - acc[3] * c1.y; o3 = acc[3] * c1.x + acc[2] * c1.y; } \
                v2u ov; ov.x = pk2(o0, o1); ov.y = pk2(o2, o3); \
                bf16* dst = isq ? (AB.Q + orow * 512 + n0) : (AB.QI + orow * 512 + (n0 - 512)); \
                *(v2u*)dst = ov; } } while (0)
#pragma unroll 1
        for (int tb2 = 0; tb2 < 8; tb2 += 2) {
#pragma unroll
            for (int ks = 0; ks < 8; ++ks) yfB[ks] = *(const bf16x8*)(Wq + (size_t)(16 * (8 * w + tb2 + 1) + r) * 256 + 32 * ks + ko);
            ATP_TILE(yfA, tb2);
            if (tb2 + 2 < 8) {
#pragma unroll
                for (int ks = 0; ks < 8; ++ks) yfA[ks] = *(const bf16x8*)(Wq + (size_t)(16 * (8 * w + tb2 + 2) + r) * 256 + 32 * ks + ko);
            }
            ATP_TILE(yfB, tb2 + 1);
        }
#undef ATP_TILE
    }
    LDS_WAIT(); __syncthreads();
}

__device__ __forceinline__ unsigned fkey(float f) { const unsigned u = __float_as_uint(f); return u ^ ((unsigned)((int)u >> 31) | 0x80000000u); }
__device__ __forceinline__ void cnt_ge(int& c, unsigned x, unsigned cand) {
    unsigned long long m;
    asm("v_cmp_ge_u32 %1, %2, %3\n\tv_addc_co_u32 %0, %1, 0, %0, %1" : "+v"(c), "=&s"(m) : "v"(x), "v"(cand));
}
template <int BIT> __device__ __forceinline__ void nib_ge(unsigned& nib, unsigned x, unsigned K) {
    unsigned t; asm volatile("v_cmp_ge_u32 vcc, %1, %2\n\tv_cndmask_b32 %0, 0, %3, vcc" : "=v"(t) : "v"(x), "v"(K), "v"(1u << BIT) : "vcc"); nib |= t;
}
constexpr int IDX_NT = 33, IDX_PF = 4;
__device__ __forceinline__ void idx_unit(const Frame& F, const bf16* __restrict__ Ua, const AttBufs& AB, int b, int qt, int flags) {
    const int lane = F.lane, w = F.wave, qc = lane & 15, g = lane >> 4, ko = 8 * g;
    LAS int* cntb = (LAS int*)F.lds;
    const int t0 = 16 * qt, ntile = qt + 1, tq = t0 + qc;
    const size_t qrow = (size_t)b * LP + tq;
    LAS bf16* QIL = (LAS bf16*)(F.lds + 8192);
    { const int tid = F.tid; const int rr = tid >> 5, cc = (tid & 31) * 16;
      const bf16* src = AB.QI + ((size_t)b * LP + t0 + rr) * 512 + cc;
      const v4u x0 = *(const v4u*)src, x1 = *(const v4u*)(src + 8);
      *(LAS v4u*)(QIL + rr * 520 + cc) = x0; *(LAS v4u*)(QIL + rr * 520 + cc + 8) = x1; }
    LDS_WAIT(); __syncthreads();
    float wq[8];
    { const v4u ww = *(const v4u*)(Ua + qrow * UA_W + 1344); float t8[8]; unpack8(ww, t8);
#pragma unroll
      for (int h = 0; h < 8; ++h) wq[h] = t8[h] * 0.35355339059327373f; }
    unsigned sc[IDX_NT][4];
    const bf16* kbase = AB.KX + (size_t)b * LP * 64;
    const int wlast = (ntile - 1 - w) >> 3;
    bf16x8 ra0[IDX_PF], ra1[IDX_PF];
#pragma unroll
    for (int p = 0; p < IDX_PF; ++p) { const unsigned ko_ = (unsigned)((16 * (w + 8 * max(min(p, wlast), 0)) + qc) * 64 + ko) ; const unsigned kc = (w < ntile) ? ko_ : (unsigned)(qc * 64 + ko);
        ra0[p] = *(const bf16x8*)(kbase + kc); ra1[p] = *(const bf16x8*)(kbase + kc + 32); }
#pragma unroll
    for (int i = 0; i < IDX_NT; ++i) {
        int wv = w; asm volatile("" : "+s"(wv));
        const int kt = wv + 8 * i;
        const bf16x8 a0 = ra0[i % IDX_PF], a1 = ra1[i % IDX_PF];
        { const int ip = max(min(i + IDX_PF, wlast), 0); const unsigned ko_ = (unsigned)((16 * (wv + 8 * ip) + qc) * 64 + ko); const unsigned kc = (wv < ntile) ? ko_ : (unsigned)(qc * 64 + ko);
          ra0[i % IDX_PF] = *(const bf16x8*)(kbase + kc); ra1[i % IDX_PF] = *(const bf16x8*)(kbase + kc + 32); }
        asm volatile("" ::: "memory");
        if (kt < ntile) {
            f32x4 acc = {0.f, 0.f, 0.f, 0.f};
#pragma unroll
            for (int hq = 0; hq < 2; ++hq) {
                bf16x8 qa[4], qb_[4];
#pragma unroll
                for (int h4 = 0; h4 < 4; ++h4) { qa[h4] = *(const LAS bf16x8*)(QIL + qc * 520 + 64 * (4 * hq + h4) + ko); qb_[h4] = *(const LAS bf16x8*)(QIL + qc * 520 + 64 * (4 * hq + h4) + 32 + ko); }
                __builtin_amdgcn_sched_group_barrier(0x100, 8, 0);
                f32x4 sh[4];
#pragma unroll
                for (int h4 = 0; h4 < 4; ++h4) { sh[h4] = (f32x4){0.f, 0.f, 0.f, 0.f}; sh[h4] = __builtin_amdgcn_mfma_f32_16x16x32_bf16(a0, qa[h4], sh[h4], 0, 0, 0); }
#pragma unroll
                for (int h4 = 0; h4 < 4; ++h4) sh[h4] = __builtin_amdgcn_mfma_f32_16x16x32_bf16(a1, qb_[h4], sh[h4], 0, 0, 0);
                __builtin_amdgcn_sched_group_barrier(0x008, 8, 0);
#pragma unroll
                for (int h4 = 0; h4 < 4; ++h4)
#pragma unroll
                    for (int r = 0; r < 4; ++r) acc[r] = fmaf(__builtin_amdgcn_fmed3f(sh[h4][r], 0.f, INFINITY), wq[4 * hq + h4], acc[r]);
                if (hq == 0) asm volatile("" ::: "memory");
            }
            if (kt == qt) {
#pragma unroll
                for (int r = 0; r < 4; ++r) sc[i][r] = (4 * g + r <= qc) ? (fkey(acc[r]) >> 1) : 0u;
            } else {
#pragma unroll
                for (int r = 0; r < 4; ++r) sc[i][r] = fkey(acc[r]) >> 1;
            }
        } else {
#pragma unroll
            for (int r = 0; r < 4; ++r) sc[i][r] = 0u;
        }
    }
    unsigned K = 0u; bool found = (tq + 1 <= 256);
    const int nwave_tiles = __builtin_amdgcn_readfirstlane(max(wlast + 1, 0));
#pragma unroll 1
    for (int bit = 30; bit >= 0; --bit) {
        const unsigned cand = K | (1u << bit);
        unsigned b0 = 0u, b1 = 0u, b2 = 0u, b3 = 0u; int lt = 0;
        int nwv = nwave_tiles; asm volatile("" : "+s"(nwv));
#pragma unroll
        for (int i = 0; i < IDX_NT; ++i) {
            if (i < nwv) {
                b0 = __builtin_amdgcn_alignbit(b0, sc[i][0] - cand, 31); b1 = __builtin_amdgcn_alignbit(b1, sc[i][1] - cand, 31);
                b2 = __builtin_amdgcn_alignbit(b2, sc[i][2] - cand, 31); b3 = __builtin_amdgcn_alignbit(b3, sc[i][3] - cand, 31);
            }
            if (i == 15 || i == 31 || i == IDX_NT - 1) { lt += __builtin_popcount(b0) + __builtin_popcount(b1) + __builtin_popcount(b2) + __builtin_popcount(b3); b0 = b1 = b2 = b3 = 0u; }
        }
        int c = 4 * nwv - lt;
        c = isum_x32(isum_x16(c));
        LAS int* cb = cntb + (bit & 1) * 128;
        if (g == 0) cb[w * 16 + qc] = c;
        LDS_WAIT(); __syncthreads();
        int tot = 0;
#pragma unroll
        for (int ww = 0; ww < 8; ++ww) tot += cb[ww * 16 + qc];
        if (!found && tot >= 256) K = cand;
        found = found || (tot == 256);
        if (__all(found)) break;
    }
    if (tq + 1 <= 256 || K == 0u) K = 1u;
    LAS unsigned short* mlds = (LAS unsigned short*)(F.lds + 32768);
    const int kend = (qt == 0) ? 4 : min(16 * (1 + ((qt - 1) >> 4)) + 4, 260);
    LAS unsigned short* mrow_ = mlds + qc * MW + w;
#pragma unroll
    for (int i = 0; i < IDX_NT; ++i) {
        unsigned nib = 0u;
        nib_ge<0>(nib, sc[i][0], K); nib_ge<1>(nib, sc[i][1], K); nib_ge<2>(nib, sc[i][2], K); nib_ge<3>(nib, sc[i][3], K);
        unsigned v = nib << (4 * g);
        v = or_x32(or_x16(v));
        if (g == 0) mrow_[8 * i] = (unsigned short)v;
    }
    LDS_WAIT(); __syncthreads();
    {
        const int npiece = kend >> 2;
        for (int p = F.tid; p < 16 * npiece; p += NTHR) { const int q_ = p / npiece, c = p % npiece;
            const v2u val = *(const LAS v2u*)(mlds + q_ * MW + 4 * c);
            *(v2u*)(AB.MASK + ((size_t)b * LP + t0 + q_) * MW + 4 * c) = val; }
    }
    LDS_WAIT(); __syncthreads();
}

__device__ __forceinline__ int crow(int r, int hi) { return (r & 3) + 8 * (r >> 2) + 4 * hi; }
constexpr int AT_K = 0, AT_V = 2 * 8192, AT_WS = 4 * 8192;
__device__ __forceinline__ void at_qkt(f32x16& p0, f32x16& p1, const LAS unsigned char* Kslot, const bf16x8* qr, const f32x16& negm, int r32, int hi) {
    const LAS unsigned char* kb = Kslot + hi * 1024 + r32 * 16;
    p0 = negm; p1 = negm;
#pragma unroll
    for (int d0 = 0; d0 < 4; ++d0) {
        const bf16x8 b0 = *(const LAS bf16x8*)(kb + d0 * 2048), b1 = *(const LAS bf16x8*)(kb + d0 * 2048 + 512);
        p0 = __builtin_amdgcn_mfma_f32_32x32x16_bf16(b0, qr[d0], p0, 0, 0, 0);
        p1 = __builtin_amdgcn_mfma_f32_32x32x16_bf16(b1, qr[d0], p1, 0, 0, 0);
    }
}
__device__ __forceinline__ float at_max3(float a, float b, float c) { float r; asm("v_max3_f32 %0, %1, %2, %3" : "=v"(r) : "v"(a), "v"(b), "v"(c)); return r; }
typedef short s16x4 __attribute__((ext_vector_type(4)));
__device__ __forceinline__ s16x4 at_vtr(const LAS unsigned char* p) { return __builtin_bit_cast(s16x4, __builtin_amdgcn_ds_read_tr16_b64_v4i16((LAS s16x4*)p)); }
__device__ __forceinline__ void at_pv(f32x16* o, const LAS unsigned char* vb, bf16x8 pa0, bf16x8 pa1, bf16x8 pa2, bf16x8 pa3) {
#pragma unroll
    for (int d0 = 0; d0 < 2; ++d0) {
        s16x4 lo[4], hi[4];
#pragma unroll
        for (int ks = 0; ks < 4; ++ks) { lo[ks] = at_vtr(vb + d0 * 4096 + ks * 1024); hi[ks] = at_vtr(vb + d0 * 4096 + ks * 1024 + 512); }
#define AT_PK(k) (bf16x8){lo[k][0], lo[k][1], lo[k][2], lo[k][3], hi[k][0], hi[k][1], hi[k][2], hi[k][3]}
        o[d0] = __builtin_amdgcn_mfma_f32_32x32x16_bf16(pa0, AT_PK(0), o[d0], 0, 0, 0);
        o[d0] = __builtin_amdgcn_mfma_f32_32x32x16_bf16(pa1, AT_PK(1), o[d0], 0, 0, 0);
        o[d0] = __builtin_amdgcn_mfma_f32_32x32x16_bf16(pa2, AT_PK(2), o[d0], 0, 0, 0);
        o[d0] = __builtin_amdgcn_mfma_f32_32x32x16_bf16(pa3, AT_PK(3), o[d0], 0, 0, 0);
#undef AT_PK
    }
}
template <class OutF> __device__ __forceinline__ void attn_unit(const Frame& F, const bf16* __restrict__ Ua, const AttBufs& AB, int b, int h, int qb, const OutF& outf) {
    const int lane = F.lane, wid = F.wave, r32 = lane & 31, hi = lane >> 5;
    const LAS unsigned char* lds = F.lds;
    LAS float* wsf = (LAS float*)(F.lds + AT_WS) + wid * 64;
    const size_t rowbase = (size_t)b * LP; const int q0 = (qb == 0) ? 0 : 16 + 256 * (qb - 1), qend = (qb == 0) ? 16 : q0 + 256;
    const int tq = q0 + wid * 32 + r32;
    const int NT = (qend + 63) / 64;
    bf16x8 qr[4];
    { const bf16* Qw = AB.Q + (rowbase + min(tq, LP - 1)) * 512 + 64 * h;
#pragma unroll
      for (int d0 = 0; d0 < 4; ++d0) qr[d0] = *(const bf16x8*)(Qw + 16 * d0 + 8 * hi); }
    const unsigned short* mrow = AB.MASK + (rowbase + min(tq, LP - 1)) * MW;
    const bf16* ksrc = Ua + (rowbase + lane) * UA_W + 256 + 64 * h + 8 * wid;
    const bf16* vsrc = Ua + (rowbase + 16 * (wid & 3) + (lane >> 2)) * UA_W + 768 + 64 * h + (wid >> 2) * 32 + (lane & 3) * 8;
    const int sdst = wid * 1024 + lane * 16;
    const int vb0 = ((lane >> 4) & 1) * 32 + (lane & 3) * 8 + (4 * hi + ((lane & 15) >> 2)) * 64;
    float m_run = 0.f, l_run = 0.f;
    f32x16 negm;
#pragma unroll
    for (int r = 0; r < 16; ++r) negm[r] = 0.f;
    f32x16 o[2];
#pragma unroll
    for (int r = 0; r < 16; ++r) { o[0][r] = 0.f; o[1][r] = 0.f; }
    v4u kreg = *(const v4u*)ksrc, vreg = *(const v4u*)vsrc;
    v2u mk_next = *(const v2u*)mrow;
    __syncthreads();
    *(LAS v4u*)(lds + AT_K + sdst) = kreg; *(LAS v4u*)(lds + AT_V + sdst) = vreg;
    for (int j = 0; j < NT; ++j) {
        const int cur = j & 1;
        if (j + 1 < NT) { kreg = *(const v4u*)(ksrc + (size_t)(j + 1) * 64 * UA_W); vreg = *(const v4u*)(vsrc + (size_t)(j + 1) * 64 * UA_W); }
        const v2u mk = mk_next;
        if (j + 1 < NT) mk_next = *(const v2u*)(mrow + 4 * (j + 1));
        LDS_WAIT(); __syncthreads();
        if (64 * j <= q0 + wid * 32 + 31 && q0 + wid * 32 < qend) {
        f32x16 p0, p1;
        at_qkt(p0, p1, lds + AT_K + cur * 8192, qr, negm, r32, hi);
        float mx;
        { float a0 = at_max3(p0[0], p0[1], p1[0]), a1 = at_max3(p0[2], p0[3], p1[1]); a0 = at_max3(a0, p1[2], p1[3]);
#pragma unroll
          for (int r = 4; r < 16; r += 4) { a0 = at_max3(a0, p0[r], p0[r + 1]); a1 = at_max3(a1, p0[r + 2], p0[r + 3]); a0 = at_max3(a0, p1[r], p1[r + 1]); a1 = at_max3(a1, p1[r + 2], p1[r + 3]); }
          mx = at_max3(a0, a1, a1); }
        { auto rr = __builtin_amdgcn_permlane32_swap(__float_as_uint(mx), __float_as_uint(mx), false, false); mx = fmaxf(__uint_as_float(rr[0]), __uint_as_float(rr[1])); }
        if (__any(mx > 4.f)) {
            const float dl = fmaxf(mx, 0.f);
            const float f = __builtin_amdgcn_exp2f(-dl);
            m_run += dl; l_run *= f;
#pragma unroll
            for (int r = 0; r < 16; ++r) { p0[r] -= dl; p1[r] -= dl; negm[r] = -m_run; }
            if (hi == 0) wsf[r32] = f;
            LDS_WAIT();
#pragma unroll
            for (int r = 0; r < 16; ++r) { const float fr = wsf[crow(r, hi)]; o[0][r] *= fr; o[1][r] *= fr; }
        }
        const int mlo = (int)(mk.x >> (4 * hi)), mhi = (int)(mk.y >> (4 * hi));
        float s = 0.f;
#pragma unroll
        for (int r = 0; r < 16; ++r) {
            int b0_, b1_;
            asm("v_bfe_i32 %0, %1, %2, 1" : "=v"(b0_) : "v"(mlo), "n"((r & 3) + 8 * (r >> 2)));
            asm("v_bfe_i32 %0, %1, %2, 1" : "=v"(b1_) : "v"(mhi), "n"((r & 3) + 8 * (r >> 2)));
            p0[r] = __uint_as_float(__float_as_uint(__builtin_amdgcn_exp2f(p0[r])) & (unsigned)b0_);
            p1[r] = __uint_as_float(__float_as_uint(__builtin_amdgcn_exp2f(p1[r])) & (unsigned)b1_);
            s += p0[r] + p1[r];
        }
        l_run += s;
        v4u pw0, pw1, pw2, pw3;
        pw0.x = pk2(p0[0], p0[1]); pw0.y = pk2(p0[2], p0[3]); pw0.z = pk2(p0[4], p0[5]); pw0.w = pk2(p0[6], p0[7]);
        pw1.x = pk2(p0[8], p0[9]); pw1.y = pk2(p0[10], p0[11]); pw1.z = pk2(p0[12], p0[13]); pw1.w = pk2(p0[14], p0[15]);
        pw2.x = pk2(p1[0], p1[1]); pw2.y = pk2(p1[2], p1[3]); pw2.z = pk2(p1[4], p1[5]); pw2.w = pk2(p1[6], p1[7]);
        pw3.x = pk2(p1[8], p1[9]); pw3.y = pk2(p1[10], p1[11]); pw3.z = pk2(p1[12], p1[13]); pw3.w = pk2(p1[14], p1[15]);
        at_pv(o, lds + AT_V + cur * 8192 + vb0, __builtin_bit_cast(bf16x8, pw0), __builtin_bit_cast(bf16x8, pw1), __builtin_bit_cast(bf16x8, pw2), __builtin_bit_cast(bf16x8, pw3));
        }
        if (j + 1 < NT) { *(LAS v4u*)(lds + AT_K + (cur ^ 1) * 8192 + sdst) = kreg; *(LAS v4u*)(lds + AT_V + (cur ^ 1) * 8192 + sdst) = vreg; }
    }
    { auto rr = __builtin_amdgcn_permlane32_swap(__float_as_uint(l_run), __float_as_uint(l_run), false, false); l_run = __uint_as_float(rr[0]) + __uint_as_float(rr[1]); }
    LDS_WAIT();
    if (hi == 0) wsf[32 + r32] = 1.f / l_run;
    LDS_WAIT();
#pragma unroll
    for (int r = 0; r < 16; ++r) {
        const int qloc = crow(r, hi), t = q0 + wid * 32 + qloc; const float li = wsf[32 + qloc];
        if (t < qend) { outf(b, t, 512 + 64 * h + r32, o[0][r] * li); outf(b, t, 512 + 64 * h + 32 + r32, o[1][r] * li); }
    }
}
constexpr int NEXP = 32, LISTCAP = 32896;
constexpr int CW_CNT = 256;
constexpr size_t WS_LIST = 236 * MiB;
constexpr size_t WS_WT = 241 * MiB;
constexpr size_t WS_PINFO = 242 * MiB;
constexpr size_t EW_GU = (size_t)512 * 1024 * 2, EW_D = (size_t)1024 * 256 * 2;
struct MoeBufs { float* MIX; float* H1; bf16* H1b; bf16* HID; bf16* F; bf16* WGU; bf16* WD; };

__device__ __forceinline__ void convert_experts(const Frame& F, const Args& a, const MoeBufs& MB, int part, int first_wg = 0) {
    LAS float* scr = (LAS float*)(F.lds + F.wave * 16384);
    if (F.bid < first_wg) return;
    const int gw = (F.bid - first_wg) * NWAVES + F.wave, NGW = (F.G - first_wg) * NWAVES;
    if (part == 0) {
        for (int it = gw; it < NEXP * 256; it += NGW) {
            const int e = it >> 8, r = it & 255;
            if (r < 128) transpose_item<4>(a.in[28] + (size_t)e * 1024 * 256, 1024, 256, MB.WGU + (size_t)e * 512 * 1024, 0, scr, r, 8, F.lane);
            else transpose_item<4>(a.in[29] + (size_t)e * 1024 * 256, 1024, 256, MB.WGU + (size_t)e * 512 * 1024, 1, scr, r - 128, 8, F.lane);
        }
    } else {
        for (int it = gw; it < NEXP * 128; it += NGW) {
            const int e = it >> 7, r = it & 127;
            transpose_item<0>(a.in[30] + (size_t)e * 256 * 1024, 256, 1024, MB.WD + (size_t)e * 1024 * 256, 0, scr, r, 32, F.lane);
        }
    }
}

constexpr int P6_HROW = 4096, P6_RGW = P6_HROW + 8 * 4096, P6_REW = P6_RGW + 16384;
static_assert(P6_REW + 65536 <= RING_BYTES, "P6 LDS map");
__device__ __forceinline__ void p6_ln1_router(const Frame& F, const Args& a, const MoeBufs& MB) {
    LAS int* lcount = (LAS int*)F.lds;
    LAS int* lbase = lcount + 32;
    LAS int* ent = lbase + 32;
    LAS float* entw = (LAS float*)(ent + 65 * 4);
    unsigned* ctl = (unsigned*)(F.ws + WS_CTL);
    const float2* rowstat = (const float2*)(F.ws + WS_ROWSTAT);
    const int lane = F.lane;
    for (int i = F.tid; i < 1024; i += NTHR) *(LAS f32x4*)(F.lds + P6_RGW + i * 16) = *(const f32x4*)(a.in[24] + (size_t)i * 4);
    for (int i = F.tid; i < 4096; i += NTHR) { const int k = i >> 2, g = i & 3; float w8[8]; ld8f(a.in[26] + (size_t)k * 32 + 8 * g, w8); st8((LAS bf16*)(F.lds + P6_REW + g * 16384 + k * 16), w8); }
    for (int blk = F.bid; blk < 256; blk += F.G) {
    if (F.tid < 32) lcount[F.tid] = 0;
    LDS_WAIT(); __syncthreads();
    f32x4 nx[4]; v2u nm[4];
    { const int pr = 65 * blk + F.wave, b = pr / LP, t = pr % LP; const int tc = (t < L) ? t : 0;
      const float* src = (tc < NM) ? (a.in[1] + (size_t)tc * D) : (a.in[0] + ((size_t)b * SEQ + (tc - NM)) * D);
#pragma unroll
      for (int j = 0; j < 4; ++j) { nx[j] = ((const f32x4*)src)[lane + 64 * j]; nm[j] = ((const v2u*)((const bf16*)MB.MIX + (size_t)pr * D))[lane + 64 * j]; } }
    for (int i = F.wave; i < 65; i += NWAVES) {
        const int pr = 65 * blk + i, t = pr % LP;
        f32x4 cx[4]; v2u cm[4];
#pragma unroll
        for (int j = 0; j < 4; ++j) { cx[j] = nx[j]; cm[j] = nm[j]; }
        if (i + NWAVES < 65) { const int pn = pr + NWAVES, bn = pn / LP, tn = pn % LP; const int tc = (tn < L) ? tn : 0;
            const float* src = (tc < NM) ? (a.in[1] + (size_t)tc * D) : (a.in[0] + ((size_t)bn * SEQ + (tc - NM)) * D);
#pragma unroll
            for (int j = 0; j < 4; ++j) { nx[j] = ((const f32x4*)src)[lane + 64 * j]; nm[j] = ((const v2u*)((const bf16*)MB.MIX + (size_t)pn * D))[lane + 64 * j]; } }
        if (t >= L) { if (lane == 0) ent[i * 4] = -1; continue; }
        const float2 st = rowstat[pr];
        f32x4 v[4]; float s = 0.f;
#pragma unroll
        for (int j = 0; j < 4; ++j) {
            const f32x4 g0 = ((const f32x4*)a.in[2])[lane + 64 * j], b0 = ((const f32x4*)a.in[3])[lane + 64 * j];
            const f32x4 mxv = {bflo(cm[j].x), bfhi(cm[j].x), bflo(cm[j].y), bfhi(cm[j].y)};
            v[j] = ((cx[j] - st.x) * st.y * g0 + b0) * DN_ALPHA + mxv;
            s += (v[j].x + v[j].y) + (v[j].z + v[j].w);
        }
        const float mean = wave_sum(s) * (1.f / D); float s2 = 0.f;
#pragma unroll
        for (int j = 0; j < 4; ++j) { v[j] = v[j] - mean; s2 += (v[j].x * v[j].x + v[j].y * v[j].y) + (v[j].z * v[j].z + v[j].w * v[j].w); }
        const float rstd = rsqrtf(wave_sum(s2) * (1.f / D) + LN_EPS);
        LAS float* hrow = (LAS float*)(F.lds + P6_HROW + F.wave * 4096);
#pragma unroll
        for (int j = 0; j < 4; ++j) {
            const f32x4 g1 = ((const f32x4*)a.in[22])[lane + 64 * j], b1 = ((const f32x4*)a.in[23])[lane + 64 * j];
            v[j] = v[j] * rstd * g1 + b1;
            ((f32x4*)(MB.H1 + (size_t)pr * D))[lane + 64 * j] = v[j];
            v2u hb; hb.x = pk2(v[j].x, v[j].y); hb.y = pk2(v[j].z, v[j].w);
            ((v2u*)(MB.H1b + (size_t)pr * D))[lane + 64 * j] = hb;
            *(LAS f32x4*)(hrow + 4 * (lane + 64 * j)) = v[j];
        }
        LDS_WAIT();
        float hk[16];
#pragma unroll
        for (int kk = 0; kk < 16; ++kk) hk[kk] = hrow[lane + 64 * kk];
        f32x4 ga = {0.f, 0.f, 0.f, 0.f};
#pragma unroll
        for (int kk = 0; kk < 16; ++kk) { const f32x4 wg = *(const LAS f32x4*)(F.lds + P6_RGW + (lane + 64 * kk) * 16); ga = ga + wg * hk[kk]; }
        float lgp[4];
#pragma unroll
        for (int g = 0; g < 4; ++g) lgp[g] = wave_sum(ga[g]) + a.in[25][g];
        int gs = 0; float gm = lgp[0];
#pragma unroll
        for (int g = 1; g < 4; ++g) if (lgp[g] > gm) { gm = lgp[g]; gs = g; }
        float den = 0.f;
#pragma unroll
        for (int g = 0; g < 4; ++g) den += __expf(lgp[g] - gm);
        const float ggate = 1.f / den;
        float el[8];
#pragma unroll
        for (int q8 = 0; q8 < 8; ++q8) el[q8] = 0.f;
#pragma unroll
        for (int kk = 0; kk < 16; ++kk) { float w8[8]; unpack8(*(const LAS v4u*)(F.lds + P6_REW + gs * 16384 + (lane + 64 * kk) * 16), w8);
#pragma unroll
            for (int q8 = 0; q8 < 8; ++q8) el[q8] = fmaf(hk[kk], w8[q8], el[q8]); }
#pragma unroll
        for (int q8 = 0; q8 < 8; ++q8) el[q8] = wave_sum(el[q8]) + a.in[27][gs * 8 + q8];
        int i1 = 0; float v1 = el[0];
#pragma unroll
        for (int q8 = 1; q8 < 8; ++q8) if (el[q8] > v1) { v1 = el[q8]; i1 = q8; }
        int i2 = 0; float v2 = -INFINITY;
#pragma unroll
        for (int q8 = 0; q8 < 8; ++q8) if (q8 != i1 && el[q8] > v2) { v2 = el[q8]; i2 = q8; }
        const float e2 = __expf(v2 - v1);
        const float w1 = ggate / (1.f + e2), w2 = ggate * e2 / (1.f + e2);
        if (lane == 0) {
            const int e0 = gs * 8 + i1, e1 = gs * 8 + i2;
            ent[i * 4] = e0; ent[i * 4 + 1] = e1;
            ent[i * 4 + 2] = atomicAdd((int*)(lcount + e0), 1); ent[i * 4 + 3] = atomicAdd((int*)(lcount + e1), 1);
            entw[i * 2] = w1; entw[i * 2 + 1] = w2;
        }
    }
    LDS_WAIT(); __syncthreads();
    if (F.tid < 32) lbase[F.tid] = (int)atomicAdd(ctl + CW_CNT + F.tid, (unsigned)lcount[F.tid]);
    LDS_WAIT(); __syncthreads();
    if (F.tid < 65) {
        const int i = F.tid, e0 = ent[i * 4];
        if (e0 >= 0) {
            const int pr = 65 * blk + i, e1 = ent[i * 4 + 1];
            int* list = (int*)(F.ws + WS_LIST); float* wt = (float*)(F.ws + WS_WT);
            list[(size_t)e0 * LISTCAP + lbase[e0] + ent[i * 4 + 2]] = pr * 2;
            list[(size_t)e1 * LISTCAP + lbase[e1] + ent[i * 4 + 3]] = pr * 2 + 1;
            wt[pr * 2] = entw[i * 2]; wt[pr * 2 + 1] = entw[i * 2 + 1];
            unsigned* pinfo = (unsigned*)(F.ws + WS_PINFO);
            pinfo[pr * 2] = ((unsigned)e0 << 16) | (unsigned)(lbase[e0] + ent[i * 4 + 2]); pinfo[pr * 2 + 1] = ((unsigned)e1 << 16) | (unsigned)(lbase[e1] + ent[i * 4 + 3]);
        }
    }
    LDS_WAIT(); __syncthreads();
    }
}
}

namespace pg8 {
struct OneUnit { int pm, pn;
    __device__ __forceinline__ bool next(int i, Unit& u) const { if (i) return false; u.pm = pm; u.pn = pn; return true; }
    __device__ __forceinline__ void a_ready(const Unit&) const {}
    __device__ __forceinline__ void done(const Unit&) const {} };
struct EpiMoeUp {
    static constexpr bool PERM = true, AFTER_DRAIN = false;
    bf16_t* HID;
    __device__ __forceinline__ void operator()(const f32x4 (&acc)[2][2][4][2], const Unit& u, int wr, int wc, int fr, int fq) const {
        const int j0 = 128 * u.pn + 16 * wc + 4 * fq;
#pragma unroll
        for (int ai = 0; ai < 2; ++ai)
#pragma unroll
            for (int m = 0; m < 4; ++m) { bf16_t* rowp = HID + (size_t)(ai * HALF + wr * 64 + m * 16 + fr) * 256 + j0;
#pragma unroll
                for (int bj = 0; bj < 2; ++bj) { const f32x4 v0 = acc[ai][bj][m][0], v1 = acc[ai][bj][m][1];
                    const float h0 = v0[0] / (1.f + __expf(-v0[0])) * v0[1], h1 = v0[2] / (1.f + __expf(-v0[2])) * v0[3];
                    const float h2 = v1[0] / (1.f + __expf(-v1[0])) * v1[1], h3 = v1[2] / (1.f + __expf(-v1[2])) * v1[3];
                    unsigned w0 = cvt_pk_bf16(h0, h1), w1 = cvt_pk_bf16(h2, h3);
                    typedef unsigned u32x2_ __attribute__((ext_vector_type(2))); u32x2_ wv; wv.x = w0; wv.y = w1;
                    *(u32x2_*)(rowp + 64 * bj) = wv; } }
    }
};
struct EpiMoeDown {
    static constexpr bool PERM = true, AFTER_DRAIN = false;
    bf16_t* O;
    __device__ __forceinline__ void operator()(const f32x4 (&acc)[2][2][4][2], const Unit& u, int wr, int wc, int fr, int fq) const {
        const int col0 = u.pn * BM + wc * 32 + 8 * fq;
#pragma unroll
        for (int ai = 0; ai < 2; ++ai)
#pragma unroll
            for (int m = 0; m < 4; ++m) { bf16_t* rowp = O + (size_t)(ai * HALF + wr * 64 + m * 16 + fr) * 1024 + col0;
#pragma unroll
                for (int bj = 0; bj < 2; ++bj) { const f32x4 v0 = acc[ai][bj][m][0], v1 = acc[ai][bj][m][1];
                    u32x4 w; w.x = cvt_pk_bf16(v0[0], v0[1]); w.y = cvt_pk_bf16(v0[2], v0[3]); w.z = cvt_pk_bf16(v1[0], v1[1]); w.w = cvt_pk_bf16(v1[2], v1[3]);
                    *(u32x4*)(rowp + bj * HALF) = w; } }
    }
};
}

namespace mk {
struct MoeTiles { int total; };
__device__ __forceinline__ int moe_find(const unsigned* cnt, int ti, int& e_out, int& i_out, int& hb_out, int& total) {
    int acc = 0, e_f = -1, i_f = 0, hb = 0;
    for (int e = 0; e < NEXP; ++e) { const int nt = ((int)cnt[e] + 255) >> 8; if (e_f < 0 && ti < acc + nt) { e_f = e; i_f = ti - acc; hb = acc; } acc += nt; }
    total = acc; e_out = e_f; i_out = i_f; hb_out = hb; return e_f;
}
constexpr int MOE_LDS_IDX = RING_BYTES;
__device__ __forceinline__ void p7_moe(const Frame& F, const MoeBufs& MB, bool down) {
    const unsigned* cnt = (const unsigned*)(F.ws + WS_CTL) + CW_CNT;
    const int* list = (const int*)(F.ws + WS_LIST);
    LAS int* lidx = (LAS int*)(F.lds + MOE_LDS_IDX);
    const int ncol = down ? 4 : 2;
    for (int u = F.bid;; u += F.G) {
        int e, i, hb, total; moe_find(cnt, u / ncol, e, i, hb, total);
        e = __builtin_amdgcn_readfirstlane(e); i = __builtin_amdgcn_readfirstlane(i); hb = __builtin_amdgcn_readfirstlane(hb); total = __builtin_amdgcn_readfirstlane(total);
        if (u >= total * ncol) break;
        const int pn = __builtin_amdgcn_readfirstlane(u % ncol), n_e = __builtin_amdgcn_readfirstlane((int)cnt[e]), base = 256 * i;
        if (!down) {
            __syncthreads();
            if (F.tid < 256) lidx[F.tid] = list[(size_t)e * LISTCAP + min(base + F.tid, n_e - 1)] >> 1;
            LDS_WAIT(); __syncthreads();
        }
        if (!down) {
            pg8::Gemm g{MB.H1b, MB.WGU + (size_t)e * 512 * 1024, 256, 512, 1024, 1024, (const int*)(F.lds + MOE_LDS_IDX)};
            pg8::OneUnit S{0, pn};
            pg8::EpiMoeUp E{MB.HID + (size_t)(hb + i) * 256 * 256};
            pg8::gemm_phase<pg8::EpiMoeUp, pg8::OneUnit, true, true, true>(F.lds, g, S, E);
        } else {
            pg8::Gemm g{MB.HID + (size_t)(hb + i) * 256 * 256, MB.WD + (size_t)e * 1024 * 256, 256, 1024, 256, 256, nullptr};
            pg8::OneUnit S{0, pn};
            pg8::EpiMoeDown E{MB.F + (size_t)(hb + i) * 256 * 1024};
            pg8::gemm_phase<pg8::EpiMoeDown, pg8::OneUnit, true, true, false>(F.lds, g, S, E);
        }
    }
}
__device__ __forceinline__ int moe_total_tiles(const unsigned* cnt) { int acc = 0; for (int e = 0; e < NEXP; ++e) acc += ((int)cnt[e] + 255) >> 8; return acc; }
__device__ __forceinline__ void p8_final(const Frame& F, const Args& a, const MoeBufs& MB) {
    const int gw = F.bid * NWAVES + F.wave, NGW = F.G * NWAVES, lane = F.lane;
    const unsigned* cnt = (const unsigned*)(F.ws + WS_CTL) + CW_CNT;
    const unsigned* pinfo = (const unsigned*)(F.ws + WS_PINFO); const float* wt = (const float*)(F.ws + WS_WT);
    int tb = 0;
    { const int nt = (lane < NEXP) ? (((int)cnt[lane & 31] + 255) >> 8) : 0; int inc = nt;
#pragma unroll
      for (int o = 1; o < 32; o <<= 1) { const int t = __shfl_up(inc, o); if ((lane & 31) >= o) inc += t; }
      tb = inc - nt; }
    const int NR = NB * SEQ;
    for (int orow = gw; orow < NR; orow += 2 * NGW) {
        f32x4 hv[2][4]; v2u fa[2][4], fb[2][4]; float w0[2], w1[2]; bool ok[2];
#pragma unroll
        for (int u = 0; u < 2; ++u) {
            const int o = orow + u * NGW; ok[u] = o < NR; const int oc = ok[u] ? o : orow;
            const size_t pr = (size_t)(oc / SEQ) * LP + NM + (oc % SEQ);
            const unsigned p0 = pinfo[pr * 2], p1 = pinfo[pr * 2 + 1]; w0[u] = wt[pr * 2]; w1[u] = wt[pr * 2 + 1];
            const size_t r0 = (size_t)__shfl(tb, (int)(p0 >> 16)) * 256 + (p0 & 0xffffu), r1 = (size_t)__shfl(tb, (int)(p1 >> 16)) * 256 + (p1 & 0xffffu);
#pragma unroll
            for (int j = 0; j < 4; ++j) { hv[u][j] = ((const f32x4*)(MB.H1 + pr * D))[lane + 64 * j]; fa[u][j] = ((const v2u*)(MB.F + r0 * D))[lane + 64 * j]; fb[u][j] = ((const v2u*)(MB.F + r1 * D))[lane + 64 * j]; }
        }
#pragma unroll
        for (int u = 0; u < 2; ++u) {
            f32x4 v[4]; float sm = 0.f;
#pragma unroll
            for (int j = 0; j < 4; ++j) {
                const f32x4 h = hv[u][j]; const v2u f0 = fa[u][j], f1 = fb[u][j];
                v[j].x = DN_ALPHA * h.x + w0[u] * bflo(f0.x) + w1[u] * bflo(f1.x); v[j].y = DN_ALPHA * h.y + w0[u] * bfhi(f0.x) + w1[u] * bfhi(f1.x);
                v[j].z = DN_ALPHA * h.z + w0[u] * bflo(f0.y) + w1[u] * bflo(f1.y); v[j].w = DN_ALPHA * h.w + w0[u] * bfhi(f0.y) + w1[u] * bfhi(f1.y);
                sm += (v[j].x + v[j].y) + (v[j].z + v[j].w);
            }
            const float mean = wave_sum(sm) * (1.f / D); float s2 = 0.f;
#pragma unroll
            for (int j = 0; j < 4; ++j) { v[j] = v[j] - mean; s2 += (v[j].x * v[j].x + v[j].y * v[j].y) + (v[j].z * v[j].z + v[j].w * v[j].w); }
            const float rstd = rsqrtf(wave_sum(s2) * (1.f / D) + LN_EPS);
            if (ok[u]) {
                const int o = orow + u * NGW;
#pragma unroll
                for (int j = 0; j < 4; ++j) { const f32x4 g2 = ((const f32x4*)a.in[31])[lane + 64 * j], b2 = ((const f32x4*)a.in[32])[lane + 64 * j];
                    ((f32x4*)(a.out + (size_t)o * D))[lane + 64 * j] = v[j] * rstd * g2 + b2; }
            }
        }
    }
}
struct OutY {
    bf16* Ur;
    __device__ __forceinline__ void operator()(int b, int t, int col, f32x4 y) const { v2u o; o.x = pk2(y[0], y[1]); o.y = pk2(y[2], y[3]); *(v2u*)(Ur + ((size_t)b * LP + t) * UR_W + col) = o; }
    __device__ __forceinline__ void operator()(int b, int t, int col, float y) const { Ur[((size_t)b * LP + t) * UR_W + col] = (bf16)f2bf(y); }
};
constexpr int CW_W3 = 16, CW_W4 = 80;
constexpr int TICKET_OFF = 15 * 9216 + 62 * 144 + 128;
__device__ __forceinline__ int next_ticket(const Frame& F, unsigned* ctr) {
    LAS int* slot = (LAS int*)(F.lds + TICKET_OFF);
    if (F.tid == 0) *slot = (int)atomicAdd(ctr, 1u);
    LDS_WAIT(); __syncthreads();
    const int t = *slot;
    LDS_WAIT(); __syncthreads();
    return t;
}
__device__ __forceinline__ int bcast_ticket(const Frame& F, int mine) {
    LAS int* slot = (LAS int*)(F.lds + TICKET_OFF);
    if (F.tid == 0) *slot = mine;
    LDS_WAIT(); __syncthreads();
    const int t = *slot;
    LDS_WAIT(); __syncthreads();
    return t;
}
constexpr size_t W_UR = 16 * MiB;
constexpr size_t W_UA = W_UR + (size_t)TP * UR_W * 2;
constexpr size_t W_RW = W_UA + (size_t)TP * UA_W * 2;
constexpr size_t W_H0B = W_RW;
constexpr size_t W_RW_M = W_RW, W_RW_N = W_RW_M + (size_t)NUNIT * 8192, W_RW_Q = W_RW_N + (size_t)NUNIT * 16384, W_RW_OP = W_RW_Q + (size_t)NUNIT * 8192,
                 W_RW_G1 = W_RW_OP + (size_t)NUNIT * 8192, W_RW_G2 = W_RW_G1 + (size_t)NUNIT * 8192, W_RW_END = W_RW_G2 + (size_t)NUNIT * 8192;
static_assert(W_RW_END <= WS_LIST, "RWKV data below the token lists");
constexpr size_t W_MIX = W_RW;
constexpr size_t W_F = W_RW;
constexpr size_t W_H1B = W_RW + 81 * MiB;
constexpr size_t W_H1 = W_UR;
constexpr size_t W_HID = 81 * MiB;
static_assert(W_H1 + (size_t)TP * 4096 <= W_HID && W_HID + (size_t)41216 * 512 <= W_RW && W_H1B + (size_t)TP * 2048 <= WS_LIST && W_F + (size_t)41216 * 2048 <= W_H1B, "late-phase overlays");
constexpr size_t O_Q = 0, O_QI = O_Q + (size_t)TP * 1024, O_HC = O_QI + (size_t)TP * 1024, O_MASK = O_HC + (size_t)NUNIT * 8192, O_KX = O_MASK + (size_t)TP * MW * 2, O_END = O_KX + (size_t)TP * 128;
constexpr size_t O_WGU = 0, O_WD = 32 * MiB;
static_assert(O_END <= 64 * MiB && O_WD + (size_t)NEXP * EW_D <= 64 * MiB, "d_out scratch");

__global__ void __launch_bounds__(NTHR, 2) mega(Args a) {
    unsigned char* const wsb_ = a.ws; unsigned char* const ob_ = (unsigned char*)a.out;
    bf16* const H0b = (bf16*)(wsb_ + W_H0B); bf16* const Ur = (bf16*)(wsb_ + W_UR); bf16* const Ua = (bf16*)(wsb_ + W_UA);
    const RwkvBufs RB{(bf16*)(wsb_ + W_RW_M), (float*)(wsb_ + W_RW_N), (bf16*)(wsb_ + W_RW_Q), (bf16*)(wsb_ + W_RW_OP), (bf16*)(wsb_ + W_RW_G1), (bf16*)(wsb_ + W_RW_G2), (bf16*)(ob_ + O_HC)};
    const AttBufs AB{(bf16*)(ob_ + O_Q), (bf16*)(ob_ + O_QI), (unsigned short*)(ob_ + O_MASK), (bf16*)(ob_ + O_KX)};
    const MoeBufs MB{(float*)(wsb_ + W_MIX), (float*)(wsb_ + W_H1), (bf16*)(wsb_ + W_H1B), (bf16*)(wsb_ + W_HID), (bf16*)(wsb_ + W_F), (bf16*)(ob_ + O_WGU), (bf16*)(ob_ + O_WD)};
    extern __shared__ __attribute__((aligned(16))) unsigned char lds[];
    Frame F;
    F.lds = (LAS unsigned char*)lds;
    F.tid = threadIdx.x; F.lane = F.tid & 63; F.wave = __builtin_amdgcn_readfirstlane(F.tid >> 6);
    F.G = gridDim.x; F.bid = blockIdx.x; F.ws = a.ws;
    unsigned* ctl = (unsigned*)(a.ws + WS_CTL);
    const int lo = a.ph_lo, hi = a.ph_hi;
    volatile LAS unsigned* MISC = (volatile LAS unsigned*)(F.lds + MISC_OFF);
    if (F.tid < 4) MISC[F.tid] = 0u;
    LDS_WAIT(); __syncthreads();
    XcdBarrier bar; bar.bar = ctl + CW_BAR; bar.x = 0; bar.st = MISC;
    if (hi - lo > 1) bar = xcd_barrier_post(ctl + CW_BAR, MISC);
#define SEAM(k) do { if (IN(k) && IN((k) + 1)) xcd_barrier(bar); } while (0)
#define IN(k) (lo <= (k) && (k) < hi)
    if (IN(0)) { p0_prologue(F, a, H0b); }
    SEAM(0);
    if (IN(1)) {
        pg8::Gemm g{H0b, (const bf16*)(F.ws + WS_WIN), TP, IN_N, 1024, 1024, nullptr};
        pg8::StaticOrder S; S.init(TP, IN_N, F.G, (int)blockIdx.x);
        pg8::EpiU E{Ur, Ua};
        pg8::gemm_phase<pg8::EpiU, pg8::StaticOrder, true, true>(F.lds, g, S, E);
    }
    SEAM(1);
    if (IN(2)) {
        {
            if (F.G == 256) { att_prep_unit(F, a, Ua, AB, F.bid); if (F.bid >= 32 && F.bid < 36) att_prep_unit(F, a, Ua, AB, 256 + F.bid - 32); }
            else for (int u = F.bid; u < TP / 64; u += F.G) att_prep_unit(F, a, Ua, AB, u);
        }
        {
            if (F.G == 256) {
                const int nk = (F.bid >= 32 && F.bid < 36) ? 7 : ((F.bid < 32 || (F.bid >= 36 && F.bid < 40)) ? 9 : 8);
#define PB(x) (32 * ((x) & 7) + ((x) >> 3))
                RwRaw R; rw_load_raw(R, Ur, PB(F.bid), F.tid);
                { RwW W0; rw_w_fetch(W0, F, a, PB(F.bid) & 7); __syncthreads(); rw_w_store(W0, F); LDS_WAIT(); __syncthreads(); }
#pragma unroll 1
                for (int kq = 0; kq < nk; ++kq) {
                    const int u = (kq < 8) ? PB(F.bid) + 256 * kq : (F.bid < 32 ? 2048 + F.bid : PB(F.bid - 4) + 256 * 7);
                    const int kn = kq + 1; const int un = (kn >= nk) ? -1 : ((kn < 8) ? PB(F.bid) + 256 * kn : (F.bid < 32 ? 2048 + F.bid : PB(F.bid - 4) + 256 * 7));
                    rwkv_unit(F, a, Ur, RB, u, R, un);
                }
            } else { RwRaw R; for (int u = F.bid; u < NUNIT; u += F.G) { rw_load_raw(R, Ur, u, F.tid); { RwW W0; rw_w_fetch(W0, F, a, u & 7); __syncthreads(); rw_w_store(W0, F); LDS_WAIT(); __syncthreads(); } rwkv_unit(F, a, Ur, RB, u, R, -1); } }
        }
    }
    SEAM(2);
    if (IN(3)) {
        if (F.bid < 32 && F.wave < 2) rwkv_scan(RB, F.bid, F.wave, F.lane);
        for (int i = next_ticket(F, ctl + CW_W3); i < 4 * 257;) {
            idx_unit(F, Ua, AB, i & 3, 256 - (i >> 2), a.flags);
            i = next_ticket(F, ctl + CW_W3);
        }
    }
    SEAM(3);
    if (IN(4)) {
        const OutY of{Ur};
        for (int u = F.bid * NWAVES + F.wave; u < NUNIT; u += F.G * NWAVES) rwkv_out_unit(RB, u, F.lane, of);
        for (int i = next_ticket(F, ctl + CW_W4); i < 17 * 32;) {
            attn_unit(F, Ua, AB, (i & 31) >> 3, i & 7, 16 - (i >> 5), of);
            i = next_ticket(F, ctl + CW_W4);
        }
    }
    SEAM(4);
    if (IN(5)) {
        pg8::Gemm g{Ur, (const bf16*)(F.ws + WS_WOUT), TP, 1024, 1024, UR_W, nullptr};
        pg8::StaticOrder S; S.init(TP, 1024, F.G, (int)blockIdx.x);
        pg8::EpiB16 E{(bf16*)MB.MIX, 1024};
        pg8::gemm_phase<pg8::EpiB16, pg8::StaticOrder, true, true>(F.lds, g, S, E);
        convert_experts(F, a, MB, 0, (TP / 256) * 4 - F.G > 0 ? (TP / 256) * 4 - F.G : 0);
    }
    SEAM(5);
    if (IN(6)) { p6_ln1_router(F, a, MB); }
    SEAM(6);
    if (IN(7)) { p7_moe(F, MB, false);
        { const int nu = 2 * moe_total_tiles((const unsigned*)(F.ws + WS_CTL) + CW_CNT); const int fw = nu - F.G; convert_experts(F, a, MB, 1, (fw > 0 && fw < F.G) ? fw : 0); } }
    SEAM(7);
    if (IN(8)) { p7_moe(F, MB, true); }
    SEAM(8);
    if (IN(9)) { p8_final(F, a, MB); }
#undef IN
#undef SEAM
}

}
extern "C" void kernel_launch(void* const* d_in, const int* in_sizes, int n_in, void* d_out, int out_size, void* d_ws, size_t ws_size, hipStream_t stream) {
    static int inited = 0;
    if (!inited) { (void)hipFuncSetAttribute((const void*)mk::mega, hipFuncAttributeMaxDynamicSharedMemorySize, mk::LDS_BYTES); inited = 1; }
    unsigned char* wsb = (unsigned char*)d_ws;
    (void)hipMemsetAsync(wsb + mk::WS_CTL, 0, mk::CTL_ZERO_BYTES, stream);
    mk::Args a{};
    for (int i = 0; i < 33; ++i) a.in[i] = (const float*)d_in[i];
    a.out = (float*)d_out; a.ws = wsb;
    static int grid = 0;
    if (!grid) { int dev = 0, cus = 0, per_cu = 0; (void)hipGetDevice(&dev); (void)hipDeviceGetAttribute(&cus, hipDeviceAttributeMultiprocessorCount, dev);
        (void)hipOccupancyMaxActiveBlocksPerMultiprocessor(&per_cu, (const void*)mk::mega, mk::NTHR, mk::LDS_BYTES); (void)hipGetLastError();
        if (per_cu < 1) per_cu = 1; if (cus < 1) cus = 256; grid = cus * per_cu; if (grid > 256) grid = 256; }
    a.ph_lo = 0; a.ph_hi = 10;
    { void* kargs[] = {(void*)&a};
      if (hipLaunchCooperativeKernel((const void*)mk::mega, dim3(grid), dim3(mk::NTHR), kargs, mk::LDS_BYTES, stream) != hipSuccess) {
          (void)hipGetLastError();
          hipLaunchKernelGGL(mk::mega, dim3(grid), dim3(mk::NTHR), mk::LDS_BYTES, stream, a);
      } }
}
```

```cpp
#include <hip/hip_runtime.h>
#include <math.h>
#include <stdint.h>
namespace pg8 {
#define PG8_LAS __attribute__((address_space(3)))
typedef unsigned short bf16_t;
typedef short bf16x8 __attribute__((ext_vector_type(8)));
typedef float f32x4 __attribute__((ext_vector_type(4)));
typedef unsigned u32x4 __attribute__((ext_vector_type(4)));
constexpr int BM = 256, BK = 64, HALF = 128, HTB = HALF * BK * 2  , STAGE_BYTES = 8 * HTB, NXCD = 8, WGM = 8;

__host__ __device__ __forceinline__ int lds_byte(int r, int c) { const int st = (r >> 4) * 2 + (c >> 5), rr = r & 15, cc = c & 31, ob = rr * 64 + cc * 2; return st * 1024 + (ob ^ (((ob >> 9) & 1) << 5)); }
__host__ __device__ __forceinline__ void stage_rc(int b, int& R, int& C) { const int st = b / 1024, sb = b % 1024, swz = sb ^ (((sb >> 9) & 1) << 5); R = (st >> 1) * 16 + swz / 64; C = (st & 1) * 32 + (swz % 64) / 2; }
__host__ __device__ __forceinline__ int perm32(int rho) { const int n = rho >> 4, i = rho & 15; return 8 * (i >> 2) + 4 * n + (i & 3); }

struct Unit { int pm, pn; };
struct Gemm { const bf16_t* A; const bf16_t* Bt; int M, N, K, lda; const int* rowidx; };

struct StaticOrder {
    int nM, nN, nwg, G, c;
    __host__ __device__ void init(int M, int N, int G_, int c_) { nM = M / BM; nN = N / BM; nwg = nM * nN; G = G_; c = c_; }
    __host__ __device__ bool next(int i, Unit& u) const {
        const long L = (long)i * G + c; if (L >= nwg) return false;
        int wgid = (int)L; { const int q = nwg / NXCD, r = nwg % NXCD, xcd = wgid % NXCD, off = wgid / NXCD; wgid = (xcd < r ? xcd * (q + 1) : r * (q + 1) + (xcd - r) * q) + off; }
        const int nig = WGM * nN, gid = wgid / nig, fm = gid * WGM, gsz = (nM - fm) < WGM ? (nM - fm) : WGM;
        u.pm = fm + ((wgid % nig) % gsz); u.pn = (wgid % nig) / gsz; return true;
    }
    __device__ __forceinline__ void a_ready(const Unit&) const {}
    __device__ __forceinline__ void done(const Unit&) const {}
};

__device__ __forceinline__ unsigned cvt_pk_bf16(float lo, float hi) { unsigned r; asm volatile("v_cvt_pk_bf16_f32 %0, %1, %2" : "=v"(r) : "v"(lo), "v"(hi)); return r; }
typedef float f32x2 __attribute__((ext_vector_type(2)));
__device__ __forceinline__ f32x2 gelu_pk(f32x2 v) {
    const f32x2 av = __builtin_elementwise_abs(v), d = av * 0.2316418882f + 1.0f;
    f32x2 t; t.x = __builtin_amdgcn_rcpf(d.x); t.y = __builtin_amdgcn_rcpf(d.y);
    f32x2 q = t * 0.5307027145f + (-0.7265760135f); q = q * t + 0.7107068705f; q = q * t + (-0.142248368f); q = q * t + 0.127414796f; q = q * t;
    const f32x2 s = (v * v) * (-0.72134752044f);
    f32x2 e; e.x = __builtin_amdgcn_exp2f(s.x); e.y = __builtin_amdgcn_exp2f(s.y);
    const f32x2 m = v * (q * e), r = v - m;
    f32x2 o; o.x = v.x < 0.f ? m.x : r.x; o.y = v.y < 0.f ? m.y : r.y; return o;
}

template <int ACT  > struct EpiBf16 {
    static constexpr bool PERM = true, AFTER_DRAIN = false; static_assert(ACT == 0 || ACT == 1, "EpiBf16: ACT is 0 (none) or 1 (gelu_pk)");
    bf16_t* O; int ldc; const float* bias; int split_cols; size_t split_stride; float scale0;
    __device__ __forceinline__ void operator()(const f32x4 (&acc)[2][2][4][2], const Unit& u, int wr, int wc, int fr, int fq) const {
        const int row0 = u.pm * BM + wr * 64 + fr; int colt = u.pn * BM; bf16_t* base = O;
        float sc = 1.f; if (split_cols) { const int t = colt / split_cols; base += (size_t)t * split_stride; colt -= t * split_cols; if (t == 0) sc = scale0; }
        const int col0 = colt + wc * 32 + 8 * fq, bcol0 = u.pn * BM + wc * 32 + 8 * fq;
        f32x4 bv[2][2];
#pragma unroll
        for (int bj = 0; bj < 2; ++bj)
#pragma unroll
            for (int n = 0; n < 2; ++n) bv[bj][n] = bias ? *(const f32x4*)(bias + bcol0 + bj * HALF + 4 * n) : (f32x4){0.f, 0.f, 0.f, 0.f};
#pragma unroll
        for (int ai = 0; ai < 2; ++ai)
#pragma unroll
            for (int m = 0; m < 4; ++m) { bf16_t* rowp = base + (size_t)(row0 + ai * HALF + m * 16) * ldc + col0;
#pragma unroll
                for (int bj = 0; bj < 2; ++bj) { f32x4 v0 = acc[ai][bj][m][0] + bv[bj][0], v1 = acc[ai][bj][m][1] + bv[bj][1];
                    if (ACT == 1) { f32x2 a = gelu_pk((f32x2){v0[0], v0[1]}), b = gelu_pk((f32x2){v0[2], v0[3]}), c = gelu_pk((f32x2){v1[0], v1[1]}), d = gelu_pk((f32x2){v1[2], v1[3]});
                        v0 = (f32x4){a.x, a.y, b.x, b.y}; v1 = (f32x4){c.x, c.y, d.x, d.y}; }
                    v0 = v0 * sc; v1 = v1 * sc; u32x4 w; w.x = cvt_pk_bf16(v0[0], v0[1]); w.y = cvt_pk_bf16(v0[2], v0[3]); w.z = cvt_pk_bf16(v1[0], v1[1]); w.w = cvt_pk_bf16(v1[2], v1[3]);
                    *(u32x4*)(rowp + bj * HALF) = w; } }
    }
};
template <class Epi, class Sched, bool ALIGN_EPI = false, bool SP2 = false, bool GATHER = false>
__device__ __forceinline__ void gemm_phase(PG8_LAS unsigned char* lds, const Gemm g, const Sched& S, const Epi& E) {
    const int tid = threadIdx.x, wid = __builtin_amdgcn_readfirstlane(tid >> 6), lane = tid & 63, wr = wid >> 2, wc = wid & 3, fr = lane & 15, fq = lane >> 4;
    const int K = g.K, nt = K / BK;
    unsigned voffA[2], voffA1[2], voffB[2];
#pragma unroll
    for (int i = 0; i < 2; ++i) { int R, C; stage_rc(tid * 16 + i * 8192, R, C); const int Rb = Epi::PERM ? ((R & ~31) + perm32(R & 31)) : R;
        if constexpr (GATHER) { voffA[i] = (unsigned)(g.rowidx[R] * g.lda + C) * 2u; voffA1[i] = (unsigned)(g.rowidx[R + HALF] * g.lda + C) * 2u; }
        else { voffA[i] = (unsigned)(R * g.lda + C) * 2u; voffA1[i] = voffA[i]; }
        voffB[i] = (unsigned)(Rb * K + C) * 2u; }
    const size_t kstep = (size_t)(BK * 2);
    const size_t hstep = (size_t)HALF * K * 2;
    const size_t tstep = 2 * hstep; const size_t hstepA = GATHER ? (size_t)0 : (size_t)HALF * g.lda * 2, tstepA = 2 * hstepA;
    const unsigned ldsw = (unsigned)wid * 1024u;
    const int aoff = lds_byte(wr * 64 + fr, fq * 8), boff = lds_byte(wc * 32 + fr, fq * 8);
#define PG8_SA(b, h) (((b) * 2 + (h)) * HTB)
#define PG8_SB(b, h) ((4 + (b) * 2 + (h)) * HTB)
#define PG8_STAGE(bufoff, gbase, voff) do { _Pragma("unroll") for (int _i = 0; _i < 2; ++_i) \
        __builtin_amdgcn_global_load_lds((const unsigned*)((const char*)(gbase) + (voff)[_i]), (PG8_LAS unsigned*)(lds + (bufoff) + ldsw + _i * 8192), 16, 0, 0); } while (0)
#define PG8_LDA(dst, b, h) do { _Pragma("unroll") for (int m = 0; m < 4; ++m) _Pragma("unroll") for (int k = 0; k < 2; ++k) dst[m][k] = *(const PG8_LAS bf16x8*)(lds + PG8_SA(b, h) + aoff + m * 2048 + k * 1024); } while (0)
#define PG8_LDB(dst, b, h) do { _Pragma("unroll") for (int n = 0; n < 2; ++n) _Pragma("unroll") for (int k = 0; k < 2; ++k) dst[n][k] = *(const PG8_LAS bf16x8*)(lds + PG8_SB(b, h) + boff + n * 2048 + k * 1024); } while (0)
#define PG8_MMA(ai, bj, At, Bt) do { __builtin_amdgcn_s_setprio(1); _Pragma("unroll") for (int m = 0; m < 4; ++m) _Pragma("unroll") for (int n = 0; n < 2; ++n) _Pragma("unroll") for (int k = 0; k < 2; ++k) \
        acc[ai][bj][m][n] = __builtin_amdgcn_mfma_f32_16x16x32_bf16(Bt[n][k], At[m][k], acc[ai][bj][m][n], 0, 0, 0); __builtin_amdgcn_s_setprio(0); } while (0)
#define PG8_WAIT_V(n) asm volatile("s_waitcnt vmcnt(" #n ")" ::: "memory")
#define PG8_WAIT_L(n) asm volatile("s_waitcnt lgkmcnt(" #n ")" ::: "memory")
#define PG8_BAR __builtin_amdgcn_s_barrier()
#define PG8_SCHED __builtin_amdgcn_sched_barrier(0)
    Unit cur, nxt; int ui = 0;
    if (!S.next(0, cur)) return;
    f32x4 acc[2][2][4][2];
#pragma unroll
    for (int a = 0; a < 2; ++a)
#pragma unroll
        for (int b = 0; b < 2; ++b)
#pragma unroll
            for (int m = 0; m < 4; ++m)
#pragma unroll
                for (int n = 0; n < 2; ++n) acc[a][b][m][n] = (f32x4){0.f, 0.f, 0.f, 0.f};
    bf16x8 At[4][2], B0[2][2], B1[2][2];
    const char* cA = (const char*)g.A + (size_t)cur.pm * tstepA; const char* cB = (const char*)g.Bt + (size_t)cur.pn * tstep;
    S.a_ready(cur);
    if constexpr (SP2) {
        PG8_STAGE(PG8_SB(0, 0), cB, voffB); PG8_STAGE(PG8_SB(0, 1), cB + hstep, voffB); PG8_STAGE(PG8_SA(0, 0), cA, voffA); PG8_STAGE(PG8_SA(0, 1), cA + hstepA, voffA1);
        if (wr == 1) PG8_BAR;
        PG8_WAIT_V(2); PG8_BAR;
        PG8_STAGE(PG8_SB(1, 0), cB + kstep, voffB); PG8_STAGE(PG8_SA(1, 0), cA + kstep, voffA); PG8_STAGE(PG8_SB(1, 1), cB + hstep + kstep, voffB);
        PG8_WAIT_V(6); PG8_BAR;
    } else {
        PG8_STAGE(PG8_SB(0, 0), cB, voffB); PG8_STAGE(PG8_SA(0, 0), cA, voffA); PG8_STAGE(PG8_SB(0, 1), cB + hstep, voffB); PG8_STAGE(PG8_SA(0, 1), cA + hstepA, voffA1);
        if (wr == 1) PG8_BAR;
        PG8_WAIT_V(4); PG8_BAR;
        PG8_STAGE(PG8_SB(1, 0), cB + kstep, voffB); PG8_STAGE(PG8_SA(1, 0), cA + kstep, voffA); PG8_STAGE(PG8_SB(1, 1), cB + hstep + kstep, voffB);
        PG8_WAIT_V(6); PG8_BAR;
    }
    for (;;) {
        const bool has_next = S.next(ui + 1, nxt);
        const char* nA = has_next ? (const char*)g.A + (size_t)nxt.pm * tstepA : cA; const char* nB = has_next ? (const char*)g.Bt + (size_t)nxt.pn * tstep : cB;
        for (int t = 0; t < nt; t += 2) {
            const bool last = (t == nt - 2);
            const char* a1 = cA + (size_t)(t + 1) * kstep;
            const char* a2 = last ? nA : cA + (size_t)(t + 2) * kstep; const char* b2 = last ? nB : cB + (size_t)(t + 2) * kstep;
            const char* a3 = a2 + kstep; const char* b3 = b2 + kstep;
            if (last && has_next) S.a_ready(nxt);
            if constexpr (SP2) {
            PG8_LDB(B0, 0, 0); PG8_LDB(B1, 0, 1); PG8_SCHED; PG8_LDA(At, 0, 0); PG8_STAGE(PG8_SA(1, 1), a1 + hstepA, voffA1);
            PG8_WAIT_V(8); PG8_WAIT_L(0); PG8_BAR; PG8_MMA(0, 0, At, B0); PG8_MMA(0, 1, At, B1); PG8_BAR; PG8_SCHED;
            PG8_LDA(At, 0, 1); PG8_STAGE(PG8_SB(0, 0), b2, voffB); PG8_STAGE(PG8_SB(0, 1), b2 + hstep, voffB); PG8_STAGE(PG8_SA(0, 0), a2, voffA);
            PG8_WAIT_V(8); PG8_WAIT_L(0); PG8_BAR; PG8_MMA(1, 0, At, B0); PG8_MMA(1, 1, At, B1); PG8_BAR; PG8_SCHED;
            PG8_LDB(B0, 1, 0); PG8_LDB(B1, 1, 1); PG8_SCHED; PG8_LDA(At, 1, 0); PG8_STAGE(PG8_SA(0, 1), a2 + hstepA, voffA1);
            PG8_WAIT_V(8); PG8_WAIT_L(0); PG8_BAR; PG8_MMA(0, 0, At, B0); PG8_MMA(0, 1, At, B1); PG8_BAR; PG8_SCHED;
            PG8_LDA(At, 1, 1); PG8_STAGE(PG8_SB(1, 0), b3, voffB); PG8_STAGE(PG8_SB(1, 1), b3 + hstep, voffB); PG8_STAGE(PG8_SA(1, 0), a3, voffA);
            PG8_WAIT_V(8); PG8_WAIT_L(0); PG8_BAR; PG8_MMA(1, 0, At, B0); PG8_MMA(1, 1, At, B1); PG8_BAR; PG8_SCHED;
            } else {
            PG8_LDB(B0, 0, 0); PG8_SCHED; PG8_LDA(At, 0, 0); PG8_STAGE(PG8_SA(1, 1), a1 + hstepA, voffA1);
            PG8_WAIT_L(8); PG8_BAR; PG8_WAIT_L(0); PG8_MMA(0, 0, At, B0); PG8_BAR; PG8_SCHED;
            PG8_LDB(B1, 0, 1); PG8_STAGE(PG8_SB(0, 0), b2, voffB);
            PG8_BAR; PG8_WAIT_L(0); PG8_MMA(0, 1, At, B1); PG8_BAR;
            PG8_LDA(At, 0, 1); PG8_STAGE(PG8_SA(0, 0), a2, voffA);
            PG8_BAR; PG8_WAIT_L(0); PG8_MMA(1, 0, At, B0); PG8_BAR; PG8_SCHED;
            PG8_STAGE(PG8_SB(0, 1), b2 + hstep, voffB);
            PG8_WAIT_V(6); PG8_BAR; PG8_MMA(1, 1, At, B1); PG8_BAR;
            PG8_LDB(B0, 1, 0); PG8_SCHED; PG8_LDA(At, 1, 0); PG8_STAGE(PG8_SA(0, 1), a2 + hstepA, voffA1);
            PG8_WAIT_L(8); PG8_BAR; PG8_WAIT_L(0); PG8_MMA(0, 0, At, B0); PG8_BAR; PG8_SCHED;
            PG8_LDB(B1, 1, 1); PG8_STAGE(PG8_SB(1, 0), b3, voffB);
            PG8_BAR; PG8_WAIT_L(0); PG8_MMA(0, 1, At, B1); PG8_BAR;
            PG8_LDA(At, 1, 1); PG8_STAGE(PG8_SA(1, 0), a3, voffA);
            PG8_BAR; PG8_WAIT_L(0); PG8_MMA(1, 0, At, B0); PG8_BAR; PG8_SCHED;
            PG8_STAGE(PG8_SB(1, 1), b3 + hstep, voffB);
            PG8_WAIT_V(6); PG8_BAR; PG8_MMA(1, 1, At, B1); PG8_BAR;
            }
        }
        if constexpr (ALIGN_EPI) { if (wr == 0) PG8_BAR; }
        if constexpr (!Epi::AFTER_DRAIN) { E(acc, cur, wr, wc, fr, fq); S.done(cur); }
        if (!has_next) break;
#pragma unroll
        for (int a = 0; a < 2; ++a)
#pragma unroll
            for (int b = 0; b < 2; ++b)
#pragma unroll
                for (int m = 0; m < 4; ++m)
#pragma unroll
                    for (int n = 0; n < 2; ++n) acc[a][b][m][n] = (f32x4){0.f, 0.f, 0.f, 0.f};
        cur = nxt; cA = nA; cB = nB; ++ui;
        if constexpr (ALIGN_EPI) { if (wr == 1) PG8_BAR; }
    }
    PG8_WAIT_V(0);
    if constexpr (!ALIGN_EPI) { if (wr == 0) PG8_BAR; }
    PG8_BAR;
    if constexpr (Epi::AFTER_DRAIN) { E.fused(acc, cur, wr, wc, fr, fq, lds, wid, lane); S.done(cur); }
#undef PG8_SA
#undef PG8_SB
#undef PG8_STAGE
#undef PG8_LDA
#undef PG8_LDB
#undef PG8_MMA
#undef PG8_WAIT_V
#undef PG8_WAIT_L
#undef PG8_BAR
#undef PG8_SCHED
}
}
namespace pg8 {
struct EpiF32 {
    static constexpr bool PERM = false, AFTER_DRAIN = false;
    float* O; int ldc;
    __device__ __forceinline__ void operator()(const f32x4 (&acc)[2][2][4][2], const Unit& u, int wr, int wc, int fr, int fq) const {
        const int row0 = u.pm * BM + wr * 64 + fr, col0 = u.pn * BM + wc * 32 + 4 * fq;
#pragma unroll
        for (int ai = 0; ai < 2; ++ai)
#pragma unroll
            for (int m = 0; m < 4; ++m) { float* rowp = O + (size_t)(row0 + ai * HALF + m * 16) * ldc + col0;
#pragma unroll
                for (int bj = 0; bj < 2; ++bj)
#pragma unroll
                    for (int n = 0; n < 2; ++n) *(f32x4*)(rowp + bj * HALF + n * 16) = acc[ai][bj][m][n]; }
    }
};
}
namespace pg8 {
struct EpiU {
    static constexpr bool PERM = true, AFTER_DRAIN = false;
    bf16_t* Ur; bf16_t* Ua;
    __device__ __forceinline__ void operator()(const f32x4 (&acc)[2][2][4][2], const Unit& u, int wr, int wc, int fr, int fq) const {
        const int row0 = u.pm * BM + wr * 64 + fr; int colt = u.pn * BM; bf16_t* base = Ur; int ld = 1792;
        if (colt >= 1792) { base = Ua; ld = 1536; colt -= 1792; }
        const int col0 = colt + wc * 32 + 8 * fq;
#pragma unroll
        for (int ai = 0; ai < 2; ++ai)
#pragma unroll
            for (int m = 0; m < 4; ++m) { bf16_t* rowp = base + (size_t)(row0 + ai * HALF + m * 16) * ld + col0;
#pragma unroll
                for (int bj = 0; bj < 2; ++bj) { const f32x4 v0 = acc[ai][bj][m][0], v1 = acc[ai][bj][m][1];
                    u32x4 w; w.x = cvt_pk_bf16(v0[0], v0[1]); w.y = cvt_pk_bf16(v0[2], v0[3]); w.z = cvt_pk_bf16(v1[0], v1[1]); w.w = cvt_pk_bf16(v1[2], v1[3]);
                    *(u32x4*)(rowp + bj * HALF) = w; } }
    }
};
}
namespace pg8 {
struct EpiB16 {
    static constexpr bool PERM = true, AFTER_DRAIN = false;
    bf16_t* O; int ldc;
    __device__ __forceinline__ void operator()(const f32x4 (&acc)[2][2][4][2], const Unit& u, int wr, int wc, int fr, int fq) const {
        const int row0 = u.pm * BM + wr * 64 + fr, col0 = u.pn * BM + wc * 32 + 8 * fq;
#pragma unroll
        for (int ai = 0; ai < 2; ++ai)
#pragma unroll
            for (int m = 0; m < 4; ++m) { bf16_t* rowp = O + (size_t)(row0 + ai * HALF + m * 16) * ldc + col0;
#pragma unroll
                for (int bj = 0; bj < 2; ++bj) { const f32x4 v0 = acc[ai][bj][m][0], v1 = acc[ai][bj][m][1];
                    u32x4 w; w.x = cvt_pk_bf16(v0[0], v0[1]); w.y = cvt_pk_bf16(v0[2], v0[3]); w.z = cvt_pk_bf16(v1[0], v1[1]); w.w = cvt_pk_bf16(v1[2], v1[3]);
                    *(u32x4*)(rowp + bj * HALF) = w; } }
    }
};
}
namespace mk {
#define GAS __attribute__((address_space(1)))
#define LAS __attribute__((address_space(3)))
typedef unsigned short bf16;
typedef unsigned v4u __attribute__((ext_vector_type(4)));
typedef unsigned v2u __attribute__((ext_vector_type(2)));
typedef float f32x4 __attribute__((ext_vector_type(4)));
typedef float f32x16 __attribute__((ext_vector_type(16)));
typedef short bf16x8 __attribute__((ext_vector_type(8)));
typedef GAS unsigned gu32;
typedef GAS unsigned long long gu64;
#define RLX_AGENT __ATOMIC_RELAXED, __HIP_MEMORY_SCOPE_AGENT
#define LDS_WAIT() asm volatile("s_waitcnt lgkmcnt(0)" ::: "memory")
#define VM_WAIT() asm volatile("s_waitcnt vmcnt(0)" ::: "memory")

constexpr int NB = 4, SEQ = 4096, NM = 16, L = 4112, LP = 4160, TP = NB * LP, D = 1024;
constexpr int NCH = LP / 64;
constexpr int UR_W = 1792, UA_W = 1536, IN_N = 3328, IN_COLS = 3144;
constexpr int NWAVES = 8, NTHR = 512;
constexpr float LN_EPS = 1e-5f, RMS_EPS = 1e-6f, GN_EPS = 64e-5f;
constexpr float DN_ALPHA = 1.189207115002721f;

typedef float f32x2_t __attribute__((ext_vector_type(2))); typedef __bf16 bf16x2_t __attribute__((ext_vector_type(2)));
__device__ __forceinline__ unsigned pk2(float lo, float hi) { f32x2_t v = {lo, hi}; bf16x2_t b = __builtin_convertvector(v, bf16x2_t); return __builtin_bit_cast(unsigned, b); }
__device__ __forceinline__ unsigned f2bf(float f) { return pk2(f, f) & 0xffffu; }
__device__ __forceinline__ float bf2f(unsigned short b) { return __uint_as_float(((unsigned)b) << 16); }
__device__ __forceinline__ float bflo(unsigned w) { return __uint_as_float(w << 16); }
__device__ __forceinline__ float bfhi(unsigned w) { return __uint_as_float(w & 0xffff0000u); }
__device__ __forceinline__ float dpp_f(float v, int ctrl_sel) {
    const int x = __float_as_int(v); int r;
    if (ctrl_sel == 0) r = __builtin_amdgcn_mov_dpp(x, 0xB1, 0xF, 0xF, true);
    else if (ctrl_sel == 1) r = __builtin_amdgcn_mov_dpp(x, 0x4E, 0xF, 0xF, true);
    else if (ctrl_sel == 2) r = __builtin_amdgcn_mov_dpp(x, 0x141, 0xF, 0xF, true);
    else r = __builtin_amdgcn_mov_dpp(x, 0x140, 0xF, 0xF, true);
    return __int_as_float(r);
}
__device__ __forceinline__ float sum_x16(float v) { auto rr = __builtin_amdgcn_permlane16_swap(__float_as_uint(v), __float_as_uint(v), false, false); return __uint_as_float(rr[0]) + __uint_as_float(rr[1]); }
__device__ __forceinline__ float sum_x32(float v) { auto rr = __builtin_amdgcn_permlane32_swap(__float_as_uint(v), __float_as_uint(v), false, false); return __uint_as_float(rr[0]) + __uint_as_float(rr[1]); }
__device__ __forceinline__ int isum_x16(int v) { auto rr = __builtin_amdgcn_permlane16_swap((unsigned)v, (unsigned)v, false, false); return (int)(rr[0] + rr[1]); }
__device__ __forceinline__ int isum_x32(int v) { auto rr = __builtin_amdgcn_permlane32_swap((unsigned)v, (unsigned)v, false, false); return (int)(rr[0] + rr[1]); }
__device__ __forceinline__ unsigned or_x16(unsigned v) { auto rr = __builtin_amdgcn_permlane16_swap(v, v, false, false); return rr[0] | rr[1]; }
__device__ __forceinline__ unsigned or_x32(unsigned v) { auto rr = __builtin_amdgcn_permlane32_swap(v, v, false, false); return rr[0] | rr[1]; }
__device__ __forceinline__ float sum8(float v) { v += dpp_f(v, 0); v += dpp_f(v, 1); v += dpp_f(v, 2); return v; }
__device__ __forceinline__ float wave_sum(float v) { v = sum8(v); v += dpp_f(v, 3); v = sum_x16(v); return sum_x32(v); }

constexpr size_t MiB = 1u << 20;
constexpr size_t WS_CTL = 0, CTL_ZERO_BYTES = 64 * 1024;
constexpr int CW_BAR = 1024;
constexpr size_t WS_ROPEQ = 1 * MiB;
constexpr size_t WS_ROPEI = WS_ROPEQ + (size_t)LP * 32 * 8;
constexpr size_t WS_ROWSTAT = WS_ROPEI + (size_t)LP * 16 * 8;
constexpr size_t WS_WIN = 3 * MiB;
constexpr size_t WS_WOUT = WS_WIN + (size_t)IN_N * 1024 * 2;
constexpr size_t WS_WQ = WS_WOUT + (size_t)1024 * 1024 * 2;
constexpr size_t WS_WW2 = WS_WQ + (size_t)1024 * 256 * 2;
constexpr size_t WS_WA2 = WS_WW2 + (size_t)512 * 64 * 2;
constexpr size_t WS_WG2 = WS_WA2 + (size_t)512 * 64 * 2;
constexpr size_t WS_WEND = WS_WG2 + (size_t)512 * 128 * 2;
static_assert(WS_WEND <= 13 * MiB, "weights region");

constexpr int RING_BYTES = 131072;
constexpr int LDS_BYTES = 147456;
constexpr int MISC_OFF = LDS_BYTES - 16;
#define XB_TMO      128
#define XB_XCNT(j)  (256  + 64 * (j))
#define XB_XSUB(j)  (1280 + 64 * (j))
#define XB_XGEN(j)  (2304 + 64 * (j))
#define XB_TOP      3328
#define XB_TOPGEN   3392
#define XCD_BAR_WORDS 3456
#define XB_SPIN_CAP (1u << 18)

__device__ __forceinline__ unsigned xb_ld(unsigned* p)              { return __hip_atomic_load(p, __ATOMIC_RELAXED, __HIP_MEMORY_SCOPE_AGENT); }
__device__ __forceinline__ unsigned xb_add(unsigned* p, unsigned v) { return __hip_atomic_fetch_add(p, v, __ATOMIC_RELAXED, __HIP_MEMORY_SCOPE_AGENT); }
__device__ __forceinline__ unsigned xb_xcc_id() { return (unsigned)__builtin_amdgcn_s_getreg((3 << 11) | 20) & 0xFu; }
#define XB_SPIN(cond, bar) do { unsigned _sp = 0; while (cond) { __builtin_amdgcn_s_sleep(1); \
    if ((++_sp & 255u) == 0u) { if (xb_ld(&(bar)[XB_TMO])) break; if (_sp > XB_SPIN_CAP) { atomicAdd(&(bar)[XB_TMO], 1u); break; } } } } while (0)

struct XcdBarrier {
    unsigned* bar; unsigned x;
    volatile LAS unsigned* st;
};

__device__ __forceinline__ XcdBarrier xcd_barrier_post(unsigned* bar, volatile LAS unsigned* st) {
    XcdBarrier b; b.bar = bar; b.x = xb_xcc_id(); b.st = st;
    if (threadIdx.x == 0) (void)xb_add(&bar[XB_XCNT(b.x)], 1u);
    return b;
}
__device__ __forceinline__ void xcd_barrier_complete(unsigned* bar, unsigned x, unsigned& nloc, unsigned& nx) {
    const unsigned G = gridDim.x * gridDim.y * gridDim.z;
    unsigned sum, cnt, mine, sp = 0u;
    for (;;) {
        sum = 0u; cnt = 0u; mine = 0u;
#pragma unroll
        for (unsigned j = 0; j < 16; ++j) { const unsigned c = xb_ld(&bar[XB_XCNT(j)]); sum += c; cnt += (c > 0u) ? 1u : 0u; mine = (j == x) ? c : mine; }
        if (sum == G) break;
        __builtin_amdgcn_s_sleep(1);
        if ((++sp & 255u) == 0u) { if (xb_ld(&bar[XB_TMO])) break; if (sp > XB_SPIN_CAP) { atomicAdd(&bar[XB_TMO], 1u); break; } }
    }
    nloc = mine > 0u ? mine : 1u; nx = cnt > 0u ? cnt : 1u;
}

__device__ __forceinline__ void xcd_barrier(const XcdBarrier& b) {
    asm volatile("s_waitcnt vmcnt(0)" ::: "memory");
    __syncthreads();
    if (threadIdx.x == 0) {
        unsigned* bar = b.bar;
        __builtin_amdgcn_s_waitcnt(0);
        unsigned nloc = b.st[0], nx = b.st[1];
        if (nloc == 0u) { xcd_barrier_complete(bar, b.x, nloc, nx); b.st[0] = nloc; b.st[1] = nx; }
        const unsigned old = xb_add(&bar[XB_XSUB(b.x)], 1u);
        const unsigned gen = old / nloc;
        if (old + 1u == (gen + 1u) * nloc) {
            __builtin_amdgcn_fence(__ATOMIC_RELEASE, "agent");
            asm volatile("s_waitcnt vmcnt(0)" ::: "memory");
            const unsigned og = xb_add(&bar[XB_TOP], 1u);
            const unsigned tg = og / nx;
            if (og + 1u == (tg + 1u) * nx) xb_add(&bar[XB_TOPGEN], 1u);
            else XB_SPIN(xb_ld(&bar[XB_TOPGEN]) == tg, bar);
            __builtin_amdgcn_fence(__ATOMIC_ACQUIRE, "agent");
            xb_add(&bar[XB_XGEN(b.x)], 1u);
            asm volatile("s_waitcnt vmcnt(0)" ::: "memory");
        } else {
            XB_SPIN(xb_ld(&bar[XB_XGEN(b.x)]) == gen, bar);
            __builtin_amdgcn_fence(__ATOMIC_ACQUIRE, "agent");
            asm volatile("s_waitcnt vmcnt(0)" ::: "memory");
        }
    }
    __syncthreads();
}
struct Args {
    const float* in[33]; float* out; unsigned char* ws; int ph_lo, ph_hi; int flags, pad_;
};
struct Frame {
    LAS unsigned char* lds;
    int tid, lane, wave, G, bid;
    unsigned char* ws;
};

__device__ __forceinline__ int rowmap_in(int n) {
    if (n >= 2048 && n < 2560) { const int d = (n - 2048) & 63, base = n - d; return base + (d < 32 ? 2 * d : 2 * (d - 32) + 1); }
    if (n >= 3072 && n < 3136) { const int d = n - 3072; return 3072 + (d < 16 ? 2 * d : (d < 32 ? 2 * (d - 16) + 1 : d)); }
    return n;
}
template <int MODE> __device__ __forceinline__ int rowmap(int n) {
    if (MODE == 1) return rowmap_in(n);
    if (MODE == 2) { const int d = n & 63, base = n - d; return base + (d < 32 ? 2 * d : 2 * (d - 32) + 1); }
    if (MODE == 4) return 2 * n;
    if (MODE == 3) { const int d = n & 63, base = n - d; return base + (d < 16 ? 2 * d : (d < 32 ? 2 * (d - 16) + 1 : d)); }
    return n;
}
template <int MODE> __device__ __forceinline__ void transpose_item(const float* __restrict__ W, int K, int N, bf16* WT, int row_off, LAS float* scr, int item, int nblk, int lane) {
    const int kb = item / nblk, nb = item % nblk, k0 = 64 * kb, n0 = 32 * nb;
    const int n = n0 + (lane & 31);
    float tv[32];
#pragma unroll
    for (int i = 0; i < 32; ++i) { const int kk = 2 * i + (lane >> 5); tv[i] = (n < N) ? W[(size_t)(k0 + kk) * N + n] : 0.f; }
#pragma unroll
    for (int i = 0; i < 32; ++i) { const int kk = 2 * i + (lane >> 5); scr[kk * 33 + (lane & 31)] = tv[i]; }
    LDS_WAIT(); asm volatile("" ::: "memory");
    const int c = lane & 7;
#pragma unroll
    for (int j = 0; j < 4; ++j) { const int nl = (lane >> 3) + 8 * j; const LAS float* s = scr + (8 * c) * 33 + nl;
        v4u o; o.x = pk2(s[0 * 33], s[1 * 33]); o.y = pk2(s[2 * 33], s[3 * 33]); o.z = pk2(s[4 * 33], s[5 * 33]); o.w = pk2(s[6 * 33], s[7 * 33]);
        *(v4u*)(WT + (size_t)(row_off + rowmap<MODE>(n0 + nl)) * K + k0 + 8 * c) = o; }
    LDS_WAIT(); asm volatile("" ::: "memory");
}
__device__ __forceinline__ void p0_ln_row(const Args& a, int pr, bf16* H0b, float2* rowstat, int lane) {
    const int b = pr / LP, t = pr % LP;
    unsigned long long* o8 = (unsigned long long*)(H0b + (size_t)pr * D) + lane;
    if (t >= L) {
#pragma unroll
        for (int j = 0; j < 4; ++j) o8[64 * j] = 0ull;
        if (lane == 0) rowstat[pr] = make_float2(0.f, 0.f);
        return;
    }
    const float* src = (t < NM) ? (a.in[1] + (size_t)t * D) : (a.in[0] + ((size_t)b * SEQ + (t - NM)) * D);
    const f32x4* xr = (const f32x4*)src + lane;
    f32x4 v[4]; float s = 0.f;
#pragma unroll
    for (int j = 0; j < 4; ++j) { v[j] = xr[64 * j]; s += (v[j].x + v[j].y) + (v[j].z + v[j].w); }
    const float mean = wave_sum(s) * (1.f / D); float s2 = 0.f;
#pragma unroll
    for (int j = 0; j < 4; ++j) { v[j] = v[j] - mean; s2 += (v[j].x * v[j].x + v[j].y * v[j].y) + (v[j].z * v[j].z + v[j].w * v[j].w); }
    const float rstd = 1.f / sqrtf(wave_sum(s2) * (1.f / D) + LN_EPS);
    const f32x4* gp = (const f32x4*)a.in[2] + lane; const f32x4* bp = (const f32x4*)a.in[3] + lane;
#pragma unroll
    for (int j = 0; j < 4; ++j) { const f32x4 g = gp[64 * j], bb = bp[64 * j]; const f32x4 y = v[j] * rstd * g + bb;
        o8[64 * j] = (unsigned long long)pk2(y.x, y.y) | ((unsigned long long)pk2(y.z, y.w) << 32); }
    if (lane == 0) rowstat[pr] = make_float2(mean, rstd);
}
__device__ __forceinline__ void p0_prologue(const Frame& F, const Args& a, bf16* H0b) {
    LAS float* scr = (LAS float*)(F.lds + F.wave * 16384);
    const int gw = F.bid * NWAVES + F.wave, NGW = F.G * NWAVES;
    bf16* Wt_in = (bf16*)(F.ws + WS_WIN); bf16* Wt_out = (bf16*)(F.ws + WS_WOUT); bf16* Wt_q = (bf16*)(F.ws + WS_WQ);
    bf16* Wt_w2 = (bf16*)(F.ws + WS_WW2); bf16* Wt_a2 = (bf16*)(F.ws + WS_WA2); bf16* Wt_g2 = (bf16*)(F.ws + WS_WG2);
    constexpr int I_IN = 16 * (IN_N / 32), I_OUT = 16 * 32, I_Q = 4 * 16, I_W2 = 1 * 16, I_G2 = 2 * 16;
    constexpr int NITEMS = I_IN + I_OUT + 2 * I_Q + 2 * I_W2 + I_G2;
    for (int it = gw; it < NITEMS; it += NGW) {
        int r = it;
        if (r < I_IN) { transpose_item<1>(a.in[4], 1024, IN_COLS, Wt_in, 0, scr, r, IN_N / 32, F.lane); continue; } r -= I_IN;
        if (r < I_OUT) { transpose_item<0>(a.in[21], 1024, 1024, Wt_out, 0, scr, r, 32, F.lane); continue; } r -= I_OUT;
        if (r < I_Q) { transpose_item<2>(a.in[17], 256, 512, Wt_q, 0, scr, r, 16, F.lane); continue; } r -= I_Q;
        if (r < I_Q) { transpose_item<3>(a.in[18], 256, 512, Wt_q, 512, scr, r, 16, F.lane); continue; } r -= I_Q;
        if (r < I_W2) { transpose_item<0>(a.in[7], 64, 512, Wt_w2, 0, scr, r, 16, F.lane); continue; } r -= I_W2;
        if (r < I_W2) { transpose_item<0>(a.in[9], 64, 512, Wt_a2, 0, scr, r, 16, F.lane); continue; } r -= I_W2;
        transpose_item<0>(a.in[10], 128, 512, Wt_g2, 0, scr, r, 16, F.lane);
    }
    float2* rowstat = (float2*)(F.ws + WS_ROWSTAT);
    for (int pr = gw; pr < TP; pr += NGW) p0_ln_row(a, pr, H0b, rowstat, F.lane);
    float2* rq = (float2*)(F.ws + WS_ROPEQ); float2* ri = (float2*)(F.ws + WS_ROPEI);
    const int gt = F.bid * NTHR + F.tid, NGT = F.G * NTHR;
    for (int i = gt; i < LP * 48; i += NGT) {
        if (i < LP * 32) { const int t = i >> 5, d = i & 31; const float ang = (float)t * exp2f(-(float)d * (13.287712379549449f / 32.f)); float sn, cs; sincosf(ang, &sn, &cs); rq[i] = make_float2(cs, sn); }
        else { const int j = i - LP * 32, t = j >> 4, d = j & 15; const float ang = (float)t * exp2f(-(float)d * (13.287712379549449f / 16.f)); float sn, cs; sincosf(ang, &sn, &cs); ri[j] = make_float2(cs, sn); }
    }
}
constexpr int LDM = 72;
constexpr int SLOT = 64 * LDM * 2;
constexpr int LDG = 136;
constexpr int RW_LW_OFF = 0 * SLOT;
constexpr int RW_LA_OFF = 4 * SLOT;
constexpr int RW_LG_OFF = 2 * SLOT;
static_assert(64 * LDG * 2 <= 2 * SLOT, "Lg fits in two slots");
constexpr int RW_A_OFF = 8 * SLOT;
constexpr int RW_G_OFF = RW_A_OFF + 16384;
constexpr int RW_CS_OFF = RW_G_OFF + 8192;
constexpr int RW_SEG_OFF = RW_CS_OFF + 16384;
constexpr int RW_GC_OFF = 13 * SLOT;
static_assert(RW_SEG_OFF + 2048 <= RW_GC_OFF, "rwkv LDS map");
constexpr size_t RW_UNIT_M = 4096 * 2, RW_UNIT_N = 4096 * 4, RW_UNIT_X = 4096 * 2;
constexpr int NUNIT = NB * NCH * 8;

struct RwkvBufs { bf16* M; float* N; bf16* Q; bf16* OP; bf16* G1; bf16* G2; bf16* HC; };

__device__ __forceinline__ bf16x8 lds_frag(const LAS bf16* base, int row, int koff) { return *(const LAS bf16x8*)(base + row * LDM + koff); }
__device__ __forceinline__ f32x4 mm_tile(const LAS bf16* X, const LAS bf16* Y, int ta, int tb, int lane, f32x4 acc) {
    const int r = lane & 15, ko = 8 * (lane >> 4);
#pragma unroll
    for (int ks = 0; ks < 2; ++ks) {
        const bf16x8 ya = lds_frag(Y, 16 * tb + r, 32 * ks + ko), xb = lds_frag(X, 16 * ta + r, 32 * ks + ko);
        acc = __builtin_amdgcn_mfma_f32_16x16x32_bf16(ya, xb, acc, 0, 0, 0);
    }
    return acc;
}
__device__ __forceinline__ void st_r(LAS bf16* dst, int a, int b0, f32x4 v) {
    v2u w; w.x = pk2(v[0], v[1]); w.y = pk2(v[2], v[3]); *(LAS v2u*)(dst + a * LDM + b0) = w;
}
__device__ __forceinline__ void st_t(LAS bf16* dst, int a, int b0, f32x4 v) {
#pragma unroll
    for (int i = 0; i < 4; ++i) dst[(b0 + i) * LDM + a] = (bf16)f2bf(v[i]);
}
__device__ __forceinline__ f32x4 ld_r(const LAS bf16* src, int a, int b0) {
    const v2u w = *(const LAS v2u*)(src + a * LDM + b0);
    return (f32x4){bflo(w.x), bfhi(w.x), bflo(w.y), bfhi(w.y)};
}
__device__ __forceinline__ void st8(LAS bf16* dst, const float (&v)[8]) {
    v4u w; w.x = pk2(v[0], v[1]); w.y = pk2(v[2], v[3]); w.z = pk2(v[4], v[5]); w.w = pk2(v[6], v[7]); *(LAS v4u*)dst = w;
}
__device__ __forceinline__ void unpack8(v4u w, float (&o)[8]) {
    o[0] = bflo(w.x); o[1] = bfhi(w.x); o[2] = bflo(w.y); o[3] = bfhi(w.y); o[4] = bflo(w.z); o[5] = bfhi(w.z); o[6] = bflo(w.w); o[7] = bfhi(w.w);
}
__device__ __forceinline__ void ld8f(const float* p, float (&o)[8]) {
    const f32x4 a = *(const f32x4*)p, b = *(const f32x4*)(p + 4);
    o[0] = a.x; o[1] = a.y; o[2] = a.z; o[3] = a.w; o[4] = b.x; o[5] = b.y; o[6] = b.z; o[7] = b.w;
}
__device__ __forceinline__ float sigmoidf_(float x) { return __builtin_amdgcn_rcpf(1.f + __expf(-x)); }
__device__ __forceinline__ float tanhf_(float x) { return 1.f - 2.f * __builtin_amdgcn_rcpf(1.f + __expf(2.f * x)); }

constexpr int RW_WG2_OFF = 13 * SLOT, RW_WB_OFF = 13 * SLOT + 64 * LDG * 2, RW_WW2_OFF = 15 * SLOT, RW_WA2_OFF = 1 * SLOT;
static_assert(RW_WB_OFF + 512 <= 15 * SLOT, "LoRA weights LDS map");
constexpr int RW_MU_OFF = 12 * SLOT;
struct RwW { v4u v[4]; float mu, bias; };
__device__ __forceinline__ void rw_w_fetch(RwW& W, const Frame& F, const Args& a, int h) {
    const bf16* W2 = (const bf16*)(F.ws + WS_WW2); const bf16* A2 = (const bf16*)(F.ws + WS_WA2); const bf16* G2w = (const bf16*)(F.ws + WS_WG2);
    const int t = F.tid;
    W.v[0] = *(const v4u*)(W2 + (size_t)(64 * h + (t >> 3)) * 64 + 8 * (t & 7));
    W.v[1] = *(const v4u*)(A2 + (size_t)(64 * h + (t >> 3)) * 64 + 8 * (t & 7));
    W.v[2] = *(const v4u*)(G2w + (size_t)(64 * h + (t >> 4)) * 128 + 8 * (t & 15));
    W.v[3] = *(const v4u*)(G2w + (size_t)(64 * h + 32 + (t >> 4)) * 128 + 8 * (t & 15));
    W.mu = (t < 192) ? a.in[5][512 * (t >> 6) + 64 * h + (t & 63)] : ((t < 448) ? a.in[5][1536 + (t - 192)] : a.in[11][64 * h + (t - 448)]);
    W.bias = (t < 64) ? a.in[6][64 * h + t] : ((t < 128) ? a.in[8][64 * h + (t - 64)] : 0.f);
}
__device__ __forceinline__ void rw_w_store(const RwW& W, const Frame& F) {
    const int t = F.tid;
    *(LAS v4u*)(F.lds + RW_WW2_OFF + ((t >> 3) * LDM + 8 * (t & 7)) * 2) = W.v[0];
    *(LAS v4u*)(F.lds + RW_WA2_OFF + ((t >> 3) * LDM + 8 * (t & 7)) * 2) = W.v[1];
    *(LAS v4u*)(F.lds + RW_WG2_OFF + ((t >> 4) * LDG + 8 * (t & 15)) * 2) = W.v[2];
    *(LAS v4u*)(F.lds + RW_WG2_OFF + ((32 + (t >> 4)) * LDG + 8 * (t & 15)) * 2) = W.v[3];
    if (t < 128) *(LAS float*)(F.lds + RW_WB_OFF + 4 * t) = W.bias;
    *(LAS float*)(F.lds + RW_MU_OFF + 4 * t) = W.mu;
}
struct RwRaw { v4u c[7], p[7]; };
__device__ __forceinline__ void rw_load_raw(RwRaw& R, const bf16* __restrict__ Ur, int uidx, int tid) {
    const int h = uidx & 7, bc = uidx >> 3, c = bc % NCH, b = bc / NCH, tau = tid >> 3, q = tid & 7;
    const size_t prow = (size_t)b * LP + (size_t)c * 64 + tau;
    const bool has_prev = (c > 0) || (tau > 0);
    const bf16* ucur = Ur + prow * UR_W; const bf16* uprv = ucur - UR_W;
    const v4u z = {0u, 0u, 0u, 0u};
#pragma unroll
    for (int j = 0; j < 7; ++j) { const int col = (j < 3) ? (512 * j + 64 * h + 8 * q) : (1536 + 64 * (j - 3) + 8 * q);
        R.c[j] = *(const v4u*)(ucur + col); R.p[j] = has_prev ? *(const v4u*)(uprv + col) : z; }
}
__device__ __forceinline__ void rwkv_unit(const Frame& F, const Args& a, const bf16* __restrict__ Ur, const RwkvBufs& RB, int uidx, RwRaw& R, int unext) {
    const int h = uidx & 7, bc = uidx >> 3, c = bc % NCH, b = bc / NCH;
    const int tid = F.tid, lane = F.lane, w = F.wave;
    LAS unsigned char* lds = F.lds;
#define MAT(i) ((LAS bf16*)(lds + (i) * SLOT))
    LAS bf16 *Rg = MAT(0), *Kg = MAT(1), *KgT = MAT(2), *Bi = MAT(3), *nBiT = MAT(4), *Ki = MAT(5), *KiT = MAT(6), *VT = MAT(7);
    LAS bf16 *Akk = MAT(8), *nArb = MAT(9), *Ark = MAT(10), *Pa = MAT(11), *PaT = MAT(12), *Pb = MAT(13), *PbT = MAT(14), *Ta = MAT(15), *Tb = MAT(1);
    LAS bf16 *AVT = MAT(3), *WuT = MAT(5), *UvT = MAT(8);
    LAS bf16* Lw = (LAS bf16*)(lds + RW_LW_OFF); LAS bf16* La = (LAS bf16*)(lds + RW_LA_OFF); LAS bf16* Lg = (LAS bf16*)(lds + RW_LG_OFF);
    LAS float* Af = (LAS float*)(lds + RW_A_OFF); LAS bf16* Gb = (LAS bf16*)(lds + RW_G_OFF); LAS float* CS = (LAS float*)(lds + RW_CS_OFF);
    LAS float* gC = (LAS float*)(lds + RW_GC_OFF); LAS float* SEG = (LAS float*)(lds + RW_SEG_OFF);
    const float* mu = a.in[5];
    const int ta = w >> 1, ar = 16 * ta + (lane & 15), ko = 8 * (lane >> 4);
    const int tau = tid >> 3, q = tid & 7;
    float r8[8], k8[8], v8[8], kk8[8];
    {
        float cu[8], pv[8], m8[8];
        const int ch0 = 64 * h + 8 * q;
        const LAS float* MUL = (const LAS float*)(lds + RW_MU_OFF);
#define RW_LD8L(p_, o_) do { const f32x4 x0_ = *(const LAS f32x4*)(p_), x1_ = *(const LAS f32x4*)((p_) + 4); o_[0] = x0_.x; o_[1] = x0_.y; o_[2] = x0_.z; o_[3] = x0_.w; o_[4] = x1_.x; o_[5] = x1_.y; o_[6] = x1_.z; o_[7] = x1_.w; } while (0)
        unpack8(R.c[0], cu); unpack8(R.p[0], pv);
        RW_LD8L(MUL + 8 * q, m8);
#pragma unroll
        for (int i = 0; i < 8; ++i) r8[i] = cu[i] + (pv[i] - cu[i]) * m8[i];
        unpack8(R.c[1], cu); unpack8(R.p[1], pv);
        RW_LD8L(MUL + 64 + 8 * q, m8);
#pragma unroll
        for (int i = 0; i < 8; ++i) k8[i] = cu[i] + (pv[i] - cu[i]) * m8[i];
        unpack8(R.c[2], cu); unpack8(R.p[2], pv);
        RW_LD8L(MUL + 128 + 8 * q, m8);
#pragma unroll
        for (int i = 0; i < 8; ++i) v8[i] = cu[i] + (pv[i] - cu[i]) * m8[i];
        float kkc[8]; RW_LD8L(MUL + 448 + 8 * q, kkc);
        float ss = 0.f;
#pragma unroll
        for (int i = 0; i < 8; ++i) { kk8[i] = k8[i] * kkc[i]; ss += kk8[i] * kk8[i]; }
        ss = sum8(ss);
        const float inv = 1.f / fmaxf(sqrtf(ss), 1e-12f);
#pragma unroll
        for (int i = 0; i < 8; ++i) kk8[i] *= inv;
#pragma unroll
        for (int i = 0; i < 4; ++i) {
            const int col = 1536 + 64 * i + 8 * q;
            unpack8(R.c[3 + i], cu); unpack8(R.p[3 + i], pv);
            RW_LD8L(MUL + 192 + 64 * i + 8 * q, m8);
            float o[8];
#pragma unroll
            for (int e = 0; e < 8; ++e) { const float x = cu[e] + (pv[e] - cu[e]) * m8[e]; o[e] = (i == 0) ? tanhf_(x) : (i == 1 ? x : sigmoidf_(x)); }
            if (i == 0) st8(Lw + tau * LDM + 8 * q, o);
            else if (i == 1) st8(La + tau * LDM + 8 * q, o);
            else st8(Lg + tau * LDG + 64 * (i - 2) + 8 * q, o);
        }
    }
    LDS_WAIT(); __syncthreads();
    {
        const LAS bf16* W2L = (const LAS bf16*)(lds + RW_WW2_OFF); const LAS bf16* A2L = (const LAS bf16*)(lds + RW_WA2_OFF); const LAS bf16* G2L = (const LAS bf16*)(lds + RW_WG2_OFF);
#pragma unroll 1
        for (int tt = 0; tt < 2; ++tt) {
            const int tb = 2 * (w & 1) + tt, b0 = 16 * tb + 4 * (lane >> 4), chl = 16 * tb + (lane & 15);
            f32x4 aw = {0.f, 0.f, 0.f, 0.f}, aa = aw, ag = aw;
#pragma unroll
            for (int ks = 0; ks < 2; ++ks) {
                const bf16x8 yw = *(const LAS bf16x8*)(W2L + chl * LDM + 32 * ks + ko), ya = *(const LAS bf16x8*)(A2L + chl * LDM + 32 * ks + ko);
                const bf16x8 xw = *(const LAS bf16x8*)(Lw + ar * LDM + 32 * ks + ko), xa = *(const LAS bf16x8*)(La + ar * LDM + 32 * ks + ko);
                aw = __builtin_amdgcn_mfma_f32_16x16x32_bf16(yw, xw, aw, 0, 0, 0);
                aa = __builtin_amdgcn_mfma_f32_16x16x32_bf16(ya, xa, aa, 0, 0, 0);
            }
#pragma unroll
            for (int ks = 0; ks < 4; ++ks) {
                const bf16x8 yg = *(const LAS bf16x8*)(G2L + chl * LDG + 32 * ks + ko);
                const bf16x8 xg = *(const LAS bf16x8*)(Lg + ar * LDG + 32 * ks + ko);
                ag = __builtin_amdgcn_mfma_f32_16x16x32_bf16(yg, xg, ag, 0, 0, 0);
            }
            const f32x4 w0v = *(const LAS f32x4*)(lds + RW_WB_OFF + 4 * b0), a0v = *(const LAS f32x4*)(lds + RW_WB_OFF + 256 + 4 * b0);
            f32x4 lw, av;
#pragma unroll
            for (int i = 0; i < 4; ++i) {
                const float xw = -(w0v[i] + aw[i]);
                const float sp = (xw > 20.f) ? xw : __logf(1.f + __expf(xw));
                lw[i] = -__expf(-sp - 0.5f);
                av[i] = sigmoidf_(a0v[i] + aa[i]);
            }
            *(LAS f32x4*)(CS + ar * 64 + b0) = lw;
            *(LAS f32x4*)(Af + ar * 64 + b0) = av;
            v2u gw; gw.x = pk2(ag[0], ag[1]); gw.y = pk2(ag[2], ag[3]); *(LAS v2u*)(Gb + ar * 64 + b0) = gw;
        }
    }
    float kac[8], rkc[8], lng[8], lnb[8];
    { const int ch0_ = 64 * h + 8 * (tid & 7); ld8f(a.in[12] + ch0_, kac); ld8f(a.in[13] + ch0_, rkc); ld8f(a.in[14] + ch0_, lng); ld8f(a.in[15] + ch0_, lnb); }
    LDS_WAIT(); __syncthreads();
    {
        const int j = tid & 63, sg = tid >> 6;
        float run = 0.f;
#pragma unroll
        for (int i = 0; i < 8; ++i) { run += CS[(8 * sg + i) * 64 + j]; CS[(8 * sg + i) * 64 + j] = run; }
        SEG[sg * 64 + j] = run;
        LDS_WAIT(); __syncthreads();
        float off = 0.f;
        for (int s = 0; s < sg; ++s) off += SEG[s * 64 + j];
#pragma unroll
        for (int i = 0; i < 8; ++i) CS[(8 * sg + i) * 64 + j] += off;
    }
    LDS_WAIT(); __syncthreads();
    {
        float cs[8], csp[8], av[8], gt[8];
        { const LAS f32x4* p = (const LAS f32x4*)(CS + tau * 64 + 8 * q); const f32x4 x0 = p[0], x1 = p[1];
          cs[0] = x0.x; cs[1] = x0.y; cs[2] = x0.z; cs[3] = x0.w; cs[4] = x1.x; cs[5] = x1.y; cs[6] = x1.z; cs[7] = x1.w; }
        if (tau > 0) { const LAS f32x4* p = (const LAS f32x4*)(CS + (tau - 1) * 64 + 8 * q); const f32x4 x0 = p[0], x1 = p[1];
          csp[0] = x0.x; csp[1] = x0.y; csp[2] = x0.z; csp[3] = x0.w; csp[4] = x1.x; csp[5] = x1.y; csp[6] = x1.z; csp[7] = x1.w; }
        else {
#pragma unroll
          for (int i = 0; i < 8; ++i) csp[i] = 0.f; }
        { const LAS f32x4* p = (const LAS f32x4*)(Af + tau * 64 + 8 * q); const f32x4 x0 = p[0], x1 = p[1];
          av[0] = x0.x; av[1] = x0.y; av[2] = x0.z; av[3] = x0.w; av[4] = x1.x; av[5] = x1.y; av[6] = x1.z; av[7] = x1.w; }
        unpack8(*(const LAS v4u*)(Gb + tau * 64 + 8 * q), gt);
        float o_rg[8], o_kg[8], o_bi[8], o_ki[8];
        float bon = 0.f;
#pragma unroll
        for (int i = 0; i < 8; ++i) {
            const float g = __expf(cs[i]), gi = __expf(-cs[i]), gm = __expf(csp[i]);
            o_rg[i] = r8[i] * g; o_kg[i] = kk8[i] * gm;
            const float bb = kk8[i] * av[i]; o_bi[i] = bb * gi;
            const float kt = k8[i] * (1.f + (av[i] - 1.f) * kac[i]); o_ki[i] = kt * gi;
            bon += r8[i] * kt * rkc[i];
            if (tau == 63) gC[8 * q + i] = g;
        }
        bon = sum8(bon);
        st8(Rg + tau * LDM + 8 * q, o_rg); st8(Kg + tau * LDM + 8 * q, o_kg); st8(Bi + tau * LDM + 8 * q, o_bi); st8(Ki + tau * LDM + 8 * q, o_ki);
#pragma unroll
        for (int i = 0; i < 8; ++i) {
            const int j = 8 * q + i;
            KgT[j * LDM + tau] = (bf16)f2bf(o_kg[i]); nBiT[j * LDM + tau] = (bf16)f2bf(-o_bi[i]); KiT[j * LDM + tau] = (bf16)f2bf(o_ki[i]); VT[j * LDM + tau] = (bf16)f2bf(v8[i]);
        }
        float g1[8], g2[8];
#pragma unroll
        for (int i = 0; i < 8; ++i) { g1[i] = lng[i] * gt[i]; g2[i] = (lnb[i] + bon * v8[i]) * gt[i]; }
        v4u w1; w1.x = pk2(g1[0], g1[1]); w1.y = pk2(g1[2], g1[3]); w1.z = pk2(g1[4], g1[5]); w1.w = pk2(g1[6], g1[7]);
        v4u w2; w2.x = pk2(g2[0], g2[1]); w2.y = pk2(g2[2], g2[3]); w2.z = pk2(g2[4], g2[5]); w2.w = pk2(g2[6], g2[7]);
        *(v4u*)(RB.G1 + (size_t)uidx * 4096 + tau * 64 + 8 * q) = w1;
        *(v4u*)(RB.G2 + (size_t)uidx * 4096 + tau * 64 + 8 * q) = w2;
    }
    LDS_WAIT(); __syncthreads();
    const f32x4 zero4 = {0.f, 0.f, 0.f, 0.f};
    const float gj = gC[ar];
    if (unext >= 0) rw_load_raw(R, Ur, unext, tid);
#pragma unroll 1
    for (int tt = 0; tt < 2; ++tt) {
        const int tb = 2 * (w & 1) + tt, b0 = 16 * tb + 4 * (lane >> 4);
        f32x4 zkb = mm_tile(Kg, Bi, ta, tb, lane, zero4), zkk = mm_tile(Kg, Ki, ta, tb, lane, zero4);
        f32x4 zrb = mm_tile(Rg, Bi, ta, tb, lane, zero4), zrk = mm_tile(Rg, Ki, ta, tb, lane, zero4);
        f32x4 p0, t0;
#pragma unroll
        for (int i = 0; i < 4; ++i) {
            const int s = b0 + i;
            p0[i] = (s < ar) ? -zkb[i] : 0.f; t0[i] = p0[i] + ((s == ar) ? 1.f : 0.f);
            zkk[i] = (s < ar) ? zkk[i] : 0.f; zrb[i] = (s <= ar) ? -zrb[i] : 0.f; zrk[i] = (s <= ar) ? zrk[i] : 0.f;
        }
        st_r(Pa, ar, b0, p0); st_t(PaT, ar, b0, p0); st_r(Ta, ar, b0, t0); st_r(Akk, ar, b0, zkk); st_r(nArb, ar, b0, zrb); st_r(Ark, ar, b0, zrk);
    }
    LDS_WAIT(); __syncthreads();
#pragma unroll 1
    for (int tt = 0; tt < 2; ++tt) {
        const int tb = 2 * (w & 1) + tt, b0 = 16 * tb + 4 * (lane >> 4);
        const f32x4 p = mm_tile(Pa, PaT, ta, tb, lane, zero4); st_r(Pb, ar, b0, p); st_t(PbT, ar, b0, p);
        const f32x4 av = mm_tile(VT, Akk, ta, tb, lane, zero4); st_r(AVT, ar, b0, av);
    }
    LDS_WAIT(); __syncthreads();
#define RW_SQ_ACC(Pin, PinT, Pout, PoutT, Tin, Tout, DO_SQ) do { _Pragma("unroll 1") for (int tt = 0; tt < 2; ++tt) { \
        const int tb = 2 * (w & 1) + tt, b0 = 16 * tb + 4 * (lane >> 4); \
        if (DO_SQ) { const f32x4 p = mm_tile(Pin, PinT, ta, tb, lane, zero4); st_r(Pout, ar, b0, p); st_t(PoutT, ar, b0, p); } \
        const f32x4 tn = mm_tile(Tin, PinT, ta, tb, lane, ld_r(Tin, ar, b0)); st_r(Tout, ar, b0, tn); } \
        LDS_WAIT(); __syncthreads(); } while (0)
    RW_SQ_ACC(Pb, PbT, Pa, PaT, Ta, Tb, true);
    RW_SQ_ACC(Pa, PaT, Pb, PbT, Tb, Ta, true);
    RW_SQ_ACC(Pb, PbT, Pa, PaT, Ta, Tb, true);
    RW_SQ_ACC(Pa, PaT, Pb, PbT, Tb, Ta, true);
    RW_SQ_ACC(Pb, PbT, Pa, PaT, Ta, Tb, false);
#undef RW_SQ_ACC
#pragma unroll 1
    for (int tt = 0; tt < 2; ++tt) {
        const int tb = 2 * (w & 1) + tt, b0 = 16 * tb + 4 * (lane >> 4);
        st_r(WuT, ar, b0, mm_tile(KgT, Tb, ta, tb, lane, zero4));
        st_r(UvT, ar, b0, mm_tile(AVT, Tb, ta, tb, lane, zero4));
    }
    LDS_WAIT(); __syncthreads();
    RwW Wn; if (unext >= 0) rw_w_fetch(Wn, F, a, unext & 7);
#pragma unroll 1
    for (int tt = 0; tt < 2; ++tt) {
        const int tb = 2 * (w & 1) + tt, b0 = 16 * tb + 4 * (lane >> 4);
        { const f32x4 z = mm_tile(nBiT, WuT, ta, tb, lane, zero4);
          const int m = ar >> 5, rp = ar & 31;
          bf16* Mo = RB.M + (size_t)uidx * 4096;
          float v4[4];
#pragma unroll
          for (int i = 0; i < 4; ++i) { const int jp = b0 + i; v4[i] = gj * (z[i] + ((jp == ar) ? 1.f : 0.f)); }
          { const int kb = b0 >> 5, qq = b0 & 31, s_ = qq >> 4, p = qq & 15, e0 = 4 * (p >> 3), hh = (p >> 2) & 1, ln = rp + 32 * hh;
            v2u w; w.x = pk2(v4[0], v4[1]); w.y = pk2(v4[2], v4[3]);
            *(v2u*)(Mo + ((((m * 2 + kb) * 2 + s_) * 64 + ln) << 3) + e0) = w; } }
        { f32x4 z = mm_tile(KiT, VT, ta, tb, lane, zero4); z = mm_tile(nBiT, UvT, ta, tb, lane, z);
          const int m = ar >> 5, qq = ar & 31, hh = (qq >> 2) & 1, rg = (qq & 3) + 4 * (qq >> 3);
          float* No = RB.N + (size_t)uidx * 4096;
          { const int n = b0 >> 5, cc = b0 & 31; *(f32x4*)(No + ((m * 2 + n) * 16 + rg) * 64 + cc + 32 * hh) = z * gj; } }
        { const f32x4 z = mm_tile(nArb, WuT, ta, tb, lane, ld_r(Rg, ar, b0)); v2u o; o.x = pk2(z[0], z[1]); o.y = pk2(z[2], z[3]);
          *(v2u*)(RB.Q + (size_t)uidx * 4096 + ar * 64 + b0) = o; }
        { f32x4 z = mm_tile(Ark, VT, ta, tb, lane, zero4); z = mm_tile(nArb, UvT, ta, tb, lane, z); v2u o; o.x = pk2(z[0], z[1]); o.y = pk2(z[2], z[3]);
          *(v2u*)(RB.OP + (size_t)uidx * 4096 + ar * 64 + b0) = o; }
    }
    if (unext >= 0) rw_w_store(Wn, F);
    LDS_WAIT(); __syncthreads();
#undef MAT
}

__device__ __forceinline__ void rwkv_scan(const RwkvBufs& RB, int bh, int n, int lane) {
    const int b = bh >> 3, h = bh & 7;
    f32x16 X0, X1;
#pragma unroll
    for (int r = 0; r < 16; ++r) { X0[r] = 0.f; X1[r] = 0.f; }
    const int cc = lane & 31, hh = lane >> 5;
    bf16x8 Mc[2][2][2], Mn[2][2][2]; f32x16 N0, N1, N0n, N1n;
    {
        const int uidx = ((b * NCH) << 3) + h;
        const bf16* Mi = RB.M + (size_t)uidx * 4096; const float* Ni = RB.N + (size_t)uidx * 4096;
#pragma unroll
        for (int m = 0; m < 2; ++m)
#pragma unroll
            for (int kb = 0; kb < 2; ++kb)
#pragma unroll
                for (int s = 0; s < 2; ++s) Mc[m][kb][s] = *(const bf16x8*)(Mi + ((((m * 2 + kb) * 2 + s) * 64 + lane) << 3));
#pragma unroll
        for (int r = 0; r < 16; ++r) { N0[r] = Ni[((0 * 2 + n) * 16 + r) * 64 + lane]; N1[r] = Ni[((1 * 2 + n) * 16 + r) * 64 + lane]; }
    }
#pragma unroll 1
    for (int c = 0; c < NCH; ++c) {
        const int uidx = ((b * NCH + c) << 3) + h;
        {
            const int un = ((b * NCH + min(c + 1, NCH - 1)) << 3) + h;
            const bf16* Mi = RB.M + (size_t)un * 4096; const float* Ni = RB.N + (size_t)un * 4096;
#pragma unroll
            for (int m = 0; m < 2; ++m)
#pragma unroll
                for (int kb = 0; kb < 2; ++kb)
#pragma unroll
                    for (int s = 0; s < 2; ++s) Mn[m][kb][s] = *(const bf16x8*)(Mi + ((((m * 2 + kb) * 2 + s) * 64 + lane) << 3));
#pragma unroll
            for (int r = 0; r < 16; ++r) { N0n[r] = Ni[((0 * 2 + n) * 16 + r) * 64 + lane]; N1n[r] = Ni[((1 * 2 + n) * 16 + r) * 64 + lane]; }
        }
        bf16* Ho = RB.HC + (size_t)uidx * 4096 + (size_t)(32 * n + cc) * 64;
#pragma unroll
        for (int g = 0; g < 4; ++g) {
            v2u w0; w0.x = pk2(X0[4 * g], X0[4 * g + 1]); w0.y = pk2(X0[4 * g + 2], X0[4 * g + 3]); *(v2u*)(Ho + 8 * g + 4 * hh) = w0;
            v2u w1; w1.x = pk2(X1[4 * g], X1[4 * g + 1]); w1.y = pk2(X1[4 * g + 2], X1[4 * g + 3]); *(v2u*)(Ho + 32 + 8 * g + 4 * hh) = w1;
        }
        bf16x8 bf[2][2];
#pragma unroll
        for (int s = 0; s < 2; ++s) {
            v4u t0; t0.x = pk2(X0[8 * s], X0[8 * s + 1]); t0.y = pk2(X0[8 * s + 2], X0[8 * s + 3]); t0.z = pk2(X0[8 * s + 4], X0[8 * s + 5]); t0.w = pk2(X0[8 * s + 6], X0[8 * s + 7]);
            v4u t1; t1.x = pk2(X1[8 * s], X1[8 * s + 1]); t1.y = pk2(X1[8 * s + 2], X1[8 * s + 3]); t1.z = pk2(X1[8 * s + 4], X1[8 * s + 5]); t1.w = pk2(X1[8 * s + 6], X1[8 * s + 7]);
            bf[0][s] = __builtin_bit_cast(bf16x8, t0); bf[1][s] = __builtin_bit_cast(bf16x8, t1);
        }
        f32x16 Y0 = N0, Y1 = N1;
#pragma unroll
        for (int kb = 0; kb < 2; ++kb)
#pragma unroll
            for (int s = 0; s < 2; ++s) {
                Y0 = __builtin_amdgcn_mfma_f32_32x32x16_bf16(Mc[0][kb][s], bf[kb][s], Y0, 0, 0, 0);
                Y1 = __builtin_amdgcn_mfma_f32_32x32x16_bf16(Mc[1][kb][s], bf[kb][s], Y1, 0, 0, 0);
            }
        X0 = Y0; X1 = Y1;
#pragma unroll
        for (int m = 0; m < 2; ++m)
#pragma unroll
            for (int kb = 0; kb < 2; ++kb)
#pragma unroll
                for (int s = 0; s < 2; ++s) Mc[m][kb][s] = Mn[m][kb][s];
        N0 = N0n; N1 = N1n;
    }
}

template <class OutF> __device__ __forceinline__ void rwkv_out_unit(const RwkvBufs& RB, int uidx, int lane, const OutF& outf) {
    const int h = uidx & 7, bc = uidx >> 3, c = bc % NCH, b = bc / NCH;
    const bf16* Q = RB.Q + (size_t)uidx * 4096; const bf16* HT = RB.HC + (size_t)uidx * 4096; const bf16* OP = RB.OP + (size_t)uidx * 4096;
    const bf16* G1 = RB.G1 + (size_t)uidx * 4096; const bf16* G2 = RB.G2 + (size_t)uidx * 4096;
    const int r = lane & 15, ko = 8 * (lane >> 4);
    bf16x8 yh[4][2];
#pragma unroll
    for (int tb = 0; tb < 4; ++tb)
#pragma unroll
        for (int ks = 0; ks < 2; ++ks) yh[tb][ks] = *(const bf16x8*)(HT + (16 * tb + r) * 64 + 32 * ks + ko);
#pragma unroll 2
    for (int ta = 0; ta < 4; ++ta) {
        const int t = 16 * ta + r;
        bf16x8 xq[2];
        xq[0] = *(const bf16x8*)(Q + t * 64 + ko); xq[1] = *(const bf16x8*)(Q + t * 64 + 32 + ko);
        f32x4 o[4]; float s = 0.f;
#pragma unroll
        for (int tb = 0; tb < 4; ++tb) {
            const int i0 = 16 * tb + 4 * (lane >> 4);
            const v2u ow = *(const v2u*)(OP + t * 64 + i0);
            f32x4 acc = {bflo(ow.x), bfhi(ow.x), bflo(ow.y), bfhi(ow.y)};
#pragma unroll
            for (int ks = 0; ks < 2; ++ks) acc = __builtin_amdgcn_mfma_f32_16x16x32_bf16(yh[tb][ks], xq[ks], acc, 0, 0, 0);
            o[tb] = acc; s += (acc[0] + acc[1]) + (acc[2] + acc[3]);
        }
        s = sum_x32(sum_x16(s));
        const float mean = s * (1.f / 64.f); float qv = 0.f;
#pragma unroll
        for (int tb = 0; tb < 4; ++tb) { o[tb] = o[tb] - mean; qv += (o[tb][0] * o[tb][0] + o[tb][1] * o[tb][1]) + (o[tb][2] * o[tb][2] + o[tb][3] * o[tb][3]); }
        qv = sum_x32(sum_x16(qv));
        const float rstd = rsqrtf(qv * (1.f / 64.f) + GN_EPS);
        const int tg = c * 64 + t;
#pragma unroll
        for (int tb = 0; tb < 4; ++tb) {
            const int i0 = 16 * tb + 4 * (lane >> 4);
            const v2u g1 = *(const v2u*)(G1 + t * 64 + i0), g2 = *(const v2u*)(G2 + t * 64 + i0);
            f32x4 y;
            y[0] = o[tb][0] * rstd * bflo(g1.x) + bflo(g2.x); y[1] = o[tb][1] * rstd * bfhi(g1.x) + bfhi(g2.x);
            y[2] = o[tb][2] * rstd * bflo(g1.y) + bflo(g2.y); y[3] = o[tb][3] * rstd * bfhi(g1.y) + bfhi(g2.y);
            if (tg < L) outf(b, tg, 64 * h + i0, y);
        }
    }
}
constexpr int MW = 264;
constexpr float QSCALE = 0.125f * 1.4426950408889634f;
struct AttBufs { bf16* Q; bf16* QI; unsigned short* MASK; bf16* KX; };

constexpr int LDQ = 264;
__device__ __forceinline__ void att_prep_unit(const Frame& F, const Args& a, bf16* Ua, const AttBufs& AB, int tile) {
    const int tid = F.tid, lane = F.lane, w = F.wave;
    LAS bf16* CQ = (LAS bf16*)F.lds;
    LAS f32x2_t* RQL = (LAS f32x2_t*)(F.lds + 34816);
    LAS f32x2_t* RIL = (LAS f32x2_t*)(F.lds + 34816 + 64 * 33 * 8);
    const int tau = tid >> 3, q = tid & 7;
    const size_t prow = (size_t)tile * 64 + tau;
    const int tpos = (int)(prow % LP);
    bf16* urow = Ua + prow * UA_W;
    const float2* rq = (const float2*)(F.ws + WS_ROPEQ) + (size_t)tpos * 32;
    const float2* ri = (const float2*)(F.ws + WS_ROPEI) + (size_t)tpos * 16;
    { const int t0p = (int)(((size_t)tile * 64) % LP);
      const f32x2_t* gq = (const f32x2_t*)(F.ws + WS_ROPEQ) + (size_t)t0p * 32; const f32x2_t* gi = (const f32x2_t*)(F.ws + WS_ROPEI) + (size_t)t0p * 16;
      for (int i = tid; i < 64 * 32; i += NTHR) RQL[(i >> 5) * 33 + (i & 31)] = gq[i];
      for (int i = tid; i < 64 * 16; i += NTHR) RIL[(i >> 4) * 17 + (i & 15)] = gi[i]; }
    {
        float x[4][8]; float ss = 0.f;
#pragma unroll
        for (int i = 0; i < 4; ++i) { unpack8(*(const v4u*)(urow + 64 * i + 8 * q), x[i]);
#pragma unroll
            for (int e = 0; e < 8; ++e) ss += x[i][e] * x[i][e]; }
        ss = sum8(ss);
        const float rs = rsqrtf(ss * (1.f / 256.f) + RMS_EPS);
#pragma unroll
        for (int i = 0; i < 4; ++i) { float g8[8], o[8]; ld8f(a.in[16] + 64 * i + 8 * q, g8);
#pragma unroll
            for (int e = 0; e < 8; ++e) o[e] = x[i][e] * rs * g8[e];
            st8(CQ + tau * LDQ + 64 * i + 8 * q, o); }
    }
#pragma unroll
    for (int i = 0; i < 8; ++i) {
        const int col = 8 * (q + 8 * i); float x[8], o[8];
        unpack8(*(const v4u*)(urow + 256 + col), x);
        const int d0 = (col & 63) >> 1;
#pragma unroll
        for (int pp = 0; pp < 4; ++pp) { const float2 cs = rq[d0 + pp]; o[2 * pp] = x[2 * pp] * cs.x - x[2 * pp + 1] * cs.y; o[2 * pp + 1] = x[2 * pp + 1] * cs.x + x[2 * pp] * cs.y; }
        v4u wv; wv.x = pk2(o[0], o[1]); wv.y = pk2(o[2], o[3]); wv.z = pk2(o[4], o[5]); wv.w = pk2(o[6], o[7]);
        *(v4u*)(urow + 256 + col) = wv;
    }
    {
        float x[8]; unpack8(*(const v4u*)(urow + 1280 + 8 * q), x);
        float s = 0.f;
#pragma unroll
        for (int e = 0; e < 8; ++e) s += x[e];
        s = sum8(s);
        const float mean = s * (1.f / 64.f); float qv = 0.f;
#pragma unroll
        for (int e = 0; e < 8; ++e) { x[e] -= mean; qv += x[e] * x[e]; }
        qv = sum8(qv);
        const float rstd = rsqrtf(qv * (1.f / 64.f) + LN_EPS);
        float y[8];
#pragma unroll
        for (int e = 0; e < 8; ++e) { const int p = 8 * q + e; const int d = (p < 32) ? ((p & 1) ? 16 + (p >> 1) : (p >> 1)) : p;
            y[e] = x[e] * rstd * a.in[19][d] + a.in[20][d]; }
        float o[8];
        if (q < 4) {
#pragma unroll
            for (int pp = 0; pp < 4; ++pp) { const float2 cs = ri[4 * q + pp]; o[2 * pp] = y[2 * pp] * cs.x - y[2 * pp + 1] * cs.y; o[2 * pp + 1] = y[2 * pp + 1] * cs.x + y[2 * pp] * cs.y; }
        } else {
#pragma unroll
            for (int e = 0; e < 8; ++e) o[e] = y[e];
        }
        v4u wv; wv.x = pk2(o[0] * 0.125f, o[1] * 0.125f); wv.y = pk2(o[2] * 0.125f, o[3] * 0.125f); wv.z = pk2(o[4] * 0.125f, o[5] * 0.125f); wv.w = pk2(o[6] * 0.125f, o[7] * 0.125f);
        *(v4u*)(AB.KX + prow * 64 + 8 * q) = wv;
    }
    LDS_WAIT(); __syncthreads();
    {
        const bf16* Wq = (const bf16*)(F.ws + WS_WQ);
        const int r = lane & 15, ko = 8 * (lane >> 4);
        bf16x8 yfA[8], yfB[8];
#pragma unroll
        for (int ks = 0; ks < 8; ++ks) yfA[ks] = *(const bf16x8*)(Wq + (size_t)(16 * (8 * w) + r) * 256 + 32 * ks + ko);
#define ATP_TILE(YF, TBL) do { const int tb = 8 * w + (TBL), n0 = 16 * tb + 4 * (lane >> 4); \
            _Pragma("unroll 1") for (int ta = 0; ta < 4; ++ta) { \
                f32x4 acc = {0.f, 0.f, 0.f, 0.f}; \
                _Pragma("unroll") for (int ks = 0; ks < 8; ++ks) { const bf16x8 xf = *(const LAS bf16x8*)(CQ + (16 * ta + r) * LDQ + 32 * ks + ko); acc = __builtin_amdgcn_mfma_f32_16x16x32_bf16(YF[ks], xf, acc, 0, 0, 0); } \
                const size_t orow = (size_t)tile * 64 + 16 * ta + r; \
                const bool isq = (n0 < 512); const int p = n0 & 63; \
                float o0 = acc[0], o1 = acc[1], o2 = acc[2], o3 = acc[3]; \
                if (isq) { const LAS f32x2_t* rr = RQL + (16 * ta + r) * 33 + (p >> 1); const f32x2_t c0 = rr[0], c1 = rr[1]; \
                    o0 = (acc[0] * c0.x - acc[1] * c0.y) * QSCALE; o1 = (acc[1] * c0.x + acc[0] * c0.y) * QSCALE; o2 = (acc[2] * c1.x - acc[3] * c1.y) * QSCALE; o3 = (acc[3] * c1.x + acc[2] * c1.y) * QSCALE; } \
                else if (p < 32) { const LAS f32x2_t* rr = RIL + (16 * ta + r) * 17 + (p >> 1); const f32x2_t c0 = rr[0], c1 = rr[1]; \
                    o0 = acc[0] * c0.x - acc[1] * c0.y; o1 = acc[1] * c0.x + acc[0] * c0.y; o2 = acc[2] * c1.x - acc[3] * c1.y; o3 = acc[3] * c1.x + acc[2] * c1.y; } \
                v2u ov; ov.x = pk2(o0, o1); ov.y = pk2(o2, o3); \
                bf16* dst = isq ? (AB.Q + orow * 512 + n0) : (AB.QI + orow * 512 + (n0 - 512)); \
                *(v2u*)dst = ov; } } while (0)
#pragma unroll 1
        for (int tb2 = 0; tb2 < 8; tb2 += 2) {
#pragma unroll
            for (int ks = 0; ks < 8; ++ks) yfB[ks] = *(const bf16x8*)(Wq + (size_t)(16 * (8 * w + tb2 + 1) + r) * 256 + 32 * ks + ko);
            ATP_TILE(yfA, tb2);
            if (tb2 + 2 < 8) {
#pragma unroll
                for (int ks = 0; ks < 8; ++ks) yfA[ks] = *(const bf16x8*)(Wq + (size_t)(16 * (8 * w + tb2 + 2) + r) * 256 + 32 * ks + ko);
            }
            ATP_TILE(yfB, tb2 + 1);
        }
#undef ATP_TILE
    }
    LDS_WAIT(); __syncthreads();
}

__device__ __forceinline__ unsigned fkey(float f) { const unsigned u = __float_as_uint(f); return u ^ ((unsigned)((int)u >> 31) | 0x80000000u); }
__device__ __forceinline__ void cnt_ge(int& c, unsigned x, unsigned cand) {
    unsigned long long m;
    asm("v_cmp_ge_u32 %1, %2, %3\n\tv_addc_co_u32 %0, %1, 0, %0, %1" : "+v"(c), "=&s"(m) : "v"(x), "v"(cand));
}
template <int BIT> __device__ __forceinline__ void nib_ge(unsigned& nib, unsigned x, unsigned K) {
    unsigned t; asm volatile("v_cmp_ge_u32 vcc, %1, %2\n\tv_cndmask_b32 %0, 0, %3, vcc" : "=v"(t) : "v"(x), "v"(K), "v"(1u << BIT) : "vcc"); nib |= t;
}
constexpr int IDX_NT = 33, IDX_PF = 4;
__device__ __forceinline__ void idx_unit(const Frame& F, const bf16* __restrict__ Ua, const AttBufs& AB, int b, int qt, int flags) {
    const int lane = F.lane, w = F.wave, qc = lane & 15, g = lane >> 4, ko = 8 * g;
    LAS int* cntb = (LAS int*)F.lds;
    const int t0 = 16 * qt, ntile = qt + 1, tq = t0 + qc;
    const size_t qrow = (size_t)b * LP + tq;
    LAS bf16* QIL = (LAS bf16*)(F.lds + 8192);
    { const int tid = F.tid; const int rr = tid >> 5, cc = (tid & 31) * 16;
      const bf16* src = AB.QI + ((size_t)b * LP + t0 + rr) * 512 + cc;
      const v4u x0 = *(const v4u*)src, x1 = *(const v4u*)(src + 8);
      *(LAS v4u*)(QIL + rr * 520 + cc) = x0; *(LAS v4u*)(QIL + rr * 520 + cc + 8) = x1; }
    LDS_WAIT(); __syncthreads();
    float wq[8];
    { const v4u ww = *(const v4u*)(Ua + qrow * UA_W + 1344); float t8[8]; unpack8(ww, t8);
#pragma unroll
      for (int h = 0; h < 8; ++h) wq[h] = t8[h] * 0.35355339059327373f; }
    unsigned sc[IDX_NT][4];
    const bf16* kbase = AB.KX + (size_t)b * LP * 64;
    const int wlast = (ntile - 1 - w) >> 3;
    bf16x8 ra0[IDX_PF], ra1[IDX_PF];
#pragma unroll
    for (int p = 0; p < IDX_PF; ++p) { const unsigned ko_ = (unsigned)((16 * (w + 8 * max(min(p, wlast), 0)) + qc) * 64 + ko) ; const unsigned kc = (w < ntile) ? ko_ : (unsigned)(qc * 64 + ko);
        ra0[p] = *(const bf16x8*)(kbase + kc); ra1[p] = *(const bf16x8*)(kbase + kc + 32); }
#pragma unroll
    for (int i = 0; i < IDX_NT; ++i) {
        int wv = w; asm volatile("" : "+s"(wv));
        const int kt = wv + 8 * i;
        const bf16x8 a0 = ra0[i % IDX_PF], a1 = ra1[i % IDX_PF];
        { const int ip = max(min(i + IDX_PF, wlast), 0); const unsigned ko_ = (unsigned)((16 * (wv + 8 * ip) + qc) * 64 + ko); const unsigned kc = (wv < ntile) ? ko_ : (unsigned)(qc * 64 + ko);
          ra0[i % IDX_PF] = *(const bf16x8*)(kbase + kc); ra1[i % IDX_PF] = *(const bf16x8*)(kbase + kc + 32); }
        asm volatile("" ::: "memory");
        if (kt < ntile) {
            f32x4 acc = {0.f, 0.f, 0.f, 0.f};
#pragma unroll
            for (int hq = 0; hq < 2; ++hq) {
                bf16x8 qa[4], qb_[4];
#pragma unroll
                for (int h4 = 0; h4 < 4; ++h4) { qa[h4] = *(const LAS bf16x8*)(QIL + qc * 520 + 64 * (4 * hq + h4) + ko); qb_[h4] = *(const LAS bf16x8*)(QIL + qc * 520 + 64 * (4 * hq + h4) + 32 + ko); }
                __builtin_amdgcn_sched_group_barrier(0x100, 8, 0);
                f32x4 sh[4];
#pragma unroll
                for (int h4 = 0; h4 < 4; ++h4) { sh[h4] = (f32x4){0.f, 0.f, 0.f, 0.f}; sh[h4] = __builtin_amdgcn_mfma_f32_16x16x32_bf16(a0, qa[h4], sh[h4], 0, 0, 0); }
#pragma unroll
                for (int h4 = 0; h4 < 4; ++h4) sh[h4] = __builtin_amdgcn_mfma_f32_16x16x32_bf16(a1, qb_[h4], sh[h4], 0, 0, 0);
                __builtin_amdgcn_sched_group_barrier(0x008, 8, 0);
#pragma unroll
                for (int h4 = 0; h4 < 4; ++h4)
#pragma unroll
                    for (int r = 0; r < 4; ++r) acc[r] = fmaf(__builtin_amdgcn_fmed3f(sh[h4][r], 0.f, INFINITY), wq[4 * hq + h4], acc[r]);
                if (hq == 0) asm volatile("" ::: "memory");
            }
            if (kt == qt) {
#pragma unroll
                for (int r = 0; r < 4; ++r) sc[i][r] = (4 * g + r <= qc) ? (fkey(acc[r]) >> 1) : 0u;
            } else {
#pragma unroll
                for (int r = 0; r < 4; ++r) sc[i][r] = fkey(acc[r]) >> 1;
            }
        } else {
#pragma unroll
            for (int r = 0; r < 4; ++r) sc[i][r] = 0u;
        }
    }
    unsigned K = 0u; bool found = (tq + 1 <= 256);
    const int nwave_tiles = __builtin_amdgcn_readfirstlane(max(wlast + 1, 0));
#pragma unroll 1
    for (int bit = 30; bit >= 0; --bit) {
        const unsigned cand = K | (1u << bit);
        unsigned b0 = 0u, b1 = 0u, b2 = 0u, b3 = 0u; int lt = 0;
        int nwv = nwave_tiles; asm volatile("" : "+s"(nwv));
#pragma unroll
        for (int i = 0; i < IDX_NT; ++i) {
            if (i < nwv) {
                b0 = __builtin_amdgcn_alignbit(b0, sc[i][0] - cand, 31); b1 = __builtin_amdgcn_alignbit(b1, sc[i][1] - cand, 31);
                b2 = __builtin_amdgcn_alignbit(b2, sc[i][2] - cand, 31); b3 = __builtin_amdgcn_alignbit(b3, sc[i][3] - cand, 31);
            }
            if (i == 15 || i == 31 || i == IDX_NT - 1) { lt += __builtin_popcount(b0) + __builtin_popcount(b1) + __builtin_popcount(b2) + __builtin_popcount(b3); b0 = b1 = b2 = b3 = 0u; }
        }
        int c = 4 * nwv - lt;
        c = isum_x32(isum_x16(c));
        LAS int* cb = cntb + (bit & 1) * 128;
        if (g == 0) cb[w * 16 + qc] = c;
        LDS_WAIT(); __syncthreads();
        int tot = 0;
#pragma unroll
        for (int ww = 0; ww < 8; ++ww) tot += cb[ww * 16 + qc];
        if (!found && tot >= 256) K = cand;
        found = found || (tot == 256);
        if (__all(found)) break;
    }
    if (tq + 1 <= 256 || K == 0u) K = 1u;
    LAS unsigned short* mlds = (LAS unsigned short*)(F.lds + 32768);
    const int kend = (qt == 0) ? 4 : min(16 * (1 + ((qt - 1) >> 4)) + 4, 260);
    LAS unsigned short* mrow_ = mlds + qc * MW + w;
#pragma unroll
    for (int i = 0; i < IDX_NT; ++i) {
        unsigned nib = 0u;
        nib_ge<0>(nib, sc[i][0], K); nib_ge<1>(nib, sc[i][1], K); nib_ge<2>(nib, sc[i][2], K); nib_ge<3>(nib, sc[i][3], K);
        unsigned v = nib << (4 * g);
        v = or_x32(or_x16(v));
        if (g == 0) mrow_[8 * i] = (unsigned short)v;
    }
    LDS_WAIT(); __syncthreads();
    {
        const int npiece = kend >> 2;
        for (int p = F.tid; p < 16 * npiece; p += NTHR) { const int q_ = p / npiece, c = p % npiece;
            const v2u val = *(const LAS v2u*)(mlds + q_ * MW + 4 * c);
            *(v2u*)(AB.MASK + ((size_t)b * LP + t0 + q_) * MW + 4 * c) = val; }
    }
    LDS_WAIT(); __syncthreads();
}

__device__ __forceinline__ int crow(int r, int hi) { return (r & 3) + 8 * (r >> 2) + 4 * hi; }
constexpr int AT_K = 0, AT_V = 2 * 8192, AT_WS = 4 * 8192;
__device__ __forceinline__ void at_qkt(f32x16& p0, f32x16& p1, const LAS unsigned char* Kslot, const bf16x8* qr, const f32x16& negm, int r32, int hi) {
    const LAS unsigned char* kb = Kslot + hi * 1024 + r32 * 16;
    p0 = negm; p1 = negm;
#pragma unroll
    for (int d0 = 0; d0 < 4; ++d0) {
        const bf16x8 b0 = *(const LAS bf16x8*)(kb + d0 * 2048), b1 = *(const LAS bf16x8*)(kb + d0 * 2048 + 512);
        p0 = __builtin_amdgcn_mfma_f32_32x32x16_bf16(b0, qr[d0], p0, 0, 0, 0);
        p1 = __builtin_amdgcn_mfma_f32_32x32x16_bf16(b1, qr[d0], p1, 0, 0, 0);
    }
}
__device__ __forceinline__ float at_max3(float a, float b, float c) { float r; asm("v_max3_f32 %0, %1, %2, %3" : "=v"(r) : "v"(a), "v"(b), "v"(c)); return r; }
typedef short s16x4 __attribute__((ext_vector_type(4)));
__device__ __forceinline__ s16x4 at_vtr(const LAS unsigned char* p) { return __builtin_bit_cast(s16x4, __builtin_amdgcn_ds_read_tr16_b64_v4i16((LAS s16x4*)p)); }
__device__ __forceinline__ void at_pv(f32x16* o, const LAS unsigned char* vb, bf16x8 pa0, bf16x8 pa1, bf16x8 pa2, bf16x8 pa3) {
#pragma unroll
    for (int d0 = 0; d0 < 2; ++d0) {
        s16x4 lo[4], hi[4];
#pragma unroll
        for (int ks = 0; ks < 4; ++ks) { lo[ks] = at_vtr(vb + d0 * 4096 + ks * 1024); hi[ks] = at_vtr(vb + d0 * 4096 + ks * 1024 + 512); }
#define AT_PK(k) (bf16x8){lo[k][0], lo[k][1], lo[k][2], lo[k][3], hi[k][0], hi[k][1], hi[k][2], hi[k][3]}
        o[d0] = __builtin_amdgcn_mfma_f32_32x32x16_bf16(pa0, AT_PK(0), o[d0], 0, 0, 0);
        o[d0] = __builtin_amdgcn_mfma_f32_32x32x16_bf16(pa1, AT_PK(1), o[d0], 0, 0, 0);
        o[d0] = __builtin_amdgcn_mfma_f32_32x32x16_bf16(pa2, AT_PK(2), o[d0], 0, 0, 0);
        o[d0] = __builtin_amdgcn_mfma_f32_32x32x16_bf16(pa3, AT_PK(3), o[d0], 0, 0, 0);
#undef AT_PK
    }
}
template <class OutF> __device__ __forceinline__ void attn_unit(const Frame& F, const bf16* __restrict__ Ua, const AttBufs& AB, int b, int h, int qb, const OutF& outf) {
    const int lane = F.lane, wid = F.wave, r32 = lane & 31, hi = lane >> 5;
    const LAS unsigned char* lds = F.lds;
    LAS float* wsf = (LAS float*)(F.lds + AT_WS) + wid * 64;
    const size_t rowbase = (size_t)b * LP; const int q0 = (qb == 0) ? 0 : 16 + 256 * (qb - 1), qend = (qb == 0) ? 16 : q0 + 256;
    const int tq = q0 + wid * 32 + r32;
    const int NT = (qend + 63) / 64;
    bf16x8 qr[4];
    { const bf16* Qw = AB.Q + (rowbase + min(tq, LP - 1)) * 512 + 64 * h;
#pragma unroll
      for (int d0 = 0; d0 < 4; ++d0) qr[d0] = *(const bf16x8*)(Qw + 16 * d0 + 8 * hi); }
    const unsigned short* mrow = AB.MASK + (rowbase + min(tq, LP - 1)) * MW;
    const bf16* ksrc = Ua + (rowbase + lane) * UA_W + 256 + 64 * h + 8 * wid;
    const bf16* vsrc = Ua + (rowbase + 16 * (wid & 3) + (lane >> 2)) * UA_W + 768 + 64 * h + (wid >> 2) * 32 + (lane & 3) * 8;
    const int sdst = wid * 1024 + lane * 16;
    const int vb0 = ((lane >> 4) & 1) * 32 + (lane & 3) * 8 + (4 * hi + ((lane & 15) >> 2)) * 64;
    float m_run = 0.f, l_run = 0.f;
    f32x16 negm;
#pragma unroll
    for (int r = 0; r < 16; ++r) negm[r] = 0.f;
    f32x16 o[2];
#pragma unroll
    for (int r = 0; r < 16; ++r) { o[0][r] = 0.f; o[1][r] = 0.f; }
    v4u kreg = *(const v4u*)ksrc, vreg = *(const v4u*)vsrc;
    v2u mk_next = *(const v2u*)mrow;
    __syncthreads();
    *(LAS v4u*)(lds + AT_K + sdst) = kreg; *(LAS v4u*)(lds + AT_V + sdst) = vreg;
    for (int j = 0; j < NT; ++j) {
        const int cur = j & 1;
        if (j + 1 < NT) { kreg = *(const v4u*)(ksrc + (size_t)(j + 1) * 64 * UA_W); vreg = *(const v4u*)(vsrc + (size_t)(j + 1) * 64 * UA_W); }
        const v2u mk = mk_next;
        if (j + 1 < NT) mk_next = *(const v2u*)(mrow + 4 * (j + 1));
        LDS_WAIT(); __syncthreads();
        if (64 * j <= q0 + wid * 32 + 31 && q0 + wid * 32 < qend) {
        f32x16 p0, p1;
        at_qkt(p0, p1, lds + AT_K + cur * 8192, qr, negm, r32, hi);
        float mx;
        { float a0 = at_max3(p0[0], p0[1], p1[0]), a1 = at_max3(p0[2], p0[3], p1[1]); a0 = at_max3(a0, p1[2], p1[3]);
#pragma unroll
          for (int r = 4; r < 16; r += 4) { a0 = at_max3(a0, p0[r], p0[r + 1]); a1 = at_max3(a1, p0[r + 2], p0[r + 3]); a0 = at_max3(a0, p1[r], p1[r + 1]); a1 = at_max3(a1, p1[r + 2], p1[r + 3]); }
          mx = at_max3(a0, a1, a1); }
        { auto rr = __builtin_amdgcn_permlane32_swap(__float_as_uint(mx), __float_as_uint(mx), false, false); mx = fmaxf(__uint_as_float(rr[0]), __uint_as_float(rr[1])); }
        if (__any(mx > 4.f)) {
            const float dl = fmaxf(mx, 0.f);
            const float f = __builtin_amdgcn_exp2f(-dl);
            m_run += dl; l_run *= f;
#pragma unroll
            for (int r = 0; r < 16; ++r) { p0[r] -= dl; p1[r] -= dl; negm[r] = -m_run; }
            if (hi == 0) wsf[r32] = f;
            LDS_WAIT();
#pragma unroll
            for (int r = 0; r < 16; ++r) { const float fr = wsf[crow(r, hi)]; o[0][r] *= fr; o[1][r] *= fr; }
        }
        const int mlo = (int)(mk.x >> (4 * hi)), mhi = (int)(mk.y >> (4 * hi));
        float s = 0.f;
#pragma unroll
        for (int r = 0; r < 16; ++r) {
            int b0_, b1_;
            asm("v_bfe_i32 %0, %1, %2, 1" : "=v"(b0_) : "v"(mlo), "n"((r & 3) + 8 * (r >> 2)));
            asm("v_bfe_i32 %0, %1, %2, 1" : "=v"(b1_) : "v"(mhi), "n"((r & 3) + 8 * (r >> 2)));
            p0[r] = __uint_as_float(__float_as_uint(__builtin_amdgcn_exp2f(p0[r])) & (unsigned)b0_);
            p1[r] = __uint_as_float(__float_as_uint(__builtin_amdgcn_exp2f(p1[r])) & (unsigned)b1_);
            s += p0[r] + p1[r];
        }
        l_run += s;
        v4u pw0, pw1, pw2, pw3;
        pw0.x = pk2(p0[0], p0[1]); pw0.y = pk2(p0[2], p0[3]); pw0.z = pk2(p0[4], p0[5]); pw0.w = pk2(p0[6], p0[7]);
        pw1.x = pk2(p0[8], p0[9]); pw1.y = pk2(p0[10], p0[11]); pw1.z = pk2(p0[12], p0[13]); pw1.w = pk2(p0[14], p0[15]);
        pw2.x = pk2(p1[0], p1[1]); pw2.y = pk2(p1[2], p1[3]); pw2.z = pk2(p1[4], p1[5]); pw2.w = pk2(p1[6], p1[7]);
        pw3.x = pk2(p1[8], p1[9]); pw3.y = pk2(p1[10], p1[11]); pw3.z = pk2(p1[12], p1[13]); pw3.w = pk2(p1[14], p1[15]);
        at_pv(o, lds + AT_V + cur * 8192 + vb0, __builtin_bit_cast(bf16x8, pw0), __builtin_bit_cast(bf16x8, pw1), __builtin_bit_cast(bf16x8, pw2), __builtin_bit_cast(bf16x8, pw3));
        }
        if (j + 1 < NT) { *(LAS v4u*)(lds + AT_K + (cur ^ 1) * 8192 + sdst) = kreg; *(LAS v4u*)(lds + AT_V + (cur ^ 1) * 8192 + sdst) = vreg; }
    }
    { auto rr = __builtin_amdgcn_permlane32_swap(__float_as_uint(l_run), __float_as_uint(l_run), false, false); l_run = __uint_as_float(rr[0]) + __uint_as_float(rr[1]); }
    LDS_WAIT();
    if (hi == 0) wsf[32 + r32] = 1.f / l_run;
    LDS_WAIT();
#pragma unroll
    for (int r = 0; r < 16; ++r) {
        const int qloc = crow(r, hi), t = q0 + wid * 32 + qloc; const float li = wsf[32 + qloc];
        if (t < qend) { outf(b, t, 512 + 64 * h + r32, o[0][r] * li); outf(b, t, 512 + 64 * h + 32 + r32, o[1][r] * li); }
    }
}
constexpr int NEXP = 32, LISTCAP = 32896;
constexpr int CW_CNT = 256;
constexpr size_t WS_LIST = 236 * MiB;
constexpr size_t WS_WT = 241 * MiB;
constexpr size_t WS_PINFO = 242 * MiB;
constexpr size_t EW_GU = (size_t)512 * 1024 * 2, EW_D = (size_t)1024 * 256 * 2;
struct MoeBufs { float* MIX; float* H1; bf16* H1b; bf16* HID; bf16* F; bf16* WGU; bf16* WD; };

__device__ __forceinline__ void convert_experts(const Frame& F, const Args& a, const MoeBufs& MB, int part, int first_wg = 0) {
    LAS float* scr = (LAS float*)(F.lds + F.wave * 16384);
    if (F.bid < first_wg) return;
    const int gw = (F.bid - first_wg) * NWAVES + F.wave, NGW = (F.G - first_wg) * NWAVES;
    if (part == 0) {
        for (int it = gw; it < NEXP * 256; it += NGW) {
            const int e = it >> 8, r = it & 255;
            if (r < 128) transpose_item<4>(a.in[28] + (size_t)e * 1024 * 256, 1024, 256, MB.WGU + (size_t)e * 512 * 1024, 0, scr, r, 8, F.lane);
            else transpose_item<4>(a.in[29] + (size_t)e * 1024 * 256, 1024, 256, MB.WGU + (size_t)e * 512 * 1024, 1, scr, r - 128, 8, F.lane);
        }
    } else {
        for (int it = gw; it < NEXP * 128; it += NGW) {
            const int e = it >> 7, r = it & 127;
            transpose_item<0>(a.in[30] + (size_t)e * 256 * 1024, 256, 1024, MB.WD + (size_t)e * 1024 * 256, 0, scr, r, 32, F.lane);
        }
    }
}

constexpr int P6_HROW = 4096, P6_RGW = P6_HROW + 8 * 4096, P6_REW = P6_RGW + 16384;
static_assert(P6_REW + 65536 <= RING_BYTES, "P6 LDS map");
__device__ __forceinline__ void p6_ln1_router(const Frame& F, const Args& a, const MoeBufs& MB) {
    LAS int* lcount = (LAS int*)F.lds;
    LAS int* lbase = lcount + 32;
    LAS int* ent = lbase + 32;
    LAS float* entw = (LAS float*)(ent + 65 * 4);
    unsigned* ctl = (unsigned*)(F.ws + WS_CTL);
    const float2* rowstat = (const float2*)(F.ws + WS_ROWSTAT);
    const int lane = F.lane;
    for (int i = F.tid; i < 1024; i += NTHR) *(LAS f32x4*)(F.lds + P6_RGW + i * 16) = *(const f32x4*)(a.in[24] + (size_t)i * 4);
    for (int i = F.tid; i < 4096; i += NTHR) { const int k = i >> 2, g = i & 3; float w8[8]; ld8f(a.in[26] + (size_t)k * 32 + 8 * g, w8); st8((LAS bf16*)(F.lds + P6_REW + g * 16384 + k * 16), w8); }
    for (int blk = F.bid; blk < 256; blk += F.G) {
    if (F.tid < 32) lcount[F.tid] = 0;
    LDS_WAIT(); __syncthreads();
    f32x4 nx[4]; v2u nm[4];
    { const int pr = 65 * blk + F.wave, b = pr / LP, t = pr % LP; const int tc = (t < L) ? t : 0;
      const float* src = (tc < NM) ? (a.in[1] + (size_t)tc * D) : (a.in[0] + ((size_t)b * SEQ + (tc - NM)) * D);
#pragma unroll
      for (int j = 0; j < 4; ++j) { nx[j] = ((const f32x4*)src)[lane + 64 * j]; nm[j] = ((const v2u*)((const bf16*)MB.MIX + (size_t)pr * D))[lane + 64 * j]; } }
    for (int i = F.wave; i < 65; i += NWAVES) {
        const int pr = 65 * blk + i, t = pr % LP;
        f32x4 cx[4]; v2u cm[4];
#pragma unroll
        for (int j = 0; j < 4; ++j) { cx[j] = nx[j]; cm[j] = nm[j]; }
        if (i + NWAVES < 65) { const int pn = pr + NWAVES, bn = pn / LP, tn = pn % LP; const int tc = (tn < L) ? tn : 0;
            const float* src = (tc < NM) ? (a.in[1] + (size_t)tc * D) : (a.in[0] + ((size_t)bn * SEQ + (tc - NM)) * D);
#pragma unroll
            for (int j = 0; j < 4; ++j) { nx[j] = ((const f32x4*)src)[lane + 64 * j]; nm[j] = ((const v2u*)((const bf16*)MB.MIX + (size_t)pn * D))[lane + 64 * j]; } }
        if (t >= L) { if (lane == 0) ent[i * 4] = -1; continue; }
        const float2 st = rowstat[pr];
        f32x4 v[4]; float s = 0.f;
#pragma unroll
        for (int j = 0; j < 4; ++j) {
            const f32x4 g0 = ((const f32x4*)a.in[2])[lane + 64 * j], b0 = ((const f32x4*)a.in[3])[lane + 64 * j];
            const f32x4 mxv = {bflo(cm[j].x), bfhi(cm[j].x), bflo(cm[j].y), bfhi(cm[j].y)};
            v[j] = ((cx[j] - st.x) * st.y * g0 + b0) * DN_ALPHA + mxv;
            s += (v[j].x + v[j].y) + (v[j].z + v[j].w);
        }
        const float mean = wave_sum(s) * (1.f / D); float s2 = 0.f;
#pragma unroll
        for (int j = 0; j < 4; ++j) { v[j] = v[j] - mean; s2 += (v[j].x * v[j].x + v[j].y * v[j].y) + (v[j].z * v[j].z + v[j].w * v[j].w); }
        const float rstd = rsqrtf(wave_sum(s2) * (1.f / D) + LN_EPS);
        LAS float* hrow = (LAS float*)(F.lds + P6_HROW + F.wave * 4096);
#pragma unroll
        for (int j = 0; j < 4; ++j) {
            const f32x4 g1 = ((const f32x4*)a.in[22])[lane + 64 * j], b1 = ((const f32x4*)a.in[23])[lane + 64 * j];
            v[j] = v[j] * rstd * g1 + b1;
            ((f32x4*)(MB.H1 + (size_t)pr * D))[lane + 64 * j] = v[j];
            v2u hb; hb.x = pk2(v[j].x, v[j].y); hb.y = pk2(v[j].z, v[j].w);
            ((v2u*)(MB.H1b + (size_t)pr * D))[lane + 64 * j] = hb;
            *(LAS f32x4*)(hrow + 4 * (lane + 64 * j)) = v[j];
        }
        LDS_WAIT();
        float hk[16];
#pragma unroll
        for (int kk = 0; kk < 16; ++kk) hk[kk] = hrow[lane + 64 * kk];
        f32x4 ga = {0.f, 0.f, 0.f, 0.f};
#pragma unroll
        for (int kk = 0; kk < 16; ++kk) { const f32x4 wg = *(const LAS f32x4*)(F.lds + P6_RGW + (lane + 64 * kk) * 16); ga = ga + wg * hk[kk]; }
        float lgp[4];
#pragma unroll
        for (int g = 0; g < 4; ++g) lgp[g] = wave_sum(ga[g]) + a.in[25][g];
        int gs = 0; float gm = lgp[0];
#pragma unroll
        for (int g = 1; g < 4; ++g) if (lgp[g] > gm) { gm = lgp[g]; gs = g; }
        float den = 0.f;
#pragma unroll
        for (int g = 0; g < 4; ++g) den += __expf(lgp[g] - gm);
        const float ggate = 1.f / den;
        float el[8];
#pragma unroll
        for (int q8 = 0; q8 < 8; ++q8) el[q8] = 0.f;
#pragma unroll
        for (int kk = 0; kk < 16; ++kk) { float w8[8]; unpack8(*(const LAS v4u*)(F.lds + P6_REW + gs * 16384 + (lane + 64 * kk) * 16), w8);
#pragma unroll
            for (int q8 = 0; q8 < 8; ++q8) el[q8] = fmaf(hk[kk], w8[q8], el[q8]); }
#pragma unroll
        for (int q8 = 0; q8 < 8; ++q8) el[q8] = wave_sum(el[q8]) + a.in[27][gs * 8 + q8];
        int i1 = 0; float v1 = el[0];
#pragma unroll
        for (int q8 = 1; q8 < 8; ++q8) if (el[q8] > v1) { v1 = el[q8]; i1 = q8; }
        int i2 = 0; float v2 = -INFINITY;
#pragma unroll
        for (int q8 = 0; q8 < 8; ++q8) if (q8 != i1 && el[q8] > v2) { v2 = el[q8]; i2 = q8; }
        const float e2 = __expf(v2 - v1);
        const float w1 = ggate / (1.f + e2), w2 = ggate * e2 / (1.f + e2);
        if (lane == 0) {
            const int e0 = gs * 8 + i1, e1 = gs * 8 + i2;
            ent[i * 4] = e0; ent[i * 4 + 1] = e1;
            ent[i * 4 + 2] = atomicAdd((int*)(lcount + e0), 1); ent[i * 4 + 3] = atomicAdd((int*)(lcount + e1), 1);
            entw[i * 2] = w1; entw[i * 2 + 1] = w2;
        }
    }
    LDS_WAIT(); __syncthreads();
    if (F.tid < 32) lbase[F.tid] = (int)atomicAdd(ctl + CW_CNT + F.tid, (unsigned)lcount[F.tid]);
    LDS_WAIT(); __syncthreads();
    if (F.tid < 65) {
        const int i = F.tid, e0 = ent[i * 4];
        if (e0 >= 0) {
            const int pr = 65 * blk + i, e1 = ent[i * 4 + 1];
            int* list = (int*)(F.ws + WS_LIST); float* wt = (float*)(F.ws + WS_WT);
            list[(size_t)e0 * LISTCAP + lbase[e0] + ent[i * 4 + 2]] = pr * 2;
            list[(size_t)e1 * LISTCAP + lbase[e1] + ent[i * 4 + 3]] = pr * 2 + 1;
            wt[pr * 2] = entw[i * 2]; wt[pr * 2 + 1] = entw[i * 2 + 1];
            unsigned* pinfo = (unsigned*)(F.ws + WS_PINFO);
            pinfo[pr * 2] = ((unsigned)e0 << 16) | (unsigned)(lbase[e0] + ent[i * 4 + 2]); pinfo[pr * 2 + 1] = ((unsigned)e1 << 16) | (unsigned)(lbase[e1] + ent[i * 4 + 3]);
        }
    }
    LDS_WAIT(); __syncthreads();
    }
}
}

namespace pg8 {
struct OneUnit { int pm, pn;
    __device__ __forceinline__ bool next(int i, Unit& u) const { if (i) return false; u.pm = pm; u.pn = pn; return true; }
    __device__ __forceinline__ void a_ready(const Unit&) const {}
    __device__ __forceinline__ void done(const Unit&) const {} };
struct EpiMoeUp {
    static constexpr bool PERM = true, AFTER_DRAIN = false;
    bf16_t* HID;
    __device__ __forceinline__ void operator()(const f32x4 (&acc)[2][2][4][2], const Unit& u, int wr, int wc, int fr, int fq) const {
        const int j0 = 128 * u.pn + 16 * wc + 4 * fq;
#pragma unroll
        for (int ai = 0; ai < 2; ++ai)
#pragma unroll
            for (int m = 0; m < 4; ++m) { bf16_t* rowp = HID + (size_t)(ai * HALF + wr * 64 + m * 16 + fr) * 256 + j0;
#pragma unroll
                for (int bj = 0; bj < 2; ++bj) { const f32x4 v0 = acc[ai][bj][m][0], v1 = acc[ai][bj][m][1];
                    const float h0 = v0[0] / (1.f + __expf(-v0[0])) * v0[1], h1 = v0[2] / (1.f + __expf(-v0[2])) * v0[3];
                    const float h2 = v1[0] / (1.f + __expf(-v1[0])) * v1[1], h3 = v1[2] / (1.f + __expf(-v1[2])) * v1[3];
                    unsigned w0 = cvt_pk_bf16(h0, h1), w1 = cvt_pk_bf16(h2, h3);
                    typedef unsigned u32x2_ __attribute__((ext_vector_type(2))); u32x2_ wv; wv.x = w0; wv.y = w1;
                    *(u32x2_*)(rowp + 64 * bj) = wv; } }
    }
};
struct EpiMoeDown {
    static constexpr bool PERM = true, AFTER_DRAIN = false;
    bf16_t* O;
    __device__ __forceinline__ void operator()(const f32x4 (&acc)[2][2][4][2], const Unit& u, int wr, int wc, int fr, int fq) const {
        const int col0 = (u.pn & 3) * BM + wc * 32 + 8 * fq;
#pragma unroll
        for (int ai = 0; ai < 2; ++ai)
#pragma unroll
            for (int m = 0; m < 4; ++m) { bf16_t* rowp = O + (size_t)(u.pm * BM + ai * HALF + wr * 64 + m * 16 + fr) * 1024 + col0;
#pragma unroll
                for (int bj = 0; bj < 2; ++bj) { const f32x4 v0 = acc[ai][bj][m][0], v1 = acc[ai][bj][m][1];
                    u32x4 w; w.x = cvt_pk_bf16(v0[0], v0[1]); w.y = cvt_pk_bf16(v0[2], v0[3]); w.z = cvt_pk_bf16(v1[0], v1[1]); w.w = cvt_pk_bf16(v1[2], v1[3]);
                    *(u32x4*)(rowp + bj * HALF) = w; } }
    }
};
struct ThreeUnits { int n, pm0, pn0, pm1, pn1, pm2, pn2;
    __device__ __forceinline__ bool next(int i, Unit& u) const { if (i >= n) return false; u.pm = (i == 0) ? pm0 : (i == 1 ? pm1 : pm2); u.pn = (i == 0) ? pn0 : (i == 1 ? pn1 : pn2); return true; }
    __device__ __forceinline__ void a_ready(const Unit&) const {}
    __device__ __forceinline__ void done(const Unit&) const {} };
}

namespace mk {
struct MoeTiles { int total; };
__device__ __forceinline__ int moe_find(const unsigned* cnt, int ti, int& e_out, int& i_out, int& hb_out, int& total) {
    int acc = 0, e_f = -1, i_f = 0, hb = 0;
    for (int e = 0; e < NEXP; ++e) { const int nt = ((int)cnt[e] + 255) >> 8; if (e_f < 0 && ti < acc + nt) { e_f = e; i_f = ti - acc; hb = acc; } acc += nt; }
    total = acc; e_out = e_f; i_out = i_f; hb_out = hb; return e_f;
}
constexpr int MOE_LDS_IDX = RING_BYTES;
__device__ __forceinline__ void p7_moe(const Frame& F, const MoeBufs& MB, bool down) {
    const unsigned* cnt = (const unsigned*)(F.ws + WS_CTL) + CW_CNT;
    const int* list = (const int*)(F.ws + WS_LIST);
    LAS int* lidx = (LAS int*)(F.lds + MOE_LDS_IDX);
    if (down) {
        pg8::ThreeUnits S{0, 0, 0, 0, 0, 0, 0};
        for (int k3 = 0; k3 < 3; ++k3) { const int v = F.bid + k3 * F.G; int e, i, hb, total; moe_find(cnt, v >> 2, e, i, hb, total);
            if (v < 4 * total) { const int pm = __builtin_amdgcn_readfirstlane(v >> 2), pn = __builtin_amdgcn_readfirstlane(e * 4 + (v & 3));
                if (k3 == 0) { S.pm0 = pm; S.pn0 = pn; } else if (k3 == 1) { S.pm1 = pm; S.pn1 = pn; } else { S.pm2 = pm; S.pn2 = pn; } S.n = k3 + 1; } }
        pg8::Gemm g{MB.HID, MB.WD, 256, 1024, 256, 256, nullptr};
        pg8::EpiMoeDown E{MB.F};
        pg8::gemm_phase<pg8::EpiMoeDown, pg8::ThreeUnits, true, false, false>(F.lds, g, S, E);
        return;
    }
    const int ncol = 2;
    for (int u = F.bid;; u += F.G) {
        int e, i, hb, total; moe_find(cnt, u / ncol, e, i, hb, total);
        e = __builtin_amdgcn_readfirstlane(e); i = __builtin_amdgcn_readfirstlane(i); hb = __builtin_amdgcn_readfirstlane(hb); total = __builtin_amdgcn_readfirstlane(total);
        if (u >= total * ncol) break;
        const int pn = __builtin_amdgcn_readfirstlane(u % ncol), n_e = __builtin_amdgcn_readfirstlane((int)cnt[e]), base = 256 * i;
        if (!down) {
            __syncthreads();
            if (F.tid < 256) lidx[F.tid] = list[(size_t)e * LISTCAP + min(base + F.tid, n_e - 1)] >> 1;
            LDS_WAIT(); __syncthreads();
        }
        if (!down) {
            pg8::Gemm g{MB.H1b, MB.WGU + (size_t)e * 512 * 1024, 256, 512, 1024, 1024, (const int*)(F.lds + MOE_LDS_IDX)};
            pg8::OneUnit S{0, pn};
            pg8::EpiMoeUp E{MB.HID + (size_t)(hb + i) * 256 * 256};
            pg8::gemm_phase<pg8::EpiMoeUp, pg8::OneUnit, true, true, true>(F.lds, g, S, E);
        }
    }
}
__device__ __forceinline__ int moe_total_tiles(const unsigned* cnt) { int acc = 0; for (int e = 0; e < NEXP; ++e) acc += ((int)cnt[e] + 255) >> 8; return acc; }
__device__ __forceinline__ void p8_final(const Frame& F, const Args& a, const MoeBufs& MB) {
    const int gw = F.bid * NWAVES + F.wave, NGW = F.G * NWAVES, lane = F.lane;
    const unsigned* cnt = (const unsigned*)(F.ws + WS_CTL) + CW_CNT;
    const unsigned* pinfo = (const unsigned*)(F.ws + WS_PINFO); const float* wt = (const float*)(F.ws + WS_WT);
    int tb = 0;
    { const int nt = (lane < NEXP) ? (((int)cnt[lane & 31] + 255) >> 8) : 0; int inc = nt;
#pragma unroll
      for (int o = 1; o < 32; o <<= 1) { const int t = __shfl_up(inc, o); if ((lane & 31) >= o) inc += t; }
      tb = inc - nt; }
    const int NR = NB * SEQ;
    for (int orow = gw; orow < NR; orow += 2 * NGW) {
        f32x4 hv[2][4]; v2u fa[2][4], fb[2][4]; float w0[2], w1[2]; bool ok[2];
#pragma unroll
        for (int u = 0; u < 2; ++u) {
            const int o = orow + u * NGW; ok[u] = o < NR; const int oc = ok[u] ? o : orow;
            const size_t pr = (size_t)(oc / SEQ) * LP + NM + (oc % SEQ);
            const unsigned p0 = pinfo[pr * 2], p1 = pinfo[pr * 2 + 1]; w0[u] = wt[pr * 2]; w1[u] = wt[pr * 2 + 1];
            const size_t r0 = (size_t)__shfl(tb, (int)(p0 >> 16)) * 256 + (p0 & 0xffffu), r1 = (size_t)__shfl(tb, (int)(p1 >> 16)) * 256 + (p1 & 0xffffu);
#pragma unroll
            for (int j = 0; j < 4; ++j) { hv[u][j] = ((const f32x4*)(MB.H1 + pr * D))[lane + 64 * j]; fa[u][j] = ((const v2u*)(MB.F + r0 * D))[lane + 64 * j]; fb[u][j] = ((const v2u*)(MB.F + r1 * D))[lane + 64 * j]; }
        }
#pragma unroll
        for (int u = 0; u < 2; ++u) {
            f32x4 v[4]; float sm = 0.f;
#pragma unroll
            for (int j = 0; j < 4; ++j) {
                const f32x4 h = hv[u][j]; const v2u f0 = fa[u][j], f1 = fb[u][j];
                v[j].x = DN_ALPHA * h.x + w0[u] * bflo(f0.x) + w1[u] * bflo(f1.x); v[j].y = DN_ALPHA * h.y + w0[u] * bfhi(f0.x) + w1[u] * bfhi(f1.x);
                v[j].z = DN_ALPHA * h.z + w0[u] * bflo(f0.y) + w1[u] * bflo(f1.y); v[j].w = DN_ALPHA * h.w + w0[u] * bfhi(f0.y) + w1[u] * bfhi(f1.y);
                sm += (v[j].x + v[j].y) + (v[j].z + v[j].w);
            }
            const float mean = wave_sum(sm) * (1.f / D); float s2 = 0.f;
#pragma unroll
            for (int j = 0; j < 4; ++j) { v[j] = v[j] - mean; s2 += (v[j].x * v[j].x + v[j].y * v[j].y) + (v[j].z * v[j].z + v[j].w * v[j].w); }
            const float rstd = rsqrtf(wave_sum(s2) * (1.f / D) + LN_EPS);
            if (ok[u]) {
                const int o = orow + u * NGW;
#pragma unroll
                for (int j = 0; j < 4; ++j) { const f32x4 g2 = ((const f32x4*)a.in[31])[lane + 64 * j], b2 = ((const f32x4*)a.in[32])[lane + 64 * j];
                    ((f32x4*)(a.out + (size_t)o * D))[lane + 64 * j] = v[j] * rstd * g2 + b2; }
            }
        }
    }
}
struct OutY {
    bf16* Ur;
    __device__ __forceinline__ void operator()(int b, int t, int col, f32x4 y) const { v2u o; o.x = pk2(y[0], y[1]); o.y = pk2(y[2], y[3]); *(v2u*)(Ur + ((size_t)b * LP + t) * UR_W + col) = o; }
    __device__ __forceinline__ void operator()(int b, int t, int col, float y) const { Ur[((size_t)b * LP + t) * UR_W + col] = (bf16)f2bf(y); }
};
constexpr int CW_W3 = 16, CW_W4 = 80;
constexpr int TICKET_OFF = 15 * 9216 + 62 * 144 + 128;
__device__ __forceinline__ int next_ticket(const Frame& F, unsigned* ctr) {
    LAS int* slot = (LAS int*)(F.lds + TICKET_OFF);
    if (F.tid == 0) *slot = (int)atomicAdd(ctr, 1u);
    LDS_WAIT(); __syncthreads();
    const int t = *slot;
    LDS_WAIT(); __syncthreads();
    return t;
}
__device__ __forceinline__ int bcast_ticket(const Frame& F, int mine) {
    LAS int* slot = (LAS int*)(F.lds + TICKET_OFF);
    if (F.tid == 0) *slot = mine;
    LDS_WAIT(); __syncthreads();
    const int t = *slot;
    LDS_WAIT(); __syncthreads();
    return t;
}
constexpr size_t W_UR = 16 * MiB;
constexpr size_t W_UA = W_UR + (size_t)TP * UR_W * 2;
constexpr size_t W_RW = W_UA + (size_t)TP * UA_W * 2;
constexpr size_t W_H0B = W_RW;
constexpr size_t W_RW_M = W_RW, W_RW_N = W_RW_M + (size_t)NUNIT * 8192, W_RW_Q = W_RW_N + (size_t)NUNIT * 16384, W_RW_OP = W_RW_Q + (size_t)NUNIT * 8192,
                 W_RW_G1 = W_RW_OP + (size_t)NUNIT * 8192, W_RW_G2 = W_RW_G1 + (size_t)NUNIT * 8192, W_RW_END = W_RW_G2 + (size_t)NUNIT * 8192;
static_assert(W_RW_END <= WS_LIST, "RWKV data below the token lists");
constexpr size_t W_MIX = W_RW;
constexpr size_t W_F = W_RW;
constexpr size_t W_H1B = W_RW + 81 * MiB;
constexpr size_t W_H1 = W_UR;
constexpr size_t W_HID = 81 * MiB;
static_assert(W_H1 + (size_t)TP * 4096 <= W_HID && W_HID + (size_t)41216 * 512 <= W_RW && W_H1B + (size_t)TP * 2048 <= WS_LIST && W_F + (size_t)41216 * 2048 <= W_H1B, "late-phase overlays");
constexpr size_t O_Q = 0, O_QI = O_Q + (size_t)TP * 1024, O_HC = O_QI + (size_t)TP * 1024, O_MASK = O_HC + (size_t)NUNIT * 8192, O_KX = O_MASK + (size_t)TP * MW * 2, O_END = O_KX + (size_t)TP * 128;
constexpr size_t O_WGU = 0, O_WD = 32 * MiB;
static_assert(O_END <= 64 * MiB && O_WD + (size_t)NEXP * EW_D <= 64 * MiB, "d_out scratch");

__global__ void __launch_bounds__(NTHR, 2) mega(Args a) {
    unsigned char* const wsb_ = a.ws; unsigned char* const ob_ = (unsigned char*)a.out;
    bf16* const H0b = (bf16*)(wsb_ + W_H0B); bf16* const Ur = (bf16*)(wsb_ + W_UR); bf16* const Ua = (bf16*)(wsb_ + W_UA);
    const RwkvBufs RB{(bf16*)(wsb_ + W_RW_M), (float*)(wsb_ + W_RW_N), (bf16*)(wsb_ + W_RW_Q), (bf16*)(wsb_ + W_RW_OP), (bf16*)(wsb_ + W_RW_G1), (bf16*)(wsb_ + W_RW_G2), (bf16*)(ob_ + O_HC)};
    const AttBufs AB{(bf16*)(ob_ + O_Q), (bf16*)(ob_ + O_QI), (unsigned short*)(ob_ + O_MASK), (bf16*)(ob_ + O_KX)};
    const MoeBufs MB{(float*)(wsb_ + W_MIX), (float*)(wsb_ + W_H1), (bf16*)(wsb_ + W_H1B), (bf16*)(wsb_ + W_HID), (bf16*)(wsb_ + W_F), (bf16*)(ob_ + O_WGU), (bf16*)(ob_ + O_WD)};
    extern __shared__ __attribute__((aligned(16))) unsigned char lds[];
    Frame F;
    F.lds = (LAS unsigned char*)lds;
    F.tid = threadIdx.x; F.lane = F.tid & 63; F.wave = __builtin_amdgcn_readfirstlane(F.tid >> 6);
    F.G = gridDim.x; F.bid = blockIdx.x; F.ws = a.ws;
    unsigned* ctl = (unsigned*)(a.ws + WS_CTL);
    const int lo = a.ph_lo, hi = a.ph_hi;
    volatile LAS unsigned* MISC = (volatile LAS unsigned*)(F.lds + MISC_OFF);
    if (F.tid < 4) MISC[F.tid] = 0u;
    LDS_WAIT(); __syncthreads();
    XcdBarrier bar; bar.bar = ctl + CW_BAR; bar.x = 0; bar.st = MISC;
    if (hi - lo > 1) bar = xcd_barrier_post(ctl + CW_BAR, MISC);
#define SEAM(k) do { if (IN(k) && IN((k) + 1)) xcd_barrier(bar); } while (0)
#define IN(k) (lo <= (k) && (k) < hi)
    if (IN(0)) { p0_prologue(F, a, H0b); }
    SEAM(0);
    if (IN(1)) {
        pg8::Gemm g{H0b, (const bf16*)(F.ws + WS_WIN), TP, IN_N, 1024, 1024, nullptr};
        pg8::StaticOrder S; S.init(TP, IN_N, F.G, (int)blockIdx.x);
        pg8::EpiU E{Ur, Ua};
        pg8::gemm_phase<pg8::EpiU, pg8::StaticOrder, true, true>(F.lds, g, S, E);
    }
    SEAM(1);
    if (IN(2)) {
        {
            if (F.G == 256) { att_prep_unit(F, a, Ua, AB, F.bid); if (F.bid >= 32 && F.bid < 36) att_prep_unit(F, a, Ua, AB, 256 + F.bid - 32); }
            else for (int u = F.bid; u < TP / 64; u += F.G) att_prep_unit(F, a, Ua, AB, u);
        }
        {
            if (F.G == 256) {
                const int nk = (F.bid >= 32 && F.bid < 36) ? 7 : ((F.bid < 32 || (F.bid >= 36 && F.bid < 40)) ? 9 : 8);
#define PB(x) (32 * ((x) & 7) + ((x) >> 3))
                RwRaw R; rw_load_raw(R, Ur, PB(F.bid), F.tid);
                { RwW W0; rw_w_fetch(W0, F, a, PB(F.bid) & 7); __syncthreads(); rw_w_store(W0, F); LDS_WAIT(); __syncthreads(); }
#pragma unroll 1
                for (int kq = 0; kq < nk; ++kq) {
                    const int u = (kq < 8) ? PB(F.bid) + 256 * kq : (F.bid < 32 ? 2048 + F.bid : PB(F.bid - 4) + 256 * 7);
                    const int kn = kq + 1; const int un = (kn >= nk) ? -1 : ((kn < 8) ? PB(F.bid) + 256 * kn : (F.bid < 32 ? 2048 + F.bid : PB(F.bid - 4) + 256 * 7));
                    rwkv_unit(F, a, Ur, RB, u, R, un);
                }
            } else { RwRaw R; for (int u = F.bid; u < NUNIT; u += F.G) { rw_load_raw(R, Ur, u, F.tid); { RwW W0; rw_w_fetch(W0, F, a, u & 7); __syncthreads(); rw_w_store(W0, F); LDS_WAIT(); __syncthreads(); } rwkv_unit(F, a, Ur, RB, u, R, -1); } }
        }
    }
    SEAM(2);
    if (IN(3)) {
        if (F.bid < 32 && F.wave < 2) rwkv_scan(RB, F.bid, F.wave, F.lane);
        for (int i = next_ticket(F, ctl + CW_W3); i < 4 * 257;) {
            idx_unit(F, Ua, AB, i & 3, 256 - (i >> 2), a.flags);
            i = next_ticket(F, ctl + CW_W3);
        }
    }
    SEAM(3);
    if (IN(4)) {
        const OutY of{Ur};
        for (int u = F.bid * NWAVES + F.wave; u < NUNIT; u += F.G * NWAVES) rwkv_out_unit(RB, u, F.lane, of);
        for (int i = next_ticket(F, ctl + CW_W4); i < 17 * 32;) {
            attn_unit(F, Ua, AB, (i & 31) >> 3, i & 7, 16 - (i >> 5), of);
            i = next_ticket(F, ctl + CW_W4);
        }
    }
    SEAM(4);
    if (IN(5)) {
        pg8::Gemm g{Ur, (const bf16*)(F.ws + WS_WOUT), TP, 1024, 1024, UR_W, nullptr};
        pg8::StaticOrder S; S.init(TP, 1024, F.G, (int)blockIdx.x);
        pg8::EpiB16 E{(bf16*)MB.MIX, 1024};
        pg8::gemm_phase<pg8::EpiB16, pg8::StaticOrder, true, true>(F.lds, g, S, E);
        convert_experts(F, a, MB, 0, (TP / 256) * 4 - F.G > 0 ? (TP / 256) * 4 - F.G : 0);
    }
    SEAM(5);
    if (IN(6)) { p6_ln1_router(F, a, MB); }
    SEAM(6);
    if (IN(7)) { p7_moe(F, MB, false);
        { const int nu = 2 * moe_total_tiles((const unsigned*)(F.ws + WS_CTL) + CW_CNT); const int fw = nu - F.G; convert_experts(F, a, MB, 1, (fw > 0 && fw < F.G) ? fw : 0); } }
    SEAM(7);
    if (IN(8)) { Frame F8 = F; { int t = F.tid; asm volatile("" : "+v"(t)); F8.tid = t; F8.lane = t & 63; } p7_moe(F8, MB, true); }
    SEAM(8);
    if (IN(9)) { Frame F9 = F; { int t = F.tid; asm volatile("" : "+v"(t)); F9.tid = t; F9.lane = t & 63; } p8_final(F9, a, MB); }
#undef IN
#undef SEAM
}

}
extern "C" void kernel_launch(void* const* d_in, const int* in_sizes, int n_in, void* d_out, int out_size, void* d_ws, size_t ws_size, hipStream_t stream) {
    static int inited = 0;
    if (!inited) { (void)hipFuncSetAttribute((const void*)mk::mega, hipFuncAttributeMaxDynamicSharedMemorySize, mk::LDS_BYTES); inited = 1; }
    unsigned char* wsb = (unsigned char*)d_ws;
    (void)hipMemsetAsync(wsb + mk::WS_CTL, 0, mk::CTL_ZERO_BYTES, stream);
    mk::Args a{};
    for (int i = 0; i < 33; ++i) a.in[i] = (const float*)d_in[i];
    a.out = (float*)d_out; a.ws = wsb;
    static int grid = 0;
    if (!grid) { int dev = 0, cus = 0, per_cu = 0; (void)hipGetDevice(&dev); (void)hipDeviceGetAttribute(&cus, hipDeviceAttributeMultiprocessorCount, dev);
        (void)hipOccupancyMaxActiveBlocksPerMultiprocessor(&per_cu, (const void*)mk::mega, mk::NTHR, mk::LDS_BYTES); (void)hipGetLastError();
        if (per_cu < 1) per_cu = 1; if (cus < 1) cus = 256; grid = cus * per_cu; if (grid > 256) grid = 256; }
    a.ph_lo = 0; a.ph_hi = 10;
    { void* kargs[] = {(void*)&a};
      if (hipLaunchCooperativeKernel((const void*)mk::mega, dim3(grid), dim3(mk::NTHR), kargs, mk::LDS_BYTES, stream) != hipSuccess) {
          (void)hipGetLastError();
          hipLaunchKernelGGL(mk::mega, dim3(grid), dim3(mk::NTHR), mk::LDS_BYTES, stream, a);
      } }
}
```

```cpp
#include <hip/hip_runtime.h>
#include <math.h>
#include <stdint.h>
namespace pg8 {
#define PG8_LAS __attribute__((address_space(3)))
typedef unsigned short bf16_t;
typedef short bf16x8 __attribute__((ext_vector_type(8)));
typedef float f32x4 __attribute__((ext_vector_type(4)));
typedef unsigned u32x4 __attribute__((ext_vector_type(4)));
constexpr int BM = 256, BK = 64, HALF = 128, HTB = HALF * BK * 2  , STAGE_BYTES = 8 * HTB, NXCD = 8, WGM = 8;

__host__ __device__ __forceinline__ int lds_byte(int r, int c) { const int st = (r >> 4) * 2 + (c >> 5), rr = r & 15, cc = c & 31, ob = rr * 64 + cc * 2; return st * 1024 + (ob ^ (((ob >> 9) & 1) << 5)); }
__host__ __device__ __forceinline__ void stage_rc(int b, int& R, int& C) { const int st = b / 1024, sb = b % 1024, swz = sb ^ (((sb >> 9) & 1) << 5); R = (st >> 1) * 16 + swz / 64; C = (st & 1) * 32 + (swz % 64) / 2; }
__host__ __device__ __forceinline__ int perm32(int rho) { const int n = rho >> 4, i = rho & 15; return 8 * (i >> 2) + 4 * n + (i & 3); }

struct Unit { int pm, pn; };
struct Gemm { const bf16_t* A; const bf16_t* Bt; int M, N, K, lda; const int* rowidx; };

struct StaticOrder {
    int nM, nN, nwg, G, c;
    __host__ __device__ void init(int M, int N, int G_, int c_) { nM = M / BM; nN = N / BM; nwg = nM * nN; G = G_; c = c_; }
    __host__ __device__ bool next(int i, Unit& u) const {
        const long L = (long)i * G + c; if (L >= nwg) return false;
        int wgid = (int)L; { const int q = nwg / NXCD, r = nwg % NXCD, xcd = wgid % NXCD, off = wgid / NXCD; wgid = (xcd < r ? xcd * (q + 1) : r * (q + 1) + (xcd - r) * q) + off; }
        const int nig = WGM * nN, gid = wgid / nig, fm = gid * WGM, gsz = (nM - fm) < WGM ? (nM - fm) : WGM;
        u.pm = fm + ((wgid % nig) % gsz); u.pn = (wgid % nig) / gsz; return true;
    }
    __device__ __forceinline__ void a_ready(const Unit&) const {}
    __device__ __forceinline__ void done(const Unit&) const {}
};

__device__ __forceinline__ unsigned cvt_pk_bf16(float lo, float hi) { unsigned r; asm volatile("v_cvt_pk_bf16_f32 %0, %1, %2" : "=v"(r) : "v"(lo), "v"(hi)); return r; }
typedef float f32x2 __attribute__((ext_vector_type(2)));
__device__ __forceinline__ f32x2 gelu_pk(f32x2 v) {
    const f32x2 av = __builtin_elementwise_abs(v), d = av * 0.2316418882f + 1.0f;
    f32x2 t; t.x = __builtin_amdgcn_rcpf(d.x); t.y = __builtin_amdgcn_rcpf(d.y);
    f32x2 q = t * 0.5307027145f + (-0.7265760135f); q = q * t + 0.7107068705f; q = q * t + (-0.142248368f); q = q * t + 0.127414796f; q = q * t;
    const f32x2 s = (v * v) * (-0.72134752044f);
    f32x2 e; e.x = __builtin_amdgcn_exp2f(s.x); e.y = __builtin_amdgcn_exp2f(s.y);
    const f32x2 m = v * (q * e), r = v - m;
    f32x2 o; o.x = v.x < 0.f ? m.x : r.x; o.y = v.y < 0.f ? m.y : r.y; return o;
}

template <int ACT  > struct EpiBf16 {
    static constexpr bool PERM = true, AFTER_DRAIN = false; static_assert(ACT == 0 || ACT == 1, "EpiBf16: ACT is 0 (none) or 1 (gelu_pk)");
    bf16_t* O; int ldc; const float* bias; int split_cols; size_t split_stride; float scale0;
    __device__ __forceinline__ void operator()(const f32x4 (&acc)[2][2][4][2], const Unit& u, int wr, int wc, int fr, int fq) const {
        const int row0 = u.pm * BM + wr * 64 + fr; int colt = u.pn * BM; bf16_t* base = O;
        float sc = 1.f; if (split_cols) { const int t = colt / split_cols; base += (size_t)t * split_stride; colt -= t * split_cols; if (t == 0) sc = scale0; }
        const int col0 = colt + wc * 32 + 8 * fq, bcol0 = u.pn * BM + wc * 32 + 8 * fq;
        f32x4 bv[2][2];
#pragma unroll
        for (int bj = 0; bj < 2; ++bj)
#pragma unroll
            for (int n = 0; n < 2; ++n) bv[bj][n] = bias ? *(const f32x4*)(bias + bcol0 + bj * HALF + 4 * n) : (f32x4){0.f, 0.f, 0.f, 0.f};
#pragma unroll
        for (int ai = 0; ai < 2; ++ai)
#pragma unroll
            for (int m = 0; m < 4; ++m) { bf16_t* rowp = base + (size_t)(row0 + ai * HALF + m * 16) * ldc + col0;
#pragma unroll
                for (int bj = 0; bj < 2; ++bj) { f32x4 v0 = acc[ai][bj][m][0] + bv[bj][0], v1 = acc[ai][bj][m][1] + bv[bj][1];
                    if (ACT == 1) { f32x2 a = gelu_pk((f32x2){v0[0], v0[1]}), b = gelu_pk((f32x2){v0[2], v0[3]}), c = gelu_pk((f32x2){v1[0], v1[1]}), d = gelu_pk((f32x2){v1[2], v1[3]});
                        v0 = (f32x4){a.x, a.y, b.x, b.y}; v1 = (f32x4){c.x, c.y, d.x, d.y}; }
                    v0 = v0 * sc; v1 = v1 * sc; u32x4 w; w.x = cvt_pk_bf16(v0[0], v0[1]); w.y = cvt_pk_bf16(v0[2], v0[3]); w.z = cvt_pk_bf16(v1[0], v1[1]); w.w = cvt_pk_bf16(v1[2], v1[3]);
                    *(u32x4*)(rowp + bj * HALF) = w; } }
    }
};
template <class Epi, class Sched, bool ALIGN_EPI = false, bool SP2 = false, bool GATHER = false>
__device__ __forceinline__ void gemm_phase(PG8_LAS unsigned char* lds, const Gemm g, const Sched& S, const Epi& E) {
    const int tid = threadIdx.x, wid = __builtin_amdgcn_readfirstlane(tid >> 6), lane = tid & 63, wr = wid >> 2, wc = wid & 3, fr = lane & 15, fq = lane >> 4;
    const int K = g.K, nt = K / BK;
    unsigned voffA[2], voffA1[2], voffB[2];
#pragma unroll
    for (int i = 0; i < 2; ++i) { int R, C; stage_rc(tid * 16 + i * 8192, R, C); const int Rb = Epi::PERM ? ((R & ~31) + perm32(R & 31)) : R;
        if constexpr (GATHER) { voffA[i] = (unsigned)(g.rowidx[R] * g.lda + C) * 2u; voffA1[i] = (unsigned)(g.rowidx[R + HALF] * g.lda + C) * 2u; }
        else { voffA[i] = (unsigned)(R * g.lda + C) * 2u; voffA1[i] = voffA[i]; }
        voffB[i] = (unsigned)(Rb * K + C) * 2u; }
    const size_t kstep = (size_t)(BK * 2);
    const size_t hstep = (size_t)HALF * K * 2;
    const size_t tstep = 2 * hstep; const size_t hstepA = GATHER ? (size_t)0 : (size_t)HALF * g.lda * 2, tstepA = 2 * hstepA;
    const unsigned ldsw = (unsigned)wid * 1024u;
    const int aoff = lds_byte(wr * 64 + fr, fq * 8), boff = lds_byte(wc * 32 + fr, fq * 8);
#define PG8_SA(b, h) (((b) * 2 + (h)) * HTB)
#define PG8_SB(b, h) ((4 + (b) * 2 + (h)) * HTB)
#define PG8_STAGE(bufoff, gbase, voff) do { _Pragma("unroll") for (int _i = 0; _i < 2; ++_i) \
        __builtin_amdgcn_global_load_lds((const unsigned*)((const char*)(gbase) + (voff)[_i]), (PG8_LAS unsigned*)(lds + (bufoff) + ldsw + _i * 8192), 16, 0, 0); } while (0)
#define PG8_LDA(dst, b, h) do { _Pragma("unroll") for (int m = 0; m < 4; ++m) _Pragma("unroll") for (int k = 0; k < 2; ++k) dst[m][k] = *(const PG8_LAS bf16x8*)(lds + PG8_SA(b, h) + aoff + m * 2048 + k * 1024); } while (0)
#define PG8_LDB(dst, b, h) do { _Pragma("unroll") for (int n = 0; n < 2; ++n) _Pragma("unroll") for (int k = 0; k < 2; ++k) dst[n][k] = *(const PG8_LAS bf16x8*)(lds + PG8_SB(b, h) + boff + n * 2048 + k * 1024); } while (0)
#define PG8_MMA(ai, bj, At, Bt) do { __builtin_amdgcn_s_setprio(1); _Pragma("unroll") for (int m = 0; m < 4; ++m) _Pragma("unroll") for (int n = 0; n < 2; ++n) _Pragma("unroll") for (int k = 0; k < 2; ++k) \
        acc[ai][bj][m][n] = __builtin_amdgcn_mfma_f32_16x16x32_bf16(Bt[n][k], At[m][k], acc[ai][bj][m][n], 0, 0, 0); __builtin_amdgcn_s_setprio(0); } while (0)
#define PG8_WAIT_V(n) asm volatile("s_waitcnt vmcnt(" #n ")" ::: "memory")
#define PG8_WAIT_L(n) asm volatile("s_waitcnt lgkmcnt(" #n ")" ::: "memory")
#define PG8_BAR __builtin_amdgcn_s_barrier()
#define PG8_SCHED __builtin_amdgcn_sched_barrier(0)
    Unit cur, nxt; int ui = 0;
    if (!S.next(0, cur)) return;
    f32x4 acc[2][2][4][2];
#pragma unroll
    for (int a = 0; a < 2; ++a)
#pragma unroll
        for (int b = 0; b < 2; ++b)
#pragma unroll
            for (int m = 0; m < 4; ++m)
#pragma unroll
                for (int n = 0; n < 2; ++n) acc[a][b][m][n] = (f32x4){0.f, 0.f, 0.f, 0.f};
    bf16x8 At[4][2], B0[2][2], B1[2][2];
    const char* cA = (const char*)g.A + (size_t)cur.pm * tstepA; const char* cB = (const char*)g.Bt + (size_t)cur.pn * tstep;
    S.a_ready(cur);
    if constexpr (SP2) {
        PG8_STAGE(PG8_SB(0, 0), cB, voffB); PG8_STAGE(PG8_SB(0, 1), cB + hstep, voffB); PG8_STAGE(PG8_SA(0, 0), cA, voffA); PG8_STAGE(PG8_SA(0, 1), cA + hstepA, voffA1);
        if (wr == 1) PG8_BAR;
        PG8_WAIT_V(2); PG8_BAR;
        PG8_STAGE(PG8_SB(1, 0), cB + kstep, voffB); PG8_STAGE(PG8_SA(1, 0), cA + kstep, voffA); PG8_STAGE(PG8_SB(1, 1), cB + hstep + kstep, voffB);
        PG8_WAIT_V(6); PG8_BAR;
    } else {
        PG8_STAGE(PG8_SB(0, 0), cB, voffB); PG8_STAGE(PG8_SA(0, 0), cA, voffA); PG8_STAGE(PG8_SB(0, 1), cB + hstep, voffB); PG8_STAGE(PG8_SA(0, 1), cA + hstepA, voffA1);
        if (wr == 1) PG8_BAR;
        PG8_WAIT_V(4); PG8_BAR;
        PG8_STAGE(PG8_SB(1, 0), cB + kstep, voffB); PG8_STAGE(PG8_SA(1, 0), cA + kstep, voffA); PG8_STAGE(PG8_SB(1, 1), cB + hstep + kstep, voffB);
        PG8_WAIT_V(6); PG8_BAR;
    }
    for (;;) {
        const bool has_next = S.next(ui + 1, nxt);
        const char* nA = has_next ? (const char*)g.A + (size_t)nxt.pm * tstepA : cA; const char* nB = has_next ? (const char*)g.Bt + (size_t)nxt.pn * tstep : cB;
        for (int t = 0; t < nt; t += 2) {
            const bool last = (t == nt - 2);
            const char* a1 = cA + (size_t)(t + 1) * kstep;
            const char* a2 = last ? nA : cA + (size_t)(t + 2) * kstep; const char* b2 = last ? nB : cB + (size_t)(t + 2) * kstep;
            const char* a3 = a2 + kstep; const char* b3 = b2 + kstep;
            if (last && has_next) S.a_ready(nxt);
            if constexpr (SP2) {
            PG8_LDB(B0, 0, 0); PG8_LDB(B1, 0, 1); PG8_SCHED; PG8_LDA(At, 0, 0); PG8_STAGE(PG8_SA(1, 1), a1 + hstepA, voffA1);
            PG8_WAIT_V(8); PG8_WAIT_L(0); PG8_BAR; PG8_MMA(0, 0, At, B0); PG8_MMA(0, 1, At, B1); PG8_BAR; PG8_SCHED;
            PG8_LDA(At, 0, 1); PG8_STAGE(PG8_SB(0, 0), b2, voffB); PG8_STAGE(PG8_SB(0, 1), b2 + hstep, voffB); PG8_STAGE(PG8_SA(0, 0), a2, voffA);
            PG8_WAIT_V(8); PG8_WAIT_L(0); PG8_BAR; PG8_MMA(1, 0, At, B0); PG8_MMA(1, 1, At, B1); PG8_BAR; PG8_SCHED;
            PG8_LDB(B0, 1, 0); PG8_LDB(B1, 1, 1); PG8_SCHED; PG8_LDA(At, 1, 0); PG8_STAGE(PG8_SA(0, 1), a2 + hstepA, voffA1);
            PG8_WAIT_V(8); PG8_WAIT_L(0); PG8_BAR; PG8_MMA(0, 0, At, B0); PG8_MMA(0, 1, At, B1); PG8_BAR; PG8_SCHED;
            PG8_LDA(At, 1, 1); PG8_STAGE(PG8_SB(1, 0), b3, voffB); PG8_STAGE(PG8_SB(1, 1), b3 + hstep, voffB); PG8_STAGE(PG8_SA(1, 0), a3, voffA);
            PG8_WAIT_V(8); PG8_WAIT_L(0); PG8_BAR; PG8_MMA(1, 0, At, B0); PG8_MMA(1, 1, At, B1); PG8_BAR; PG8_SCHED;
            } else {
            PG8_LDB(B0, 0, 0); PG8_SCHED; PG8_LDA(At, 0, 0); PG8_STAGE(PG8_SA(1, 1), a1 + hstepA, voffA1);
            PG8_WAIT_L(8); PG8_BAR; PG8_WAIT_L(0); PG8_MMA(0, 0, At, B0); PG8_BAR; PG8_SCHED;
            PG8_LDB(B1, 0, 1); PG8_STAGE(PG8_SB(0, 0), b2, voffB);
            PG8_BAR; PG8_WAIT_L(0); PG8_MMA(0, 1, At, B1); PG8_BAR;
            PG8_LDA(At, 0, 1); PG8_STAGE(PG8_SA(0, 0), a2, voffA);
            PG8_BAR; PG8_WAIT_L(0); PG8_MMA(1, 0, At, B0); PG8_BAR; PG8_SCHED;
            PG8_STAGE(PG8_SB(0, 1), b2 + hstep, voffB);
            PG8_WAIT_V(6); PG8_BAR; PG8_MMA(1, 1, At, B1); PG8_BAR;
            PG8_LDB(B0, 1, 0); PG8_SCHED; PG8_LDA(At, 1, 0); PG8_STAGE(PG8_SA(0, 1), a2 + hstepA, voffA1);
            PG8_WAIT_L(8); PG8_BAR; PG8_WAIT_L(0); PG8_MMA(0, 0, At, B0); PG8_BAR; PG8_SCHED;
            PG8_LDB(B1, 1, 1); PG8_STAGE(PG8_SB(1, 0), b3, voffB);
            PG8_BAR; PG8_WAIT_L(0); PG8_MMA(0, 1, At, B1); PG8_BAR;
            PG8_LDA(At, 1, 1); PG8_STAGE(PG8_SA(1, 0), a3, voffA);
            PG8_BAR; PG8_WAIT_L(0); PG8_MMA(1, 0, At, B0); PG8_BAR; PG8_SCHED;
            PG8_STAGE(PG8_SB(1, 1), b3 + hstep, voffB);
            PG8_WAIT_V(6); PG8_BAR; PG8_MMA(1, 1, At, B1); PG8_BAR;
            }
        }
        if constexpr (ALIGN_EPI) { if (wr == 0) PG8_BAR; }
        if constexpr (!Epi::AFTER_DRAIN) { E(acc, cur, wr, wc, fr, fq); S.done(cur); }
        if (!has_next) break;
#pragma unroll
        for (int a = 0; a < 2; ++a)
#pragma unroll
            for (int b = 0; b < 2; ++b)
#pragma unroll
                for (int m = 0; m < 4; ++m)
#pragma unroll
                    for (int n = 0; n < 2; ++n) acc[a][b][m][n] = (f32x4){0.f, 0.f, 0.f, 0.f};
        cur = nxt; cA = nA; cB = nB; ++ui;
        if constexpr (ALIGN_EPI) { if (wr == 1) PG8_BAR; }
    }
    PG8_WAIT_V(0);
    if constexpr (!ALIGN_EPI) { if (wr == 0) PG8_BAR; }
    PG8_BAR;
    if constexpr (Epi::AFTER_DRAIN) { E.fused(acc, cur, wr, wc, fr, fq, lds, wid, lane); S.done(cur); }
#undef PG8_SA
#undef PG8_SB
#undef PG8_STAGE
#undef PG8_LDA
#undef PG8_LDB
#undef PG8_MMA
#undef PG8_WAIT_V
#undef PG8_WAIT_L
#undef PG8_BAR
#undef PG8_SCHED
}
}
namespace pg8 {
struct EpiF32 {
    static constexpr bool PERM = false, AFTER_DRAIN = false;
    float* O; int ldc;
    __device__ __forceinline__ void operator()(const f32x4 (&acc)[2][2][4][2], const Unit& u, int wr, int wc, int fr, int fq) const {
        const int row0 = u.pm * BM + wr * 64 + fr, col0 = u.pn * BM + wc * 32 + 4 * fq;
#pragma unroll
        for (int ai = 0; ai < 2; ++ai)
#pragma unroll
            for (int m = 0; m < 4; ++m) { float* rowp = O + (size_t)(row0 + ai * HALF + m * 16) * ldc + col0;
#pragma unroll
                for (int bj = 0; bj < 2; ++bj)
#pragma unroll
                    for (int n = 0; n < 2; ++n) *(f32x4*)(rowp + bj * HALF + n * 16) = acc[ai][bj][m][n]; }
    }
};
}
namespace pg8 {
struct EpiU {
    static constexpr bool PERM = true, AFTER_DRAIN = false;
    bf16_t* Ur; bf16_t* Ua;
    __device__ __forceinline__ void operator()(const f32x4 (&acc)[2][2][4][2], const Unit& u, int wr, int wc, int fr, int fq) const {
        const int row0 = u.pm * BM + wr * 64 + fr; int colt = u.pn * BM; bf16_t* base = Ur; int ld = 1792;
        if (colt >= 1792) { base = Ua; ld = 1536; colt -= 1792; }
        const int col0 = colt + wc * 32 + 8 * fq;
#pragma unroll
        for (int ai = 0; ai < 2; ++ai)
#pragma unroll
            for (int m = 0; m < 4; ++m) { bf16_t* rowp = base + (size_t)(row0 + ai * HALF + m * 16) * ld + col0;
#pragma unroll
                for (int bj = 0; bj < 2; ++bj) { const f32x4 v0 = acc[ai][bj][m][0], v1 = acc[ai][bj][m][1];
                    u32x4 w; w.x = cvt_pk_bf16(v0[0], v0[1]); w.y = cvt_pk_bf16(v0[2], v0[3]); w.z = cvt_pk_bf16(v1[0], v1[1]); w.w = cvt_pk_bf16(v1[2], v1[3]);
                    *(u32x4*)(rowp + bj * HALF) = w; } }
    }
};
}
namespace pg8 {
struct EpiB16 {
    static constexpr bool PERM = true, AFTER_DRAIN = false;
    bf16_t* O; int ldc;
    __device__ __forceinline__ void operator()(const f32x4 (&acc)[2][2][4][2], const Unit& u, int wr, int wc, int fr, int fq) const {
        const int row0 = u.pm * BM + wr * 64 + fr, col0 = u.pn * BM + wc * 32 + 8 * fq;
#pragma unroll
        for (int ai = 0; ai < 2; ++ai)
#pragma unroll
            for (int m = 0; m < 4; ++m) { bf16_t* rowp = O + (size_t)(row0 + ai * HALF + m * 16) * ldc + col0;
#pragma unroll
                for (int bj = 0; bj < 2; ++bj) { const f32x4 v0 = acc[ai][bj][m][0], v1 = acc[ai][bj][m][1];
                    u32x4 w; w.x = cvt_pk_bf16(v0[0], v0[1]); w.y = cvt_pk_bf16(v0[2], v0[3]); w.z = cvt_pk_bf16(v1[0], v1[1]); w.w = cvt_pk_bf16(v1[2], v1[3]);
                    *(u32x4*)(rowp + bj * HALF) = w; } }
    }
};
}
namespace mk {
#define GAS __attribute__((address_space(1)))
#define LAS __attribute__((address_space(3)))
typedef unsigned short bf16;
typedef unsigned v4u __attribute__((ext_vector_type(4)));
typedef unsigned v2u __attribute__((ext_vector_type(2)));
typedef float f32x4 __attribute__((ext_vector_type(4)));
typedef float f32x16 __attribute__((ext_vector_type(16)));
typedef short bf16x8 __attribute__((ext_vector_type(8)));
typedef GAS unsigned gu32;
typedef GAS unsigned long long gu64;
#define RLX_AGENT __ATOMIC_RELAXED, __HIP_MEMORY_SCOPE_AGENT
#define LDS_WAIT() asm volatile("s_waitcnt lgkmcnt(0)" ::: "memory")
#define VM_WAIT() asm volatile("s_waitcnt vmcnt(0)" ::: "memory")

constexpr int NB = 4, SEQ = 4096, NM = 16, L = 4112, LP = 4160, TP = NB * LP, D = 1024;
constexpr int NCH = LP / 64;
constexpr int UR_W = 1792, UA_W = 1536, IN_N = 3328, IN_COLS = 3144;
constexpr int NWAVES = 8, NTHR = 512;
constexpr float LN_EPS = 1e-5f, RMS_EPS = 1e-6f, GN_EPS = 64e-5f;
constexpr float DN_ALPHA = 1.189207115002721f;

typedef float f32x2_t __attribute__((ext_vector_type(2))); typedef __bf16 bf16x2_t __attribute__((ext_vector_type(2)));
__device__ __forceinline__ unsigned pk2(float lo, float hi) { f32x2_t v = {lo, hi}; bf16x2_t b = __builtin_convertvector(v, bf16x2_t); return __builtin_bit_cast(unsigned, b); }
__device__ __forceinline__ unsigned f2bf(float f) { return pk2(f, f) & 0xffffu; }
__device__ __forceinline__ float bf2f(unsigned short b) { return __uint_as_float(((unsigned)b) << 16); }
__device__ __forceinline__ float bflo(unsigned w) { return __uint_as_float(w << 16); }
__device__ __forceinline__ float bfhi(unsigned w) { return __uint_as_float(w & 0xffff0000u); }
__device__ __forceinline__ float dpp_f(float v, int ctrl_sel) {
    const int x = __float_as_int(v); int r;
    if (ctrl_sel == 0) r = __builtin_amdgcn_mov_dpp(x, 0xB1, 0xF, 0xF, true);
    else if (ctrl_sel == 1) r = __builtin_amdgcn_mov_dpp(x, 0x4E, 0xF, 0xF, true);
    else if (ctrl_sel == 2) r = __builtin_amdgcn_mov_dpp(x, 0x141, 0xF, 0xF, true);
    else r = __builtin_amdgcn_mov_dpp(x, 0x140, 0xF, 0xF, true);
    return __int_as_float(r);
}
__device__ __forceinline__ float sum_x16(float v) { auto rr = __builtin_amdgcn_permlane16_swap(__float_as_uint(v), __float_as_uint(v), false, false); return __uint_as_float(rr[0]) + __uint_as_float(rr[1]); }
__device__ __forceinline__ float sum_x32(float v) { auto rr = __builtin_amdgcn_permlane32_swap(__float_as_uint(v), __float_as_uint(v), false, false); return __uint_as_float(rr[0]) + __uint_as_float(rr[1]); }
__device__ __forceinline__ int isum_x16(int v) { auto rr = __builtin_amdgcn_permlane16_swap((unsigned)v, (unsigned)v, false, false); return (int)(rr[0] + rr[1]); }
__device__ __forceinline__ int isum_x32(int v) { auto rr = __builtin_amdgcn_permlane32_swap((unsigned)v, (unsigned)v, false, false); return (int)(rr[0] + rr[1]); }
__device__ __forceinline__ unsigned or_x16(unsigned v) { auto rr = __builtin_amdgcn_permlane16_swap(v, v, false, false); return rr[0] | rr[1]; }
__device__ __forceinline__ unsigned or_x32(unsigned v) { auto rr = __builtin_amdgcn_permlane32_swap(v, v, false, false); return rr[0] | rr[1]; }
__device__ __forceinline__ float sum8(float v) { v += dpp_f(v, 0); v += dpp_f(v, 1); v += dpp_f(v, 2); return v; }
__device__ __forceinline__ float wave_sum(float v) { v = sum8(v); v += dpp_f(v, 3); v = sum_x16(v); return sum_x32(v); }

constexpr size_t MiB = 1u << 20;
constexpr size_t WS_CTL = 0, CTL_ZERO_BYTES = 64 * 1024;
constexpr int CW_BAR = 1024;
constexpr size_t WS_ROPEQ = 1 * MiB;
constexpr size_t WS_ROPEI = WS_ROPEQ + (size_t)LP * 32 * 8;
constexpr size_t WS_ROWSTAT = WS_ROPEI + (size_t)LP * 16 * 8;
constexpr size_t WS_WIN = 3 * MiB;
constexpr size_t WS_WOUT = WS_WIN + (size_t)IN_N * 1024 * 2;
constexpr size_t WS_WQ = WS_WOUT + (size_t)1024 * 1024 * 2;
constexpr size_t WS_WW2 = WS_WQ + (size_t)1024 * 256 * 2;
constexpr size_t WS_WA2 = WS_WW2 + (size_t)512 * 64 * 2;
constexpr size_t WS_WG2 = WS_WA2 + (size_t)512 * 64 * 2;
constexpr size_t WS_WEND = WS_WG2 + (size_t)512 * 128 * 2;
static_assert(WS_WEND <= 13 * MiB, "weights region");

constexpr int RING_BYTES = 131072;
constexpr int LDS_BYTES = 147456;
constexpr int MISC_OFF = LDS_BYTES - 16;
#define XB_TMO      128
#define XB_XCNT(j)  (256  + 64 * (j))
#define XB_XSUB(j)  (1280 + 64 * (j))
#define XB_XGEN(j)  (2304 + 64 * (j))
#define XB_TOP      3328
#define XB_TOPGEN   3392
#define XCD_BAR_WORDS 3456
#define XB_SPIN_CAP (1u << 18)

__device__ __forceinline__ unsigned xb_ld(unsigned* p)              { return __hip_atomic_load(p, __ATOMIC_RELAXED, __HIP_MEMORY_SCOPE_AGENT); }
__device__ __forceinline__ unsigned xb_add(unsigned* p, unsigned v) { return __hip_atomic_fetch_add(p, v, __ATOMIC_RELAXED, __HIP_MEMORY_SCOPE_AGENT); }
__device__ __forceinline__ unsigned xb_xcc_id() { return (unsigned)__builtin_amdgcn_s_getreg((3 << 11) | 20) & 0xFu; }
#define XB_SPIN(cond, bar) do { unsigned _sp = 0; while (cond) { __builtin_amdgcn_s_sleep(1); \
    if ((++_sp & 255u) == 0u) { if (xb_ld(&(bar)[XB_TMO])) break; if (_sp > XB_SPIN_CAP) { atomicAdd(&(bar)[XB_TMO], 1u); break; } } } } while (0)

struct XcdBarrier {
    unsigned* bar; unsigned x;
    volatile LAS unsigned* st;
};

__device__ __forceinline__ XcdBarrier xcd_barrier_post(unsigned* bar, volatile LAS unsigned* st) {
    XcdBarrier b; b.bar = bar; b.x = xb_xcc_id(); b.st = st;
    if (threadIdx.x == 0) (void)xb_add(&bar[XB_XCNT(b.x)], 1u);
    return b;
}
__device__ __forceinline__ void xcd_barrier_complete(unsigned* bar, unsigned x, unsigned& nloc, unsigned& nx) {
    const unsigned G = gridDim.x * gridDim.y * gridDim.z;
    unsigned sum, cnt, mine, sp = 0u;
    for (;;) {
        sum = 0u; cnt = 0u; mine = 0u;
#pragma unroll
        for (unsigned j = 0; j < 16; ++j) { const unsigned c = xb_ld(&bar[XB_XCNT(j)]); sum += c; cnt += (c > 0u) ? 1u : 0u; mine = (j == x) ? c : mine; }
        if (sum == G) break;
        __builtin_amdgcn_s_sleep(1);
        if ((++sp & 255u) == 0u) { if (xb_ld(&bar[XB_TMO])) break; if (sp > XB_SPIN_CAP) { atomicAdd(&bar[XB_TMO], 1u); break; } }
    }
    nloc = mine > 0u ? mine : 1u; nx = cnt > 0u ? cnt : 1u;
}

__device__ __forceinline__ void xcd_barrier(const XcdBarrier& b) {
    asm volatile("s_waitcnt vmcnt(0)" ::: "memory");
    __syncthreads();
    if (threadIdx.x == 0) {
        unsigned* bar = b.bar;
        __builtin_amdgcn_s_waitcnt(0);
        unsigned nloc = b.st[0], nx = b.st[1];
        if (nloc == 0u) { xcd_barrier_complete(bar, b.x, nloc, nx); b.st[0] = nloc; b.st[1] = nx; }
        const unsigned old = xb_add(&bar[XB_XSUB(b.x)], 1u);
        const unsigned gen = old / nloc;
        if (old + 1u == (gen + 1u) * nloc) {
            __builtin_amdgcn_fence(__ATOMIC_RELEASE, "agent");
            asm volatile("s_waitcnt vmcnt(0)" ::: "memory");
            const unsigned og = xb_add(&bar[XB_TOP], 1u);
            const unsigned tg = og / nx;
            if (og + 1u == (tg + 1u) * nx) xb_add(&bar[XB_TOPGEN], 1u);
            else XB_SPIN(xb_ld(&bar[XB_TOPGEN]) == tg, bar);
            __builtin_amdgcn_fence(__ATOMIC_ACQUIRE, "agent");
            xb_add(&bar[XB_XGEN(b.x)], 1u);
            asm volatile("s_waitcnt vmcnt(0)" ::: "memory");
        } else {
            XB_SPIN(xb_ld(&bar[XB_XGEN(b.x)]) == gen, bar);
            __builtin_amdgcn_fence(__ATOMIC_ACQUIRE, "agent");
            asm volatile("s_waitcnt vmcnt(0)" ::: "memory");
        }
    }
    __syncthreads();
}
struct Args {
    const float* in[33]; float* out; unsigned char* ws; int ph_lo, ph_hi; int flags, pad_;
};
struct Frame {
    LAS unsigned char* lds;
    int tid, lane, wave, G, bid;
    unsigned char* ws;
};

__device__ __forceinline__ int rowmap_in(int n) {
    if (n >= 2048 && n < 2560) { const int d = (n - 2048) & 63, base = n - d; return base + (d < 32 ? 2 * d : 2 * (d - 32) + 1); }
    if (n >= 3072 && n < 3136) { const int d = n - 3072; return 3072 + (d < 16 ? 2 * d : (d < 32 ? 2 * (d - 16) + 1 : d)); }
    return n;
}
template <int MODE> __device__ __forceinline__ int rowmap(int n) {
    if (MODE == 1) return rowmap_in(n);
    if (MODE == 2) { const int d = n & 63, base = n - d; return base + (d < 32 ? 2 * d : 2 * (d - 32) + 1); }
    if (MODE == 4) return 2 * n;
    if (MODE == 3) { const int d = n & 63, base = n - d; return base + (d < 16 ? 2 * d : (d < 32 ? 2 * (d - 16) + 1 : d)); }
    return n;
}
template <int MODE> __device__ __forceinline__ void transpose_item(const float* __restrict__ W, int K, int N, bf16* WT, int row_off, LAS float* scr, int item, int nblk, int lane) {
    const int kb = item / nblk, nb = item % nblk, k0 = 64 * kb, n0 = 32 * nb;
    const int n = n0 + (lane & 31);
    float tv[32];
#pragma unroll
    for (int i = 0; i < 32; ++i) { const int kk = 2 * i + (lane >> 5); tv[i] = (n < N) ? W[(size_t)(k0 + kk) * N + n] : 0.f; }
#pragma unroll
    for (int i = 0; i < 32; ++i) { const int kk = 2 * i + (lane >> 5); scr[kk * 33 + (lane & 31)] = tv[i]; }
    LDS_WAIT(); asm volatile("" ::: "memory");
    const int c = lane & 7;
#pragma unroll
    for (int j = 0; j < 4; ++j) { const int nl = (lane >> 3) + 8 * j; const LAS float* s = scr + (8 * c) * 33 + nl;
        v4u o; o.x = pk2(s[0 * 33], s[1 * 33]); o.y = pk2(s[2 * 33], s[3 * 33]); o.z = pk2(s[4 * 33], s[5 * 33]); o.w = pk2(s[6 * 33], s[7 * 33]);
        *(v4u*)(WT + (size_t)(row_off + rowmap<MODE>(n0 + nl)) * K + k0 + 8 * c) = o; }
    LDS_WAIT(); asm volatile("" ::: "memory");
}
__device__ __forceinline__ void p0_ln_row(const Args& a, int pr, bf16* H0b, float2* rowstat, int lane) {
    const int b = pr / LP, t = pr % LP;
    unsigned long long* o8 = (unsigned long long*)(H0b + (size_t)pr * D) + lane;
    if (t >= L) {
#pragma unroll
        for (int j = 0; j < 4; ++j) o8[64 * j] = 0ull;
        if (lane == 0) rowstat[pr] = make_float2(0.f, 0.f);
        return;
    }
    const float* src = (t < NM) ? (a.in[1] + (size_t)t * D) : (a.in[0] + ((size_t)b * SEQ + (t - NM)) * D);
    const f32x4* xr = (const f32x4*)src + lane;
    f32x4 v[4]; float s = 0.f;
#pragma unroll
    for (int j = 0; j < 4; ++j) { v[j] = xr[64 * j]; s += (v[j].x + v[j].y) + (v[j].z + v[j].w); }
    const float mean = wave_sum(s) * (1.f / D); float s2 = 0.f;
#pragma unroll
    for (int j = 0; j < 4; ++j) { v[j] = v[j] - mean; s2 += (v[j].x * v[j].x + v[j].y * v[j].y) + (v[j].z * v[j].z + v[j].w * v[j].w); }
    const float rstd = 1.f / sqrtf(wave_sum(s2) * (1.f / D) + LN_EPS);
    const f32x4* gp = (const f32x4*)a.in[2] + lane; const f32x4* bp = (const f32x4*)a.in[3] + lane;
#pragma unroll
    for (int j = 0; j < 4; ++j) { const f32x4 g = gp[64 * j], bb = bp[64 * j]; const f32x4 y = v[j] * rstd * g + bb;
        o8[64 * j] = (unsigned long long)pk2(y.x, y.y) | ((unsigned long long)pk2(y.z, y.w) << 32); }
    if (lane == 0) rowstat[pr] = make_float2(mean, rstd);
}
__device__ __forceinline__ void p0_prologue(const Frame& F, const Args& a, bf16* H0b) {
    LAS float* scr = (LAS float*)(F.lds + F.wave * 16384);
    const int gw = F.bid * NWAVES + F.wave, NGW = F.G * NWAVES;
    bf16* Wt_in = (bf16*)(F.ws + WS_WIN); bf16* Wt_out = (bf16*)(F.ws + WS_WOUT); bf16* Wt_q = (bf16*)(F.ws + WS_WQ);
    bf16* Wt_w2 = (bf16*)(F.ws + WS_WW2); bf16* Wt_a2 = (bf16*)(F.ws + WS_WA2); bf16* Wt_g2 = (bf16*)(F.ws + WS_WG2);
    constexpr int I_IN = 16 * (IN_N / 32), I_OUT = 16 * 32, I_Q = 4 * 16, I_W2 = 1 * 16, I_G2 = 2 * 16;
    constexpr int NITEMS = I_IN + I_OUT + 2 * I_Q + 2 * I_W2 + I_G2;
    for (int it = gw; it < NITEMS; it += NGW) {
        int r = it;
        if (r < I_IN) { transpose_item<1>(a.in[4], 1024, IN_COLS, Wt_in, 0, scr, r, IN_N / 32, F.lane); continue; } r -= I_IN;
        if (r < I_OUT) { transpose_item<0>(a.in[21], 1024, 1024, Wt_out, 0, scr, r, 32, F.lane); continue; } r -= I_OUT;
        if (r < I_Q) { transpose_item<2>(a.in[17], 256, 512, Wt_q, 0, scr, r, 16, F.lane); continue; } r -= I_Q;
        if (r < I_Q) { transpose_item<3>(a.in[18], 256, 512, Wt_q, 512, scr, r, 16, F.lane); continue; } r -= I_Q;
        if (r < I_W2) { transpose_item<0>(a.in[7], 64, 512, Wt_w2, 0, scr, r, 16, F.lane); continue; } r -= I_W2;
        if (r < I_W2) { transpose_item<0>(a.in[9], 64, 512, Wt_a2, 0, scr, r, 16, F.lane); continue; } r -= I_W2;
        transpose_item<0>(a.in[10], 128, 512, Wt_g2, 0, scr, r, 16, F.lane);
    }
    float2* rowstat = (float2*)(F.ws + WS_ROWSTAT);
    for (int pr = gw; pr < TP; pr += NGW) p0_ln_row(a, pr, H0b, rowstat, F.lane);
    float2* rq = (float2*)(F.ws + WS_ROPEQ); float2* ri = (float2*)(F.ws + WS_ROPEI);
    const int gt = F.bid * NTHR + F.tid, NGT = F.G * NTHR;
    for (int i = gt; i < LP * 48; i += NGT) {
        if (i < LP * 32) { const int t = i >> 5, d = i & 31; const float ang = (float)t * exp2f(-(float)d * (13.287712379549449f / 32.f)); float sn, cs; sincosf(ang, &sn, &cs); rq[i] = make_float2(cs, sn); }
        else { const int j = i - LP * 32, t = j >> 4, d = j & 15; const float ang = (float)t * exp2f(-(float)d * (13.287712379549449f / 16.f)); float sn, cs; sincosf(ang, &sn, &cs); ri[j] = make_float2(cs, sn); }
    }
}
constexpr int LDM = 72;
constexpr int SLOT = 64 * LDM * 2;
constexpr int LDG = 136;
constexpr int RW_LW_OFF = 0 * SLOT;
constexpr int RW_LA_OFF = 4 * SLOT;
constexpr int RW_LG_OFF = 2 * SLOT;
static_assert(64 * LDG * 2 <= 2 * SLOT, "Lg fits in two slots");
constexpr int RW_A_OFF = 8 * SLOT;
constexpr int RW_G_OFF = RW_A_OFF + 16384;
constexpr int RW_CS_OFF = RW_G_OFF + 8192;
constexpr int RW_SEG_OFF = RW_CS_OFF + 16384;
constexpr int RW_GC_OFF = 13 * SLOT;
static_assert(RW_SEG_OFF + 2048 <= RW_GC_OFF, "rwkv LDS map");
constexpr size_t RW_UNIT_M = 4096 * 2, RW_UNIT_N = 4096 * 4, RW_UNIT_X = 4096 * 2;
constexpr int NUNIT = NB * NCH * 8;

struct RwkvBufs { bf16* M; float* N; bf16* Q; bf16* OP; bf16* G1; bf16* G2; bf16* HC; };

__device__ __forceinline__ bf16x8 lds_frag(const LAS bf16* base, int row, int koff) { return *(const LAS bf16x8*)(base + row * LDM + koff); }
__device__ __forceinline__ f32x4 mm_tile(const LAS bf16* X, const LAS bf16* Y, int ta, int tb, int lane, f32x4 acc) {
    const int r = lane & 15, ko = 8 * (lane >> 4);
#pragma unroll
    for (int ks = 0; ks < 2; ++ks) {
        const bf16x8 ya = lds_frag(Y, 16 * tb + r, 32 * ks + ko), xb = lds_frag(X, 16 * ta + r, 32 * ks + ko);
        acc = __builtin_amdgcn_mfma_f32_16x16x32_bf16(ya, xb, acc, 0, 0, 0);
    }
    return acc;
}
__device__ __forceinline__ void st_r(LAS bf16* dst, int a, int b0, f32x4 v) {
    v2u w; w.x = pk2(v[0], v[1]); w.y = pk2(v[2], v[3]); *(LAS v2u*)(dst + a * LDM + b0) = w;
}
__device__ __forceinline__ void st_t(LAS bf16* dst, int a, int b0, f32x4 v) {
#pragma unroll
    for (int i = 0; i < 4; ++i) dst[(b0 + i) * LDM + a] = (bf16)f2bf(v[i]);
}
__device__ __forceinline__ f32x4 ld_r(const LAS bf16* src, int a, int b0) {
    const v2u w = *(const LAS v2u*)(src + a * LDM + b0);
    return (f32x4){bflo(w.x), bfhi(w.x), bflo(w.y), bfhi(w.y)};
}
__device__ __forceinline__ void st8(LAS bf16* dst, const float (&v)[8]) {
    v4u w; w.x = pk2(v[0], v[1]); w.y = pk2(v[2], v[3]); w.z = pk2(v[4], v[5]); w.w = pk2(v[6], v[7]); *(LAS v4u*)dst = w;
}
__device__ __forceinline__ void unpack8(v4u w, float (&o)[8]) {
    o[0] = bflo(w.x); o[1] = bfhi(w.x); o[2] = bflo(w.y); o[3] = bfhi(w.y); o[4] = bflo(w.z); o[5] = bfhi(w.z); o[6] = bflo(w.w); o[7] = bfhi(w.w);
}
__device__ __forceinline__ void ld8f(const float* p, float (&o)[8]) {
    const f32x4 a = *(const f32x4*)p, b = *(const f32x4*)(p + 4);
    o[0] = a.x; o[1] = a.y; o[2] = a.z; o[3] = a.w; o[4] = b.x; o[5] = b.y; o[6] = b.z; o[7] = b.w;
}
__device__ __forceinline__ float sigmoidf_(float x) { return __builtin_amdgcn_rcpf(1.f + __expf(-x)); }
__device__ __forceinline__ float tanhf_(float x) { return 1.f - 2.f * __builtin_amdgcn_rcpf(1.f + __expf(2.f * x)); }

constexpr int RW_WG2_OFF = 13 * SLOT, RW_WB_OFF = 13 * SLOT + 64 * LDG * 2, RW_WW2_OFF = 15 * SLOT, RW_WA2_OFF = 1 * SLOT;
static_assert(RW_WB_OFF + 512 <= 15 * SLOT, "LoRA weights LDS map");
constexpr int RW_MU_OFF = 12 * SLOT;
struct RwW { v4u v[4]; float mu, bias; };
__device__ __forceinline__ void rw_w_fetch(RwW& W, const Frame& F, const Args& a, int h) {
    const bf16* W2 = (const bf16*)(F.ws + WS_WW2); const bf16* A2 = (const bf16*)(F.ws + WS_WA2); const bf16* G2w = (const bf16*)(F.ws + WS_WG2);
    const int t = F.tid;
    W.v[0] = *(const v4u*)(W2 + (size_t)(64 * h + (t >> 3)) * 64 + 8 * (t & 7));
    W.v[1] = *(const v4u*)(A2 + (size_t)(64 * h + (t >> 3)) * 64 + 8 * (t & 7));
    W.v[2] = *(const v4u*)(G2w + (size_t)(64 * h + (t >> 4)) * 128 + 8 * (t & 15));
    W.v[3] = *(const v4u*)(G2w + (size_t)(64 * h + 32 + (t >> 4)) * 128 + 8 * (t & 15));
    W.mu = (t < 192) ? a.in[5][512 * (t >> 6) + 64 * h + (t & 63)] : ((t < 448) ? a.in[5][1536 + (t - 192)] : a.in[11][64 * h + (t - 448)]);
    W.bias = (t < 64) ? a.in[6][64 * h + t] : ((t < 128) ? a.in[8][64 * h + (t - 64)] : 0.f);
}
__device__ __forceinline__ void rw_w_store(const RwW& W, const Frame& F) {
    const int t = F.tid;
    *(LAS v4u*)(F.lds + RW_WW2_OFF + ((t >> 3) * LDM + 8 * (t & 7)) * 2) = W.v[0];
    *(LAS v4u*)(F.lds + RW_WA2_OFF + ((t >> 3) * LDM + 8 * (t & 7)) * 2) = W.v[1];
    *(LAS v4u*)(F.lds + RW_WG2_OFF + ((t >> 4) * LDG + 8 * (t & 15)) * 2) = W.v[2];
    *(LAS v4u*)(F.lds + RW_WG2_OFF + ((32 + (t >> 4)) * LDG + 8 * (t & 15)) * 2) = W.v[3];
    if (t < 128) *(LAS float*)(F.lds + RW_WB_OFF + 4 * t) = W.bias;
    *(LAS float*)(F.lds + RW_MU_OFF + 4 * t) = W.mu;
}
struct RwRaw { v4u c[7], p[7]; };
__device__ __forceinline__ void rw_load_raw(RwRaw& R, const bf16* __restrict__ Ur, int uidx, int tid) {
    const int h = uidx & 7, bc = uidx >> 3, c = bc % NCH, b = bc / NCH, tau = tid >> 3, q = tid & 7;
    const size_t prow = (size_t)b * LP + (size_t)c * 64 + tau;
    const bool has_prev = (c > 0) || (tau > 0);
    const bf16* ucur = Ur + prow * UR_W; const bf16* uprv = ucur - UR_W;
    const v4u z = {0u, 0u, 0u, 0u};
#pragma unroll
    for (int j = 0; j < 7; ++j) { const int col = (j < 3) ? (512 * j + 64 * h + 8 * q) : (1536 + 64 * (j - 3) + 8 * q);
        R.c[j] = *(const v4u*)(ucur + col); R.p[j] = has_prev ? *(const v4u*)(uprv + col) : z; }
}
__device__ __forceinline__ void rwkv_unit(const Frame& F, const Args& a, const bf16* __restrict__ Ur, const RwkvBufs& RB, int uidx, RwRaw& R, int unext) {
    const int h = uidx & 7, bc = uidx >> 3, c = bc % NCH, b = bc / NCH;
    const int tid = F.tid, lane = F.lane, w = F.wave;
    LAS unsigned char* lds = F.lds;
#define MAT(i) ((LAS bf16*)(lds + (i) * SLOT))
    LAS bf16 *Rg = MAT(0), *Kg = MAT(1), *KgT = MAT(2), *Bi = MAT(3), *nBiT = MAT(4), *Ki = MAT(5), *KiT = MAT(6), *VT = MAT(7);
    LAS bf16 *Akk = MAT(8), *nArb = MAT(9), *Ark = MAT(10), *Pa = MAT(11), *PaT = MAT(12), *Pb = MAT(13), *PbT = MAT(14), *Ta = MAT(15), *Tb = MAT(1);
    LAS bf16 *AVT = MAT(3), *WuT = MAT(5), *UvT = MAT(8);
    LAS bf16* Lw = (LAS bf16*)(lds + RW_LW_OFF); LAS bf16* La = (LAS bf16*)(lds + RW_LA_OFF); LAS bf16* Lg = (LAS bf16*)(lds + RW_LG_OFF);
    LAS float* Af = (LAS float*)(lds + RW_A_OFF); LAS bf16* Gb = (LAS bf16*)(lds + RW_G_OFF); LAS float* CS = (LAS float*)(lds + RW_CS_OFF);
    LAS float* gC = (LAS float*)(lds + RW_GC_OFF); LAS float* SEG = (LAS float*)(lds + RW_SEG_OFF);
    const float* mu = a.in[5];
    const int ta = w >> 1, ar = 16 * ta + (lane & 15), ko = 8 * (lane >> 4);
    const int tau = tid >> 3, q = tid & 7;
    float r8[8], k8[8], v8[8], kk8[8];
    {
        float cu[8], pv[8], m8[8];
        const int ch0 = 64 * h + 8 * q;
        const LAS float* MUL = (const LAS float*)(lds + RW_MU_OFF);
#define RW_LD8L(p_, o_) do { const f32x4 x0_ = *(const LAS f32x4*)(p_), x1_ = *(const LAS f32x4*)((p_) + 4); o_[0] = x0_.x; o_[1] = x0_.y; o_[2] = x0_.z; o_[3] = x0_.w; o_[4] = x1_.x; o_[5] = x1_.y; o_[6] = x1_.z; o_[7] = x1_.w; } while (0)
        unpack8(R.c[0], cu); unpack8(R.p[0], pv);
        RW_LD8L(MUL + 8 * q, m8);
#pragma unroll
        for (int i = 0; i < 8; ++i) r8[i] = cu[i] + (pv[i] - cu[i]) * m8[i];
        unpack8(R.c[1], cu); unpack8(R.p[1], pv);
        RW_LD8L(MUL + 64 + 8 * q, m8);
#pragma unroll
        for (int i = 0; i < 8; ++i) k8[i] = cu[i] + (pv[i] - cu[i]) * m8[i];
        unpack8(R.c[2], cu); unpack8(R.p[2], pv);
        RW_LD8L(MUL + 128 + 8 * q, m8);
#pragma unroll
        for (int i = 0; i < 8; ++i) v8[i] = cu[i] + (pv[i] - cu[i]) * m8[i];
        float kkc[8]; RW_LD8L(MUL + 448 + 8 * q, kkc);
        float ss = 0.f;
#pragma unroll
        for (int i = 0; i < 8; ++i) { kk8[i] = k8[i] * kkc[i]; ss += kk8[i] * kk8[i]; }
        ss = sum8(ss);
        const float inv = 1.f / fmaxf(sqrtf(ss), 1e-12f);
#pragma unroll
        for (int i = 0; i < 8; ++i) kk8[i] *= inv;
#pragma unroll
        for (int i = 0; i < 4; ++i) {
            const int col = 1536 + 64 * i + 8 * q;
            unpack8(R.c[3 + i], cu); unpack8(R.p[3 + i], pv);
            RW_LD8L(MUL + 192 + 64 * i + 8 * q, m8);
            float o[8];
#pragma unroll
            for (int e = 0; e < 8; ++e) { const float x = cu[e] + (pv[e] - cu[e]) * m8[e]; o[e] = (i == 0) ? tanhf_(x) : (i == 1 ? x : sigmoidf_(x)); }
            if (i == 0) st8(Lw + tau * LDM + 8 * q, o);
            else if (i == 1) st8(La + tau * LDM + 8 * q, o);
            else st8(Lg + tau * LDG + 64 * (i - 2) + 8 * q, o);
        }
    }
    LDS_WAIT(); __syncthreads();
    {
        const LAS bf16* W2L = (const LAS bf16*)(lds + RW_WW2_OFF); const LAS bf16* A2L = (const LAS bf16*)(lds + RW_WA2_OFF); const LAS bf16* G2L = (const LAS bf16*)(lds + RW_WG2_OFF);
#pragma unroll 1
        for (int tt = 0; tt < 2; ++tt) {
            const int tb = 2 * (w & 1) + tt, b0 = 16 * tb + 4 * (lane >> 4), chl = 16 * tb + (lane & 15);
            f32x4 aw = {0.f, 0.f, 0.f, 0.f}, aa = aw, ag = aw;
#pragma unroll
            for (int ks = 0; ks < 2; ++ks) {
                const bf16x8 yw = *(const LAS bf16x8*)(W2L + chl * LDM + 32 * ks + ko), ya = *(const LAS bf16x8*)(A2L + chl * LDM + 32 * ks + ko);
                const bf16x8 xw = *(const LAS bf16x8*)(Lw + ar * LDM + 32 * ks + ko), xa = *(const LAS bf16x8*)(La + ar * LDM + 32 * ks + ko);
                aw = __builtin_amdgcn_mfma_f32_16x16x32_bf16(yw, xw, aw, 0, 0, 0);
                aa = __builtin_amdgcn_mfma_f32_16x16x32_bf16(ya, xa, aa, 0, 0, 0);
            }
#pragma unroll
            for (int ks = 0; ks < 4; ++ks) {
                const bf16x8 yg = *(const LAS bf16x8*)(G2L + chl * LDG + 32 * ks + ko);
                const bf16x8 xg = *(const LAS bf16x8*)(Lg + ar * LDG + 32 * ks + ko);
                ag = __builtin_amdgcn_mfma_f32_16x16x32_bf16(yg, xg, ag, 0, 0, 0);
            }
            const f32x4 w0v = *(const LAS f32x4*)(lds + RW_WB_OFF + 4 * b0), a0v = *(const LAS f32x4*)(lds + RW_WB_OFF + 256 + 4 * b0);
            f32x4 lw, av;
#pragma unroll
            for (int i = 0; i < 4; ++i) {
                const float xw = -(w0v[i] + aw[i]);
                const float sp = (xw > 20.f) ? xw : __logf(1.f + __expf(xw));
                lw[i] = -__expf(-sp - 0.5f);
                av[i] = sigmoidf_(a0v[i] + aa[i]);
            }
            *(LAS f32x4*)(CS + ar * 64 + b0) = lw;
            *(LAS f32x4*)(Af + ar * 64 + b0) = av;
            v2u gw; gw.x = pk2(ag[0], ag[1]); gw.y = pk2(ag[2], ag[3]); *(LAS v2u*)(Gb + ar * 64 + b0) = gw;
        }
    }
    float kac[8], rkc[8], lng[8], lnb[8];
    { const int ch0_ = 64 * h + 8 * (tid & 7); ld8f(a.in[12] + ch0_, kac); ld8f(a.in[13] + ch0_, rkc); ld8f(a.in[14] + ch0_, lng); ld8f(a.in[15] + ch0_, lnb); }
    LDS_WAIT(); __syncthreads();
    {
        const int j = tid & 63, sg = tid >> 6;
        float run = 0.f;
#pragma unroll
        for (int i = 0; i < 8; ++i) { run += CS[(8 * sg + i) * 64 + j]; CS[(8 * sg + i) * 64 + j] = run; }
        SEG[sg * 64 + j] = run;
        LDS_WAIT(); __syncthreads();
        float off = 0.f;
        for (int s = 0; s < sg; ++s) off += SEG[s * 64 + j];
#pragma unroll
        for (int i = 0; i < 8; ++i) CS[(8 * sg + i) * 64 + j] += off;
    }
    LDS_WAIT(); __syncthreads();
    {
        float cs[8], csp[8], av[8], gt[8];
        { const LAS f32x4* p = (const LAS f32x4*)(CS + tau * 64 + 8 * q); const f32x4 x0 = p[0], x1 = p[1];
          cs[0] = x0.x; cs[1] = x0.y; cs[2] = x0.z; cs[3] = x0.w; cs[4] = x1.x; cs[5] = x1.y; cs[6] = x1.z; cs[7] = x1.w; }
        if (tau > 0) { const LAS f32x4* p = (const LAS f32x4*)(CS + (tau - 1) * 64 + 8 * q); const f32x4 x0 = p[0], x1 = p[1];
          csp[0] = x0.x; csp[1] = x0.y; csp[2] = x0.z; csp[3] = x0.w; csp[4] = x1.x; csp[5] = x1.y; csp[6] = x1.z; csp[7] = x1.w; }
        else {
#pragma unroll
          for (int i = 0; i < 8; ++i) csp[i] = 0.f; }
        { const LAS f32x4* p = (const LAS f32x4*)(Af + tau * 64 + 8 * q); const f32x4 x0 = p[0], x1 = p[1];
          av[0] = x0.x; av[1] = x0.y; av[2] = x0.z; av[3] = x0.w; av[4] = x1.x; av[5] = x1.y; av[6] = x1.z; av[7] = x1.w; }
        unpack8(*(const LAS v4u*)(Gb + tau * 64 + 8 * q), gt);
        float o_rg[8], o_kg[8], o_bi[8], o_ki[8];
        float bon = 0.f;
#pragma unroll
        for (int i = 0; i < 8; ++i) {
            const float g = __expf(cs[i]), gi = __expf(-cs[i]), gm = __expf(csp[i]);
            o_rg[i] = r8[i] * g; o_kg[i] = kk8[i] * gm;
            const float bb = kk8[i] * av[i]; o_bi[i] = bb * gi;
            const float kt = k8[i] * (1.f + (av[i] - 1.f) * kac[i]); o_ki[i] = kt * gi;
            bon += r8[i] * kt * rkc[i];
            if (tau == 63) gC[8 * q + i] = g;
        }
        bon = sum8(bon);
        st8(Rg + tau * LDM + 8 * q, o_rg); st8(Kg + tau * LDM + 8 * q, o_kg); st8(Bi + tau * LDM + 8 * q, o_bi); st8(Ki + tau * LDM + 8 * q, o_ki);
#pragma unroll
        for (int i = 0; i < 8; ++i) {
            const int j = 8 * q + i;
            KgT[j * LDM + tau] = (bf16)f2bf(o_kg[i]); nBiT[j * LDM + tau] = (bf16)f2bf(-o_bi[i]); KiT[j * LDM + tau] = (bf16)f2bf(o_ki[i]); VT[j * LDM + tau] = (bf16)f2bf(v8[i]);
        }
        float g1[8], g2[8];
#pragma unroll
        for (int i = 0; i < 8; ++i) { g1[i] = lng[i] * gt[i]; g2[i] = (lnb[i] + bon * v8[i]) * gt[i]; }
        v4u w1; w1.x = pk2(g1[0], g1[1]); w1.y = pk2(g1[2], g1[3]); w1.z = pk2(g1[4], g1[5]); w1.w = pk2(g1[6], g1[7]);
        v4u w2; w2.x = pk2(g2[0], g2[1]); w2.y = pk2(g2[2], g2[3]); w2.z = pk2(g2[4], g2[5]); w2.w = pk2(g2[6], g2[7]);
        *(v4u*)(RB.G1 + (size_t)uidx * 4096 + tau * 64 + 8 * q) = w1;
        *(v4u*)(RB.G2 + (size_t)uidx * 4096 + tau * 64 + 8 * q) = w2;
    }
    LDS_WAIT(); __syncthreads();
    const f32x4 zero4 = {0.f, 0.f, 0.f, 0.f};
    const float gj = gC[ar];
    if (unext >= 0) rw_load_raw(R, Ur, unext, tid);
#pragma unroll 1
    for (int tt = 0; tt < 2; ++tt) {
        const int tb = 2 * (w & 1) + tt, b0 = 16 * tb + 4 * (lane >> 4);
        f32x4 zkb = mm_tile(Kg, Bi, ta, tb, lane, zero4), zkk = mm_tile(Kg, Ki, ta, tb, lane, zero4);
        f32x4 zrb = mm_tile(Rg, Bi, ta, tb, lane, zero4), zrk = mm_tile(Rg, Ki, ta, tb, lane, zero4);
        f32x4 p0, t0;
#pragma unroll
        for (int i = 0; i < 4; ++i) {
            const int s = b0 + i;
            p0[i] = (s < ar) ? -zkb[i] : 0.f; t0[i] = p0[i] + ((s == ar) ? 1.f : 0.f);
            zkk[i] = (s < ar) ? zkk[i] : 0.f; zrb[i] = (s <= ar) ? -zrb[i] : 0.f; zrk[i] = (s <= ar) ? zrk[i] : 0.f;
        }
        st_r(Pa, ar, b0, p0); st_t(PaT, ar, b0, p0); st_r(Ta, ar, b0, t0); st_r(Akk, ar, b0, zkk); st_r(nArb, ar, b0, zrb); st_r(Ark, ar, b0, zrk);
    }
    LDS_WAIT(); __syncthreads();
#pragma unroll 1
    for (int tt = 0; tt < 2; ++tt) {
        const int tb = 2 * (w & 1) + tt, b0 = 16 * tb + 4 * (lane >> 4);
        const f32x4 p = mm_tile(Pa, PaT, ta, tb, lane, zero4); st_r(Pb, ar, b0, p); st_t(PbT, ar, b0, p);
        const f32x4 av = mm_tile(VT, Akk, ta, tb, lane, zero4); st_r(AVT, ar, b0, av);
    }
    LDS_WAIT(); __syncthreads();
#define RW_SQ_ACC(Pin, PinT, Pout, PoutT, Tin, Tout, DO_SQ) do { _Pragma("unroll 1") for (int tt = 0; tt < 2; ++tt) { \
        const int tb = 2 * (w & 1) + tt, b0 = 16 * tb + 4 * (lane >> 4); \
        if (DO_SQ) { const f32x4 p = mm_tile(Pin, PinT, ta, tb, lane, zero4); st_r(Pout, ar, b0, p); st_t(PoutT, ar, b0, p); } \
        const f32x4 tn = mm_tile(Tin, PinT, ta, tb, lane, ld_r(Tin, ar, b0)); st_r(Tout, ar, b0, tn); } \
        LDS_WAIT(); __syncthreads(); } while (0)
    RW_SQ_ACC(Pb, PbT, Pa, PaT, Ta, Tb, true);
    RW_SQ_ACC(Pa, PaT, Pb, PbT, Tb, Ta, true);
    RW_SQ_ACC(Pb, PbT, Pa, PaT, Ta, Tb, true);
    RW_SQ_ACC(Pa, PaT, Pb, PbT, Tb, Ta, true);
    RW_SQ_ACC(Pb, PbT, Pa, PaT, Ta, Tb, false);
#undef RW_SQ_ACC
#pragma unroll 1
    for (int tt = 0; tt < 2; ++tt) {
        const int tb = 2 * (w & 1) + tt, b0 = 16 * tb + 4 * (lane >> 4);
        st_r(WuT, ar, b0, mm_tile(KgT, Tb, ta, tb, lane, zero4));
        st_r(UvT, ar, b0, mm_tile(AVT, Tb, ta, tb, lane, zero4));
    }
    LDS_WAIT(); __syncthreads();
    RwW Wn; if (unext >= 0) rw_w_fetch(Wn, F, a, unext & 7);
#pragma unroll 1
    for (int tt = 0; tt < 2; ++tt) {
        const int tb = 2 * (w & 1) + tt, b0 = 16 * tb + 4 * (lane >> 4);
        { const f32x4 z = mm_tile(nBiT, WuT, ta, tb, lane, zero4);
          const int m = ar >> 5, rp = ar & 31;
          bf16* Mo = RB.M + (size_t)uidx * 4096;
          float v4[4];
#pragma unroll
          for (int i = 0; i < 4; ++i) { const int jp = b0 + i; v4[i] = gj * (z[i] + ((jp == ar) ? 1.f : 0.f)); }
          { const int kb = b0 >> 5, qq = b0 & 31, s_ = qq >> 4, p = qq & 15, e0 = 4 * (p >> 3), hh = (p >> 2) & 1, ln = rp + 32 * hh;
            v2u w; w.x = pk2(v4[0], v4[1]); w.y = pk2(v4[2], v4[3]);
            *(v2u*)(Mo + ((((m * 2 + kb) * 2 + s_) * 64 + ln) << 3) + e0) = w; } }
        { f32x4 z = mm_tile(KiT, VT, ta, tb, lane, zero4); z = mm_tile(nBiT, UvT, ta, tb, lane, z);
          const int m = ar >> 5, qq = ar & 31, hh = (qq >> 2) & 1, rg = (qq & 3) + 4 * (qq >> 3);
          float* No = RB.N + (size_t)uidx * 4096;
          { const int n = b0 >> 5, cc = b0 & 31; *(f32x4*)(No + ((m * 2 + n) * 16 + rg) * 64 + cc + 32 * hh) = z * gj; } }
        { const f32x4 z = mm_tile(nArb, WuT, ta, tb, lane, ld_r(Rg, ar, b0)); v2u o; o.x = pk2(z[0], z[1]); o.y = pk2(z[2], z[3]);
          *(v2u*)(RB.Q + (size_t)uidx * 4096 + ar * 64 + b0) = o; }
        { f32x4 z = mm_tile(Ark, VT, ta, tb, lane, zero4); z = mm_tile(nArb, UvT, ta, tb, lane, z); v2u o; o.x = pk2(z[0], z[1]); o.y = pk2(z[2], z[3]);
          *(v2u*)(RB.OP + (size_t)uidx * 4096 + ar * 64 + b0) = o; }
    }
    if (unext >= 0) rw_w_store(Wn, F);
    LDS_WAIT(); __syncthreads();
#undef MAT
}

__device__ __forceinline__ void rwkv_scan(const RwkvBufs& RB, int bh, int n, int lane) {
    const int b = bh >> 3, h = bh & 7;
    f32x16 X0, X1;
#pragma unroll
    for (int r = 0; r < 16; ++r) { X0[r] = 0.f; X1[r] = 0.f; }
    const int cc = lane & 31, hh = lane >> 5;
    bf16x8 Mc[2][2][2], Mn[2][2][2]; f32x16 N0, N1, N0n, N1n;
    {
        const int uidx = ((b * NCH) << 3) + h;
        const bf16* Mi = RB.M + (size_t)uidx * 4096; const float* Ni = RB.N + (size_t)uidx * 4096;
#pragma unroll
        for (int m = 0; m < 2; ++m)
#pragma unroll
            for (int kb = 0; kb < 2; ++kb)
#pragma unroll
                for (int s = 0; s < 2; ++s) Mc[m][kb][s] = *(const bf16x8*)(Mi + ((((m * 2 + kb) * 2 + s) * 64 + lane) << 3));
#pragma unroll
        for (int r = 0; r < 16; ++r) { N0[r] = Ni[((0 * 2 + n) * 16 + r) * 64 + lane]; N1[r] = Ni[((1 * 2 + n) * 16 + r) * 64 + lane]; }
    }
#pragma unroll 1
    for (int c = 0; c < NCH; ++c) {
        const int uidx = ((b * NCH + c) << 3) + h;
        {
            const int un = ((b * NCH + min(c + 1, NCH - 1)) << 3) + h;
            const bf16* Mi = RB.M + (size_t)un * 4096; const float* Ni = RB.N + (size_t)un * 4096;
#pragma unroll
            for (int m = 0; m < 2; ++m)
#pragma unroll
                for (int kb = 0; kb < 2; ++kb)
#pragma unroll
                    for (int s = 0; s < 2; ++s) Mn[m][kb][s] = *(const bf16x8*)(Mi + ((((m * 2 + kb) * 2 + s) * 64 + lane) << 3));
#pragma unroll
            for (int r = 0; r < 16; ++r) { N0n[r] = Ni[((0 * 2 + n) * 16 + r) * 64 + lane]; N1n[r] = Ni[((1 * 2 + n) * 16 + r) * 64 + lane]; }
        }
        bf16* Ho = RB.HC + (size_t)uidx * 4096 + (size_t)(32 * n + cc) * 64;
#pragma unroll
        for (int g = 0; g < 4; ++g) {
            v2u w0; w0.x = pk2(X0[4 * g], X0[4 * g + 1]); w0.y = pk2(X0[4 * g + 2], X0[4 * g + 3]); *(v2u*)(Ho + 8 * g + 4 * hh) = w0;
            v2u w1; w1.x = pk2(X1[4 * g], X1[4 * g + 1]); w1.y = pk2(X1[4 * g + 2], X1[4 * g + 3]); *(v2u*)(Ho + 32 + 8 * g + 4 * hh) = w1;
        }
        bf16x8 bf[2][2];
#pragma unroll
        for (int s = 0; s < 2; ++s) {
            v4u t0; t0.x = pk2(X0[8 * s], X0[8 * s + 1]); t0.y = pk2(X0[8 * s + 2], X0[8 * s + 3]); t0.z = pk2(X0[8 * s + 4], X0[8 * s + 5]); t0.w = pk2(X0[8 * s + 6], X0[8 * s + 7]);
            v4u t1; t1.x = pk2(X1[8 * s], X1[8 * s + 1]); t1.y = pk2(X1[8 * s + 2], X1[8 * s + 3]); t1.z = pk2(X1[8 * s + 4], X1[8 * s + 5]); t1.w = pk2(X1[8 * s + 6], X1[8 * s + 7]);
            bf[0][s] = __builtin_bit_cast(bf16x8, t0); bf[1][s] = __builtin_bit_cast(bf16x8, t1);
        }
        f32x16 Y0 = N0, Y1 = N1;
#pragma unroll
        for (int kb = 0; kb < 2; ++kb)
#pragma unroll
            for (int s = 0; s < 2; ++s) {
                Y0 = __builtin_amdgcn_mfma_f32_32x32x16_bf16(Mc[0][kb][s], bf[kb][s], Y0, 0, 0, 0);
                Y1 = __builtin_amdgcn_mfma_f32_32x32x16_bf16(Mc[1][kb][s], bf[kb][s], Y1, 0, 0, 0);
            }
        X0 = Y0; X1 = Y1;
#pragma unroll
        for (int m = 0; m < 2; ++m)
#pragma unroll
            for (int kb = 0; kb < 2; ++kb)
#pragma unroll
                for (int s = 0; s < 2; ++s) Mc[m][kb][s] = Mn[m][kb][s];
        N0 = N0n; N1 = N1n;
    }
}

template <class OutF> __device__ __forceinline__ void rwkv_out_unit(const RwkvBufs& RB, int uidx, int lane, const OutF& outf) {
    const int h = uidx & 7, bc = uidx >> 3, c = bc % NCH, b = bc / NCH;
    const bf16* Q = RB.Q + (size_t)uidx * 4096; const bf16* HT = RB.HC + (size_t)uidx * 4096; const bf16* OP = RB.OP + (size_t)uidx * 4096;
    const bf16* G1 = RB.G1 + (size_t)uidx * 4096; const bf16* G2 = RB.G2 + (size_t)uidx * 4096;
    const int r = lane & 15, ko = 8 * (lane >> 4);
    bf16x8 yh[4][2];
#pragma unroll
    for (int tb = 0; tb < 4; ++tb)
#pragma unroll
        for (int ks = 0; ks < 2; ++ks) yh[tb][ks] = *(const bf16x8*)(HT + (16 * tb + r) * 64 + 32 * ks + ko);
#pragma unroll 2
    for (int ta = 0; ta < 4; ++ta) {
        const int t = 16 * ta + r;
        bf16x8 xq[2];
        xq[0] = *(const bf16x8*)(Q + t * 64 + ko); xq[1] = *(const bf16x8*)(Q + t * 64 + 32 + ko);
        f32x4 o[4]; float s = 0.f;
#pragma unroll
        for (int tb = 0; tb < 4; ++tb) {
            const int i0 = 16 * tb + 4 * (lane >> 4);
            const v2u ow = *(const v2u*)(OP + t * 64 + i0);
            f32x4 acc = {bflo(ow.x), bfhi(ow.x), bflo(ow.y), bfhi(ow.y)};
#pragma unroll
            for (int ks = 0; ks < 2; ++ks) acc = __builtin_amdgcn_mfma_f32_16x16x32_bf16(yh[tb][ks], xq[ks], acc, 0, 0, 0);
            o[tb] = acc; s += (acc[0] + acc[1]) + (acc[2] + acc[3]);
        }
        s = sum_x32(sum_x16(s));
        const float mean = s * (1.f / 64.f); float qv = 0.f;
#pragma unroll
        for (int tb = 0; tb < 4; ++tb) { o[tb] = o[tb] - mean; qv += (o[tb][0] * o[tb][0] + o[tb][1] * o[tb][1]) + (o[tb][2] * o[tb][2] + o[tb][3] * o[tb][3]); }
        qv = sum_x32(sum_x16(qv));
        const float rstd = rsqrtf(qv * (1.f / 64.f) + GN_EPS);
        const int tg = c * 64 + t;
#pragma unroll
        for (int tb = 0; tb < 4; ++tb) {
            const int i0 = 16 * tb + 4 * (lane >> 4);
            const v2u g1 = *(const v2u*)(G1 + t * 64 + i0), g2 = *(const v2u*)(G2 + t * 64 + i0);
            f32x4 y;
            y[0] = o[tb][0] * rstd * bflo(g1.x) + bflo(g2.x); y[1] = o[tb][1] * rstd * bfhi(g1.x) + bfhi(g2.x);
            y[2] = o[tb][2] * rstd * bflo(g1.y) + bflo(g2.y); y[3] = o[tb][3] * rstd * bfhi(g1.y) + bfhi(g2.y);
            if (tg < L) outf(b, tg, 64 * h + i0, y);
        }
    }
}
constexpr int MW = 264;
constexpr float QSCALE = 0.125f * 1.4426950408889634f;
struct AttBufs { bf16* Q; bf16* QI; unsigned short* MASK; bf16* KX; };

constexpr int LDQ = 264;
__device__ __forceinline__ void att_prep_unit(const Frame& F, const Args& a, bf16* Ua, const AttBufs& AB, int tile) {
    const int tid = F.tid, lane = F.lane, w = F.wave;
    LAS bf16* CQ = (LAS bf16*)F.lds;
    LAS f32x2_t* RQL = (LAS f32x2_t*)(F.lds + 34816);
    LAS f32x2_t* RIL = (LAS f32x2_t*)(F.lds + 34816 + 64 * 33 * 8);
    const int tau = tid >> 3, q = tid & 7;
    const size_t prow = (size_t)tile * 64 + tau;
    const int tpos = (int)(prow % LP);
    bf16* urow = Ua + prow * UA_W;
    const float2* rq = (const float2*)(F.ws + WS_ROPEQ) + (size_t)tpos * 32;
    const float2* ri = (const float2*)(F.ws + WS_ROPEI) + (size_t)tpos * 16;
    { const int t0p = (int)(((size_t)tile * 64) % LP);
      const f32x2_t* gq = (const f32x2_t*)(F.ws + WS_ROPEQ) + (size_t)t0p * 32; const f32x2_t* gi = (const f32x2_t*)(F.ws + WS_ROPEI) + (size_t)t0p * 16;
      for (int i = tid; i < 64 * 32; i += NTHR) RQL[(i >> 5) * 33 + (i & 31)] = gq[i];
      for (int i = tid; i < 64 * 16; i += NTHR) RIL[(i >> 4) * 17 + (i & 15)] = gi[i]; }
    {
        float x[4][8]; float ss = 0.f;
#pragma unroll
        for (int i = 0; i < 4; ++i) { unpack8(*(const v4u*)(urow + 64 * i + 8 * q), x[i]);
#pragma unroll
            for (int e = 0; e < 8; ++e) ss += x[i][e] * x[i][e]; }
        ss = sum8(ss);
        const float rs = rsqrtf(ss * (1.f / 256.f) + RMS_EPS);
#pragma unroll
        for (int i = 0; i < 4; ++i) { float g8[8], o[8]; ld8f(a.in[16] + 64 * i + 8 * q, g8);
#pragma unroll
            for (int e = 0; e < 8; ++e) o[e] = x[i][e] * rs * g8[e];
            st8(CQ + tau * LDQ + 64 * i + 8 * q, o); }
    }
#pragma unroll
    for (int i = 0; i < 8; ++i) {
        const int col = 8 * (q + 8 * i); float x[8], o[8];
        unpack8(*(const v4u*)(urow + 256 + col), x);
        const int d0 = (col & 63) >> 1;
#pragma unroll
        for (int pp = 0; pp < 4; ++pp) { const float2 cs = rq[d0 + pp]; o[2 * pp] = x[2 * pp] * cs.x - x[2 * pp + 1] * cs.y; o[2 * pp + 1] = x[2 * pp + 1] * cs.x + x[2 * pp] * cs.y; }
        v4u wv; wv.x = pk2(o[0], o[1]); wv.y = pk2(o[2], o[3]); wv.z = pk2(o[4], o[5]); wv.w = pk2(o[6], o[7]);
        *(v4u*)(urow + 256 + col) = wv;
    }
    {
        float x[8]; unpack8(*(const v4u*)(urow + 1280 + 8 * q), x);
        float s = 0.f;
#pragma unroll
        for (int e = 0; e < 8; ++e) s += x[e];
        s = sum8(s);
        const float mean = s * (1.f / 64.f); float qv = 0.f;
#pragma unroll
        for (int e = 0; e < 8; ++e) { x[e] -= mean; qv += x[e] * x[e]; }
        qv = sum8(qv);
        const float rstd = rsqrtf(qv * (1.f / 64.f) + LN_EPS);
        float y[8];
#pragma unroll
        for (int e = 0; e < 8; ++e) { const int p = 8 * q + e; const int d = (p < 32) ? ((p & 1) ? 16 + (p >> 1) : (p >> 1)) : p;
            y[e] = x[e] * rstd * a.in[19][d] + a.in[20][d]; }
        float o[8];
        if (q < 4) {
#pragma unroll
            for (int pp = 0; pp < 4; ++pp) { const float2 cs = ri[4 * q + pp]; o[2 * pp] = y[2 * pp] * cs.x - y[2 * pp + 1] * cs.y; o[2 * pp + 1] = y[2 * pp + 1] * cs.x + y[2 * pp] * cs.y; }
        } else {
#pragma unroll
            for (int e = 0; e < 8; ++e) o[e] = y[e];
        }
        v4u wv; wv.x = pk2(o[0] * 0.125f, o[1] * 0.125f); wv.y = pk2(o[2] * 0.125f, o[3] * 0.125f); wv.z = pk2(o[4] * 0.125f, o[5] * 0.125f); wv.w = pk2(o[6] * 0.125f, o[7] * 0.125f);
        *(v4u*)(AB.KX + prow * 64 + 8 * q) = wv;
    }
    LDS_WAIT(); __syncthreads();
    {
        const bf16* Wq = (const bf16*)(F.ws + WS_WQ);
        const int r = lane & 15, ko = 8 * (lane >> 4);
        bf16x8 yfA[8], yfB[8];
#pragma unroll
        for (int ks = 0; ks < 8; ++ks) yfA[ks] = *(const bf16x8*)(Wq + (size_t)(16 * (8 * w) + r) * 256 + 32 * ks + ko);
#define ATP_TILE(YF, TBL) do { const int tb = 8 * w + (TBL), n0 = 16 * tb + 4 * (lane >> 4); \
            _Pragma("unroll 1") for (int ta = 0; ta < 4; ++ta) { \
                f32x4 acc = {0.f, 0.f, 0.f, 0.f}; \
                _Pragma("unroll") for (int ks = 0; ks < 8; ++ks) { const bf16x8 xf = *(const LAS bf16x8*)(CQ + (16 * ta + r) * LDQ + 32 * ks + ko); acc = __builtin_amdgcn_mfma_f32_16x16x32_bf16(YF[ks], xf, acc, 0, 0, 0); } \
                const size_t orow = (size_t)tile * 64 + 16 * ta + r; \
                const bool isq = (n0 < 512); const int p = n0 & 63; \
                float o0 = acc[0], o1 = acc[1], o2 = acc[2], o3 = acc[3]; \
                if (isq) { const LAS f32x2_t* rr = RQL + (16 * ta + r) * 33 + (p >> 1); const f32x2_t c0 = rr[0], c1 = rr[1]; \
                    o0 = (acc[0] * c0.x - acc[1] * c0.y) * QSCALE; o1 = (acc[1] * c0.x + acc[0] * c0.y) * QSCALE; o2 = (acc[2] * c1.x - acc[3] * c1.y) * QSCALE; o3 = (acc[3] * c1.x + acc[2] * c1.y) * QSCALE; } \
                else if (p < 32) { const LAS f32x2_t* rr = RIL + (16 * ta + r) * 17 + (p >> 1); const f32x2_t c0 = rr[0], c1 = rr[1]; \
                    o0 = acc[0] * c0.x - acc[1] * c0.y; o1 = acc[1] * c0.x + acc[0] * c0.y; o2 = acc[2] * c1.x - acc[3] * c1.y; o3 = acc[3] * c1.x + acc[2] * c1.y; } \
                v2u ov; ov.x = pk2(o0, o1); ov.y = pk2(o2, o3); \
                bf16* dst = isq ? (AB.Q + orow * 512 + n0) : (AB.QI + orow * 512 + (n0 - 512)); \
                *(v2u*)dst = ov; } } while (0)
#pragma unroll 1
        for (int tb2 = 0; tb2 < 8; tb2 += 2) {
#pragma unroll
            for (int ks = 0; ks < 8; ++ks) yfB[ks] = *(const bf16x8*)(Wq + (size_t)(16 * (8 * w + tb2 + 1) + r) * 256 + 32 * ks + ko);
            ATP_TILE(yfA, tb2);
            if (tb2 + 2 < 8) {
#pragma unroll
                for (int ks = 0; ks < 8; ++ks) yfA[ks] = *(const bf16x8*)(Wq + (size_t)(16 * (8 * w + tb2 + 2) + r) * 256 + 32 * ks + ko);
            }
            ATP_TILE(yfB, tb2 + 1);
        }
#undef ATP_TILE
    }
    LDS_WAIT(); __syncthreads();
}

__device__ __forceinline__ unsigned fkey(float f) { const unsigned u = __float_as_uint(f); return u ^ ((unsigned)((int)u >> 31) | 0x80000000u); }
__device__ __forceinline__ void cnt_ge(int& c, unsigned x, unsigned cand) {
    unsigned long long m;
    asm("v_cmp_ge_u32 %1, %2, %3\n\tv_addc_co_u32 %0, %1, 0, %0, %1" : "+v"(c), "=&s"(m) : "v"(x), "v"(cand));
}
template <int BIT> __device__ __forceinline__ void nib_ge(unsigned& nib, unsigned x, unsigned K) {
    unsigned t; asm volatile("v_cmp_ge_u32 vcc, %1, %2\n\tv_cndmask_b32 %0, 0, %3, vcc" : "=v"(t) : "v"(x), "v"(K), "v"(1u << BIT) : "vcc"); nib |= t;
}
constexpr int IDX_NT = 33, IDX_PF = 4;
__device__ __forceinline__ void idx_unit(const Frame& F, const bf16* __restrict__ Ua, const AttBufs& AB, int b, int qt, int flags) {
    const int lane = F.lane, w = F.wave, qc = lane & 15, g = lane >> 4, ko = 8 * g;
    LAS int* cntb = (LAS int*)F.lds;
    const int t0 = 16 * qt, ntile = qt + 1, tq = t0 + qc;
    const size_t qrow = (size_t)b * LP + tq;
    LAS bf16* QIL = (LAS bf16*)(F.lds + 8192);
    { const int tid = F.tid; const int rr = tid >> 5, cc = (tid & 31) * 16;
      const bf16* src = AB.QI + ((size_t)b * LP + t0 + rr) * 512 + cc;
      const v4u x0 = *(const v4u*)src, x1 = *(const v4u*)(src + 8);
      *(LAS v4u*)(QIL + rr * 520 + cc) = x0; *(LAS v4u*)(QIL + rr * 520 + cc + 8) = x1; }
    LDS_WAIT(); __syncthreads();
    float wq[8];
    { const v4u ww = *(const v4u*)(Ua + qrow * UA_W + 1344); float t8[8]; unpack8(ww, t8);
#pragma unroll
      for (int h = 0; h < 8; ++h) wq[h] = t8[h] * 0.35355339059327373f; }
    unsigned sc[IDX_NT][4];
    const bf16* kbase = AB.KX + (size_t)b * LP * 64;
    const int wlast = (ntile - 1 - w) >> 3;
    bf16x8 ra0[IDX_PF], ra1[IDX_PF];
#pragma unroll
    for (int p = 0; p < IDX_PF; ++p) { const unsigned ko_ = (unsigned)((16 * (w + 8 * max(min(p, wlast), 0)) + qc) * 64 + ko) ; const unsigned kc = (w < ntile) ? ko_ : (unsigned)(qc * 64 + ko);
        ra0[p] = *(const bf16x8*)(kbase + kc); ra1[p] = *(const bf16x8*)(kbase + kc + 32); }
#pragma unroll
    for (int i = 0; i < IDX_NT; ++i) {
        int wv = w; asm volatile("" : "+s"(wv));
        const int kt = wv + 8 * i;
        const bf16x8 a0 = ra0[i % IDX_PF], a1 = ra1[i % IDX_PF];
        { const int ip = max(min(i + IDX_PF, wlast), 0); const unsigned ko_ = (unsigned)((16 * (wv + 8 * ip) + qc) * 64 + ko); const unsigned kc = (wv < ntile) ? ko_ : (unsigned)(qc * 64 + ko);
          ra0[i % IDX_PF] = *(const bf16x8*)(kbase + kc); ra1[i % IDX_PF] = *(const bf16x8*)(kbase + kc + 32); }
        asm volatile("" ::: "memory");
        if (kt < ntile) {
            f32x4 acc = {0.f, 0.f, 0.f, 0.f};
#pragma unroll
            for (int hq = 0; hq < 2; ++hq) {
                bf16x8 qa[4], qb_[4];
#pragma unroll
                for (int h4 = 0; h4 < 4; ++h4) { qa[h4] = *(const LAS bf16x8*)(QIL + qc * 520 + 64 * (4 * hq + h4) + ko); qb_[h4] = *(const LAS bf16x8*)(QIL + qc * 520 + 64 * (4 * hq + h4) + 32 + ko); }
                __builtin_amdgcn_sched_group_barrier(0x100, 8, 0);
                f32x4 sh[4];
#pragma unroll
                for (int h4 = 0; h4 < 4; ++h4) { sh[h4] = (f32x4){0.f, 0.f, 0.f, 0.f}; sh[h4] = __builtin_amdgcn_mfma_f32_16x16x32_bf16(a0, qa[h4], sh[h4], 0, 0, 0); }
#pragma unroll
                for (int h4 = 0; h4 < 4; ++h4) sh[h4] = __builtin_amdgcn_mfma_f32_16x16x32_bf16(a1, qb_[h4], sh[h4], 0, 0, 0);
                __builtin_amdgcn_sched_group_barrier(0x008, 8, 0);
#pragma unroll
                for (int h4 = 0; h4 < 4; ++h4)
#pragma unroll
                    for (int r = 0; r < 4; ++r) acc[r] = fmaf(__builtin_amdgcn_fmed3f(sh[h4][r], 0.f, INFINITY), wq[4 * hq + h4], acc[r]);
                if (hq == 0) asm volatile("" ::: "memory");
            }
            if (kt == qt) {
#pragma unroll
                for (int r = 0; r < 4; ++r) sc[i][r] = (4 * g + r <= qc) ? (fkey(acc[r]) >> 1) : 0u;
            } else {
#pragma unroll
                for (int r = 0; r < 4; ++r) sc[i][r] = fkey(acc[r]) >> 1;
            }
        } else {
#pragma unroll
            for (int r = 0; r < 4; ++r) sc[i][r] = 0u;
        }
    }
    unsigned K = 0u; bool found = (tq + 1 <= 256);
    const int nwave_tiles = __builtin_amdgcn_readfirstlane(max(wlast + 1, 0));
#pragma unroll 1
    for (int bit = 30; bit >= 0; --bit) {
        const unsigned cand = K | (1u << bit);
        unsigned b0 = 0u, b1 = 0u, b2 = 0u, b3 = 0u; int lt = 0;
        int nwv = nwave_tiles; asm volatile("" : "+s"(nwv));
#pragma unroll
        for (int i = 0; i < IDX_NT; ++i) {
            if (i < nwv) {
                b0 = __builtin_amdgcn_alignbit(b0, sc[i][0] - cand, 31); b1 = __builtin_amdgcn_alignbit(b1, sc[i][1] - cand, 31);
                b2 = __builtin_amdgcn_alignbit(b2, sc[i][2] - cand, 31); b3 = __builtin_amdgcn_alignbit(b3, sc[i][3] - cand, 31);
            }
            if (i == 15 || i == 31 || i == IDX_NT - 1) { lt += __builtin_popcount(b0) + __builtin_popcount(b1) + __builtin_popcount(b2) + __builtin_popcount(b3); b0 = b1 = b2 = b3 = 0u; }
        }
        int c = 4 * nwv - lt;
        c = isum_x32(isum_x16(c));
        LAS int* cb = cntb + (bit & 1) * 128;
        if (g == 0) cb[w * 16 + qc] = c;
        LDS_WAIT(); __syncthreads();
        int tot = 0;
#pragma unroll
        for (int ww = 0; ww < 8; ++ww) tot += cb[ww * 16 + qc];
        if (!found && tot >= 256) K = cand;
        found = found || (tot == 256);
        if (__all(found)) break;
    }
    if (tq + 1 <= 256 || K == 0u) K = 1u;
    LAS unsigned short* mlds = (LAS unsigned short*)(F.lds + 32768);
    const int kend = (qt == 0) ? 4 : min(16 * (1 + ((qt - 1) >> 4)) + 4, 260);
    LAS unsigned short* mrow_ = mlds + qc * MW + w;
#pragma unroll
    for (int i = 0; i < IDX_NT; ++i) {
        unsigned nib = 0u;
        nib_ge<0>(nib, sc[i][0], K); nib_ge<1>(nib, sc[i][1], K); nib_ge<2>(nib, sc[i][2], K); nib_ge<3>(nib, sc[i][3], K);
        unsigned v = nib << (4 * g);
        v = or_x32(or_x16(v));
        if (g == 0) mrow_[8 * i] = (unsigned short)v;
    }
    LDS_WAIT(); __syncthreads();
    {
        const int npiece = kend >> 2;
        for (int p = F.tid; p < 16 * npiece; p += NTHR) { const int q_ = p / npiece, c = p % npiece;
            const v2u val = *(const LAS v2u*)(mlds + q_ * MW + 4 * c);
            *(v2u*)(AB.MASK + ((size_t)b * LP + t0 + q_) * MW + 4 * c) = val; }
    }
    LDS_WAIT(); __syncthreads();
}

__device__ __forceinline__ int crow(int r, int hi) { return (r & 3) + 8 * (r >> 2) + 4 * hi; }
constexpr int AT_K = 0, AT_V = 2 * 8192, AT_WS = 4 * 8192;
__device__ __forceinline__ void at_qkt(f32x16& p0, f32x16& p1, const LAS unsigned char* Kslot, const bf16x8* qr, const f32x16& negm, int r32, int hi) {
    const LAS unsigned char* kb = Kslot + hi * 1024 + r32 * 16;
    p0 = negm; p1 = negm;
#pragma unroll
    for (int d0 = 0; d0 < 4; ++d0) {
        const bf16x8 b0 = *(const LAS bf16x8*)(kb + d0 * 2048), b1 = *(const LAS bf16x8*)(kb + d0 * 2048 + 512);
        p0 = __builtin_amdgcn_mfma_f32_32x32x16_bf16(b0, qr[d0], p0, 0, 0, 0);
        p1 = __builtin_amdgcn_mfma_f32_32x32x16_bf16(b1, qr[d0], p1, 0, 0, 0);
    }
}
__device__ __forceinline__ float at_max3(float a, float b, float c) { float r; asm("v_max3_f32 %0, %1, %2, %3" : "=v"(r) : "v"(a), "v"(b), "v"(c)); return r; }
typedef short s16x4 __attribute__((ext_vector_type(4)));
__device__ __forceinline__ s16x4 at_vtr(const LAS unsigned char* p) { return __builtin_bit_cast(s16x4, __builtin_amdgcn_ds_read_tr16_b64_v4i16((LAS s16x4*)p)); }
__device__ __forceinline__ void at_pv(f32x16* o, const LAS unsigned char* vb, bf16x8 pa0, bf16x8 pa1, bf16x8 pa2, bf16x8 pa3) {
#pragma unroll
    for (int d0 = 0; d0 < 2; ++d0) {
        s16x4 lo[4], hi[4];
#pragma unroll
        for (int ks = 0; ks < 4; ++ks) { lo[ks] = at_vtr(vb + d0 * 4096 + ks * 1024); hi[ks] = at_vtr(vb + d0 * 4096 + ks * 1024 + 512); }
#define AT_PK(k) (bf16x8){lo[k][0], lo[k][1], lo[k][2], lo[k][3], hi[k][0], hi[k][1], hi[k][2], hi[k][3]}
        o[d0] = __builtin_amdgcn_mfma_f32_32x32x16_bf16(pa0, AT_PK(0), o[d0], 0, 0, 0);
        o[d0] = __builtin_amdgcn_mfma_f32_32x32x16_bf16(pa1, AT_PK(1), o[d0], 0, 0, 0);
        o[d0] = __builtin_amdgcn_mfma_f32_32x32x16_bf16(pa2, AT_PK(2), o[d0], 0, 0, 0);
        o[d0] = __builtin_amdgcn_mfma_f32_32x32x16_bf16(pa3, AT_PK(3), o[d0], 0, 0, 0);
#undef AT_PK
    }
}
template <class OutF> __device__ __forceinline__ void attn_unit(const Frame& F, const bf16* __restrict__ Ua, const AttBufs& AB, int b, int h, int qb, const OutF& outf) {
    const int lane = F.lane, wid = F.wave, r32 = lane & 31, hi = lane >> 5;
    const LAS unsigned char* lds = F.lds;
    LAS float* wsf = (LAS float*)(F.lds + AT_WS) + wid * 64;
    const size_t rowbase = (size_t)b * LP; const int q0 = (qb == 0) ? 0 : 16 + 256 * (qb - 1), qend = (qb == 0) ? 16 : q0 + 256;
    const int tq = q0 + wid * 32 + r32;
    const int NT = (qend + 63) / 64;
    bf16x8 qr[4];
    { const bf16* Qw = AB.Q + (rowbase + min(tq, LP - 1)) * 512 + 64 * h;
#pragma unroll
      for (int d0 = 0; d0 < 4; ++d0) qr[d0] = *(const bf16x8*)(Qw + 16 * d0 + 8 * hi); }
    const unsigned short* mrow = AB.MASK + (rowbase + min(tq, LP - 1)) * MW;
    const bf16* ksrc = Ua + (rowbase + lane) * UA_W + 256 + 64 * h + 8 * wid;
    const bf16* vsrc = Ua + (rowbase + 16 * (wid & 3) + (lane >> 2)) * UA_W + 768 + 64 * h + (wid >> 2) * 32 + (lane & 3) * 8;
    const int sdst = wid * 1024 + lane * 16;
    const int vb0 = ((lane >> 4) & 1) * 32 + (lane & 3) * 8 + (4 * hi + ((lane & 15) >> 2)) * 64;
    float m_run = 0.f, l_run = 0.f;
    f32x16 negm;
#pragma unroll
    for (int r = 0; r < 16; ++r) negm[r] = 0.f;
    f32x16 o[2];
#pragma unroll
    for (int r = 0; r < 16; ++r) { o[0][r] = 0.f; o[1][r] = 0.f; }
    v4u kreg = *(const v4u*)ksrc, vreg = *(const v4u*)vsrc;
    v2u mk_next = *(const v2u*)mrow;
    __syncthreads();
    *(LAS v4u*)(lds + AT_K + sdst) = kreg; *(LAS v4u*)(lds + AT_V + sdst) = vreg;
    for (int j = 0; j < NT; ++j) {
        const int cur = j & 1;
        if (j + 1 < NT) { kreg = *(const v4u*)(ksrc + (size_t)(j + 1) * 64 * UA_W); vreg = *(const v4u*)(vsrc + (size_t)(j + 1) * 64 * UA_W); }
        const v2u mk = mk_next;
        if (j + 1 < NT) mk_next = *(const v2u*)(mrow + 4 * (j + 1));
        LDS_WAIT(); __syncthreads();
        if (64 * j <= q0 + wid * 32 + 31 && q0 + wid * 32 < qend) {
        f32x16 p0, p1;
        at_qkt(p0, p1, lds + AT_K + cur * 8192, qr, negm, r32, hi);
        float mx;
        { float a0 = at_max3(p0[0], p0[1], p1[0]), a1 = at_max3(p0[2], p0[3], p1[1]); a0 = at_max3(a0, p1[2], p1[3]);
#pragma unroll
          for (int r = 4; r < 16; r += 4) { a0 = at_max3(a0, p0[r], p0[r + 1]); a1 = at_max3(a1, p0[r + 2], p0[r + 3]); a0 = at_max3(a0, p1[r], p1[r + 1]); a1 = at_max3(a1, p1[r + 2], p1[r + 3]); }
          mx = at_max3(a0, a1, a1); }
        { auto rr = __builtin_amdgcn_permlane32_swap(__float_as_uint(mx), __float_as_uint(mx), false, false); mx = fmaxf(__uint_as_float(rr[0]), __uint_as_float(rr[1])); }
        if (__any(mx > 4.f)) {
            const float dl = fmaxf(mx, 0.f);
            const float f = __builtin_amdgcn_exp2f(-dl);
            m_run += dl; l_run *= f;
#pragma unroll
            for (int r = 0; r < 16; ++r) { p0[r] -= dl; p1[r] -= dl; negm[r] = -m_run; }
            if (hi == 0) wsf[r32] = f;
            LDS_WAIT();
#pragma unroll
            for (int r = 0; r < 16; ++r) { const float fr = wsf[crow(r, hi)]; o[0][r] *= fr; o[1][r] *= fr; }
        }
        const int mlo = (int)(mk.x >> (4 * hi)), mhi = (int)(mk.y >> (4 * hi));
        float s = 0.f;
#pragma unroll
        for (int r = 0; r < 16; ++r) {
            int b0_, b1_;
            asm("v_bfe_i32 %0, %1, %2, 1" : "=v"(b0_) : "v"(mlo), "n"((r & 3) + 8 * (r >> 2)));
            asm("v_bfe_i32 %0, %1, %2, 1" : "=v"(b1_) : "v"(mhi), "n"((r & 3) + 8 * (r >> 2)));
            p0[r] = __uint_as_float(__float_as_uint(__builtin_amdgcn_exp2f(p0[r])) & (unsigned)b0_);
            p1[r] = __uint_as_float(__float_as_uint(__builtin_amdgcn_exp2f(p1[r])) & (unsigned)b1_);
            s += p0[r] + p1[r];
        }
        l_run += s;
        v4u pw0, pw1, pw2, pw3;
        pw0.x = pk2(p0[0], p0[1]); pw0.y = pk2(p0[2], p0[3]); pw0.z = pk2(p0[4], p0[5]); pw0.w = pk2(p0[6], p0[7]);
        pw1.x = pk2(p0[8], p0[9]); pw1.y = pk2(p0[10], p0[11]); pw1.z = pk2(p0[12], p0[13]); pw1.w = pk2(p0[14], p0[15]);
        pw2.x = pk2(p1[0], p1[1]); pw2.y = pk2(p1[2], p1[3]); pw2.z = pk2(p1[4], p1[5]); pw2.w = pk2(p1[6], p1[7]);
        pw3.x = pk2(p1[8], p1[9]); pw3.y = pk2(p1[10], p1[11]); pw3.z = pk2(p1[12], p1[13]); pw3.w = pk2(p1[14], p1[15]);
        at_pv(o, lds + AT_V + cur * 8192 + vb0, __builtin_bit_cast(bf16x8, pw0), __builtin_bit_cast(bf16x8, pw1), __builtin_bit_cast(bf16x8, pw2), __builtin_bit_cast(bf16x8, pw3));
        }
        if (j + 1 < NT) { *(LAS v4u*)(lds + AT_K + (cur ^ 1) * 8192 + sdst) = kreg; *(LAS v4u*)(lds + AT_V + (cur ^ 1) * 8192 + sdst) = vreg; }
    }
    { auto rr = __builtin_amdgcn_permlane32_swap(__float_as_uint(l_run), __float_as_uint(l_run), false, false); l_run = __uint_as_float(rr[0]) + __uint_as_float(rr[1]); }
    LDS_WAIT();
    if (hi == 0) wsf[32 + r32] = 1.f / l_run;
    LDS_WAIT();
#pragma unroll
    for (int r = 0; r < 16; ++r) {
        const int qloc = crow(r, hi), t = q0 + wid * 32 + qloc; const float li = wsf[32 + qloc];
        if (t < qend) { outf(b, t, 512 + 64 * h + r32, o[0][r] * li); outf(b, t, 512 + 64 * h + 32 + r32, o[1][r] * li); }
    }
}
constexpr int NEXP = 32, LISTCAP = 32896;
constexpr int CW_CNT = 256;
constexpr size_t WS_LIST = 236 * MiB;
constexpr size_t WS_WT = 241 * MiB;
constexpr size_t WS_PINFO = 242 * MiB;
constexpr size_t EW_GU = (size_t)512 * 1024 * 2, EW_D = (size_t)1024 * 256 * 2;
struct MoeBufs { float* MIX; float* H1; bf16* H1b; bf16* HID; bf16* F; bf16* WGU; bf16* WD; };

__device__ __forceinline__ void convert_experts(const Frame& F, const Args& a, const MoeBufs& MB, int part, int first_wg = 0) {
    LAS float* scr = (LAS float*)(F.lds + F.wave * 16384);
    if (F.bid < first_wg) return;
    const int gw = (F.bid - first_wg) * NWAVES + F.wave, NGW = (F.G - first_wg) * NWAVES;
    if (part == 0) {
        for (int it = gw; it < NEXP * 256; it += NGW) {
            const int e = it >> 8, r = it & 255;
            if (r < 128) transpose_item<4>(a.in[28] + (size_t)e * 1024 * 256, 1024, 256, MB.WGU + (size_t)e * 512 * 1024, 0, scr, r, 8, F.lane);
            else transpose_item<4>(a.in[29] + (size_t)e * 1024 * 256, 1024, 256, MB.WGU + (size_t)e * 512 * 1024, 1, scr, r - 128, 8, F.lane);
        }
    } else {
        for (int it = gw; it < NEXP * 128; it += NGW) {
            const int e = it >> 7, r = it & 127;
            transpose_item<0>(a.in[30] + (size_t)e * 256 * 1024, 256, 1024, MB.WD + (size_t)e * 1024 * 256, 0, scr, r, 32, F.lane);
        }
    }
}

constexpr int P6_HROW = 4096, P6_RGW = P6_HROW + 8 * 4096, P6_REW = P6_RGW + 16384;
static_assert(P6_REW + 65536 <= RING_BYTES, "P6 LDS map");
__device__ __forceinline__ void p6_ln1_router(const Frame& F, const Args& a, const MoeBufs& MB) {
    LAS int* lcount = (LAS int*)F.lds;
    LAS int* lbase = lcount + 32;
    LAS int* ent = lbase + 32;
    LAS float* entw = (LAS float*)(ent + 65 * 4);
    unsigned* ctl = (unsigned*)(F.ws + WS_CTL);
    const float2* rowstat = (const float2*)(F.ws + WS_ROWSTAT);
    const int lane = F.lane;
    for (int i = F.tid; i < 1024; i += NTHR) *(LAS f32x4*)(F.lds + P6_RGW + i * 16) = *(const f32x4*)(a.in[24] + (size_t)i * 4);
    for (int i = F.tid; i < 4096; i += NTHR) { const int k = i >> 2, g = i & 3; float w8[8]; ld8f(a.in[26] + (size_t)k * 32 + 8 * g, w8); st8((LAS bf16*)(F.lds + P6_REW + g * 16384 + k * 16), w8); }
    for (int blk = F.bid; blk < 256; blk += F.G) {
    if (F.tid < 32) lcount[F.tid] = 0;
    LDS_WAIT(); __syncthreads();
    f32x4 nx[4]; v2u nm[4];
    { const int pr = 65 * blk + F.wave, b = pr / LP, t = pr % LP; const int tc = (t < L) ? t : 0;
      const float* src = (tc < NM) ? (a.in[1] + (size_t)tc * D) : (a.in[0] + ((size_t)b * SEQ + (tc - NM)) * D);
#pragma unroll
      for (int j = 0; j < 4; ++j) { nx[j] = ((const f32x4*)src)[lane + 64 * j]; nm[j] = ((const v2u*)((const bf16*)MB.MIX + (size_t)pr * D))[lane + 64 * j]; } }
    for (int i = F.wave; i < 65; i += NWAVES) {
        const int pr = 65 * blk + i, t = pr % LP;
        f32x4 cx[4]; v2u cm[4];
#pragma unroll
        for (int j = 0; j < 4; ++j) { cx[j] = nx[j]; cm[j] = nm[j]; }
        if (i + NWAVES < 65) { const int pn = pr + NWAVES, bn = pn / LP, tn = pn % LP; const int tc = (tn < L) ? tn : 0;
            const float* src = (tc < NM) ? (a.in[1] + (size_t)tc * D) : (a.in[0] + ((size_t)bn * SEQ + (tc - NM)) * D);
#pragma unroll
            for (int j = 0; j < 4; ++j) { nx[j] = ((const f32x4*)src)[lane + 64 * j]; nm[j] = ((const v2u*)((const bf16*)MB.MIX + (size_t)pn * D))[lane + 64 * j]; } }
        if (t >= L) { if (lane == 0) ent[i * 4] = -1; continue; }
        const float2 st = rowstat[pr];
        f32x4 v[4]; float s = 0.f;
#pragma unroll
        for (int j = 0; j < 4; ++j) {
            const f32x4 g0 = ((const f32x4*)a.in[2])[lane + 64 * j], b0 = ((const f32x4*)a.in[3])[lane + 64 * j];
            const f32x4 mxv = {bflo(cm[j].x), bfhi(cm[j].x), bflo(cm[j].y), bfhi(cm[j].y)};
            v[j] = ((cx[j] - st.x) * st.y * g0 + b0) * DN_ALPHA + mxv;
            s += (v[j].x + v[j].y) + (v[j].z + v[j].w);
        }
        const float mean = wave_sum(s) * (1.f / D); float s2 = 0.f;
#pragma unroll
        for (int j = 0; j < 4; ++j) { v[j] = v[j] - mean; s2 += (v[j].x * v[j].x + v[j].y * v[j].y) + (v[j].z * v[j].z + v[j].w * v[j].w); }
        const float rstd = rsqrtf(wave_sum(s2) * (1.f / D) + LN_EPS);
        LAS float* hrow = (LAS float*)(F.lds + P6_HROW + F.wave * 4096);
#pragma unroll
        for (int j = 0; j < 4; ++j) {
            const f32x4 g1 = ((const f32x4*)a.in[22])[lane + 64 * j], b1 = ((const f32x4*)a.in[23])[lane + 64 * j];
            v[j] = v[j] * rstd * g1 + b1;
            v2u hb; hb.x = pk2(v[j].x, v[j].y); hb.y = pk2(v[j].z, v[j].w);
            ((v2u*)(MB.H1b + (size_t)pr * D))[lane + 64 * j] = hb;
            *(LAS f32x4*)(hrow + 4 * (lane + 64 * j)) = v[j];
        }
        LDS_WAIT();
        float hk[16];
#pragma unroll
        for (int kk = 0; kk < 16; ++kk) hk[kk] = hrow[lane + 64 * kk];
        f32x4 ga = {0.f, 0.f, 0.f, 0.f};
#pragma unroll
        for (int kk = 0; kk < 16; ++kk) { const f32x4 wg = *(const LAS f32x4*)(F.lds + P6_RGW + (lane + 64 * kk) * 16); ga = ga + wg * hk[kk]; }
        float lgp[4];
#pragma unroll
        for (int g = 0; g < 4; ++g) lgp[g] = wave_sum(ga[g]) + a.in[25][g];
        int gs = 0; float gm = lgp[0];
#pragma unroll
        for (int g = 1; g < 4; ++g) if (lgp[g] > gm) { gm = lgp[g]; gs = g; }
        float den = 0.f;
#pragma unroll
        for (int g = 0; g < 4; ++g) den += __expf(lgp[g] - gm);
        const float ggate = 1.f / den;
        float el[8];
#pragma unroll
        for (int q8 = 0; q8 < 8; ++q8) el[q8] = 0.f;
#pragma unroll
        for (int kk = 0; kk < 16; ++kk) { float w8[8]; unpack8(*(const LAS v4u*)(F.lds + P6_REW + gs * 16384 + (lane + 64 * kk) * 16), w8);
#pragma unroll
            for (int q8 = 0; q8 < 8; ++q8) el[q8] = fmaf(hk[kk], w8[q8], el[q8]); }
#pragma unroll
        for (int q8 = 0; q8 < 8; ++q8) el[q8] = wave_sum(el[q8]) + a.in[27][gs * 8 + q8];
        int i1 = 0; float v1 = el[0];
#pragma unroll
        for (int q8 = 1; q8 < 8; ++q8) if (el[q8] > v1) { v1 = el[q8]; i1 = q8; }
        int i2 = 0; float v2 = -INFINITY;
#pragma unroll
        for (int q8 = 0; q8 < 8; ++q8) if (q8 != i1 && el[q8] > v2) { v2 = el[q8]; i2 = q8; }
        const float e2 = __expf(v2 - v1);
        const float w1 = ggate / (1.f + e2), w2 = ggate * e2 / (1.f + e2);
        if (lane == 0) {
            const int e0 = gs * 8 + i1, e1 = gs * 8 + i2;
            ent[i * 4] = e0; ent[i * 4 + 1] = e1;
            ent[i * 4 + 2] = atomicAdd((int*)(lcount + e0), 1); ent[i * 4 + 3] = atomicAdd((int*)(lcount + e1), 1);
            entw[i * 2] = w1; entw[i * 2 + 1] = w2;
        }
    }
    LDS_WAIT(); __syncthreads();
    if (F.tid < 32) lbase[F.tid] = (int)atomicAdd(ctl + CW_CNT + F.tid, (unsigned)lcount[F.tid]);
    LDS_WAIT(); __syncthreads();
    if (F.tid < 65) {
        const int i = F.tid, e0 = ent[i * 4];
        if (e0 >= 0) {
            const int pr = 65 * blk + i, e1 = ent[i * 4 + 1];
            int* list = (int*)(F.ws + WS_LIST); float* wt = (float*)(F.ws + WS_WT);
            list[(size_t)e0 * LISTCAP + lbase[e0] + ent[i * 4 + 2]] = pr * 2;
            list[(size_t)e1 * LISTCAP + lbase[e1] + ent[i * 4 + 3]] = pr * 2 + 1;
            wt[pr * 2] = entw[i * 2]; wt[pr * 2 + 1] = entw[i * 2 + 1];
            unsigned* pinfo = (unsigned*)(F.ws + WS_PINFO);
            pinfo[pr * 2] = ((unsigned)e0 << 16) | (unsigned)(lbase[e0] + ent[i * 4 + 2]); pinfo[pr * 2 + 1] = ((unsigned)e1 << 16) | (unsigned)(lbase[e1] + ent[i * 4 + 3]);
        }
    }
    LDS_WAIT(); __syncthreads();
    }
}
}

namespace pg8 {
struct OneUnit { int pm, pn;
    __device__ __forceinline__ bool next(int i, Unit& u) const { if (i) return false; u.pm = pm; u.pn = pn; return true; }
    __device__ __forceinline__ void a_ready(const Unit&) const {}
    __device__ __forceinline__ void done(const Unit&) const {} };
struct EpiMoeUp {
    static constexpr bool PERM = true, AFTER_DRAIN = false;
    bf16_t* HID;
    __device__ __forceinline__ void operator()(const f32x4 (&acc)[2][2][4][2], const Unit& u, int wr, int wc, int fr, int fq) const {
        const int j0 = 128 * u.pn + 16 * wc + 4 * fq;
#pragma unroll
        for (int ai = 0; ai < 2; ++ai)
#pragma unroll
            for (int m = 0; m < 4; ++m) { bf16_t* rowp = HID + (size_t)(ai * HALF + wr * 64 + m * 16 + fr) * 256 + j0;
#pragma unroll
                for (int bj = 0; bj < 2; ++bj) { const f32x4 v0 = acc[ai][bj][m][0], v1 = acc[ai][bj][m][1];
                    const float h0 = v0[0] / (1.f + __expf(-v0[0])) * v0[1], h1 = v0[2] / (1.f + __expf(-v0[2])) * v0[3];
                    const float h2 = v1[0] / (1.f + __expf(-v1[0])) * v1[1], h3 = v1[2] / (1.f + __expf(-v1[2])) * v1[3];
                    unsigned w0 = cvt_pk_bf16(h0, h1), w1 = cvt_pk_bf16(h2, h3);
                    typedef unsigned u32x2_ __attribute__((ext_vector_type(2))); u32x2_ wv; wv.x = w0; wv.y = w1;
                    *(u32x2_*)(rowp + 64 * bj) = wv; } }
    }
};
struct EpiMoeDown {
    static constexpr bool PERM = true, AFTER_DRAIN = false;
    bf16_t* O;
    __device__ __forceinline__ void operator()(const f32x4 (&acc)[2][2][4][2], const Unit& u, int wr, int wc, int fr, int fq) const {
        const int col0 = (u.pn & 3) * BM + wc * 32 + 8 * fq;
#pragma unroll
        for (int ai = 0; ai < 2; ++ai)
#pragma unroll
            for (int m = 0; m < 4; ++m) { bf16_t* rowp = O + (size_t)(u.pm * BM + ai * HALF + wr * 64 + m * 16 + fr) * 1024 + col0;
#pragma unroll
                for (int bj = 0; bj < 2; ++bj) { const f32x4 v0 = acc[ai][bj][m][0], v1 = acc[ai][bj][m][1];
                    u32x4 w; w.x = cvt_pk_bf16(v0[0], v0[1]); w.y = cvt_pk_bf16(v0[2], v0[3]); w.z = cvt_pk_bf16(v1[0], v1[1]); w.w = cvt_pk_bf16(v1[2], v1[3]);
                    *(u32x4*)(rowp + bj * HALF) = w; } }
    }
};
struct ThreeUnits { int n, pm0, pn0, pm1, pn1, pm2, pn2;
    __device__ __forceinline__ bool next(int i, Unit& u) const { if (i >= n) return false; u.pm = (i == 0) ? pm0 : (i == 1 ? pm1 : pm2); u.pn = (i == 0) ? pn0 : (i == 1 ? pn1 : pn2); return true; }
    __device__ __forceinline__ void a_ready(const Unit&) const {}
    __device__ __forceinline__ void done(const Unit&) const {} };
}

namespace mk {
struct MoeTiles { int total; };
__device__ __forceinline__ int moe_find(const unsigned* cnt, int ti, int& e_out, int& i_out, int& hb_out, int& total) {
    int acc = 0, e_f = -1, i_f = 0, hb = 0;
    for (int e = 0; e < NEXP; ++e) { const int nt = ((int)cnt[e] + 255) >> 8; if (e_f < 0 && ti < acc + nt) { e_f = e; i_f = ti - acc; hb = acc; } acc += nt; }
    total = acc; e_out = e_f; i_out = i_f; hb_out = hb; return e_f;
}
constexpr int MOE_LDS_IDX = RING_BYTES;
__device__ __forceinline__ void p7_moe(const Frame& F, const MoeBufs& MB, bool down) {
    const unsigned* cnt = (const unsigned*)(F.ws + WS_CTL) + CW_CNT;
    const int* list = (const int*)(F.ws + WS_LIST);
    LAS int* lidx = (LAS int*)(F.lds + MOE_LDS_IDX);
    if (down) {
        pg8::ThreeUnits S{0, 0, 0, 0, 0, 0, 0};
        for (int k3 = 0; k3 < 3; ++k3) { const int v = F.bid + k3 * F.G; int e, i, hb, total; moe_find(cnt, v >> 2, e, i, hb, total);
            if (v < 4 * total) { const int pm = __builtin_amdgcn_readfirstlane(v >> 2), pn = __builtin_amdgcn_readfirstlane(e * 4 + (v & 3));
                if (k3 == 0) { S.pm0 = pm; S.pn0 = pn; } else if (k3 == 1) { S.pm1 = pm; S.pn1 = pn; } else { S.pm2 = pm; S.pn2 = pn; } S.n = k3 + 1; } }
        pg8::Gemm g{MB.HID, MB.WD, 256, 1024, 256, 256, nullptr};
        pg8::EpiMoeDown E{MB.F};
        pg8::gemm_phase<pg8::EpiMoeDown, pg8::ThreeUnits, true, false, false>(F.lds, g, S, E);
        return;
    }
    const int ncol = 2;
    for (int u = F.bid;; u += F.G) {
        int e, i, hb, total; moe_find(cnt, u / ncol, e, i, hb, total);
        e = __builtin_amdgcn_readfirstlane(e); i = __builtin_amdgcn_readfirstlane(i); hb = __builtin_amdgcn_readfirstlane(hb); total = __builtin_amdgcn_readfirstlane(total);
        if (u >= total * ncol) break;
        const int pn = __builtin_amdgcn_readfirstlane(u % ncol), n_e = __builtin_amdgcn_readfirstlane((int)cnt[e]), base = 256 * i;
        if (!down) {
            __syncthreads();
            if (F.tid < 256) lidx[F.tid] = list[(size_t)e * LISTCAP + min(base + F.tid, n_e - 1)] >> 1;
            LDS_WAIT(); __syncthreads();
        }
        if (!down) {
            pg8::Gemm g{MB.H1b, MB.WGU + (size_t)e * 512 * 1024, 256, 512, 1024, 1024, (const int*)(F.lds + MOE_LDS_IDX)};
            pg8::OneUnit S{0, pn};
            pg8::EpiMoeUp E{MB.HID + (size_t)(hb + i) * 256 * 256};
            pg8::gemm_phase<pg8::EpiMoeUp, pg8::OneUnit, true, true, true>(F.lds, g, S, E);
        }
    }
}
__device__ __forceinline__ int moe_total_tiles(const unsigned* cnt) { int acc = 0; for (int e = 0; e < NEXP; ++e) acc += ((int)cnt[e] + 255) >> 8; return acc; }
__device__ __forceinline__ void p8_final(const Frame& F, const Args& a, const MoeBufs& MB) {
    const int gw = F.bid * NWAVES + F.wave, NGW = F.G * NWAVES, lane = F.lane;
    const unsigned* cnt = (const unsigned*)(F.ws + WS_CTL) + CW_CNT;
    const unsigned* pinfo = (const unsigned*)(F.ws + WS_PINFO); const float* wt = (const float*)(F.ws + WS_WT);
    int tb = 0;
    { const int nt = (lane < NEXP) ? (((int)cnt[lane & 31] + 255) >> 8) : 0; int inc = nt;
#pragma unroll
      for (int o = 1; o < 32; o <<= 1) { const int t = __shfl_up(inc, o); if ((lane & 31) >= o) inc += t; }
      tb = inc - nt; }
    const int NR = NB * SEQ;
    for (int orow = gw; orow < NR; orow += 2 * NGW) {
        v2u hv[2][4], fa[2][4], fb[2][4]; float w0[2], w1[2]; bool ok[2];
#pragma unroll
        for (int u = 0; u < 2; ++u) {
            const int o = orow + u * NGW; ok[u] = o < NR; const int oc = ok[u] ? o : orow;
            const size_t pr = (size_t)(oc / SEQ) * LP + NM + (oc % SEQ);
            const unsigned p0 = pinfo[pr * 2], p1 = pinfo[pr * 2 + 1]; w0[u] = wt[pr * 2]; w1[u] = wt[pr * 2 + 1];
            const size_t r0 = (size_t)__shfl(tb, (int)(p0 >> 16)) * 256 + (p0 & 0xffffu), r1 = (size_t)__shfl(tb, (int)(p1 >> 16)) * 256 + (p1 & 0xffffu);
#pragma unroll
            for (int j = 0; j < 4; ++j) { hv[u][j] = ((const v2u*)(MB.H1b + pr * D))[lane + 64 * j]; fa[u][j] = ((const v2u*)(MB.F + r0 * D))[lane + 64 * j]; fb[u][j] = ((const v2u*)(MB.F + r1 * D))[lane + 64 * j]; }
        }
#pragma unroll
        for (int u = 0; u < 2; ++u) {
            f32x4 v[4]; float sm = 0.f;
#pragma unroll
            for (int j = 0; j < 4; ++j) {
                const f32x4 h = {bflo(hv[u][j].x), bfhi(hv[u][j].x), bflo(hv[u][j].y), bfhi(hv[u][j].y)}; const v2u f0 = fa[u][j], f1 = fb[u][j];
                v[j].x = DN_ALPHA * h.x + w0[u] * bflo(f0.x) + w1[u] * bflo(f1.x); v[j].y = DN_ALPHA * h.y + w0[u] * bfhi(f0.x) + w1[u] * bfhi(f1.x);
                v[j].z = DN_ALPHA * h.z + w0[u] * bflo(f0.y) + w1[u] * bflo(f1.y); v[j].w = DN_ALPHA * h.w + w0[u] * bfhi(f0.y) + w1[u] * bfhi(f1.y);
                sm += (v[j].x + v[j].y) + (v[j].z + v[j].w);
            }
            const float mean = wave_sum(sm) * (1.f / D); float s2 = 0.f;
#pragma unroll
            for (int j = 0; j < 4; ++j) { v[j] = v[j] - mean; s2 += (v[j].x * v[j].x + v[j].y * v[j].y) + (v[j].z * v[j].z + v[j].w * v[j].w); }
            const float rstd = rsqrtf(wave_sum(s2) * (1.f / D) + LN_EPS);
            if (ok[u]) {
                const int o = orow + u * NGW;
#pragma unroll
                for (int j = 0; j < 4; ++j) { const f32x4 g2 = ((const f32x4*)a.in[31])[lane + 64 * j], b2 = ((const f32x4*)a.in[32])[lane + 64 * j];
                    ((f32x4*)(a.out + (size_t)o * D))[lane + 64 * j] = v[j] * rstd * g2 + b2; }
            }
        }
    }
}
struct OutY {
    bf16* Ur;
    __device__ __forceinline__ void operator()(int b, int t, int col, f32x4 y) const { v2u o; o.x = pk2(y[0], y[1]); o.y = pk2(y[2], y[3]); *(v2u*)(Ur + ((size_t)b * LP + t) * UR_W + col) = o; }
    __device__ __forceinline__ void operator()(int b, int t, int col, float y) const { Ur[((size_t)b * LP + t) * UR_W + col] = (bf16)f2bf(y); }
};
constexpr int CW_W3 = 16, CW_W4 = 80;
constexpr int TICKET_OFF = 15 * 9216 + 62 * 144 + 128;
__device__ __forceinline__ int next_ticket(const Frame& F, unsigned* ctr) {
    LAS int* slot = (LAS int*)(F.lds + TICKET_OFF);
    if (F.tid == 0) *slot = (int)atomicAdd(ctr, 1u);
    LDS_WAIT(); __syncthreads();
    const int t = *slot;
    LDS_WAIT(); __syncthreads();
    return t;
}
__device__ __forceinline__ int bcast_ticket(const Frame& F, int mine) {
    LAS int* slot = (LAS int*)(F.lds + TICKET_OFF);
    if (F.tid == 0) *slot = mine;
    LDS_WAIT(); __syncthreads();
    const int t = *slot;
    LDS_WAIT(); __syncthreads();
    return t;
}
constexpr size_t W_UR = 16 * MiB;
constexpr size_t W_UA = W_UR + (size_t)TP * UR_W * 2;
constexpr size_t W_RW = W_UA + (size_t)TP * UA_W * 2;
constexpr size_t W_H0B = W_RW;
constexpr size_t W_RW_M = W_RW, W_RW_N = W_RW_M + (size_t)NUNIT * 8192, W_RW_Q = W_RW_N + (size_t)NUNIT * 16384, W_RW_OP = W_RW_Q + (size_t)NUNIT * 8192,
                 W_RW_G1 = W_RW_OP + (size_t)NUNIT * 8192, W_RW_G2 = W_RW_G1 + (size_t)NUNIT * 8192, W_RW_END = W_RW_G2 + (size_t)NUNIT * 8192;
static_assert(W_RW_END <= WS_LIST, "RWKV data below the token lists");
constexpr size_t W_MIX = W_RW;
constexpr size_t W_F = W_RW;
constexpr size_t W_H1B = W_RW + 81 * MiB;
constexpr size_t W_H1 = W_UR;
constexpr size_t W_HID = 81 * MiB;
static_assert(W_H1 + (size_t)TP * 4096 <= W_HID && W_HID + (size_t)41216 * 512 <= W_RW && W_H1B + (size_t)TP * 2048 <= WS_LIST && W_F + (size_t)41216 * 2048 <= W_H1B, "late-phase overlays");
constexpr size_t O_Q = 0, O_QI = O_Q + (size_t)TP * 1024, O_HC = O_QI + (size_t)TP * 1024, O_MASK = O_HC + (size_t)NUNIT * 8192, O_KX = O_MASK + (size_t)TP * MW * 2, O_END = O_KX + (size_t)TP * 128;
constexpr size_t O_WGU = 0, O_WD = 32 * MiB;
static_assert(O_END <= 64 * MiB && O_WD + (size_t)NEXP * EW_D <= 64 * MiB, "d_out scratch");

__global__ void __launch_bounds__(NTHR, 2) mega(Args a) {
    unsigned char* const wsb_ = a.ws; unsigned char* const ob_ = (unsigned char*)a.out;
    bf16* const H0b = (bf16*)(wsb_ + W_H0B); bf16* const Ur = (bf16*)(wsb_ + W_UR); bf16* const Ua = (bf16*)(wsb_ + W_UA);
    const RwkvBufs RB{(bf16*)(wsb_ + W_RW_M), (float*)(wsb_ + W_RW_N), (bf16*)(wsb_ + W_RW_Q), (bf16*)(wsb_ + W_RW_OP), (bf16*)(wsb_ + W_RW_G1), (bf16*)(wsb_ + W_RW_G2), (bf16*)(ob_ + O_HC)};
    const AttBufs AB{(bf16*)(ob_ + O_Q), (bf16*)(ob_ + O_QI), (unsigned short*)(ob_ + O_MASK), (bf16*)(ob_ + O_KX)};
    const MoeBufs MB{(float*)(wsb_ + W_MIX), (float*)(wsb_ + W_H1), (bf16*)(wsb_ + W_H1B), (bf16*)(wsb_ + W_HID), (bf16*)(wsb_ + W_F), (bf16*)(ob_ + O_WGU), (bf16*)(ob_ + O_WD)};
    extern __shared__ __attribute__((aligned(16))) unsigned char lds[];
    Frame F;
    F.lds = (LAS unsigned char*)lds;
    F.tid = threadIdx.x; F.lane = F.tid & 63; F.wave = __builtin_amdgcn_readfirstlane(F.tid >> 6);
    F.G = gridDim.x; F.bid = blockIdx.x; F.ws = a.ws;
    unsigned* ctl = (unsigned*)(a.ws + WS_CTL);
    const int lo = a.ph_lo, hi = a.ph_hi;
    volatile LAS unsigned* MISC = (volatile LAS unsigned*)(F.lds + MISC_OFF);
    if (F.tid < 4) MISC[F.tid] = 0u;
    LDS_WAIT(); __syncthreads();
    XcdBarrier bar; bar.bar = ctl + CW_BAR; bar.x = 0; bar.st = MISC;
    if (hi - lo > 1) bar = xcd_barrier_post(ctl + CW_BAR, MISC);
#define SEAM(k) do { if (IN(k) && IN((k) + 1)) xcd_barrier(bar); } while (0)
#define IN(k) (lo <= (k) && (k) < hi)
    if (IN(0)) { p0_prologue(F, a, H0b); }
    SEAM(0);
    if (IN(1)) {
        pg8::Gemm g{H0b, (const bf16*)(F.ws + WS_WIN), TP, IN_N, 1024, 1024, nullptr};
        pg8::StaticOrder S; S.init(TP, IN_N, F.G, (int)blockIdx.x);
        pg8::EpiU E{Ur, Ua};
        pg8::gemm_phase<pg8::EpiU, pg8::StaticOrder, true, true>(F.lds, g, S, E);
    }
    SEAM(1);
    if (IN(2)) {
        {
            if (F.G == 256) { att_prep_unit(F, a, Ua, AB, F.bid); if (F.bid >= 32 && F.bid < 36) att_prep_unit(F, a, Ua, AB, 256 + F.bid - 32); }
            else for (int u = F.bid; u < TP / 64; u += F.G) att_prep_unit(F, a, Ua, AB, u);
        }
        {
            if (F.G == 256) {
                const int nk = (F.bid >= 32 && F.bid < 36) ? 7 : ((F.bid < 32 || (F.bid >= 36 && F.bid < 40)) ? 9 : 8);
#define PB(x) (32 * ((x) & 7) + ((x) >> 3))
                RwRaw R; rw_load_raw(R, Ur, PB(F.bid), F.tid);
                { RwW W0; rw_w_fetch(W0, F, a, PB(F.bid) & 7); __syncthreads(); rw_w_store(W0, F); LDS_WAIT(); __syncthreads(); }
#pragma unroll 1
                for (int kq = 0; kq < nk; ++kq) {
                    const int u = (kq < 8) ? PB(F.bid) + 256 * kq : (F.bid < 32 ? 2048 + F.bid : PB(F.bid - 4) + 256 * 7);
                    const int kn = kq + 1; const int un = (kn >= nk) ? -1 : ((kn < 8) ? PB(F.bid) + 256 * kn : (F.bid < 32 ? 2048 + F.bid : PB(F.bid - 4) + 256 * 7));
                    rwkv_unit(F, a, Ur, RB, u, R, un);
                }
            } else { RwRaw R; for (int u = F.bid; u < NUNIT; u += F.G) { rw_load_raw(R, Ur, u, F.tid); { RwW W0; rw_w_fetch(W0, F, a, u & 7); __syncthreads(); rw_w_store(W0, F); LDS_WAIT(); __syncthreads(); } rwkv_unit(F, a, Ur, RB, u, R, -1); } }
        }
    }
    SEAM(2);
    if (IN(3)) {
        if (F.bid < 32 && F.wave < 2) rwkv_scan(RB, F.bid, F.wave, F.lane);
        for (int i = next_ticket(F, ctl + CW_W3); i < 4 * 257;) {
            idx_unit(F, Ua, AB, i & 3, 256 - (i >> 2), a.flags);
            i = next_ticket(F, ctl + CW_W3);
        }
    }
    SEAM(3);
    if (IN(4)) {
        const OutY of{Ur};
        for (int u = F.bid * NWAVES + F.wave; u < NUNIT; u += F.G * NWAVES) rwkv_out_unit(RB, u, F.lane, of);
        for (int i = next_ticket(F, ctl + CW_W4); i < 17 * 32;) {
            attn_unit(F, Ua, AB, (i & 31) >> 3, i & 7, 16 - (i >> 5), of);
            i = next_ticket(F, ctl + CW_W4);
        }
    }
    SEAM(4);
    if (IN(5)) {
        pg8::Gemm g{Ur, (const bf16*)(F.ws + WS_WOUT), TP, 1024, 1024, UR_W, nullptr};
        pg8::StaticOrder S; S.init(TP, 1024, F.G, (int)blockIdx.x);
        pg8::EpiB16 E{(bf16*)MB.MIX, 1024};
        pg8::gemm_phase<pg8::EpiB16, pg8::StaticOrder, true, true>(F.lds, g, S, E);
        convert_experts(F, a, MB, 0, (TP / 256) * 4 - F.G > 0 ? (TP / 256) * 4 - F.G : 0);
    }
    SEAM(5);
    if (IN(6)) { p6_ln1_router(F, a, MB); }
    SEAM(6);
    if (IN(7)) { p7_moe(F, MB, false);
        { const int nu = 2 * moe_total_tiles((const unsigned*)(F.ws + WS_CTL) + CW_CNT); const int fw = nu - F.G; convert_experts(F, a, MB, 1, (fw > 0 && fw < F.G) ? fw : 0); } }
    SEAM(7);
    if (IN(8)) { Frame F8 = F; { int t = F.tid; asm volatile("" : "+v"(t)); F8.tid = t; F8.lane = t & 63; } p7_moe(F8, MB, true); }
    SEAM(8);
    if (IN(9)) { Frame F9 = F; { int t = F.tid; asm volatile("" : "+v"(t)); F9.tid = t; F9.lane = t & 63; } p8_final(F9, a, MB); }
#undef IN
#undef SEAM
}

}
extern "C" void kernel_launch(void* const* d_in, const int* in_sizes, int n_in, void* d_out, int out_size, void* d_ws, size_t ws_size, hipStream_t stream) {
    static int inited = 0;
    if (!inited) { (void)hipFuncSetAttribute((const void*)mk::mega, hipFuncAttributeMaxDynamicSharedMemorySize, mk::LDS_BYTES); inited = 1; }
    unsigned char* wsb = (unsigned char*)d_ws;
    (void)hipMemsetAsync(wsb + mk::WS_CTL, 0, mk::CTL_ZERO_BYTES, stream);
    mk::Args a{};
    for (int i = 0; i < 33; ++i) a.in[i] = (const float*)d_in[i];
    a.out = (float*)d_out; a.ws = wsb;
    static int grid = 0;
    if (!grid) { int dev = 0, cus = 0, per_cu = 0; (void)hipGetDevice(&dev); (void)hipDeviceGetAttribute(&cus, hipDeviceAttributeMultiprocessorCount, dev);
        (void)hipOccupancyMaxActiveBlocksPerMultiprocessor(&per_cu, (const void*)mk::mega, mk::NTHR, mk::LDS_BYTES); (void)hipGetLastError();
        if (per_cu < 1) per_cu = 1; if (cus < 1) cus = 256; grid = cus * per_cu; if (grid > 256) grid = 256; }
    a.ph_lo = 0; a.ph_hi = 10;
    { void* kargs[] = {(void*)&a};
      if (hipLaunchCooperativeKernel((const void*)mk::mega, dim3(grid), dim3(mk::NTHR), kargs, mk::LDS_BYTES, stream) != hipSuccess) {
          (void)hipGetLastError();
          hipLaunchKernelGGL(mk::mega, dim3(grid), dim3(mk::NTHR), mk::LDS_BYTES, stream, a);
      } }
}
```

```cpp
#include <hip/hip_runtime.h>
#include <math.h>
#include <stdint.h>
namespace pg8 {
#define PG8_LAS __attribute__((address_space(3)))
typedef unsigned short bf16_t;
typedef short bf16x8 __attribute__((ext_vector_type(8)));
typedef float f32x4 __attribute__((ext_vector_type(4)));
typedef unsigned u32x4 __attribute__((ext_vector_type(4)));
constexpr int BM = 256, BK = 64, HALF = 128, HTB = HALF * BK * 2  , STAGE_BYTES = 8 * HTB, NXCD = 8, WGM = 8;

__host__ __device__ __forceinline__ int lds_byte(int r, int c) { const int st = (r >> 4) * 2 + (c >> 5), rr = r & 15, cc = c & 31, ob = rr * 64 + cc * 2; return st * 1024 + (ob ^ (((ob >> 9) & 1) << 5)); }
__host__ __device__ __forceinline__ void stage_rc(int b, int& R, int& C) { const int st = b / 1024, sb = b % 1024, swz = sb ^ (((sb >> 9) & 1) << 5); R = (st >> 1) * 16 + swz / 64; C = (st & 1) * 32 + (swz % 64) / 2; }
__host__ __device__ __forceinline__ int perm32(int rho) { const int n = rho >> 4, i = rho & 15; return 8 * (i >> 2) + 4 * n + (i & 3); }

struct Unit { int pm, pn; };
struct Gemm { const bf16_t* A; const bf16_t* Bt; int M, N, K, lda; const int* rowidx; };

struct StaticOrder {
    int nM, nN, nwg, G, c;
    __host__ __device__ void init(int M, int N, int G_, int c_) { nM = M / BM; nN = N / BM; nwg = nM * nN; G = G_; c = c_; }
    __host__ __device__ bool next(int i, Unit& u) const {
        const long L = (long)i * G + c; if (L >= nwg) return false;
        int wgid = (int)L; { const int q = nwg / NXCD, r = nwg % NXCD, xcd = wgid % NXCD, off = wgid / NXCD; wgid = (xcd < r ? xcd * (q + 1) : r * (q + 1) + (xcd - r) * q) + off; }
        const int nig = WGM * nN, gid = wgid / nig, fm = gid * WGM, gsz = (nM - fm) < WGM ? (nM - fm) : WGM;
        u.pm = fm + ((wgid % nig) % gsz); u.pn = (wgid % nig) / gsz; return true;
    }
    __device__ __forceinline__ void a_ready(const Unit&) const {}
    __device__ __forceinline__ void done(const Unit&) const {}
};

__device__ __forceinline__ unsigned cvt_pk_bf16(float lo, float hi) { unsigned r; asm volatile("v_cvt_pk_bf16_f32 %0, %1, %2" : "=v"(r) : "v"(lo), "v"(hi)); return r; }
typedef float f32x2 __attribute__((ext_vector_type(2)));
__device__ __forceinline__ f32x2 gelu_pk(f32x2 v) {
    const f32x2 av = __builtin_elementwise_abs(v), d = av * 0.2316418882f + 1.0f;
    f32x2 t; t.x = __builtin_amdgcn_rcpf(d.x); t.y = __builtin_amdgcn_rcpf(d.y);
    f32x2 q = t * 0.5307027145f + (-0.7265760135f); q = q * t + 0.7107068705f; q = q * t + (-0.142248368f); q = q * t + 0.127414796f; q = q * t;
    const f32x2 s = (v * v) * (-0.72134752044f);
    f32x2 e; e.x = __builtin_amdgcn_exp2f(s.x); e.y = __builtin_amdgcn_exp2f(s.y);
    const f32x2 m = v * (q * e), r = v - m;
    f32x2 o; o.x = v.x < 0.f ? m.x : r.x; o.y = v.y < 0.f ? m.y : r.y; return o;
}

template <int ACT  > struct EpiBf16 {
    static constexpr bool PERM = true, AFTER_DRAIN = false; static_assert(ACT == 0 || ACT == 1, "EpiBf16: ACT is 0 (none) or 1 (gelu_pk)");
    bf16_t* O; int ldc; const float* bias; int split_cols; size_t split_stride; float scale0;
    __device__ __forceinline__ void operator()(const f32x4 (&acc)[2][2][4][2], const Unit& u, int wr, int wc, int fr, int fq) const {
        const int row0 = u.pm * BM + wr * 64 + fr; int colt = u.pn * BM; bf16_t* base = O;
        float sc = 1.f; if (split_cols) { const int t = colt / split_cols; base += (size_t)t * split_stride; colt -= t * split_cols; if (t == 0) sc = scale0; }
        const int col0 = colt + wc * 32 + 8 * fq, bcol0 = u.pn * BM + wc * 32 + 8 * fq;
        f32x4 bv[2][2];
#pragma unroll
        for (int bj = 0; bj < 2; ++bj)
#pragma unroll
            for (int n = 0; n < 2; ++n) bv[bj][n] = bias ? *(const f32x4*)(bias + bcol0 + bj * HALF + 4 * n) : (f32x4){0.f, 0.f, 0.f, 0.f};
#pragma unroll
        for (int ai = 0; ai < 2; ++ai)
#pragma unroll
            for (int m = 0; m < 4; ++m) { bf16_t* rowp = base + (size_t)(row0 + ai * HALF + m * 16) * ldc + col0;
#pragma unroll
                for (int bj = 0; bj < 2; ++bj) { f32x4 v0 = acc[ai][bj][m][0] + bv[bj][0], v1 = acc[ai][bj][m][1] + bv[bj][1];
                    if (ACT == 1) { f32x2 a = gelu_pk((f32x2){v0[0], v0[1]}), b = gelu_pk((f32x2){v0[2], v0[3]}), c = gelu_pk((f32x2){v1[0], v1[1]}), d = gelu_pk((f32x2){v1[2], v1[3]});
                        v0 = (f32x4){a.x, a.y, b.x, b.y}; v1 = (f32x4){c.x, c.y, d.x, d.y}; }
                    v0 = v0 * sc; v1 = v1 * sc; u32x4 w; w.x = cvt_pk_bf16(v0[0], v0[1]); w.y = cvt_pk_bf16(v0[2], v0[3]); w.z = cvt_pk_bf16(v1[0], v1[1]); w.w = cvt_pk_bf16(v1[2], v1[3]);
                    *(u32x4*)(rowp + bj * HALF) = w; } }
    }
};
template <class Epi, class Sched, bool ALIGN_EPI = false, bool SP2 = false, bool GATHER = false>
__device__ __forceinline__ void gemm_phase(PG8_LAS unsigned char* lds, const Gemm g, const Sched& S, const Epi& E) {
    const int tid = threadIdx.x, wid = __builtin_amdgcn_readfirstlane(tid >> 6), lane = tid & 63, wr = wid >> 2, wc = wid & 3, fr = lane & 15, fq = lane >> 4;
    const int K = g.K, nt = K / BK;
    unsigned voffA[2], voffA1[2], voffB[2];
#pragma unroll
    for (int i = 0; i < 2; ++i) { int R, C; stage_rc(tid * 16 + i * 8192, R, C); const int Rb = Epi::PERM ? ((R & ~31) + perm32(R & 31)) : R;
        if constexpr (GATHER) { voffA[i] = (unsigned)(g.rowidx[R] * g.lda + C) * 2u; voffA1[i] = (unsigned)(g.rowidx[R + HALF] * g.lda + C) * 2u; }
        else { voffA[i] = (unsigned)(R * g.lda + C) * 2u; voffA1[i] = voffA[i]; }
        voffB[i] = (unsigned)(Rb * K + C) * 2u; }
    const size_t kstep = (size_t)(BK * 2);
    const size_t hstep = (size_t)HALF * K * 2;
    const size_t tstep = 2 * hstep; const size_t hstepA = GATHER ? (size_t)0 : (size_t)HALF * g.lda * 2, tstepA = 2 * hstepA;
    const unsigned ldsw = (unsigned)wid * 1024u;
    const int aoff = lds_byte(wr * 64 + fr, fq * 8), boff = lds_byte(wc * 32 + fr, fq * 8);
#define PG8_SA(b, h) (((b) * 2 + (h)) * HTB)
#define PG8_SB(b, h) ((4 + (b) * 2 + (h)) * HTB)
#define PG8_STAGE(bufoff, gbase, voff) do { _Pragma("unroll") for (int _i = 0; _i < 2; ++_i) \
        __builtin_amdgcn_global_load_lds((const unsigned*)((const char*)(gbase) + (voff)[_i]), (PG8_LAS unsigned*)(lds + (bufoff) + ldsw + _i * 8192), 16, 0, 0); } while (0)
#define PG8_LDA(dst, b, h) do { _Pragma("unroll") for (int m = 0; m < 4; ++m) _Pragma("unroll") for (int k = 0; k < 2; ++k) dst[m][k] = *(const PG8_LAS bf16x8*)(lds + PG8_SA(b, h) + aoff + m * 2048 + k * 1024); } while (0)
#define PG8_LDB(dst, b, h) do { _Pragma("unroll") for (int n = 0; n < 2; ++n) _Pragma("unroll") for (int k = 0; k < 2; ++k) dst[n][k] = *(const PG8_LAS bf16x8*)(lds + PG8_SB(b, h) + boff + n * 2048 + k * 1024); } while (0)
#define PG8_MMA(ai, bj, At, Bt) do { __builtin_amdgcn_s_setprio(1); _Pragma("unroll") for (int m = 0; m < 4; ++m) _Pragma("unroll") for (int n = 0; n < 2; ++n) _Pragma("unroll") for (int k = 0; k < 2; ++k) \
        acc[ai][bj][m][n] = __builtin_amdgcn_mfma_f32_16x16x32_bf16(Bt[n][k], At[m][k], acc[ai][bj][m][n], 0, 0, 0); __builtin_amdgcn_s_setprio(0); } while (0)
#define PG8_WAIT_V(n) asm volatile("s_waitcnt vmcnt(" #n ")" ::: "memory")
#define PG8_WAIT_L(n) asm volatile("s_waitcnt lgkmcnt(" #n ")" ::: "memory")
#define PG8_BAR __builtin_amdgcn_s_barrier()
#define PG8_SCHED __builtin_amdgcn_sched_barrier(0)
    Unit cur, nxt; int ui = 0;
    if (!S.next(0, cur)) return;
    f32x4 acc[2][2][4][2];
#pragma unroll
    for (int a = 0; a < 2; ++a)
#pragma unroll
        for (int b = 0; b < 2; ++b)
#pragma unroll
            for (int m = 0; m < 4; ++m)
#pragma unroll
                for (int n = 0; n < 2; ++n) acc[a][b][m][n] = (f32x4){0.f, 0.f, 0.f, 0.f};
    bf16x8 At[4][2], B0[2][2], B1[2][2];
    const char* cA = (const char*)g.A + (size_t)cur.pm * tstepA; const char* cB = (const char*)g.Bt + (size_t)cur.pn * tstep;
    S.a_ready(cur);
    if constexpr (SP2) {
        PG8_STAGE(PG8_SB(0, 0), cB, voffB); PG8_STAGE(PG8_SB(0, 1), cB + hstep, voffB); PG8_STAGE(PG8_SA(0, 0), cA, voffA); PG8_STAGE(PG8_SA(0, 1), cA + hstepA, voffA1);
        if (wr == 1) PG8_BAR;
        PG8_WAIT_V(2); PG8_BAR;
        PG8_STAGE(PG8_SB(1, 0), cB + kstep, voffB); PG8_STAGE(PG8_SA(1, 0), cA + kstep, voffA); PG8_STAGE(PG8_SB(1, 1), cB + hstep + kstep, voffB);
        PG8_WAIT_V(6); PG8_BAR;
    } else {
        PG8_STAGE(PG8_SB(0, 0), cB, voffB); PG8_STAGE(PG8_SA(0, 0), cA, voffA); PG8_STAGE(PG8_SB(0, 1), cB + hstep, voffB); PG8_STAGE(PG8_SA(0, 1), cA + hstepA, voffA1);
        if (wr == 1) PG8_BAR;
        PG8_WAIT_V(4); PG8_BAR;
        PG8_STAGE(PG8_SB(1, 0), cB + kstep, voffB); PG8_STAGE(PG8_SA(1, 0), cA + kstep, voffA); PG8_STAGE(PG8_SB(1, 1), cB + hstep + kstep, voffB);
        PG8_WAIT_V(6); PG8_BAR;
    }
    for (;;) {
        const bool has_next = S.next(ui + 1, nxt);
        const char* nA = has_next ? (const char*)g.A + (size_t)nxt.pm * tstepA : cA; const char* nB = has_next ? (const char*)g.Bt + (size_t)nxt.pn * tstep : cB;
        for (int t = 0; t < nt; t += 2) {
            const bool last = (t == nt - 2);
            const char* a1 = cA + (size_t)(t + 1) * kstep;
            const char* a2 = last ? nA : cA + (size_t)(t + 2) * kstep; const char* b2 = last ? nB : cB + (size_t)(t + 2) * kstep;
            const char* a3 = a2 + kstep; const char* b3 = b2 + kstep;
            if (last && has_next) S.a_ready(nxt);
            if constexpr (SP2) {
            PG8_LDB(B0, 0, 0); PG8_LDB(B1, 0, 1); PG8_SCHED; PG8_LDA(At, 0, 0); PG8_STAGE(PG8_SA(1, 1), a1 + hstepA, voffA1);
            PG8_WAIT_V(8); PG8_WAIT_L(0); PG8_BAR; PG8_MMA(0, 0, At, B0); PG8_MMA(0, 1, At, B1); PG8_BAR; PG8_SCHED;
            PG8_LDA(At, 0, 1); PG8_STAGE(PG8_SB(0, 0), b2, voffB); PG8_STAGE(PG8_SB(0, 1), b2 + hstep, voffB); PG8_STAGE(PG8_SA(0, 0), a2, voffA);
            PG8_WAIT_V(8); PG8_WAIT_L(0); PG8_BAR; PG8_MMA(1, 0, At, B0); PG8_MMA(1, 1, At, B1); PG8_BAR; PG8_SCHED;
            PG8_LDB(B0, 1, 0); PG8_LDB(B1, 1, 1); PG8_SCHED; PG8_LDA(At, 1, 0); PG8_STAGE(PG8_SA(0, 1), a2 + hstepA, voffA1);
            PG8_WAIT_V(8); PG8_WAIT_L(0); PG8_BAR; PG8_MMA(0, 0, At, B0); PG8_MMA(0, 1, At, B1); PG8_BAR; PG8_SCHED;
            PG8_LDA(At, 1, 1); PG8_STAGE(PG8_SB(1, 0), b3, voffB); PG8_STAGE(PG8_SB(1, 1), b3 + hstep, voffB); PG8_STAGE(PG8_SA(1, 0), a3, voffA);
            PG8_WAIT_V(8); PG8_WAIT_L(0); PG8_BAR; PG8_MMA(1, 0, At, B0); PG8_MMA(1, 1, At, B1); PG8_BAR; PG8_SCHED;
            } else {
            PG8_LDB(B0, 0, 0); PG8_SCHED; PG8_LDA(At, 0, 0); PG8_STAGE(PG8_SA(1, 1), a1 + hstepA, voffA1);
            PG8_WAIT_L(8); PG8_BAR; PG8_WAIT_L(0); PG8_MMA(0, 0, At, B0); PG8_BAR; PG8_SCHED;
            PG8_LDB(B1, 0, 1); PG8_STAGE(PG8_SB(0, 0), b2, voffB);
            PG8_BAR; PG8_WAIT_L(0); PG8_MMA(0, 1, At, B1); PG8_BAR;
            PG8_LDA(At, 0, 1); PG8_STAGE(PG8_SA(0, 0), a2, voffA);
            PG8_BAR; PG8_WAIT_L(0); PG8_MMA(1, 0, At, B0); PG8_BAR; PG8_SCHED;
            PG8_STAGE(PG8_SB(0, 1), b2 + hstep, voffB);
            PG8_WAIT_V(6); PG8_BAR; PG8_MMA(1, 1, At, B1); PG8_BAR;
            PG8_LDB(B0, 1, 0); PG8_SCHED; PG8_LDA(At, 1, 0); PG8_STAGE(PG8_SA(0, 1), a2 + hstepA, voffA1);
            PG8_WAIT_L(8); PG8_BAR; PG8_WAIT_L(0); PG8_MMA(0, 0, At, B0); PG8_BAR; PG8_SCHED;
            PG8_LDB(B1, 1, 1); PG8_STAGE(PG8_SB(1, 0), b3, voffB);
            PG8_BAR; PG8_WAIT_L(0); PG8_MMA(0, 1, At, B1); PG8_BAR;
            PG8_LDA(At, 1, 1); PG8_STAGE(PG8_SA(1, 0), a3, voffA);
            PG8_BAR; PG8_WAIT_L(0); PG8_MMA(1, 0, At, B0); PG8_BAR; PG8_SCHED;
            PG8_STAGE(PG8_SB(1, 1), b3 + hstep, voffB);
            PG8_WAIT_V(6); PG8_BAR; PG8_MMA(1, 1, At, B1); PG8_BAR;
            }
        }
        if constexpr (ALIGN_EPI) { if (wr == 0) PG8_BAR; }
        if constexpr (!Epi::AFTER_DRAIN) { E(acc, cur, wr, wc, fr, fq); S.done(cur); }
        if (!has_next) break;
#pragma unroll
        for (int a = 0; a < 2; ++a)
#pragma unroll
            for (int b = 0; b < 2; ++b)
#pragma unroll
                for (int m = 0; m < 4; ++m)
#pragma unroll
                    for (int n = 0; n < 2; ++n) acc[a][b][m][n] = (f32x4){0.f, 0.f, 0.f, 0.f};
        cur = nxt; cA = nA; cB = nB; ++ui;
        if constexpr (ALIGN_EPI) { if (wr == 1) PG8_BAR; }
    }
    PG8_WAIT_V(0);
    if constexpr (!ALIGN_EPI) { if (wr == 0) PG8_BAR; }
    PG8_BAR;
    if constexpr (Epi::AFTER_DRAIN) { E.fused(acc, cur, wr, wc, fr, fq, lds, wid, lane); S.done(cur); }
#undef PG8_SA
#undef PG8_SB
#undef PG8_STAGE
#undef PG8_LDA
#undef PG8_LDB
#undef PG8_MMA
#undef PG8_WAIT_V
#undef PG8_WAIT_L
#undef PG8_BAR
#undef PG8_SCHED
}
}
namespace pg8 {
struct EpiF32 {
    static constexpr bool PERM = false, AFTER_DRAIN = false;
    float* O; int ldc;
    __device__ __forceinline__ void operator()(const f32x4 (&acc)[2][2][4][2], const Unit& u, int wr, int wc, int fr, int fq) const {
        const int row0 = u.pm * BM + wr * 64 + fr, col0 = u.pn * BM + wc * 32 + 4 * fq;
#pragma unroll
        for (int ai = 0; ai < 2; ++ai)
#pragma unroll
            for (int m = 0; m < 4; ++m) { float* rowp = O + (size_t)(row0 + ai * HALF + m * 16) * ldc + col0;
#pragma unroll
                for (int bj = 0; bj < 2; ++bj)
#pragma unroll
                    for (int n = 0; n < 2; ++n) *(f32x4*)(rowp + bj * HALF + n * 16) = acc[ai][bj][m][n]; }
    }
};
}
namespace pg8 {
struct EpiU {
    static constexpr bool PERM = true, AFTER_DRAIN = false;
    bf16_t* Ur; bf16_t* Ua;
    __device__ __forceinline__ void operator()(const f32x4 (&acc)[2][2][4][2], const Unit& u, int wr, int wc, int fr, int fq) const {
        const int row0 = u.pm * BM + wr * 64 + fr; int colt = u.pn * BM; bf16_t* base = Ur; int ld = 1792;
        if (colt >= 1792) { base = Ua; ld = 1536; colt -= 1792; }
        const int col0 = colt + wc * 32 + 8 * fq;
#pragma unroll
        for (int ai = 0; ai < 2; ++ai)
#pragma unroll
            for (int m = 0; m < 4; ++m) { bf16_t* rowp = base + (size_t)(row0 + ai * HALF + m * 16) * ld + col0;
#pragma unroll
                for (int bj = 0; bj < 2; ++bj) { const f32x4 v0 = acc[ai][bj][m][0], v1 = acc[ai][bj][m][1];
                    u32x4 w; w.x = cvt_pk_bf16(v0[0], v0[1]); w.y = cvt_pk_bf16(v0[2], v0[3]); w.z = cvt_pk_bf16(v1[0], v1[1]); w.w = cvt_pk_bf16(v1[2], v1[3]);
                    *(u32x4*)(rowp + bj * HALF) = w; } }
    }
};
}
namespace pg8 {
struct EpiB16 {
    static constexpr bool PERM = true, AFTER_DRAIN = false;
    bf16_t* O; int ldc;
    __device__ __forceinline__ void operator()(const f32x4 (&acc)[2][2][4][2], const Unit& u, int wr, int wc, int fr, int fq) const {
        const int row0 = u.pm * BM + wr * 64 + fr, col0 = u.pn * BM + wc * 32 + 8 * fq;
#pragma unroll
        for (int ai = 0; ai < 2; ++ai)
#pragma unroll
            for (int m = 0; m < 4; ++m) { bf16_t* rowp = O + (size_t)(row0 + ai * HALF + m * 16) * ldc + col0;
#pragma unroll
                for (int bj = 0; bj < 2; ++bj) { const f32x4 v0 = acc[ai][bj][m][0], v1 = acc[ai][bj][m][1];
                    u32x4 w; w.x = cvt_pk_bf16(v0[0], v0[1]); w.y = cvt_pk_bf16(v0[2], v0[3]); w.z = cvt_pk_bf16(v1[0], v1[1]); w.w = cvt_pk_bf16(v1[2], v1[3]);
                    *(u32x4*)(rowp + bj * HALF) = w; } }
    }
};
}
namespace mk {
#define GAS __attribute__((address_space(1)))
#define LAS __attribute__((address_space(3)))
typedef unsigned short bf16;
typedef unsigned v4u __attribute__((ext_vector_type(4)));
typedef unsigned v2u __attribute__((ext_vector_type(2)));
typedef float f32x4 __attribute__((ext_vector_type(4)));
typedef float f32x16 __attribute__((ext_vector_type(16)));
typedef short bf16x8 __attribute__((ext_vector_type(8)));
typedef GAS unsigned gu32;
typedef GAS unsigned long long gu64;
#define RLX_AGENT __ATOMIC_RELAXED, __HIP_MEMORY_SCOPE_AGENT
#define LDS_WAIT() asm volatile("s_waitcnt lgkmcnt(0)" ::: "memory")
#define VM_WAIT() asm volatile("s_waitcnt vmcnt(0)" ::: "memory")

constexpr int NB = 4, SEQ = 4096, NM = 16, L = 4112, LP = 4160, TP = NB * LP, D = 1024;
constexpr int NCH = LP / 64;
constexpr int UR_W = 1792, UA_W = 1536, IN_N = 3328, IN_COLS = 3144;
constexpr int NWAVES = 8, NTHR = 512;
constexpr float LN_EPS = 1e-5f, RMS_EPS = 1e-6f, GN_EPS = 64e-5f;
constexpr float DN_ALPHA = 1.189207115002721f;

typedef float f32x2_t __attribute__((ext_vector_type(2))); typedef __bf16 bf16x2_t __attribute__((ext_vector_type(2)));
__device__ __forceinline__ unsigned pk2(float lo, float hi) { f32x2_t v = {lo, hi}; bf16x2_t b = __builtin_convertvector(v, bf16x2_t); return __builtin_bit_cast(unsigned, b); }
__device__ __forceinline__ unsigned f2bf(float f) { return pk2(f, f) & 0xffffu; }
__device__ __forceinline__ float bf2f(unsigned short b) { return __uint_as_float(((unsigned)b) << 16); }
__device__ __forceinline__ float bflo(unsigned w) { return __uint_as_float(w << 16); }
__device__ __forceinline__ float bfhi(unsigned w) { return __uint_as_float(w & 0xffff0000u); }
__device__ __forceinline__ float dpp_f(float v, int ctrl_sel) {
    const int x = __float_as_int(v); int r;
    if (ctrl_sel == 0) r = __builtin_amdgcn_mov_dpp(x, 0xB1, 0xF, 0xF, true);
    else if (ctrl_sel == 1) r = __builtin_amdgcn_mov_dpp(x, 0x4E, 0xF, 0xF, true);
    else if (ctrl_sel == 2) r = __builtin_amdgcn_mov_dpp(x, 0x141, 0xF, 0xF, true);
    else r = __builtin_amdgcn_mov_dpp(x, 0x140, 0xF, 0xF, true);
    return __int_as_float(r);
}
__device__ __forceinline__ float sum_x16(float v) { auto rr = __builtin_amdgcn_permlane16_swap(__float_as_uint(v), __float_as_uint(v), false, false); return __uint_as_float(rr[0]) + __uint_as_float(rr[1]); }
__device__ __forceinline__ float sum_x32(float v) { auto rr = __builtin_amdgcn_permlane32_swap(__float_as_uint(v), __float_as_uint(v), false, false); return __uint_as_float(rr[0]) + __uint_as_float(rr[1]); }
__device__ __forceinline__ int isum_x16(int v) { auto rr = __builtin_amdgcn_permlane16_swap((unsigned)v, (unsigned)v, false, false); return (int)(rr[0] + rr[1]); }
__device__ __forceinline__ int isum_x32(int v) { auto rr = __builtin_amdgcn_permlane32_swap((unsigned)v, (unsigned)v, false, false); return (int)(rr[0] + rr[1]); }
__device__ __forceinline__ unsigned or_x16(unsigned v) { auto rr = __builtin_amdgcn_permlane16_swap(v, v, false, false); return rr[0] | rr[1]; }
__device__ __forceinline__ unsigned or_x32(unsigned v) { auto rr = __builtin_amdgcn_permlane32_swap(v, v, false, false); return rr[0] | rr[1]; }
__device__ __forceinline__ float sum8(float v) { v += dpp_f(v, 0); v += dpp_f(v, 1); v += dpp_f(v, 2); return v; }
__device__ __forceinline__ float wave_sum(float v) { v = sum8(v); v += dpp_f(v, 3); v = sum_x16(v); return sum_x32(v); }

constexpr size_t MiB = 1u << 20;
constexpr size_t WS_CTL = 0, CTL_ZERO_BYTES = 64 * 1024;
constexpr int CW_BAR = 1024;
constexpr size_t WS_ROPEQ = 1 * MiB;
constexpr size_t WS_ROPEI = WS_ROPEQ + (size_t)LP * 32 * 8;
constexpr size_t WS_ROWSTAT = WS_ROPEI + (size_t)LP * 16 * 8;
constexpr size_t WS_WIN = 3 * MiB;
constexpr size_t WS_WOUT = WS_WIN + (size_t)IN_N * 1024 * 2;
constexpr size_t WS_WQ = WS_WOUT + (size_t)1024 * 1024 * 2;
constexpr size_t WS_WW2 = WS_WQ + (size_t)1024 * 256 * 2;
constexpr size_t WS_WA2 = WS_WW2 + (size_t)512 * 64 * 2;
constexpr size_t WS_WG2 = WS_WA2 + (size_t)512 * 64 * 2;
constexpr size_t WS_WEND = WS_WG2 + (size_t)512 * 128 * 2;
static_assert(WS_WEND <= 13 * MiB, "weights region");

constexpr int RING_BYTES = 131072;
constexpr int LDS_BYTES = 147456;
constexpr int MISC_OFF = LDS_BYTES - 16;
#define XB_TMO      128
#define XB_XCNT(j)  (256  + 64 * (j))
#define XB_XSUB(j)  (1280 + 64 * (j))
#define XB_XGEN(j)  (2304 + 64 * (j))
#define XB_TOP      3328
#define XB_TOPGEN   3392
#define XCD_BAR_WORDS 3456
#define XB_SPIN_CAP (1u << 18)

__device__ __forceinline__ unsigned xb_ld(unsigned* p)              { return __hip_atomic_load(p, __ATOMIC_RELAXED, __HIP_MEMORY_SCOPE_AGENT); }
__device__ __forceinline__ unsigned xb_add(unsigned* p, unsigned v) { return __hip_atomic_fetch_add(p, v, __ATOMIC_RELAXED, __HIP_MEMORY_SCOPE_AGENT); }
__device__ __forceinline__ unsigned xb_xcc_id() { return (unsigned)__builtin_amdgcn_s_getreg((3 << 11) | 20) & 0xFu; }
#define XB_SPIN(cond, bar) do { unsigned _sp = 0; while (cond) { __builtin_amdgcn_s_sleep(1); \
    if ((++_sp & 255u) == 0u) { if (xb_ld(&(bar)[XB_TMO])) break; if (_sp > XB_SPIN_CAP) { atomicAdd(&(bar)[XB_TMO], 1u); break; } } } } while (0)

struct XcdBarrier {
    unsigned* bar; unsigned x;
    volatile LAS unsigned* st;
};

__device__ __forceinline__ XcdBarrier xcd_barrier_post(unsigned* bar, volatile LAS unsigned* st) {
    XcdBarrier b; b.bar = bar; b.x = xb_xcc_id(); b.st = st;
    if (threadIdx.x == 0) (void)xb_add(&bar[XB_XCNT(b.x)], 1u);
    return b;
}
__device__ __forceinline__ void xcd_barrier_complete(unsigned* bar, unsigned x, unsigned& nloc, unsigned& nx) {
    const unsigned G = gridDim.x * gridDim.y * gridDim.z;
    unsigned sum, cnt, mine, sp = 0u;
    for (;;) {
        sum = 0u; cnt = 0u; mine = 0u;
#pragma unroll
        for (unsigned j = 0; j < 16; ++j) { const unsigned c = xb_ld(&bar[XB_XCNT(j)]); sum += c; cnt += (c > 0u) ? 1u : 0u; mine = (j == x) ? c : mine; }
        if (sum == G) break;
        __builtin_amdgcn_s_sleep(1);
        if ((++sp & 255u) == 0u) { if (xb_ld(&bar[XB_TMO])) break; if (sp > XB_SPIN_CAP) { atomicAdd(&bar[XB_TMO], 1u); break; } }
    }
    nloc = mine > 0u ? mine : 1u; nx = cnt > 0u ? cnt : 1u;
}

__device__ __forceinline__ void xcd_barrier(const XcdBarrier& b) {
    asm volatile("s_waitcnt vmcnt(0)" ::: "memory");
    __syncthreads();
    if (threadIdx.x == 0) {
        unsigned* bar = b.bar;
        __builtin_amdgcn_s_waitcnt(0);
        unsigned nloc = b.st[0], nx = b.st[1];
        if (nloc == 0u) { xcd_barrier_complete(bar, b.x, nloc, nx); b.st[0] = nloc; b.st[1] = nx; }
        const unsigned old = xb_add(&bar[XB_XSUB(b.x)], 1u);
        const unsigned gen = old / nloc;
        if (old + 1u == (gen + 1u) * nloc) {
            __builtin_amdgcn_fence(__ATOMIC_RELEASE, "agent");
            asm volatile("s_waitcnt vmcnt(0)" ::: "memory");
            const unsigned og = xb_add(&bar[XB_TOP], 1u);
            const unsigned tg = og / nx;
            if (og + 1u == (tg + 1u) * nx) xb_add(&bar[XB_TOPGEN], 1u);
            else XB_SPIN(xb_ld(&bar[XB_TOPGEN]) == tg, bar);
            __builtin_amdgcn_fence(__ATOMIC_ACQUIRE, "agent");
            xb_add(&bar[XB_XGEN(b.x)], 1u);
            asm volatile("s_waitcnt vmcnt(0)" ::: "memory");
        } else {
            XB_SPIN(xb_ld(&bar[XB_XGEN(b.x)]) == gen, bar);
            __builtin_amdgcn_fence(__ATOMIC_ACQUIRE, "agent");
            asm volatile("s_waitcnt vmcnt(0)" ::: "memory");
        }
    }
    __syncthreads();
}
struct Args {
    const float* in[33]; float* out; unsigned char* ws; int ph_lo, ph_hi; int flags, pad_;
};
struct Frame {
    LAS unsigned char* lds;
    int tid, lane, wave, G, bid;
    unsigned char* ws;
};

__device__ __forceinline__ int rowmap_in(int n) {
    if (n >= 2048 && n < 2560) { const int d = (n - 2048) & 63, base = n - d; return base + (d < 32 ? 2 * d : 2 * (d - 32) + 1); }
    if (n >= 3072 && n < 3136) { const int d = n - 3072; return 3072 + (d < 16 ? 2 * d : (d < 32 ? 2 * (d - 16) + 1 : d)); }
    return n;
}
template <int MODE> __device__ __forceinline__ int rowmap(int n) {
    if (MODE == 1) return rowmap_in(n);
    if (MODE == 2) { const int d = n & 63, base = n - d; return base + (d < 32 ? 2 * d : 2 * (d - 32) + 1); }
    if (MODE == 4) return 2 * n;
    if (MODE == 3) { const int d = n & 63, base = n - d; return base + (d < 16 ? 2 * d : (d < 32 ? 2 * (d - 16) + 1 : d)); }
    return n;
}
template <int MODE> __device__ __forceinline__ void transpose_item(const float* __restrict__ W, int K, int N, bf16* WT, int row_off, LAS float* scr, int item, int nblk, int lane) {
    const int kb = item / nblk, nb = item % nblk, k0 = 64 * kb, n0 = 32 * nb;
    const int n = n0 + (lane & 31);
    float tv[32];
#pragma unroll
    for (int i = 0; i < 32; ++i) { const int kk = 2 * i + (lane >> 5); tv[i] = (n < N) ? W[(size_t)(k0 + kk) * N + n] : 0.f; }
#pragma unroll
    for (int i = 0; i < 32; ++i) { const int kk = 2 * i + (lane >> 5); scr[kk * 33 + (lane & 31)] = tv[i]; }
    LDS_WAIT(); asm volatile("" ::: "memory");
    const int c = lane & 7;
#pragma unroll
    for (int j = 0; j < 4; ++j) { const int nl = (lane >> 3) + 8 * j; const LAS float* s = scr + (8 * c) * 33 + nl;
        v4u o; o.x = pk2(s[0 * 33], s[1 * 33]); o.y = pk2(s[2 * 33], s[3 * 33]); o.z = pk2(s[4 * 33], s[5 * 33]); o.w = pk2(s[6 * 33], s[7 * 33]);
        *(v4u*)(WT + (size_t)(row_off + rowmap<MODE>(n0 + nl)) * K + k0 + 8 * c) = o; }
    LDS_WAIT(); asm volatile("" ::: "memory");
}
__device__ __forceinline__ void p0_ln_row(const Args& a, int pr, bf16* H0b, float2* rowstat, int lane) {
    const int b = pr / LP, t = pr % LP;
    unsigned long long* o8 = (unsigned long long*)(H0b + (size_t)pr * D) + lane;
    if (t >= L) {
#pragma unroll
        for (int j = 0; j < 4; ++j) o8[64 * j] = 0ull;
        if (lane == 0) rowstat[pr] = make_float2(0.f, 0.f);
        return;
    }
    const float* src = (t < NM) ? (a.in[1] + (size_t)t * D) : (a.in[0] + ((size_t)b * SEQ + (t - NM)) * D);
    const f32x4* xr = (const f32x4*)src + lane;
    f32x4 v[4]; float s = 0.f;
#pragma unroll
    for (int j = 0; j < 4; ++j) { v[j] = xr[64 * j]; s += (v[j].x + v[j].y) + (v[j].z + v[j].w); }
    const float mean = wave_sum(s) * (1.f / D); float s2 = 0.f;
#pragma unroll
    for (int j = 0; j < 4; ++j) { v[j] = v[j] - mean; s2 += (v[j].x * v[j].x + v[j].y * v[j].y) + (v[j].z * v[j].z + v[j].w * v[j].w); }
    const float rstd = 1.f / sqrtf(wave_sum(s2) * (1.f / D) + LN_EPS);
    const f32x4* gp = (const f32x4*)a.in[2] + lane; const f32x4* bp = (const f32x4*)a.in[3] + lane;
#pragma unroll
    for (int j = 0; j < 4; ++j) { const f32x4 g = gp[64 * j], bb = bp[64 * j]; const f32x4 y = v[j] * rstd * g + bb;
        o8[64 * j] = (unsigned long long)pk2(y.x, y.y) | ((unsigned long long)pk2(y.z, y.w) << 32); }
    if (lane == 0) rowstat[pr] = make_float2(mean, rstd);
}
__device__ __forceinline__ void p0_prologue(const Frame& F, const Args& a, bf16* H0b) {
    LAS float* scr = (LAS float*)(F.lds + F.wave * 16384);
    const int gw = F.bid * NWAVES + F.wave, NGW = F.G * NWAVES;
    bf16* Wt_in = (bf16*)(F.ws + WS_WIN); bf16* Wt_out = (bf16*)(F.ws + WS_WOUT); bf16* Wt_q = (bf16*)(F.ws + WS_WQ);
    bf16* Wt_w2 = (bf16*)(F.ws + WS_WW2); bf16* Wt_a2 = (bf16*)(F.ws + WS_WA2); bf16* Wt_g2 = (bf16*)(F.ws + WS_WG2);
    constexpr int I_IN = 16 * (IN_N / 32), I_OUT = 16 * 32, I_Q = 4 * 16, I_W2 = 1 * 16, I_G2 = 2 * 16;
    constexpr int NITEMS = I_IN + I_OUT + 2 * I_Q + 2 * I_W2 + I_G2;
    for (int it = gw; it < NITEMS; it += NGW) {
        int r = it;
        if (r < I_IN) { transpose_item<1>(a.in[4], 1024, IN_COLS, Wt_in, 0, scr, r, IN_N / 32, F.lane); continue; } r -= I_IN;
        if (r < I_OUT) { transpose_item<0>(a.in[21], 1024, 1024, Wt_out, 0, scr, r, 32, F.lane); continue; } r -= I_OUT;
        if (r < I_Q) { transpose_item<2>(a.in[17], 256, 512, Wt_q, 0, scr, r, 16, F.lane); continue; } r -= I_Q;
        if (r < I_Q) { transpose_item<3>(a.in[18], 256, 512, Wt_q, 512, scr, r, 16, F.lane); continue; } r -= I_Q;
        if (r < I_W2) { transpose_item<0>(a.in[7], 64, 512, Wt_w2, 0, scr, r, 16, F.lane); continue; } r -= I_W2;
        if (r < I_W2) { transpose_item<0>(a.in[9], 64, 512, Wt_a2, 0, scr, r, 16, F.lane); continue; } r -= I_W2;
        transpose_item<0>(a.in[10], 128, 512, Wt_g2, 0, scr, r, 16, F.lane);
    }
    float2* rowstat = (float2*)(F.ws + WS_ROWSTAT);
    for (int pr = gw; pr < TP; pr += NGW) p0_ln_row(a, pr, H0b, rowstat, F.lane);
    float2* rq = (float2*)(F.ws + WS_ROPEQ); float2* ri = (float2*)(F.ws + WS_ROPEI);
    const int gt = F.bid * NTHR + F.tid, NGT = F.G * NTHR;
    for (int i = gt; i < LP * 48; i += NGT) {
        if (i < LP * 32) { const int t = i >> 5, d = i & 31; const float ang = (float)t * exp2f(-(float)d * (13.287712379549449f / 32.f)); float sn, cs; sincosf(ang, &sn, &cs); rq[i] = make_float2(cs, sn); }
        else { const int j = i - LP * 32, t = j >> 4, d = j & 15; const float ang = (float)t * exp2f(-(float)d * (13.287712379549449f / 16.f)); float sn, cs; sincosf(ang, &sn, &cs); ri[j] = make_float2(cs, sn); }
    }
}
constexpr int LDM = 72;
constexpr int SLOT = 64 * LDM * 2;
constexpr int LDG = 136;
constexpr int RW_LW_OFF = 0 * SLOT;
constexpr int RW_LA_OFF = 4 * SLOT;
constexpr int RW_LG_OFF = 2 * SLOT;
static_assert(64 * LDG * 2 <= 2 * SLOT, "Lg fits in two slots");
constexpr int RW_A_OFF = 8 * SLOT;
constexpr int RW_G_OFF = RW_A_OFF + 16384;
constexpr int RW_CS_OFF = RW_G_OFF + 8192;
constexpr int RW_SEG_OFF = RW_CS_OFF + 16384;
constexpr int RW_GC_OFF = 13 * SLOT;
static_assert(RW_SEG_OFF + 2048 <= RW_GC_OFF, "rwkv LDS map");
constexpr size_t RW_UNIT_M = 4096 * 2, RW_UNIT_N = 4096 * 4, RW_UNIT_X = 4096 * 2;
constexpr int NUNIT = NB * NCH * 8;

struct RwkvBufs { bf16* M; float* N; bf16* Q; bf16* OP; bf16* G1; bf16* G2; bf16* HC; };

__device__ __forceinline__ bf16x8 lds_frag(const LAS bf16* base, int row, int koff) { return *(const LAS bf16x8*)(base + row * LDM + koff); }
__device__ __forceinline__ f32x4 mm_tile(const LAS bf16* X, const LAS bf16* Y, int ta, int tb, int lane, f32x4 acc) {
    const int r = lane & 15, ko = 8 * (lane >> 4);
#pragma unroll
    for (int ks = 0; ks < 2; ++ks) {
        const bf16x8 ya = lds_frag(Y, 16 * tb + r, 32 * ks + ko), xb = lds_frag(X, 16 * ta + r, 32 * ks + ko);
        acc = __builtin_amdgcn_mfma_f32_16x16x32_bf16(ya, xb, acc, 0, 0, 0);
    }
    return acc;
}
__device__ __forceinline__ void st_r(LAS bf16* dst, int a, int b0, f32x4 v) {
    v2u w; w.x = pk2(v[0], v[1]); w.y = pk2(v[2], v[3]); *(LAS v2u*)(dst + a * LDM + b0) = w;
}
__device__ __forceinline__ void st_t(LAS bf16* dst, int a, int b0, f32x4 v) {
#pragma unroll
    for (int i = 0; i < 4; ++i) dst[(b0 + i) * LDM + a] = (bf16)f2bf(v[i]);
}
__device__ __forceinline__ f32x4 ld_r(const LAS bf16* src, int a, int b0) {
    const v2u w = *(const LAS v2u*)(src + a * LDM + b0);
    return (f32x4){bflo(w.x), bfhi(w.x), bflo(w.y), bfhi(w.y)};
}
__device__ __forceinline__ void st8(LAS bf16* dst, const float (&v)[8]) {
    v4u w; w.x = pk2(v[0], v[1]); w.y = pk2(v[2], v[3]); w.z = pk2(v[4], v[5]); w.w = pk2(v[6], v[7]); *(LAS v4u*)dst = w;
}
__device__ __forceinline__ void unpack8(v4u w, float (&o)[8]) {
    o[0] = bflo(w.x); o[1] = bfhi(w.x); o[2] = bflo(w.y); o[3] = bfhi(w.y); o[4] = bflo(w.z); o[5] = bfhi(w.z); o[6] = bflo(w.w); o[7] = bfhi(w.w);
}
__device__ __forceinline__ void ld8f(const float* p, float (&o)[8]) {
    const f32x4 a = *(const f32x4*)p, b = *(const f32x4*)(p + 4);
    o[0] = a.x; o[1] = a.y; o[2] = a.z; o[3] = a.w; o[4] = b.x; o[5] = b.y; o[6] = b.z; o[7] = b.w;
}
__device__ __forceinline__ float sigmoidf_(float x) { return __builtin_amdgcn_rcpf(1.f + __expf(-x)); }
__device__ __forceinline__ float tanhf_(float x) { return 1.f - 2.f * __builtin_amdgcn_rcpf(1.f + __expf(2.f * x)); }

constexpr int RW_WG2_OFF = 13 * SLOT, RW_WB_OFF = 13 * SLOT + 64 * LDG * 2, RW_WW2_OFF = 15 * SLOT, RW_WA2_OFF = 1 * SLOT;
static_assert(RW_WB_OFF + 512 <= 15 * SLOT, "LoRA weights LDS map");
constexpr int RW_MU_OFF = 12 * SLOT;
struct RwW { v4u v[4]; float mu, bias; };
__device__ __forceinline__ void rw_w_fetch(RwW& W, const Frame& F, const Args& a, int h) {
    const bf16* W2 = (const bf16*)(F.ws + WS_WW2); const bf16* A2 = (const bf16*)(F.ws + WS_WA2); const bf16* G2w = (const bf16*)(F.ws + WS_WG2);
    const int t = F.tid;
    W.v[0] = *(const v4u*)(W2 + (size_t)(64 * h + (t >> 3)) * 64 + 8 * (t & 7));
    W.v[1] = *(const v4u*)(A2 + (size_t)(64 * h + (t >> 3)) * 64 + 8 * (t & 7));
    W.v[2] = *(const v4u*)(G2w + (size_t)(64 * h + (t >> 4)) * 128 + 8 * (t & 15));
    W.v[3] = *(const v4u*)(G2w + (size_t)(64 * h + 32 + (t >> 4)) * 128 + 8 * (t & 15));
    W.mu = (t < 192) ? a.in[5][512 * (t >> 6) + 64 * h + (t & 63)] : ((t < 448) ? a.in[5][1536 + (t - 192)] : a.in[11][64 * h + (t - 448)]);
    W.bias = (t < 64) ? a.in[6][64 * h + t] : ((t < 128) ? a.in[8][64 * h + (t - 64)] : 0.f);
}
__device__ __forceinline__ void rw_w_store(const RwW& W, const Frame& F) {
    const int t = F.tid;
    *(LAS v4u*)(F.lds + RW_WW2_OFF + ((t >> 3) * LDM + 8 * (t & 7)) * 2) = W.v[0];
    *(LAS v4u*)(F.lds + RW_WA2_OFF + ((t >> 3) * LDM + 8 * (t & 7)) * 2) = W.v[1];
    *(LAS v4u*)(F.lds + RW_WG2_OFF + ((t >> 4) * LDG + 8 * (t & 15)) * 2) = W.v[2];
    *(LAS v4u*)(F.lds + RW_WG2_OFF + ((32 + (t >> 4)) * LDG + 8 * (t & 15)) * 2) = W.v[3];
    if (t < 128) *(LAS float*)(F.lds + RW_WB_OFF + 4 * t) = W.bias;
    *(LAS float*)(F.lds + RW_MU_OFF + 4 * t) = W.mu;
}
struct RwRaw { v4u c[7], p[7]; };
__device__ __forceinline__ void rw_load_raw(RwRaw& R, const bf16* __restrict__ Ur, int uidx, int tid) {
    const int h = uidx & 7, bc = uidx >> 3, c = bc % NCH, b = bc / NCH, tau = tid >> 3, q = tid & 7;
    const size_t prow = (size_t)b * LP + (size_t)c * 64 + tau;
    const bool has_prev = (c > 0) || (tau > 0);
    const bf16* ucur = Ur + prow * UR_W; const bf16* uprv = ucur - UR_W;
    const v4u z = {0u, 0u, 0u, 0u};
#pragma unroll
    for (int j = 0; j < 7; ++j) { const int col = (j < 3) ? (512 * j + 64 * h + 8 * q) : (1536 + 64 * (j - 3) + 8 * q);
        R.c[j] = *(const v4u*)(ucur + col); R.p[j] = has_prev ? *(const v4u*)(uprv + col) : z; }
}
__device__ __forceinline__ void rwkv_unit(const Frame& F, const Args& a, const bf16* __restrict__ Ur, const RwkvBufs& RB, int uidx, RwRaw& R, int unext) {
    const int h = uidx & 7, bc = uidx >> 3, c = bc % NCH, b = bc / NCH;
    const int tid = F.tid, lane = F.lane, w = F.wave;
    LAS unsigned char* lds = F.lds;
#define MAT(i) ((LAS bf16*)(lds + (i) * SLOT))
    LAS bf16 *Rg = MAT(0), *Kg = MAT(1), *KgT = MAT(2), *Bi = MAT(3), *nBiT = MAT(4), *Ki = MAT(5), *KiT = MAT(6), *VT = MAT(7);
    LAS bf16 *Akk = MAT(8), *nArb = MAT(9), *Ark = MAT(10), *Pa = MAT(11), *PaT = MAT(12), *Pb = MAT(13), *PbT = MAT(14), *Ta = MAT(15), *Tb = MAT(1);
    LAS bf16 *AVT = MAT(3), *WuT = MAT(5), *UvT = MAT(8);
    LAS bf16* Lw = (LAS bf16*)(lds + RW_LW_OFF); LAS bf16* La = (LAS bf16*)(lds + RW_LA_OFF); LAS bf16* Lg = (LAS bf16*)(lds + RW_LG_OFF);
    LAS float* Af = (LAS float*)(lds + RW_A_OFF); LAS bf16* Gb = (LAS bf16*)(lds + RW_G_OFF); LAS float* CS = (LAS float*)(lds + RW_CS_OFF);
    LAS float* gC = (LAS float*)(lds + RW_GC_OFF); LAS float* SEG = (LAS float*)(lds + RW_SEG_OFF);
    const float* mu = a.in[5];
    const int ta = w >> 1, ar = 16 * ta + (lane & 15), ko = 8 * (lane >> 4);
    const int tau = tid >> 3, q = tid & 7;
    float r8[8], k8[8], v8[8], kk8[8];
    {
        float cu[8], pv[8], m8[8];
        const int ch0 = 64 * h + 8 * q;
        const LAS float* MUL = (const LAS float*)(lds + RW_MU_OFF);
#define RW_LD8L(p_, o_) do { const f32x4 x0_ = *(const LAS f32x4*)(p_), x1_ = *(const LAS f32x4*)((p_) + 4); o_[0] = x0_.x; o_[1] = x0_.y; o_[2] = x0_.z; o_[3] = x0_.w; o_[4] = x1_.x; o_[5] = x1_.y; o_[6] = x1_.z; o_[7] = x1_.w; } while (0)
        unpack8(R.c[0], cu); unpack8(R.p[0], pv);
        RW_LD8L(MUL + 8 * q, m8);
#pragma unroll
        for (int i = 0; i < 8; ++i) r8[i] = cu[i] + (pv[i] - cu[i]) * m8[i];
        unpack8(R.c[1], cu); unpack8(R.p[1], pv);
        RW_LD8L(MUL + 64 + 8 * q, m8);
#pragma unroll
        for (int i = 0; i < 8; ++i) k8[i] = cu[i] + (pv[i] - cu[i]) * m8[i];
        unpack8(R.c[2], cu); unpack8(R.p[2], pv);
        RW_LD8L(MUL + 128 + 8 * q, m8);
#pragma unroll
        for (int i = 0; i < 8; ++i) v8[i] = cu[i] + (pv[i] - cu[i]) * m8[i];
        float kkc[8]; RW_LD8L(MUL + 448 + 8 * q, kkc);
        float ss = 0.f;
#pragma unroll
        for (int i = 0; i < 8; ++i) { kk8[i] = k8[i] * kkc[i]; ss += kk8[i] * kk8[i]; }
        ss = sum8(ss);
        const float inv = 1.f / fmaxf(sqrtf(ss), 1e-12f);
#pragma unroll
        for (int i = 0; i < 8; ++i) kk8[i] *= inv;
#pragma unroll
        for (int i = 0; i < 4; ++i) {
            const int col = 1536 + 64 * i + 8 * q;
            unpack8(R.c[3 + i], cu); unpack8(R.p[3 + i], pv);
            RW_LD8L(MUL + 192 + 64 * i + 8 * q, m8);
            float o[8];
#pragma unroll
            for (int e = 0; e < 8; ++e) { const float x = cu[e] + (pv[e] - cu[e]) * m8[e]; o[e] = (i == 0) ? tanhf_(x) : (i == 1 ? x : sigmoidf_(x)); }
            if (i == 0) st8(Lw + tau * LDM + 8 * q, o);
            else if (i == 1) st8(La + tau * LDM + 8 * q, o);
            else st8(Lg + tau * LDG + 64 * (i - 2) + 8 * q, o);
        }
    }
    LDS_WAIT(); __syncthreads();
    {
        const LAS bf16* W2L = (const LAS bf16*)(lds + RW_WW2_OFF); const LAS bf16* A2L = (const LAS bf16*)(lds + RW_WA2_OFF); const LAS bf16* G2L = (const LAS bf16*)(lds + RW_WG2_OFF);
#pragma unroll 1
        for (int tt = 0; tt < 2; ++tt) {
            const int tb = 2 * (w & 1) + tt, b0 = 16 * tb + 4 * (lane >> 4), chl = 16 * tb + (lane & 15);
            f32x4 aw = {0.f, 0.f, 0.f, 0.f}, aa = aw, ag = aw;
#pragma unroll
            for (int ks = 0; ks < 2; ++ks) {
                const bf16x8 yw = *(const LAS bf16x8*)(W2L + chl * LDM + 32 * ks + ko), ya = *(const LAS bf16x8*)(A2L + chl * LDM + 32 * ks + ko);
                const bf16x8 xw = *(const LAS bf16x8*)(Lw + ar * LDM + 32 * ks + ko), xa = *(const LAS bf16x8*)(La + ar * LDM + 32 * ks + ko);
                aw = __builtin_amdgcn_mfma_f32_16x16x32_bf16(yw, xw, aw, 0, 0, 0);
                aa = __builtin_amdgcn_mfma_f32_16x16x32_bf16(ya, xa, aa, 0, 0, 0);
            }
#pragma unroll
            for (int ks = 0; ks < 4; ++ks) {
                const bf16x8 yg = *(const LAS bf16x8*)(G2L + chl * LDG + 32 * ks + ko);
                const bf16x8 xg = *(const LAS bf16x8*)(Lg + ar * LDG + 32 * ks + ko);
                ag = __builtin_amdgcn_mfma_f32_16x16x32_bf16(yg, xg, ag, 0, 0, 0);
            }
            const f32x4 w0v = *(const LAS f32x4*)(lds + RW_WB_OFF + 4 * b0), a0v = *(const LAS f32x4*)(lds + RW_WB_OFF + 256 + 4 * b0);
            f32x4 lw, av;
#pragma unroll
            for (int i = 0; i < 4; ++i) {
                const float xw = -(w0v[i] + aw[i]);
                const float sp = (xw > 20.f) ? xw : __logf(1.f + __expf(xw));
                lw[i] = -__expf(-sp - 0.5f);
                av[i] = sigmoidf_(a0v[i] + aa[i]);
            }
            *(LAS f32x4*)(CS + ar * 64 + b0) = lw;
            *(LAS f32x4*)(Af + ar * 64 + b0) = av;
            v2u gw; gw.x = pk2(ag[0], ag[1]); gw.y = pk2(ag[2], ag[3]); *(LAS v2u*)(Gb + ar * 64 + b0) = gw;
        }
    }
    float kac[8], rkc[8], lng[8], lnb[8];
    { const int ch0_ = 64 * h + 8 * (tid & 7); ld8f(a.in[12] + ch0_, kac); ld8f(a.in[13] + ch0_, rkc); ld8f(a.in[14] + ch0_, lng); ld8f(a.in[15] + ch0_, lnb); }
    LDS_WAIT(); __syncthreads();
    {
        const int j = tid & 63, sg = tid >> 6;
        float run = 0.f;
#pragma unroll
        for (int i = 0; i < 8; ++i) { run += CS[(8 * sg + i) * 64 + j]; CS[(8 * sg + i) * 64 + j] = run; }
        SEG[sg * 64 + j] = run;
        LDS_WAIT(); __syncthreads();
        float off = 0.f;
        for (int s = 0; s < sg; ++s) off += SEG[s * 64 + j];
#pragma unroll
        for (int i = 0; i < 8; ++i) CS[(8 * sg + i) * 64 + j] += off;
    }
    LDS_WAIT(); __syncthreads();
    {
        float cs[8], csp[8], av[8], gt[8];
        { const LAS f32x4* p = (const LAS f32x4*)(CS + tau * 64 + 8 * q); const f32x4 x0 = p[0], x1 = p[1];
          cs[0] = x0.x; cs[1] = x0.y; cs[2] = x0.z; cs[3] = x0.w; cs[4] = x1.x; cs[5] = x1.y; cs[6] = x1.z; cs[7] = x1.w; }
        if (tau > 0) { const LAS f32x4* p = (const LAS f32x4*)(CS + (tau - 1) * 64 + 8 * q); const f32x4 x0 = p[0], x1 = p[1];
          csp[0] = x0.x; csp[1] = x0.y; csp[2] = x0.z; csp[3] = x0.w; csp[4] = x1.x; csp[5] = x1.y; csp[6] = x1.z; csp[7] = x1.w; }
        else {
#pragma unroll
          for (int i = 0; i < 8; ++i) csp[i] = 0.f; }
        { const LAS f32x4* p = (const LAS f32x4*)(Af + tau * 64 + 8 * q); const f32x4 x0 = p[0], x1 = p[1];
          av[0] = x0.x; av[1] = x0.y; av[2] = x0.z; av[3] = x0.w; av[4] = x1.x; av[5] = x1.y; av[6] = x1.z; av[7] = x1.w; }
        unpack8(*(const LAS v4u*)(Gb + tau * 64 + 8 * q), gt);
        float o_rg[8], o_kg[8], o_bi[8], o_ki[8];
        float bon = 0.f;
#pragma unroll
        for (int i = 0; i < 8; ++i) {
            const float g = __expf(cs[i]), gi = __expf(-cs[i]), gm = __expf(csp[i]);
            o_rg[i] = r8[i] * g; o_kg[i] = kk8[i] * gm;
            const float bb = kk8[i] * av[i]; o_bi[i] = bb * gi;
            const float kt = k8[i] * (1.f + (av[i] - 1.f) * kac[i]); o_ki[i] = kt * gi;
            bon += r8[i] * kt * rkc[i];
            if (tau == 63) gC[8 * q + i] = g;
        }
        bon = sum8(bon);
        st8(Rg + tau * LDM + 8 * q, o_rg); st8(Kg + tau * LDM + 8 * q, o_kg); st8(Bi + tau * LDM + 8 * q, o_bi); st8(Ki + tau * LDM + 8 * q, o_ki);
#pragma unroll
        for (int i = 0; i < 8; ++i) {
            const int j = 8 * q + i;
            KgT[j * LDM + tau] = (bf16)f2bf(o_kg[i]); nBiT[j * LDM + tau] = (bf16)f2bf(-o_bi[i]); KiT[j * LDM + tau] = (bf16)f2bf(o_ki[i]); VT[j * LDM + tau] = (bf16)f2bf(v8[i]);
        }
        float g1[8], g2[8];
#pragma unroll
        for (int i = 0; i < 8; ++i) { g1[i] = lng[i] * gt[i]; g2[i] = (lnb[i] + bon * v8[i]) * gt[i]; }
        v4u w1; w1.x = pk2(g1[0], g1[1]); w1.y = pk2(g1[2], g1[3]); w1.z = pk2(g1[4], g1[5]); w1.w = pk2(g1[6], g1[7]);
        v4u w2; w2.x = pk2(g2[0], g2[1]); w2.y = pk2(g2[2], g2[3]); w2.z = pk2(g2[4], g2[5]); w2.w = pk2(g2[6], g2[7]);
        *(v4u*)(RB.G1 + (size_t)uidx * 4096 + tau * 64 + 8 * q) = w1;
        *(v4u*)(RB.G2 + (size_t)uidx * 4096 + tau * 64 + 8 * q) = w2;
    }
    LDS_WAIT(); __syncthreads();
    const f32x4 zero4 = {0.f, 0.f, 0.f, 0.f};
    const float gj = gC[ar];
    if (unext >= 0) rw_load_raw(R, Ur, unext, tid);
#pragma unroll 1
    for (int tt = 0; tt < 2; ++tt) {
        const int tb = 2 * (w & 1) + tt, b0 = 16 * tb + 4 * (lane >> 4);
        f32x4 zkb = mm_tile(Kg, Bi, ta, tb, lane, zero4), zkk = mm_tile(Kg, Ki, ta, tb, lane, zero4);
        f32x4 zrb = mm_tile(Rg, Bi, ta, tb, lane, zero4), zrk = mm_tile(Rg, Ki, ta, tb, lane, zero4);
        f32x4 p0, t0;
#pragma unroll
        for (int i = 0; i < 4; ++i) {
            const int s = b0 + i;
            p0[i] = (s < ar) ? -zkb[i] : 0.f; t0[i] = p0[i] + ((s == ar) ? 1.f : 0.f);
            zkk[i] = (s < ar) ? zkk[i] : 0.f; zrb[i] = (s <= ar) ? -zrb[i] : 0.f; zrk[i] = (s <= ar) ? zrk[i] : 0.f;
        }
        st_r(Pa, ar, b0, p0); st_t(PaT, ar, b0, p0); st_r(Ta, ar, b0, t0); st_r(Akk, ar, b0, zkk); st_r(nArb, ar, b0, zrb); st_r(Ark, ar, b0, zrk);
    }
    LDS_WAIT(); __syncthreads();
#pragma unroll 1
    for (int tt = 0; tt < 2; ++tt) {
        const int tb = 2 * (w & 1) + tt, b0 = 16 * tb + 4 * (lane >> 4);
        const f32x4 p = mm_tile(Pa, PaT, ta, tb, lane, zero4); st_r(Pb, ar, b0, p); st_t(PbT, ar, b0, p);
        const f32x4 av = mm_tile(VT, Akk, ta, tb, lane, zero4); st_r(AVT, ar, b0, av);
    }
    LDS_WAIT(); __syncthreads();
#define RW_SQ_ACC(Pin, PinT, Pout, PoutT, Tin, Tout, DO_SQ) do { _Pragma("unroll 1") for (int tt = 0; tt < 2; ++tt) { \
        const int tb = 2 * (w & 1) + tt, b0 = 16 * tb + 4 * (lane >> 4); \
        if (DO_SQ) { const f32x4 p = mm_tile(Pin, PinT, ta, tb, lane, zero4); st_r(Pout, ar, b0, p); st_t(PoutT, ar, b0, p); } \
        const f32x4 tn = mm_tile(Tin, PinT, ta, tb, lane, ld_r(Tin, ar, b0)); st_r(Tout, ar, b0, tn); } \
        LDS_WAIT(); __syncthreads(); } while (0)
    RW_SQ_ACC(Pb, PbT, Pa, PaT, Ta, Tb, true);
    RW_SQ_ACC(Pa, PaT, Pb, PbT, Tb, Ta, true);
    RW_SQ_ACC(Pb, PbT, Pa, PaT, Ta, Tb, true);
    RW_SQ_ACC(Pa, PaT, Pb, PbT, Tb, Ta, true);
    RW_SQ_ACC(Pb, PbT, Pa, PaT, Ta, Tb, false);
#undef RW_SQ_ACC
#pragma unroll 1
    for (int tt = 0; tt < 2; ++tt) {
        const int tb = 2 * (w & 1) + tt, b0 = 16 * tb + 4 * (lane >> 4);
        st_r(WuT, ar, b0, mm_tile(KgT, Tb, ta, tb, lane, zero4));
        st_r(UvT, ar, b0, mm_tile(AVT, Tb, ta, tb, lane, zero4));
    }
    LDS_WAIT(); __syncthreads();
    RwW Wn; if (unext >= 0) rw_w_fetch(Wn, F, a, unext & 7);
#pragma unroll 1
    for (int tt = 0; tt < 2; ++tt) {
        const int tb = 2 * (w & 1) + tt, b0 = 16 * tb + 4 * (lane >> 4);
        { const f32x4 z = mm_tile(nBiT, WuT, ta, tb, lane, zero4);
          const int m = ar >> 5, rp = ar & 31;
          bf16* Mo = RB.M + (size_t)uidx * 4096;
          float v4[4];
#pragma unroll
          for (int i = 0; i < 4; ++i) { const int jp = b0 + i; v4[i] = gj * (z[i] + ((jp == ar) ? 1.f : 0.f)); }
          { const int kb = b0 >> 5, qq = b0 & 31, s_ = qq >> 4, p = qq & 15, e0 = 4 * (p >> 3), hh = (p >> 2) & 1, ln = rp + 32 * hh;
            v2u w; w.x = pk2(v4[0], v4[1]); w.y = pk2(v4[2], v4[3]);
            *(v2u*)(Mo + ((((m * 2 + kb) * 2 + s_) * 64 + ln) << 3) + e0) = w; } }
        { f32x4 z = mm_tile(KiT, VT, ta, tb, lane, zero4); z = mm_tile(nBiT, UvT, ta, tb, lane, z);
          const int m = ar >> 5, qq = ar & 31, hh = (qq >> 2) & 1, rg = (qq & 3) + 4 * (qq >> 3);
          float* No = RB.N + (size_t)uidx * 4096;
          { const int n = b0 >> 5, cc = b0 & 31; *(f32x4*)(No + ((m * 2 + n) * 16 + rg) * 64 + cc + 32 * hh) = z * gj; } }
        { const f32x4 z = mm_tile(nArb, WuT, ta, tb, lane, ld_r(Rg, ar, b0)); v2u o; o.x = pk2(z[0], z[1]); o.y = pk2(z[2], z[3]);
          *(v2u*)(RB.Q + (size_t)uidx * 4096 + ar * 64 + b0) = o; }
        { f32x4 z = mm_tile(Ark, VT, ta, tb, lane, zero4); z = mm_tile(nArb, UvT, ta, tb, lane, z); v2u o; o.x = pk2(z[0], z[1]); o.y = pk2(z[2], z[3]);
          *(v2u*)(RB.OP + (size_t)uidx * 4096 + ar * 64 + b0) = o; }
    }
    if (unext >= 0) rw_w_store(Wn, F);
    LDS_WAIT(); __syncthreads();
#undef MAT
}

__device__ __forceinline__ void rwkv_scan(const RwkvBufs& RB, int bh, int n, int lane) {
    const int b = bh >> 3, h = bh & 7;
    f32x16 X0, X1;
#pragma unroll
    for (int r = 0; r < 16; ++r) { X0[r] = 0.f; X1[r] = 0.f; }
    const int cc = lane & 31, hh = lane >> 5;
    bf16x8 Mc[2][2][2], Mn[2][2][2]; f32x16 N0, N1, N0n, N1n;
    {
        const int uidx = ((b * NCH) << 3) + h;
        const bf16* Mi = RB.M + (size_t)uidx * 4096; const float* Ni = RB.N + (size_t)uidx * 4096;
#pragma unroll
        for (int m = 0; m < 2; ++m)
#pragma unroll
            for (int kb = 0; kb < 2; ++kb)
#pragma unroll
                for (int s = 0; s < 2; ++s) Mc[m][kb][s] = *(const bf16x8*)(Mi + ((((m * 2 + kb) * 2 + s) * 64 + lane) << 3));
#pragma unroll
        for (int r = 0; r < 16; ++r) { N0[r] = Ni[((0 * 2 + n) * 16 + r) * 64 + lane]; N1[r] = Ni[((1 * 2 + n) * 16 + r) * 64 + lane]; }
    }
#pragma unroll 1
    for (int c = 0; c < NCH; ++c) {
        const int uidx = ((b * NCH + c) << 3) + h;
        {
            const int un = ((b * NCH + min(c + 1, NCH - 1)) << 3) + h;
            const bf16* Mi = RB.M + (size_t)un * 4096; const float* Ni = RB.N + (size_t)un * 4096;
#pragma unroll
            for (int m = 0; m < 2; ++m)
#pragma unroll
                for (int kb = 0; kb < 2; ++kb)
#pragma unroll
                    for (int s = 0; s < 2; ++s) Mn[m][kb][s] = *(const bf16x8*)(Mi + ((((m * 2 + kb) * 2 + s) * 64 + lane) << 3));
#pragma unroll
            for (int r = 0; r < 16; ++r) { N0n[r] = Ni[((0 * 2 + n) * 16 + r) * 64 + lane]; N1n[r] = Ni[((1 * 2 + n) * 16 + r) * 64 + lane]; }
        }
        bf16* Ho = RB.HC + (size_t)uidx * 4096 + (size_t)(32 * n + cc) * 64;
#pragma unroll
        for (int g = 0; g < 4; ++g) {
            v2u w0; w0.x = pk2(X0[4 * g], X0[4 * g + 1]); w0.y = pk2(X0[4 * g + 2], X0[4 * g + 3]); *(v2u*)(Ho + 8 * g + 4 * hh) = w0;
            v2u w1; w1.x = pk2(X1[4 * g], X1[4 * g + 1]); w1.y = pk2(X1[4 * g + 2], X1[4 * g + 3]); *(v2u*)(Ho + 32 + 8 * g + 4 * hh) = w1;
        }
        bf16x8 bf[2][2];
#pragma unroll
        for (int s = 0; s < 2; ++s) {
            v4u t0; t0.x = pk2(X0[8 * s], X0[8 * s + 1]); t0.y = pk2(X0[8 * s + 2], X0[8 * s + 3]); t0.z = pk2(X0[8 * s + 4], X0[8 * s + 5]); t0.w = pk2(X0[8 * s + 6], X0[8 * s + 7]);
            v4u t1; t1.x = pk2(X1[8 * s], X1[8 * s + 1]); t1.y = pk2(X1[8 * s + 2], X1[8 * s + 3]); t1.z = pk2(X1[8 * s + 4], X1[8 * s + 5]); t1.w = pk2(X1[8 * s + 6], X1[8 * s + 7]);
            bf[0][s] = __builtin_bit_cast(bf16x8, t0); bf[1][s] = __builtin_bit_cast(bf16x8, t1);
        }
        f32x16 Y0 = N0, Y1 = N1;
#pragma unroll
        for (int kb = 0; kb < 2; ++kb)
#pragma unroll
            for (int s = 0; s < 2; ++s) {
                Y0 = __builtin_amdgcn_mfma_f32_32x32x16_bf16(Mc[0][kb][s], bf[kb][s], Y0, 0, 0, 0);
                Y1 = __builtin_amdgcn_mfma_f32_32x32x16_bf16(Mc[1][kb][s], bf[kb][s], Y1, 0, 0, 0);
            }
        X0 = Y0; X1 = Y1;
#pragma unroll
        for (int m = 0; m < 2; ++m)
#pragma unroll
            for (int kb = 0; kb < 2; ++kb)
#pragma unroll
                for (int s = 0; s < 2; ++s) Mc[m][kb][s] = Mn[m][kb][s];
        N0 = N0n; N1 = N1n;
    }
}

template <class OutF> __device__ __forceinline__ void rwkv_out_unit(const RwkvBufs& RB, int uidx, int lane, const OutF& outf) {
    const int h = uidx & 7, bc = uidx >> 3, c = bc % NCH, b = bc / NCH;
    const bf16* Q = RB.Q + (size_t)uidx * 4096; const bf16* HT = RB.HC + (size_t)uidx * 4096; const bf16* OP = RB.OP + (size_t)uidx * 4096;
    const bf16* G1 = RB.G1 + (size_t)uidx * 4096; const bf16* G2 = RB.G2 + (size_t)uidx * 4096;
    const int r = lane & 15, ko = 8 * (lane >> 4);
    bf16x8 yh[4][2];
#pragma unroll
    for (int tb = 0; tb < 4; ++tb)
#pragma unroll
        for (int ks = 0; ks < 2; ++ks) yh[tb][ks] = *(const bf16x8*)(HT + (16 * tb + r) * 64 + 32 * ks + ko);
#pragma unroll 2
    for (int ta = 0; ta < 4; ++ta) {
        const int t = 16 * ta + r;
        bf16x8 xq[2];
        xq[0] = *(const bf16x8*)(Q + t * 64 + ko); xq[1] = *(const bf16x8*)(Q + t * 64 + 32 + ko);
        f32x4 o[4]; float s = 0.f;
#pragma unroll
        for (int tb = 0; tb < 4; ++tb) {
            const int i0 = 16 * tb + 4 * (lane >> 4);
            const v2u ow = *(const v2u*)(OP + t * 64 + i0);
            f32x4 acc = {bflo(ow.x), bfhi(ow.x), bflo(ow.y), bfhi(ow.y)};
#pragma unroll
            for (int ks = 0; ks < 2; ++ks) acc = __builtin_amdgcn_mfma_f32_16x16x32_bf16(yh[tb][ks], xq[ks], acc, 0, 0, 0);
            o[tb] = acc; s += (acc[0] + acc[1]) + (acc[2] + acc[3]);
        }
        s = sum_x32(sum_x16(s));
        const float mean = s * (1.f / 64.f); float qv = 0.f;
#pragma unroll
        for (int tb = 0; tb < 4; ++tb) { o[tb] = o[tb] - mean; qv += (o[tb][0] * o[tb][0] + o[tb][1] * o[tb][1]) + (o[tb][2] * o[tb][2] + o[tb][3] * o[tb][3]); }
        qv = sum_x32(sum_x16(qv));
        const float rstd = rsqrtf(qv * (1.f / 64.f) + GN_EPS);
        const int tg = c * 64 + t;
#pragma unroll
        for (int tb = 0; tb < 4; ++tb) {
            const int i0 = 16 * tb + 4 * (lane >> 4);
            const v2u g1 = *(const v2u*)(G1 + t * 64 + i0), g2 = *(const v2u*)(G2 + t * 64 + i0);
            f32x4 y;
            y[0] = o[tb][0] * rstd * bflo(g1.x) + bflo(g2.x); y[1] = o[tb][1] * rstd * bfhi(g1.x) + bfhi(g2.x);
            y[2] = o[tb][2] * rstd * bflo(g1.y) + bflo(g2.y); y[3] = o[tb][3] * rstd * bfhi(g1.y) + bfhi(g2.y);
            if (tg < L) outf(b, tg, 64 * h + i0, y);
        }
    }
}
constexpr int MW = 264;
constexpr float QSCALE = 0.125f * 1.4426950408889634f;
struct AttBufs { bf16* Q; bf16* QI; unsigned short* MASK; bf16* KX; };

constexpr int LDQ = 264;
__device__ __forceinline__ void att_prep_unit(const Frame& F, const Args& a, bf16* Ua, const AttBufs& AB, int tile) {
    const int tid = F.tid, lane = F.lane, w = F.wave;
    LAS bf16* CQ = (LAS bf16*)F.lds;
    LAS f32x2_t* RQL = (LAS f32x2_t*)(F.lds + 34816);
    LAS f32x2_t* RIL = (LAS f32x2_t*)(F.lds + 34816 + 64 * 33 * 8);
    const int tau = tid >> 3, q = tid & 7;
    const size_t prow = (size_t)tile * 64 + tau;
    const int tpos = (int)(prow % LP);
    bf16* urow = Ua + prow * UA_W;
    const float2* rq = (const float2*)(F.ws + WS_ROPEQ) + (size_t)tpos * 32;
    const float2* ri = (const float2*)(F.ws + WS_ROPEI) + (size_t)tpos * 16;
    { const int t0p = (int)(((size_t)tile * 64) % LP);
      const f32x2_t* gq = (const f32x2_t*)(F.ws + WS_ROPEQ) + (size_t)t0p * 32; const f32x2_t* gi = (const f32x2_t*)(F.ws + WS_ROPEI) + (size_t)t0p * 16;
      for (int i = tid; i < 64 * 32; i += NTHR) RQL[(i >> 5) * 33 + (i & 31)] = gq[i];
      for (int i = tid; i < 64 * 16; i += NTHR) RIL[(i >> 4) * 17 + (i & 15)] = gi[i]; }
    {
        float x[4][8]; float ss = 0.f;
#pragma unroll
        for (int i = 0; i < 4; ++i) { unpack8(*(const v4u*)(urow + 64 * i + 8 * q), x[i]);
#pragma unroll
            for (int e = 0; e < 8; ++e) ss += x[i][e] * x[i][e]; }
        ss = sum8(ss);
        const float rs = rsqrtf(ss * (1.f / 256.f) + RMS_EPS);
#pragma unroll
        for (int i = 0; i < 4; ++i) { float g8[8], o[8]; ld8f(a.in[16] + 64 * i + 8 * q, g8);
#pragma unroll
            for (int e = 0; e < 8; ++e) o[e] = x[i][e] * rs * g8[e];
            st8(CQ + tau * LDQ + 64 * i + 8 * q, o); }
    }
#pragma unroll
    for (int i = 0; i < 8; ++i) {
        const int col = 8 * (q + 8 * i); float x[8], o[8];
        unpack8(*(const v4u*)(urow + 256 + col), x);
        const int d0 = (col & 63) >> 1;
#pragma unroll
        for (int pp = 0; pp < 4; ++pp) { const float2 cs = rq[d0 + pp]; o[2 * pp] = x[2 * pp] * cs.x - x[2 * pp + 1] * cs.y; o[2 * pp + 1] = x[2 * pp + 1] * cs.x + x[2 * pp] * cs.y; }
        v4u wv; wv.x = pk2(o[0], o[1]); wv.y = pk2(o[2], o[3]); wv.z = pk2(o[4], o[5]); wv.w = pk2(o[6], o[7]);
        *(v4u*)(urow + 256 + col) = wv;
    }
    {
        float x[8]; unpack8(*(const v4u*)(urow + 1280 + 8 * q), x);
        float s = 0.f;
#pragma unroll
        for (int e = 0; e < 8; ++e) s += x[e];
        s = sum8(s);
        const float mean = s * (1.f / 64.f); float qv = 0.f;
#pragma unroll
        for (int e = 0; e < 8; ++e) { x[e] -= mean; qv += x[e] * x[e]; }
        qv = sum8(qv);
        const float rstd = rsqrtf(qv * (1.f / 64.f) + LN_EPS);
        float y[8];
#pragma unroll
        for (int e = 0; e < 8; ++e) { const int p = 8 * q + e; const int d = (p < 32) ? ((p & 1) ? 16 + (p >> 1) : (p >> 1)) : p;
            y[e] = x[e] * rstd * a.in[19][d] + a.in[20][d]; }
        float o[8];
        if (q < 4) {
#pragma unroll
            for (int pp = 0; pp < 4; ++pp) { const float2 cs = ri[4 * q + pp]; o[2 * pp] = y[2 * pp] * cs.x - y[2 * pp + 1] * cs.y; o[2 * pp + 1] = y[2 * pp + 1] * cs.x + y[2 * pp] * cs.y; }
        } else {
#pragma unroll
            for (int e = 0; e < 8; ++e) o[e] = y[e];
        }
        v4u wv; wv.x = pk2(o[0] * 0.125f, o[1] * 0.125f); wv.y = pk2(o[2] * 0.125f, o[3] * 0.125f); wv.z = pk2(o[4] * 0.125f, o[5] * 0.125f); wv.w = pk2(o[6] * 0.125f, o[7] * 0.125f);
        *(v4u*)(AB.KX + prow * 64 + 8 * q) = wv;
    }
    LDS_WAIT(); __syncthreads();
    {
        const bf16* Wq = (const bf16*)(F.ws + WS_WQ);
        const int r = lane & 15, ko = 8 * (lane >> 4);
        bf16x8 yfA[8], yfB[8];
#pragma unroll
        for (int ks = 0; ks < 8; ++ks) yfA[ks] = *(const bf16x8*)(Wq + (size_t)(16 * (8 * w) + r) * 256 + 32 * ks + ko);
#define ATP_TILE(YF, TBL) do { const int tb = 8 * w + (TBL), n0 = 16 * tb + 4 * (lane >> 4); \
            _Pragma("unroll 1") for (int ta = 0; ta < 4; ++ta) { \
                f32x4 acc = {0.f, 0.f, 0.f, 0.f}; \
                _Pragma("unroll") for (int ks = 0; ks < 8; ++ks) { const bf16x8 xf = *(const LAS bf16x8*)(CQ + (16 * ta + r) * LDQ + 32 * ks + ko); acc = __builtin_amdgcn_mfma_f32_16x16x32_bf16(YF[ks], xf, acc, 0, 0, 0); } \
                const size_t orow = (size_t)tile * 64 + 16 * ta + r; \
                const bool isq = (n0 < 512); const int p = n0 & 63; \
                float o0 = acc[0], o1 = acc[1], o2 = acc[2], o3 = acc[3]; \
                if (isq) { const LAS f32x2_t* rr = RQL + (16 * ta + r) * 33 + (p >> 1); const f32x2_t c0 = rr[0], c1 = rr[1]; \
                    o0 = (acc[0] * c0.x - acc[1] * c0.y) * QSCALE; o1 = (acc[1] * c0.x + acc[0] * c0.y) * QSCALE; o2 = (acc[2] * c1.x - acc[3] * c1.y) * QSCALE; o3 = (acc[3] * c1.x + acc[2] * c1.y) * QSCALE; } \
                else if (p < 32) { const LAS f32x2_t* rr = RIL + (16 * ta + r) * 17 + (p >> 1); const f32x2_t c0 = rr[0], c1 = rr[1]; \
                    o0 = acc[0] * c0.x - acc[1] * c0.y; o1 = acc[1] * c0.x + acc[0] * c0.y; o2 = acc[2] * c1.x - acc[3] * c1.y; o3 = acc[3] * c1.x + acc[2] * c1.y; } \
                v2u ov; ov.x = pk2(o0, o1); ov.y = pk2(o2, o3); \
                bf16* dst = isq ? (AB.Q + orow * 512 + n0) : (AB.QI + orow * 512 + (n0 - 512)); \
                *(v2u*)dst = ov; } } while (0)
#pragma unroll 1
        for (int tb2 = 0; tb2 < 8; tb2 += 2) {
#pragma unroll
            for (int ks = 0; ks < 8; ++ks) yfB[ks] = *(const bf16x8*)(Wq + (size_t)(16 * (8 * w + tb2 + 1) + r) * 256 + 32 * ks + ko);
            ATP_TILE(yfA, tb2);
            if (tb2 + 2 < 8) {
#pragma unroll
                for (int ks = 0; ks < 8; ++ks) yfA[ks] = *(const bf16x8*)(Wq + (size_t)(16 * (8 * w + tb2 + 2) + r) * 256 + 32 * ks + ko);
            }
            ATP_TILE(yfB, tb2 + 1);
        }
#undef ATP_TILE
    }
    LDS_WAIT(); __syncthreads();
}

__device__ __forceinline__ unsigned fkey(float f) { const unsigned u = __float_as_uint(f); return u ^ ((unsigned)((int)u >> 31) | 0x80000000u); }
__device__ __forceinline__ void cnt_ge(int& c, unsigned x, unsigned cand) {
    unsigned long long m;
    asm("v_cmp_ge_u32 %1, %2, %3\n\tv_addc_co_u32 %0, %1, 0, %0, %1" : "+v"(c), "=&s"(m) : "v"(x), "v"(cand));
}
template <int BIT> __device__ __forceinline__ void nib_ge(unsigned& nib, unsigned x, unsigned K) {
    unsigned t; asm volatile("v_cmp_ge_u32 vcc, %1, %2\n\tv_cndmask_b32 %0, 0, %3, vcc" : "=v"(t) : "v"(x), "v"(K), "v"(1u << BIT) : "vcc"); nib |= t;
}
constexpr int IDX_NT = 33, IDX_PF = 4;
__device__ __forceinline__ void idx_unit(const Frame& F, const bf16* __restrict__ Ua, const AttBufs& AB, int b, int qt, int flags) {
    const int lane = F.lane, w = F.wave, qc = lane & 15, g = lane >> 4, ko = 8 * g;
    LAS int* cntb = (LAS int*)F.lds;
    const int t0 = 16 * qt, ntile = qt + 1, tq = t0 + qc;
    const size_t qrow = (size_t)b * LP + tq;
    LAS bf16* QIL = (LAS bf16*)(F.lds + 8192);
    { const int tid = F.tid; const int rr = tid >> 5, cc = (tid & 31) * 16;
      const bf16* src = AB.QI + ((size_t)b * LP + t0 + rr) * 512 + cc;
      const v4u x0 = *(const v4u*)src, x1 = *(const v4u*)(src + 8);
      *(LAS v4u*)(QIL + rr * 520 + cc) = x0; *(LAS v4u*)(QIL + rr * 520 + cc + 8) = x1; }
    LDS_WAIT(); __syncthreads();
    float wq[8];
    { const v4u ww = *(const v4u*)(Ua + qrow * UA_W + 1344); float t8[8]; unpack8(ww, t8);
#pragma unroll
      for (int h = 0; h < 8; ++h) wq[h] = t8[h] * 0.35355339059327373f; }
    unsigned sc[IDX_NT][4];
    const bf16* kbase = AB.KX + (size_t)b * LP * 64;
    const int wlast = (ntile - 1 - w) >> 3;
    bf16x8 ra0[IDX_PF], ra1[IDX_PF];
#pragma unroll
    for (int p = 0; p < IDX_PF; ++p) { const unsigned ko_ = (unsigned)((16 * (w + 8 * max(min(p, wlast), 0)) + qc) * 64 + ko) ; const unsigned kc = (w < ntile) ? ko_ : (unsigned)(qc * 64 + ko);
        ra0[p] = *(const bf16x8*)(kbase + kc); ra1[p] = *(const bf16x8*)(kbase + kc + 32); }
#pragma unroll
    for (int i = 0; i < IDX_NT; ++i) {
        int wv = w; asm volatile("" : "+s"(wv));
        const int kt = wv + 8 * i;
        const bf16x8 a0 = ra0[i % IDX_PF], a1 = ra1[i % IDX_PF];
        { const int ip = max(min(i + IDX_PF, wlast), 0); const unsigned ko_ = (unsigned)((16 * (wv + 8 * ip) + qc) * 64 + ko); const unsigned kc = (wv < ntile) ? ko_ : (unsigned)(qc * 64 + ko);
          ra0[i % IDX_PF] = *(const bf16x8*)(kbase + kc); ra1[i % IDX_PF] = *(const bf16x8*)(kbase + kc + 32); }
        asm volatile("" ::: "memory");
        if (kt < ntile) {
            f32x4 acc = {0.f, 0.f, 0.f, 0.f};
#pragma unroll
            for (int hq = 0; hq < 2; ++hq) {
                bf16x8 qa[4], qb_[4];
#pragma unroll
                for (int h4 = 0; h4 < 4; ++h4) { qa[h4] = *(const LAS bf16x8*)(QIL + qc * 520 + 64 * (4 * hq + h4) + ko); qb_[h4] = *(const LAS bf16x8*)(QIL + qc * 520 + 64 * (4 * hq + h4) + 32 + ko); }
                __builtin_amdgcn_sched_group_barrier(0x100, 8, 0);
                f32x4 sh[4];
#pragma unroll
                for (int h4 = 0; h4 < 4; ++h4) { sh[h4] = (f32x4){0.f, 0.f, 0.f, 0.f}; sh[h4] = __builtin_amdgcn_mfma_f32_16x16x32_bf16(a0, qa[h4], sh[h4], 0, 0, 0); }
#pragma unroll
                for (int h4 = 0; h4 < 4; ++h4) sh[h4] = __builtin_amdgcn_mfma_f32_16x16x32_bf16(a1, qb_[h4], sh[h4], 0, 0, 0);
                __builtin_amdgcn_sched_group_barrier(0x008, 8, 0);
#pragma unroll
                for (int h4 = 0; h4 < 4; ++h4)
#pragma unroll
                    for (int r = 0; r < 4; ++r) acc[r] = fmaf(__builtin_amdgcn_fmed3f(sh[h4][r], 0.f, INFINITY), wq[4 * hq + h4], acc[r]);
                if (hq == 0) asm volatile("" ::: "memory");
            }
            if (kt == qt) {
#pragma unroll
                for (int r = 0; r < 4; ++r) sc[i][r] = (4 * g + r <= qc) ? (fkey(acc[r]) >> 1) : 0u;
            } else {
#pragma unroll
                for (int r = 0; r < 4; ++r) sc[i][r] = fkey(acc[r]) >> 1;
            }
        } else {
#pragma unroll
            for (int r = 0; r < 4; ++r) sc[i][r] = 0u;
        }
    }
    unsigned K = 0u; bool found = (tq + 1 <= 256);
    const int nwave_tiles = __builtin_amdgcn_readfirstlane(max(wlast + 1, 0));
#pragma unroll 1
    for (int bit = 30; bit >= 0; --bit) {
        const unsigned cand = K | (1u << bit);
        unsigned b0 = 0u, b1 = 0u, b2 = 0u, b3 = 0u; int lt = 0;
        int nwv = nwave_tiles; asm volatile("" : "+s"(nwv));
#pragma unroll
        for (int i = 0; i < IDX_NT; ++i) {
            if (i < nwv) {
                b0 = __builtin_amdgcn_alignbit(b0, sc[i][0] - cand, 31); b1 = __builtin_amdgcn_alignbit(b1, sc[i][1] - cand, 31);
                b2 = __builtin_amdgcn_alignbit(b2, sc[i][2] - cand, 31); b3 = __builtin_amdgcn_alignbit(b3, sc[i][3] - cand, 31);
            }
            if (i == 15 || i == 31 || i == IDX_NT - 1) { lt += __builtin_popcount(b0) + __builtin_popcount(b1) + __builtin_popcount(b2) + __builtin_popcount(b3); b0 = b1 = b2 = b3 = 0u; }
        }
        int c = 4 * nwv - lt;
        c = isum_x32(isum_x16(c));
        LAS int* cb = cntb + (bit & 1) * 128;
        if (g == 0) cb[w * 16 + qc] = c;
        LDS_WAIT(); __syncthreads();
        int tot = 0;
#pragma unroll
        for (int ww = 0; ww < 8; ++ww) tot += cb[ww * 16 + qc];
        if (!found && tot >= 256) K = cand;
        found = found || (tot == 256);
        if (__all(found)) break;
    }
    if (tq + 1 <= 256 || K == 0u) K = 1u;
    LAS unsigned short* mlds = (LAS unsigned short*)(F.lds + 32768);
    const int kend = (qt == 0) ? 4 : min(16 * (1 + ((qt - 1) >> 4)) + 4, 260);
    LAS unsigned short* mrow_ = mlds + qc * MW + w;
#pragma unroll
    for (int i = 0; i < IDX_NT; ++i) {
        unsigned nib = 0u;
        nib_ge<0>(nib, sc[i][0], K); nib_ge<1>(nib, sc[i][1], K); nib_ge<2>(nib, sc[i][2], K); nib_ge<3>(nib, sc[i][3], K);
        unsigned v = nib << (4 * g);
        v = or_x32(or_x16(v));
        if (g == 0) mrow_[8 * i] = (unsigned short)v;
    }
    LDS_WAIT(); __syncthreads();
    {
        const int npiece = kend >> 2;
        for (int p = F.tid; p < 16 * npiece; p += NTHR) { const int q_ = p / npiece, c = p % npiece;
            const v2u val = *(const LAS v2u*)(mlds + q_ * MW + 4 * c);
            *(v2u*)(AB.MASK + ((size_t)b * LP + t0 + q_) * MW + 4 * c) = val; }
    }
    LDS_WAIT(); __syncthreads();
}

__device__ __forceinline__ int crow(int r, int hi) { return (r & 3) + 8 * (r >> 2) + 4 * hi; }
constexpr int AT_K = 0, AT_V = 2 * 8192, AT_WS = 4 * 8192;
__device__ __forceinline__ void at_qkt(f32x16& p0, f32x16& p1, const LAS unsigned char* Kslot, const bf16x8* qr, const f32x16& negm, int r32, int hi) {
    const LAS unsigned char* kb = Kslot + hi * 1024 + r32 * 16;
    p0 = negm; p1 = negm;
#pragma unroll
    for (int d0 = 0; d0 < 4; ++d0) {
        const bf16x8 b0 = *(const LAS bf16x8*)(kb + d0 * 2048), b1 = *(const LAS bf16x8*)(kb + d0 * 2048 + 512);
        p0 = __builtin_amdgcn_mfma_f32_32x32x16_bf16(b0, qr[d0], p0, 0, 0, 0);
        p1 = __builtin_amdgcn_mfma_f32_32x32x16_bf16(b1, qr[d0], p1, 0, 0, 0);
    }
}
__device__ __forceinline__ float at_max3(float a, float b, float c) { float r; asm("v_max3_f32 %0, %1, %2, %3" : "=v"(r) : "v"(a), "v"(b), "v"(c)); return r; }
typedef short s16x4 __attribute__((ext_vector_type(4)));
__device__ __forceinline__ s16x4 at_vtr(const LAS unsigned char* p) { return __builtin_bit_cast(s16x4, __builtin_amdgcn_ds_read_tr16_b64_v4i16((LAS s16x4*)p)); }
__device__ __forceinline__ void at_pv(f32x16* o, const LAS unsigned char* vb, bf16x8 pa0, bf16x8 pa1, bf16x8 pa2, bf16x8 pa3) {
#pragma unroll
    for (int d0 = 0; d0 < 2; ++d0) {
        s16x4 lo[4], hi[4];
#pragma unroll
        for (int ks = 0; ks < 4; ++ks) { lo[ks] = at_vtr(vb + d0 * 4096 + ks * 1024); hi[ks] = at_vtr(vb + d0 * 4096 + ks * 1024 + 512); }
#define AT_PK(k) (bf16x8){lo[k][0], lo[k][1], lo[k][2], lo[k][3], hi[k][0], hi[k][1], hi[k][2], hi[k][3]}
        o[d0] = __builtin_amdgcn_mfma_f32_32x32x16_bf16(pa0, AT_PK(0), o[d0], 0, 0, 0);
        o[d0] = __builtin_amdgcn_mfma_f32_32x32x16_bf16(pa1, AT_PK(1), o[d0], 0, 0, 0);
        o[d0] = __builtin_amdgcn_mfma_f32_32x32x16_bf16(pa2, AT_PK(2), o[d0], 0, 0, 0);
        o[d0] = __builtin_amdgcn_mfma_f32_32x32x16_bf16(pa3, AT_PK(3), o[d0], 0, 0, 0);
#undef AT_PK
    }
}
template <class OutF> __device__ __forceinline__ void attn_unit(const Frame& F, const bf16* __restrict__ Ua, const AttBufs& AB, int b, int h, int qb, const OutF& outf) {
    const int lane = F.lane, wid = F.wave, r32 = lane & 31, hi = lane >> 5;
    const LAS unsigned char* lds = F.lds;
    LAS float* wsf = (LAS float*)(F.lds + AT_WS) + wid * 64;
    const size_t rowbase = (size_t)b * LP; const int q0 = (qb == 0) ? 0 : 16 + 256 * (qb - 1), qend = (qb == 0) ? 16 : q0 + 256;
    const int tq = q0 + wid * 32 + r32;
    const int NT = (qend + 63) / 64;
    bf16x8 qr[4];
    { const bf16* Qw = AB.Q + (rowbase + min(tq, LP - 1)) * 512 + 64 * h;
#pragma unroll
      for (int d0 = 0; d0 < 4; ++d0) qr[d0] = *(const bf16x8*)(Qw + 16 * d0 + 8 * hi); }
    const unsigned short* mrow = AB.MASK + (rowbase + min(tq, LP - 1)) * MW;
    const bf16* ksrc = Ua + (rowbase + lane) * UA_W + 256 + 64 * h + 8 * wid;
    const bf16* vsrc = Ua + (rowbase + 16 * (wid & 3) + (lane >> 2)) * UA_W + 768 + 64 * h + (wid >> 2) * 32 + (lane & 3) * 8;
    const int sdst = wid * 1024 + lane * 16;
    const int vb0 = ((lane >> 4) & 1) * 32 + (lane & 3) * 8 + (4 * hi + ((lane & 15) >> 2)) * 64;
    float m_run = 0.f, l_run = 0.f;
    f32x16 negm;
#pragma unroll
    for (int r = 0; r < 16; ++r) negm[r] = 0.f;
    f32x16 o[2];
#pragma unroll
    for (int r = 0; r < 16; ++r) { o[0][r] = 0.f; o[1][r] = 0.f; }
    v4u kreg = *(const v4u*)ksrc, vreg = *(const v4u*)vsrc;
    v2u mk_next = *(const v2u*)mrow;
    __syncthreads();
    *(LAS v4u*)(lds + AT_K + sdst) = kreg; *(LAS v4u*)(lds + AT_V + sdst) = vreg;
    for (int j = 0; j < NT; ++j) {
        const int cur = j & 1;
        if (j + 1 < NT) { kreg = *(const v4u*)(ksrc + (size_t)(j + 1) * 64 * UA_W); vreg = *(const v4u*)(vsrc + (size_t)(j + 1) * 64 * UA_W); }
        const v2u mk = mk_next;
        if (j + 1 < NT) mk_next = *(const v2u*)(mrow + 4 * (j + 1));
        LDS_WAIT(); __syncthreads();
        if (64 * j <= q0 + wid * 32 + 31 && q0 + wid * 32 < qend) {
        f32x16 p0, p1;
        at_qkt(p0, p1, lds + AT_K + cur * 8192, qr, negm, r32, hi);
        float mx;
        { float a0 = at_max3(p0[0], p0[1], p1[0]), a1 = at_max3(p0[2], p0[3], p1[1]); a0 = at_max3(a0, p1[2], p1[3]);
#pragma unroll
          for (int r = 4; r < 16; r += 4) { a0 = at_max3(a0, p0[r], p0[r + 1]); a1 = at_max3(a1, p0[r + 2], p0[r + 3]); a0 = at_max3(a0, p1[r], p1[r + 1]); a1 = at_max3(a1, p1[r + 2], p1[r + 3]); }
          mx = at_max3(a0, a1, a1); }
        { auto rr = __builtin_amdgcn_permlane32_swap(__float_as_uint(mx), __float_as_uint(mx), false, false); mx = fmaxf(__uint_as_float(rr[0]), __uint_as_float(rr[1])); }
        if (__any(mx > 4.f)) {
            const float dl = fmaxf(mx, 0.f);
            const float f = __builtin_amdgcn_exp2f(-dl);
            m_run += dl; l_run *= f;
#pragma unroll
            for (int r = 0; r < 16; ++r) { p0[r] -= dl; p1[r] -= dl; negm[r] = -m_run; }
            if (hi == 0) wsf[r32] = f;
            LDS_WAIT();
#pragma unroll
            for (int r = 0; r < 16; ++r) { const float fr = wsf[crow(r, hi)]; o[0][r] *= fr; o[1][r] *= fr; }
        }
        const int mlo = (int)(mk.x >> (4 * hi)), mhi = (int)(mk.y >> (4 * hi));
        float s = 0.f;
#pragma unroll
        for (int r = 0; r < 16; ++r) {
            int b0_, b1_;
            asm("v_bfe_i32 %0, %1, %2, 1" : "=v"(b0_) : "v"(mlo), "n"((r & 3) + 8 * (r >> 2)));
            asm("v_bfe_i32 %0, %1, %2, 1" : "=v"(b1_) : "v"(mhi), "n"((r & 3) + 8 * (r >> 2)));
            p0[r] = __uint_as_float(__float_as_uint(__builtin_amdgcn_exp2f(p0[r])) & (unsigned)b0_);
            p1[r] = __uint_as_float(__float_as_uint(__builtin_amdgcn_exp2f(p1[r])) & (unsigned)b1_);
            s += p0[r] + p1[r];
        }
        l_run += s;
        v4u pw0, pw1, pw2, pw3;
        pw0.x = pk2(p0[0], p0[1]); pw0.y = pk2(p0[2], p0[3]); pw0.z = pk2(p0[4], p0[5]); pw0.w = pk2(p0[6], p0[7]);
        pw1.x = pk2(p0[8], p0[9]); pw1.y = pk2(p0[10], p0[11]); pw1.z = pk2(p0[12], p0[13]); pw1.w = pk2(p0[14], p0[15]);
        pw2.x = pk2(p1[0], p1[1]); pw2.y = pk2(p1[2], p1[3]); pw2.z = pk2(p1[4], p1[5]); pw2.w = pk2(p1[6], p1[7]);
        pw3.x = pk2(p1[8], p1[9]); pw3.y = pk2(p1[10], p1[11]); pw3.z = pk2(p1[12], p1[13]); pw3.w = pk2(p1[14], p1[15]);
        at_pv(o, lds + AT_V + cur * 8192 + vb0, __builtin_bit_cast(bf16x8, pw0), __builtin_bit_cast(bf16x8, pw1), __builtin_bit_cast(bf16x8, pw2), __builtin_bit_cast(bf16x8, pw3));
        }
        if (j + 1 < NT) { *(LAS v4u*)(lds + AT_K + (cur ^ 1) * 8192 + sdst) = kreg; *(LAS v4u*)(lds + AT_V + (cur ^ 1) * 8192 + sdst) = vreg; }
    }
    { auto rr = __builtin_amdgcn_permlane32_swap(__float_as_uint(l_run), __float_as_uint(l_run), false, false); l_run = __uint_as_float(rr[0]) + __uint_as_float(rr[1]); }
    LDS_WAIT();
    if (hi == 0) wsf[32 + r32] = 1.f / l_run;
    LDS_WAIT();
#pragma unroll
    for (int r = 0; r < 16; ++r) {
        const int qloc = crow(r, hi), t = q0 + wid * 32 + qloc; const float li = wsf[32 + qloc];
        if (t < qend) { outf(b, t, 512 + 64 * h + r32, o[0][r] * li); outf(b, t, 512 + 64 * h + 32 + r32, o[1][r] * li); }
    }
}
constexpr int NEXP = 32, LISTCAP = 32896;
constexpr int CW_CNT = 256;
constexpr size_t WS_LIST = 236 * MiB;
constexpr size_t WS_WT = 241 * MiB;
constexpr size_t WS_PINFO = 242 * MiB;
constexpr size_t EW_GU = (size_t)512 * 1024 * 2, EW_D = (size_t)1024 * 256 * 2;
struct MoeBufs { float* MIX; float* H1; bf16* H1b; bf16* HID; bf16* F; bf16* WGU; bf16* WD; };

__device__ __forceinline__ void convert_experts(const Frame& F, const Args& a, const MoeBufs& MB, int part, int first_wg = 0) {
    LAS float* scr = (LAS float*)(F.lds + F.wave * 16384);
    if (F.bid < first_wg) return;
    const int gw = (F.bid - first_wg) * NWAVES + F.wave, NGW = (F.G - first_wg) * NWAVES;
    if (part == 0) {
        for (int it = gw; it < NEXP * 256; it += NGW) {
            const int e = it >> 8, r = it & 255;
            if (r < 128) transpose_item<4>(a.in[28] + (size_t)e * 1024 * 256, 1024, 256, MB.WGU + (size_t)e * 512 * 1024, 0, scr, r, 8, F.lane);
            else transpose_item<4>(a.in[29] + (size_t)e * 1024 * 256, 1024, 256, MB.WGU + (size_t)e * 512 * 1024, 1, scr, r - 128, 8, F.lane);
        }
    } else {
        for (int it = gw; it < NEXP * 128; it += NGW) {
            const int e = it >> 7, r = it & 127;
            transpose_item<0>(a.in[30] + (size_t)e * 256 * 1024, 256, 1024, MB.WD + (size_t)e * 1024 * 256, 0, scr, r, 32, F.lane);
        }
    }
}

constexpr int P6_HROW = 4096, P6_RGW = P6_HROW + 8 * 4096, P6_REW = P6_RGW + 16384;
static_assert(P6_REW + 65536 <= RING_BYTES, "P6 LDS map");
__device__ __forceinline__ void p6_ln1_router(const Frame& F, const Args& a, const MoeBufs& MB) {
    LAS int* lcount = (LAS int*)F.lds;
    LAS int* lbase = lcount + 32;
    LAS int* ent = lbase + 32;
    LAS float* entw = (LAS float*)(ent + 65 * 4);
    unsigned* ctl = (unsigned*)(F.ws + WS_CTL);
    const float2* rowstat = (const float2*)(F.ws + WS_ROWSTAT);
    const int lane = F.lane;
    for (int i = F.tid; i < 1024; i += NTHR) *(LAS f32x4*)(F.lds + P6_RGW + i * 16) = *(const f32x4*)(a.in[24] + (size_t)i * 4);
    for (int i = F.tid; i < 4096; i += NTHR) { const int k = i >> 2, g = i & 3; float w8[8]; ld8f(a.in[26] + (size_t)k * 32 + 8 * g, w8); st8((LAS bf16*)(F.lds + P6_REW + g * 16384 + k * 16), w8); }
    for (int blk = F.bid; blk < 256; blk += F.G) {
    if (F.tid < 32) lcount[F.tid] = 0;
    LDS_WAIT(); __syncthreads();
    f32x4 nx[4]; v2u nm[4];
    { const int pr = 65 * blk + F.wave, b = pr / LP, t = pr % LP; const int tc = (t < L) ? t : 0;
      const float* src = (tc < NM) ? (a.in[1] + (size_t)tc * D) : (a.in[0] + ((size_t)b * SEQ + (tc - NM)) * D);
#pragma unroll
      for (int j = 0; j < 4; ++j) { nx[j] = ((const f32x4*)src)[lane + 64 * j]; nm[j] = ((const v2u*)((const bf16*)MB.MIX + (size_t)pr * D))[lane + 64 * j]; } }
    for (int i = F.wave; i < 65; i += NWAVES) {
        const int pr = 65 * blk + i, t = pr % LP;
        f32x4 cx[4]; v2u cm[4];
#pragma unroll
        for (int j = 0; j < 4; ++j) { cx[j] = nx[j]; cm[j] = nm[j]; }
        if (i + NWAVES < 65) { const int pn = pr + NWAVES, bn = pn / LP, tn = pn % LP; const int tc = (tn < L) ? tn : 0;
            const float* src = (tc < NM) ? (a.in[1] + (size_t)tc * D) : (a.in[0] + ((size_t)bn * SEQ + (tc - NM)) * D);
#pragma unroll
            for (int j = 0; j < 4; ++j) { nx[j] = ((const f32x4*)src)[lane + 64 * j]; nm[j] = ((const v2u*)((const bf16*)MB.MIX + (size_t)pn * D))[lane + 64 * j]; } }
        if (t >= L || t < NM) { if (lane == 0) ent[i * 4] = -1; continue; }
        const float2 st = rowstat[pr];
        f32x4 v[4]; float s = 0.f;
#pragma unroll
        for (int j = 0; j < 4; ++j) {
            const f32x4 g0 = ((const f32x4*)a.in[2])[lane + 64 * j], b0 = ((const f32x4*)a.in[3])[lane + 64 * j];
            const f32x4 mxv = {bflo(cm[j].x), bfhi(cm[j].x), bflo(cm[j].y), bfhi(cm[j].y)};
            v[j] = ((cx[j] - st.x) * st.y * g0 + b0) * DN_ALPHA + mxv;
            s += (v[j].x + v[j].y) + (v[j].z + v[j].w);
        }
        const float mean = wave_sum(s) * (1.f / D); float s2 = 0.f;
#pragma unroll
        for (int j = 0; j < 4; ++j) { v[j] = v[j] - mean; s2 += (v[j].x * v[j].x + v[j].y * v[j].y) + (v[j].z * v[j].z + v[j].w * v[j].w); }
        const float rstd = rsqrtf(wave_sum(s2) * (1.f / D) + LN_EPS);
        LAS float* hrow = (LAS float*)(F.lds + P6_HROW + F.wave * 4096);
#pragma unroll
        for (int j = 0; j < 4; ++j) {
            const f32x4 g1 = ((const f32x4*)a.in[22])[lane + 64 * j], b1 = ((const f32x4*)a.in[23])[lane + 64 * j];
            v[j] = v[j] * rstd * g1 + b1;
            v2u hb; hb.x = pk2(v[j].x, v[j].y); hb.y = pk2(v[j].z, v[j].w);
            ((v2u*)(MB.H1b + (size_t)pr * D))[lane + 64 * j] = hb;
            *(LAS f32x4*)(hrow + 4 * (lane + 64 * j)) = v[j];
        }
        LDS_WAIT();
        float hk[16];
#pragma unroll
        for (int kk = 0; kk < 16; ++kk) hk[kk] = hrow[lane + 64 * kk];
        f32x4 ga = {0.f, 0.f, 0.f, 0.f};
#pragma unroll
        for (int kk = 0; kk < 16; ++kk) { const f32x4 wg = *(const LAS f32x4*)(F.lds + P6_RGW + (lane + 64 * kk) * 16); ga = ga + wg * hk[kk]; }
        float lgp[4];
#pragma unroll
        for (int g = 0; g < 4; ++g) lgp[g] = wave_sum(ga[g]) + a.in[25][g];
        int gs = 0; float gm = lgp[0];
#pragma unroll
        for (int g = 1; g < 4; ++g) if (lgp[g] > gm) { gm = lgp[g]; gs = g; }
        float den = 0.f;
#pragma unroll
        for (int g = 0; g < 4; ++g) den += __expf(lgp[g] - gm);
        const float ggate = 1.f / den;
        float el[8];
#pragma unroll
        for (int q8 = 0; q8 < 8; ++q8) el[q8] = 0.f;
#pragma unroll
        for (int kk = 0; kk < 16; ++kk) { float w8[8]; unpack8(*(const LAS v4u*)(F.lds + P6_REW + gs * 16384 + (lane + 64 * kk) * 16), w8);
#pragma unroll
            for (int q8 = 0; q8 < 8; ++q8) el[q8] = fmaf(hk[kk], w8[q8], el[q8]); }
#pragma unroll
        for (int q8 = 0; q8 < 8; ++q8) el[q8] = wave_sum(el[q8]) + a.in[27][gs * 8 + q8];
        int i1 = 0; float v1 = el[0];
#pragma unroll
        for (int q8 = 1; q8 < 8; ++q8) if (el[q8] > v1) { v1 = el[q8]; i1 = q8; }
        int i2 = 0; float v2 = -INFINITY;
#pragma unroll
        for (int q8 = 0; q8 < 8; ++q8) if (q8 != i1 && el[q8] > v2) { v2 = el[q8]; i2 = q8; }
        const float e2 = __expf(v2 - v1);
        const float w1 = ggate / (1.f + e2), w2 = ggate * e2 / (1.f + e2);
        if (lane == 0) {
            const int e0 = gs * 8 + i1, e1 = gs * 8 + i2;
            ent[i * 4] = e0; ent[i * 4 + 1] = e1;
            ent[i * 4 + 2] = atomicAdd((int*)(lcount + e0), 1); ent[i * 4 + 3] = atomicAdd((int*)(lcount + e1), 1);
            entw[i * 2] = w1; entw[i * 2 + 1] = w2;
        }
    }
    LDS_WAIT(); __syncthreads();
    if (F.tid < 32) lbase[F.tid] = (int)atomicAdd(ctl + CW_CNT + F.tid, (unsigned)lcount[F.tid]);
    LDS_WAIT(); __syncthreads();
    if (F.tid < 65) {
        const int i = F.tid, e0 = ent[i * 4];
        if (e0 >= 0) {
            const int pr = 65 * blk + i, e1 = ent[i * 4 + 1];
            int* list = (int*)(F.ws + WS_LIST); float* wt = (float*)(F.ws + WS_WT);
            list[(size_t)e0 * LISTCAP + lbase[e0] + ent[i * 4 + 2]] = pr * 2;
            list[(size_t)e1 * LISTCAP + lbase[e1] + ent[i * 4 + 3]] = pr * 2 + 1;
            wt[pr * 2] = entw[i * 2]; wt[pr * 2 + 1] = entw[i * 2 + 1];
            unsigned* pinfo = (unsigned*)(F.ws + WS_PINFO);
            pinfo[pr * 2] = ((unsigned)e0 << 16) | (unsigned)(lbase[e0] + ent[i * 4 + 2]); pinfo[pr * 2 + 1] = ((unsigned)e1 << 16) | (unsigned)(lbase[e1] + ent[i * 4 + 3]);
        }
    }
    LDS_WAIT(); __syncthreads();
    }
}
}

namespace pg8 {
struct OneUnit { int pm, pn;
    __device__ __forceinline__ bool next(int i, Unit& u) const { if (i) return false; u.pm = pm; u.pn = pn; return true; }
    __device__ __forceinline__ void a_ready(const Unit&) const {}
    __device__ __forceinline__ void done(const Unit&) const {} };
struct EpiMoeUp {
    static constexpr bool PERM = true, AFTER_DRAIN = false;
    bf16_t* HID;
    __device__ __forceinline__ void operator()(const f32x4 (&acc)[2][2][4][2], const Unit& u, int wr, int wc, int fr, int fq) const {
        const int j0 = 128 * u.pn + 16 * wc + 4 * fq;
#pragma unroll
        for (int ai = 0; ai < 2; ++ai)
#pragma unroll
            for (int m = 0; m < 4; ++m) { bf16_t* rowp = HID + (size_t)(ai * HALF + wr * 64 + m * 16 + fr) * 256 + j0;
#pragma unroll
                for (int bj = 0; bj < 2; ++bj) { const f32x4 v0 = acc[ai][bj][m][0], v1 = acc[ai][bj][m][1];
                    const float h0 = v0[0] / (1.f + __expf(-v0[0])) * v0[1], h1 = v0[2] / (1.f + __expf(-v0[2])) * v0[3];
                    const float h2 = v1[0] / (1.f + __expf(-v1[0])) * v1[1], h3 = v1[2] / (1.f + __expf(-v1[2])) * v1[3];
                    unsigned w0 = cvt_pk_bf16(h0, h1), w1 = cvt_pk_bf16(h2, h3);
                    typedef unsigned u32x2_ __attribute__((ext_vector_type(2))); u32x2_ wv; wv.x = w0; wv.y = w1;
                    *(u32x2_*)(rowp + 64 * bj) = wv; } }
    }
};
struct EpiMoeDown {
    static constexpr bool PERM = true, AFTER_DRAIN = false;
    bf16_t* O;
    __device__ __forceinline__ void operator()(const f32x4 (&acc)[2][2][4][2], const Unit& u, int wr, int wc, int fr, int fq) const {
        const int col0 = (u.pn & 3) * BM + wc * 32 + 8 * fq;
#pragma unroll
        for (int ai = 0; ai < 2; ++ai)
#pragma unroll
            for (int m = 0; m < 4; ++m) { bf16_t* rowp = O + (size_t)(u.pm * BM + ai * HALF + wr * 64 + m * 16 + fr) * 1024 + col0;
#pragma unroll
                for (int bj = 0; bj < 2; ++bj) { const f32x4 v0 = acc[ai][bj][m][0], v1 = acc[ai][bj][m][1];
                    u32x4 w; w.x = cvt_pk_bf16(v0[0], v0[1]); w.y = cvt_pk_bf16(v0[2], v0[3]); w.z = cvt_pk_bf16(v1[0], v1[1]); w.w = cvt_pk_bf16(v1[2], v1[3]);
                    *(u32x4*)(rowp + bj * HALF) = w; } }
    }
};
struct ThreeUnits { int n, pm0, pn0, pm1, pn1, pm2, pn2;
    __device__ __forceinline__ bool next(int i, Unit& u) const { if (i >= n) return false; u.pm = (i == 0) ? pm0 : (i == 1 ? pm1 : pm2); u.pn = (i == 0) ? pn0 : (i == 1 ? pn1 : pn2); return true; }
    __device__ __forceinline__ void a_ready(const Unit&) const {}
    __device__ __forceinline__ void done(const Unit&) const {} };
}

namespace mk {
struct MoeTiles { int total; };
__device__ __forceinline__ int moe_find(const unsigned* cnt, int ti, int& e_out, int& i_out, int& hb_out, int& total) {
    int acc = 0, e_f = -1, i_f = 0, hb = 0;
    for (int e = 0; e < NEXP; ++e) { const int nt = ((int)cnt[e] + 255) >> 8; if (e_f < 0 && ti < acc + nt) { e_f = e; i_f = ti - acc; hb = acc; } acc += nt; }
    total = acc; e_out = e_f; i_out = i_f; hb_out = hb; return e_f;
}
constexpr int MOE_LDS_IDX = RING_BYTES;
__device__ __forceinline__ void p7_moe(const Frame& F, const MoeBufs& MB, bool down) {
    const unsigned* cnt = (const unsigned*)(F.ws + WS_CTL) + CW_CNT;
    const int* list = (const int*)(F.ws + WS_LIST);
    LAS int* lidx = (LAS int*)(F.lds + MOE_LDS_IDX);
    if (down) {
        pg8::ThreeUnits S{0, 0, 0, 0, 0, 0, 0};
        for (int k3 = 0; k3 < 3; ++k3) { const int v = F.bid + k3 * F.G; int e, i, hb, total; moe_find(cnt, v >> 2, e, i, hb, total);
            if (v < 4 * total) { const int pm = __builtin_amdgcn_readfirstlane(v >> 2), pn = __builtin_amdgcn_readfirstlane(e * 4 + (v & 3));
                if (k3 == 0) { S.pm0 = pm; S.pn0 = pn; } else if (k3 == 1) { S.pm1 = pm; S.pn1 = pn; } else { S.pm2 = pm; S.pn2 = pn; } S.n = k3 + 1; } }
        pg8::Gemm g{MB.HID, MB.WD, 256, 1024, 256, 256, nullptr};
        pg8::EpiMoeDown E{MB.F};
        pg8::gemm_phase<pg8::EpiMoeDown, pg8::ThreeUnits, true, false, false>(F.lds, g, S, E);
        return;
    }
    const int ncol = 2;
    for (int u = F.bid;; u += F.G) {
        int e, i, hb, total; moe_find(cnt, u / ncol, e, i, hb, total);
        e = __builtin_amdgcn_readfirstlane(e); i = __builtin_amdgcn_readfirstlane(i); hb = __builtin_amdgcn_readfirstlane(hb); total = __builtin_amdgcn_readfirstlane(total);
        if (u >= total * ncol) break;
        const int pn = __builtin_amdgcn_readfirstlane(u % ncol), n_e = __builtin_amdgcn_readfirstlane((int)cnt[e]), base = 256 * i;
        if (!down) {
            __syncthreads();
            if (F.tid < 256) lidx[F.tid] = list[(size_t)e * LISTCAP + min(base + F.tid, n_e - 1)] >> 1;
            LDS_WAIT(); __syncthreads();
        }
        if (!down) {
            pg8::Gemm g{MB.H1b, MB.WGU + (size_t)e * 512 * 1024, 256, 512, 1024, 1024, (const int*)(F.lds + MOE_LDS_IDX)};
            pg8::OneUnit S{0, pn};
            pg8::EpiMoeUp E{MB.HID + (size_t)(hb + i) * 256 * 256};
            pg8::gemm_phase<pg8::EpiMoeUp, pg8::OneUnit, true, true, true>(F.lds, g, S, E);
        }
    }
}
__device__ __forceinline__ int moe_total_tiles(const unsigned* cnt) { int acc = 0; for (int e = 0; e < NEXP; ++e) acc += ((int)cnt[e] + 255) >> 8; return acc; }
__device__ __forceinline__ void p8_final(const Frame& F, const Args& a, const MoeBufs& MB) {
    const int gw = F.bid * NWAVES + F.wave, NGW = F.G * NWAVES, lane = F.lane;
    const unsigned* cnt = (const unsigned*)(F.ws + WS_CTL) + CW_CNT;
    const unsigned* pinfo = (const unsigned*)(F.ws + WS_PINFO); const float* wt = (const float*)(F.ws + WS_WT);
    int tb = 0;
    { const int nt = (lane < NEXP) ? (((int)cnt[lane & 31] + 255) >> 8) : 0; int inc = nt;
#pragma unroll
      for (int o = 1; o < 32; o <<= 1) { const int t = __shfl_up(inc, o); if ((lane & 31) >= o) inc += t; }
      tb = inc - nt; }
    const int NR = NB * SEQ;
    for (int orow = gw; orow < NR; orow += 2 * NGW) {
        v2u hv[2][4], fa[2][4], fb[2][4]; float w0[2], w1[2]; bool ok[2];
#pragma unroll
        for (int u = 0; u < 2; ++u) {
            const int o = orow + u * NGW; ok[u] = o < NR; const int oc = ok[u] ? o : orow;
            const size_t pr = (size_t)(oc / SEQ) * LP + NM + (oc % SEQ);
            const unsigned p0 = pinfo[pr * 2], p1 = pinfo[pr * 2 + 1]; w0[u] = wt[pr * 2]; w1[u] = wt[pr * 2 + 1];
            const size_t r0 = (size_t)__shfl(tb, (int)(p0 >> 16)) * 256 + (p0 & 0xffffu), r1 = (size_t)__shfl(tb, (int)(p1 >> 16)) * 256 + (p1 & 0xffffu);
#pragma unroll
            for (int j = 0; j < 4; ++j) { hv[u][j] = ((const v2u*)(MB.H1b + pr * D))[lane + 64 * j]; fa[u][j] = ((const v2u*)(MB.F + r0 * D))[lane + 64 * j]; fb[u][j] = ((const v2u*)(MB.F + r1 * D))[lane + 64 * j]; }
        }
#pragma unroll
        for (int u = 0; u < 2; ++u) {
            f32x4 v[4]; float sm = 0.f;
#pragma unroll
            for (int j = 0; j < 4; ++j) {
                const f32x4 h = {bflo(hv[u][j].x), bfhi(hv[u][j].x), bflo(hv[u][j].y), bfhi(hv[u][j].y)}; const v2u f0 = fa[u][j], f1 = fb[u][j];
                v[j].x = DN_ALPHA * h.x + w0[u] * bflo(f0.x) + w1[u] * bflo(f1.x); v[j].y = DN_ALPHA * h.y + w0[u] * bfhi(f0.x) + w1[u] * bfhi(f1.x);
                v[j].z = DN_ALPHA * h.z + w0[u] * bflo(f0.y) + w1[u] * bflo(f1.y); v[j].w = DN_ALPHA * h.w + w0[u] * bfhi(f0.y) + w1[u] * bfhi(f1.y);
                sm += (v[j].x + v[j].y) + (v[j].z + v[j].w);
            }
            const float mean = wave_sum(sm) * (1.f / D); float s2 = 0.f;
#pragma unroll
            for (int j = 0; j < 4; ++j) { v[j] = v[j] - mean; s2 += (v[j].x * v[j].x + v[j].y * v[j].y) + (v[j].z * v[j].z + v[j].w * v[j].w); }
            const float rstd = rsqrtf(wave_sum(s2) * (1.f / D) + LN_EPS);
            if (ok[u]) {
                const int o = orow + u * NGW;
#pragma unroll
                for (int j = 0; j < 4; ++j) { const f32x4 g2 = ((const f32x4*)a.in[31])[lane + 64 * j], b2 = ((const f32x4*)a.in[32])[lane + 64 * j];
                    ((f32x4*)(a.out + (size_t)o * D))[lane + 64 * j] = v[j] * rstd * g2 + b2; }
            }
        }
    }
}
struct OutY {
    bf16* Ur;
    __device__ __forceinline__ void operator()(int b, int t, int col, f32x4 y) const { v2u o; o.x = pk2(y[0], y[1]); o.y = pk2(y[2], y[3]); *(v2u*)(Ur + ((size_t)b * LP + t) * UR_W + col) = o; }
    __device__ __forceinline__ void operator()(int b, int t, int col, float y) const { Ur[((size_t)b * LP + t) * UR_W + col] = (bf16)f2bf(y); }
};
constexpr int CW_W3 = 16, CW_W4 = 80;
constexpr int TICKET_OFF = 15 * 9216 + 62 * 144 + 128;
__device__ __forceinline__ int next_ticket(const Frame& F, unsigned* ctr) {
    LAS int* slot = (LAS int*)(F.lds + TICKET_OFF);
    if (F.tid == 0) *slot = (int)atomicAdd(ctr, 1u);
    LDS_WAIT(); __syncthreads();
    const int t = *slot;
    LDS_WAIT(); __syncthreads();
    return t;
}
__device__ __forceinline__ int bcast_ticket(const Frame& F, int mine) {
    LAS int* slot = (LAS int*)(F.lds + TICKET_OFF);
    if (F.tid == 0) *slot = mine;
    LDS_WAIT(); __syncthreads();
    const int t = *slot;
    LDS_WAIT(); __syncthreads();
    return t;
}
constexpr size_t W_UR = 16 * MiB;
constexpr size_t W_UA = W_UR + (size_t)TP * UR_W * 2;
constexpr size_t W_RW = W_UA + (size_t)TP * UA_W * 2;
constexpr size_t W_H0B = W_RW;
constexpr size_t W_RW_M = W_RW, W_RW_N = W_RW_M + (size_t)NUNIT * 8192, W_RW_Q = W_RW_N + (size_t)NUNIT * 16384, W_RW_OP = W_RW_Q + (size_t)NUNIT * 8192,
                 W_RW_G1 = W_RW_OP + (size_t)NUNIT * 8192, W_RW_G2 = W_RW_G1 + (size_t)NUNIT * 8192, W_RW_END = W_RW_G2 + (size_t)NUNIT * 8192;
static_assert(W_RW_END <= WS_LIST, "RWKV data below the token lists");
constexpr size_t W_MIX = W_RW;
constexpr size_t W_F = W_RW;
constexpr size_t W_H1B = W_RW + 81 * MiB;
constexpr size_t W_H1 = W_UR;
constexpr size_t W_HID = 81 * MiB;
static_assert(W_H1 + (size_t)TP * 4096 <= W_HID && W_HID + (size_t)41216 * 512 <= W_RW && W_H1B + (size_t)TP * 2048 <= WS_LIST && W_F + (size_t)41216 * 2048 <= W_H1B, "late-phase overlays");
constexpr size_t O_Q = 0, O_QI = O_Q + (size_t)TP * 1024, O_HC = O_QI + (size_t)TP * 1024, O_MASK = O_HC + (size_t)NUNIT * 8192, O_KX = O_MASK + (size_t)TP * MW * 2, O_END = O_KX + (size_t)TP * 128;
constexpr size_t O_WGU = 0, O_WD = 32 * MiB;
static_assert(O_END <= 64 * MiB && O_WD + (size_t)NEXP * EW_D <= 64 * MiB, "d_out scratch");

__global__ void __launch_bounds__(NTHR, 2) mega(Args a) {
    unsigned char* const wsb_ = a.ws; unsigned char* const ob_ = (unsigned char*)a.out;
    bf16* const H0b = (bf16*)(wsb_ + W_H0B); bf16* const Ur = (bf16*)(wsb_ + W_UR); bf16* const Ua = (bf16*)(wsb_ + W_UA);
    const RwkvBufs RB{(bf16*)(wsb_ + W_RW_M), (float*)(wsb_ + W_RW_N), (bf16*)(wsb_ + W_RW_Q), (bf16*)(wsb_ + W_RW_OP), (bf16*)(wsb_ + W_RW_G1), (bf16*)(wsb_ + W_RW_G2), (bf16*)(ob_ + O_HC)};
    const AttBufs AB{(bf16*)(ob_ + O_Q), (bf16*)(ob_ + O_QI), (unsigned short*)(ob_ + O_MASK), (bf16*)(ob_ + O_KX)};
    const MoeBufs MB{(float*)(wsb_ + W_MIX), (float*)(wsb_ + W_H1), (bf16*)(wsb_ + W_H1B), (bf16*)(wsb_ + W_HID), (bf16*)(wsb_ + W_F), (bf16*)(ob_ + O_WGU), (bf16*)(ob_ + O_WD)};
    extern __shared__ __attribute__((aligned(16))) unsigned char lds[];
    Frame F;
    F.lds = (LAS unsigned char*)lds;
    F.tid = threadIdx.x; F.lane = F.tid & 63; F.wave = __builtin_amdgcn_readfirstlane(F.tid >> 6);
    F.G = gridDim.x; F.bid = blockIdx.x; F.ws = a.ws;
    unsigned* ctl = (unsigned*)(a.ws + WS_CTL);
    const int lo = a.ph_lo, hi = a.ph_hi;
    volatile LAS unsigned* MISC = (volatile LAS unsigned*)(F.lds + MISC_OFF);
    if (F.tid < 4) MISC[F.tid] = 0u;
    LDS_WAIT(); __syncthreads();
    XcdBarrier bar; bar.bar = ctl + CW_BAR; bar.x = 0; bar.st = MISC;
    if (hi - lo > 1) bar = xcd_barrier_post(ctl + CW_BAR, MISC);
#define SEAM(k) do { if (IN(k) && IN((k) + 1)) xcd_barrier(bar); } while (0)
#define IN(k) (lo <= (k) && (k) < hi)
    if (IN(0)) { p0_prologue(F, a, H0b); }
    SEAM(0);
    if (IN(1)) {
        pg8::Gemm g{H0b, (const bf16*)(F.ws + WS_WIN), TP, IN_N, 1024, 1024, nullptr};
        pg8::StaticOrder S; S.init(TP, IN_N, F.G, (int)blockIdx.x);
        pg8::EpiU E{Ur, Ua};
        pg8::gemm_phase<pg8::EpiU, pg8::StaticOrder, true, true>(F.lds, g, S, E);
    }
    SEAM(1);
    if (IN(2)) {
        {
            if (F.G == 256) { att_prep_unit(F, a, Ua, AB, F.bid); if (F.bid >= 32 && F.bid < 36) att_prep_unit(F, a, Ua, AB, 256 + F.bid - 32); }
            else for (int u = F.bid; u < TP / 64; u += F.G) att_prep_unit(F, a, Ua, AB, u);
        }
        {
            if (F.G == 256) {
                const int nk = (F.bid >= 32 && F.bid < 36) ? 7 : ((F.bid < 32 || (F.bid >= 36 && F.bid < 40)) ? 9 : 8);
#define PB(x) (32 * ((x) & 7) + ((x) >> 3))
                RwRaw R; rw_load_raw(R, Ur, PB(F.bid), F.tid);
                { RwW W0; rw_w_fetch(W0, F, a, PB(F.bid) & 7); __syncthreads(); rw_w_store(W0, F); LDS_WAIT(); __syncthreads(); }
#pragma unroll 1
                for (int kq = 0; kq < nk; ++kq) {
                    const int u = (kq < 8) ? PB(F.bid) + 256 * kq : (F.bid < 32 ? 2048 + F.bid : PB(F.bid - 4) + 256 * 7);
                    const int kn = kq + 1; const int un = (kn >= nk) ? -1 : ((kn < 8) ? PB(F.bid) + 256 * kn : (F.bid < 32 ? 2048 + F.bid : PB(F.bid - 4) + 256 * 7));
                    rwkv_unit(F, a, Ur, RB, u, R, un);
                }
            } else { RwRaw R; for (int u = F.bid; u < NUNIT; u += F.G) { rw_load_raw(R, Ur, u, F.tid); { RwW W0; rw_w_fetch(W0, F, a, u & 7); __syncthreads(); rw_w_store(W0, F); LDS_WAIT(); __syncthreads(); } rwkv_unit(F, a, Ur, RB, u, R, -1); } }
        }
    }
    SEAM(2);
    if (IN(3)) {
        if (F.bid < 32 && F.wave < 2) rwkv_scan(RB, F.bid, F.wave, F.lane);
        for (int i = next_ticket(F, ctl + CW_W3); i < 4 * 257;) {
            idx_unit(F, Ua, AB, i & 3, 256 - (i >> 2), a.flags);
            i = next_ticket(F, ctl + CW_W3);
        }
    }
    SEAM(3);
    if (IN(4)) {
        const OutY of{Ur};
        for (int u = F.bid * NWAVES + F.wave; u < NUNIT; u += F.G * NWAVES) rwkv_out_unit(RB, u, F.lane, of);
        for (int i = next_ticket(F, ctl + CW_W4); i < 17 * 32;) {
            attn_unit(F, Ua, AB, (i & 31) >> 3, i & 7, 16 - (i >> 5), of);
            i = next_ticket(F, ctl + CW_W4);
        }
    }
    SEAM(4);
    if (IN(5)) {
        for (int v = F.bid; v < 256; v += F.G) {
            const int y = v >> 3, pmc = (v & 7) * 8 + (y >> 2), pn = y & 3;
            const size_t row0 = (size_t)(pmc >> 4) * LP + NM + 256 * (pmc & 15);
            pg8::Gemm g{Ur + row0 * UR_W, (const bf16*)(F.ws + WS_WOUT), 256, 1024, 1024, UR_W, nullptr};
            pg8::OneUnit S{0, pn};
            pg8::EpiB16 E{(bf16*)MB.MIX + row0 * 1024, 1024};
            pg8::gemm_phase<pg8::EpiB16, pg8::OneUnit, true, true>(F.lds, g, S, E);
        }
        convert_experts(F, a, MB, 0, 0);
    }
    SEAM(5);
    if (IN(6)) { p6_ln1_router(F, a, MB); }
    SEAM(6);
    if (IN(7)) { p7_moe(F, MB, false);
        { const int nu = 2 * moe_total_tiles((const unsigned*)(F.ws + WS_CTL) + CW_CNT); const int fw = nu - F.G; convert_experts(F, a, MB, 1, (fw > 0 && fw < F.G) ? fw : 0); } }
    SEAM(7);
    if (IN(8)) { Frame F8 = F; { int t = F.tid; asm volatile("" : "+v"(t)); F8.tid = t; F8.lane = t & 63; } p7_moe(F8, MB, true); }
    SEAM(8);
    if (IN(9)) { Frame F9 = F; { int t = F.tid; asm volatile("" : "+v"(t)); F9.tid = t; F9.lane = t & 63; } p8_final(F9, a, MB); }
#undef IN
#undef SEAM
}

}
extern "C" void kernel_launch(void* const* d_in, const int* in_sizes, int n_in, void* d_out, int out_size, void* d_ws, size_t ws_size, hipStream_t stream) {
    static int inited = 0;
    if (!inited) { (void)hipFuncSetAttribute((const void*)mk::mega, hipFuncAttributeMaxDynamicSharedMemorySize, mk::LDS_BYTES); inited = 1; }
    unsigned char* wsb = (unsigned char*)d_ws;
    (void)hipMemsetAsync(wsb + mk::WS_CTL, 0, mk::CTL_ZERO_BYTES, stream);
    mk::Args a{};
    for (int i = 0; i < 33; ++i) a.in[i] = (const float*)d_in[i];
    a.out = (float*)d_out; a.ws = wsb;
    static int grid = 0;
    if (!grid) { int dev = 0, cus = 0, per_cu = 0; (void)hipGetDevice(&dev); (void)hipDeviceGetAttribute(&cus, hipDeviceAttributeMultiprocessorCount, dev);
        (void)hipOccupancyMaxActiveBlocksPerMultiprocessor(&per_cu, (const void*)mk::mega, mk::NTHR, mk::LDS_BYTES); (void)hipGetLastError();
        if (per_cu < 1) per_cu = 1; if (cus < 1) cus = 256; grid = cus * per_cu; if (grid > 256) grid = 256; }
    a.ph_lo = 0; a.ph_hi = 10;
    { void* kargs[] = {(void*)&a};
      if (hipLaunchCooperativeKernel((const void*)mk::mega, dim3(grid), dim3(mk::NTHR), kargs, mk::LDS_BYTES, stream) != hipSuccess) {
          (void)hipGetLastError();
          hipLaunchKernelGGL(mk::mega, dim3(grid), dim3(mk::NTHR), mk::LDS_BYTES, stream, a);
      } }
}
```

```cpp
#include <hip/hip_runtime.h>
#include <math.h>
#include <stdint.h>
namespace pg8 {
#define PG8_LAS __attribute__((address_space(3)))
typedef unsigned short bf16_t;
typedef short bf16x8 __attribute__((ext_vector_type(8)));
typedef float f32x4 __attribute__((ext_vector_type(4)));
typedef unsigned u32x4 __attribute__((ext_vector_type(4)));
constexpr int BM = 256, BK = 64, HALF = 128, HTB = HALF * BK * 2  , STAGE_BYTES = 8 * HTB, NXCD = 8, WGM = 8;

__host__ __device__ __forceinline__ int lds_byte(int r, int c) { const int st = (r >> 4) * 2 + (c >> 5), rr = r & 15, cc = c & 31, ob = rr * 64 + cc * 2; return st * 1024 + (ob ^ (((ob >> 9) & 1) << 5)); }
__host__ __device__ __forceinline__ void stage_rc(int b, int& R, int& C) { const int st = b / 1024, sb = b % 1024, swz = sb ^ (((sb >> 9) & 1) << 5); R = (st >> 1) * 16 + swz / 64; C = (st & 1) * 32 + (swz % 64) / 2; }
__host__ __device__ __forceinline__ int perm32(int rho) { const int n = rho >> 4, i = rho & 15; return 8 * (i >> 2) + 4 * n + (i & 3); }

struct Unit { int pm, pn; };
struct Gemm { const bf16_t* A; const bf16_t* Bt; int M, N, K, lda; const int* rowidx; };

struct StaticOrder {
    int nM, nN, nwg, G, c;
    __host__ __device__ void init(int M, int N, int G_, int c_) { nM = M / BM; nN = N / BM; nwg = nM * nN; G = G_; c = c_; }
    __host__ __device__ bool next(int i, Unit& u) const {
        const long L = (long)i * G + c; if (L >= nwg) return false;
        int wgid = (int)L; { const int q = nwg / NXCD, r = nwg % NXCD, xcd = wgid % NXCD, off = wgid / NXCD; wgid = (xcd < r ? xcd * (q + 1) : r * (q + 1) + (xcd - r) * q) + off; }
        const int nig = WGM * nN, gid = wgid / nig, fm = gid * WGM, gsz = (nM - fm) < WGM ? (nM - fm) : WGM;
        u.pm = fm + ((wgid % nig) % gsz); u.pn = (wgid % nig) / gsz; return true;
    }
    __device__ __forceinline__ void a_ready(const Unit&) const {}
    __device__ __forceinline__ void done(const Unit&) const {}
};

__device__ __forceinline__ unsigned cvt_pk_bf16(float lo, float hi) { unsigned r; asm volatile("v_cvt_pk_bf16_f32 %0, %1, %2" : "=v"(r) : "v"(lo), "v"(hi)); return r; }
typedef float f32x2 __attribute__((ext_vector_type(2)));
__device__ __forceinline__ f32x2 gelu_pk(f32x2 v) {
    const f32x2 av = __builtin_elementwise_abs(v), d = av * 0.2316418882f + 1.0f;
    f32x2 t; t.x = __builtin_amdgcn_rcpf(d.x); t.y = __builtin_amdgcn_rcpf(d.y);
    f32x2 q = t * 0.5307027145f + (-0.7265760135f); q = q * t + 0.7107068705f; q = q * t + (-0.142248368f); q = q * t + 0.127414796f; q = q * t;
    const f32x2 s = (v * v) * (-0.72134752044f);
    f32x2 e; e.x = __builtin_amdgcn_exp2f(s.x); e.y = __builtin_amdgcn_exp2f(s.y);
    const f32x2 m = v * (q * e), r = v - m;
    f32x2 o; o.x = v.x < 0.f ? m.x : r.x; o.y = v.y < 0.f ? m.y : r.y; return o;
}

template <int ACT  > struct EpiBf16 {
    static constexpr bool PERM = true, AFTER_DRAIN = false; static_assert(ACT == 0 || ACT == 1, "EpiBf16: ACT is 0 (none) or 1 (gelu_pk)");
    bf16_t* O; int ldc; const float* bias; int split_cols; size_t split_stride; float scale0;
    __device__ __forceinline__ void operator()(const f32x4 (&acc)[2][2][4][2], const Unit& u, int wr, int wc, int fr, int fq) const {
        const int row0 = u.pm * BM + wr * 64 + fr; int colt = u.pn * BM; bf16_t* base = O;
        float sc = 1.f; if (split_cols) { const int t = colt / split_cols; base += (size_t)t * split_stride; colt -= t * split_cols; if (t == 0) sc = scale0; }
        const int col0 = colt + wc * 32 + 8 * fq, bcol0 = u.pn * BM + wc * 32 + 8 * fq;
        f32x4 bv[2][2];
#pragma unroll
        for (int bj = 0; bj < 2; ++bj)
#pragma unroll
            for (int n = 0; n < 2; ++n) bv[bj][n] = bias ? *(const f32x4*)(bias + bcol0 + bj * HALF + 4 * n) : (f32x4){0.f, 0.f, 0.f, 0.f};
#pragma unroll
        for (int ai = 0; ai < 2; ++ai)
#pragma unroll
            for (int m = 0; m < 4; ++m) { bf16_t* rowp = base + (size_t)(row0 + ai * HALF + m * 16) * ldc + col0;
#pragma unroll
                for (int bj = 0; bj < 2; ++bj) { f32x4 v0 = acc[ai][bj][m][0] + bv[bj][0], v1 = acc[ai][bj][m][1] + bv[bj][1];
                    if (ACT == 1) { f32x2 a = gelu_pk((f32x2){v0[0], v0[1]}), b = gelu_pk((f32x2){v0[2], v0[3]}), c = gelu_pk((f32x2){v1[0], v1[1]}), d = gelu_pk((f32x2){v1[2], v1[3]});
                        v0 = (f32x4){a.x, a.y, b.x, b.y}; v1 = (f32x4){c.x, c.y, d.x, d.y}; }
                    v0 = v0 * sc; v1 = v1 * sc; u32x4 w; w.x = cvt_pk_bf16(v0[0], v0[1]); w.y = cvt_pk_bf16(v0[2], v0[3]); w.z = cvt_pk_bf16(v1[0], v1[1]); w.w = cvt_pk_bf16(v1[2], v1[3]);
                    *(u32x4*)(rowp + bj * HALF) = w; } }
    }
};
template <class Epi, class Sched, bool ALIGN_EPI = false, bool SP2 = false, bool GATHER = false>
__device__ __forceinline__ void gemm_phase(PG8_LAS unsigned char* lds, const Gemm g, const Sched& S, const Epi& E, int wave_hint) {
    int wh_ = wave_hint; asm volatile("" : "+s"(wh_));
    int lid_; asm volatile("v_mbcnt_lo_u32_b32 %0, -1, 0\n\tv_mbcnt_hi_u32_b32 %0, -1, %0" : "=&v"(lid_));
    int tid_ = wh_ * 64 + lid_; asm volatile("" : "+v"(tid_));
    const int tid = tid_, wid = __builtin_amdgcn_readfirstlane(tid >> 6), lane = tid & 63, wr = wid >> 2, wc = wid & 3, fr = lane & 15, fq = lane >> 4;
    const int K = g.K, nt = K / BK;
    unsigned voffA[2], voffA1[2], voffB[2];
#pragma unroll
    for (int i = 0; i < 2; ++i) { int R, C; stage_rc(tid * 16 + i * 8192, R, C); const int Rb = Epi::PERM ? ((R & ~31) + perm32(R & 31)) : R;
        if constexpr (GATHER) { voffA[i] = (unsigned)(g.rowidx[R] * g.lda + C) * 2u; voffA1[i] = (unsigned)(g.rowidx[R + HALF] * g.lda + C) * 2u; }
        else { voffA[i] = (unsigned)(R * g.lda + C) * 2u; voffA1[i] = voffA[i]; }
        voffB[i] = (unsigned)(Rb * K + C) * 2u; }
    const size_t kstep = (size_t)(BK * 2);
    const size_t hstep = (size_t)HALF * K * 2;
    const size_t tstep = 2 * hstep; const size_t hstepA = GATHER ? (size_t)0 : (size_t)HALF * g.lda * 2, tstepA = 2 * hstepA;
    const unsigned ldsw = (unsigned)wid * 1024u;
    const int aoff = lds_byte(wr * 64 + fr, fq * 8), boff = lds_byte(wc * 32 + fr, fq * 8);
#define PG8_SA(b, h) (((b) * 2 + (h)) * HTB)
#define PG8_SB(b, h) ((4 + (b) * 2 + (h)) * HTB)
#define PG8_STAGE(bufoff, gbase, voff) do { _Pragma("unroll") for (int _i = 0; _i < 2; ++_i) \
        __builtin_amdgcn_global_load_lds((const unsigned*)((const char*)(gbase) + (voff)[_i]), (PG8_LAS unsigned*)(lds + (bufoff) + ldsw + _i * 8192), 16, 0, 0); } while (0)
#define PG8_LDA(dst, b, h) do { _Pragma("unroll") for (int m = 0; m < 4; ++m) _Pragma("unroll") for (int k = 0; k < 2; ++k) dst[m][k] = *(const PG8_LAS bf16x8*)(lds + PG8_SA(b, h) + aoff + m * 2048 + k * 1024); } while (0)
#define PG8_LDB(dst, b, h) do { _Pragma("unroll") for (int n = 0; n < 2; ++n) _Pragma("unroll") for (int k = 0; k < 2; ++k) dst[n][k] = *(const PG8_LAS bf16x8*)(lds + PG8_SB(b, h) + boff + n * 2048 + k * 1024); } while (0)
#define PG8_MMA(ai, bj, At, Bt) do { __builtin_amdgcn_s_setprio(1); _Pragma("unroll") for (int m = 0; m < 4; ++m) _Pragma("unroll") for (int n = 0; n < 2; ++n) _Pragma("unroll") for (int k = 0; k < 2; ++k) \
        acc[ai][bj][m][n] = __builtin_amdgcn_mfma_f32_16x16x32_bf16(Bt[n][k], At[m][k], acc[ai][bj][m][n], 0, 0, 0); __builtin_amdgcn_s_setprio(0); } while (0)
#define PG8_WAIT_V(n) asm volatile("s_waitcnt vmcnt(" #n ")" ::: "memory")
#define PG8_WAIT_L(n) asm volatile("s_waitcnt lgkmcnt(" #n ")" ::: "memory")
#define PG8_BAR __builtin_amdgcn_s_barrier()
#define PG8_SCHED __builtin_amdgcn_sched_barrier(0)
    Unit cur, nxt; int ui = 0;
    if (!S.next(0, cur)) return;
    f32x4 acc[2][2][4][2];
#pragma unroll
    for (int a = 0; a < 2; ++a)
#pragma unroll
        for (int b = 0; b < 2; ++b)
#pragma unroll
            for (int m = 0; m < 4; ++m)
#pragma unroll
                for (int n = 0; n < 2; ++n) acc[a][b][m][n] = (f32x4){0.f, 0.f, 0.f, 0.f};
    bf16x8 At[4][2], B0[2][2], B1[2][2];
    const char* cA = (const char*)g.A + (size_t)cur.pm * tstepA; const char* cB = (const char*)g.Bt + (size_t)cur.pn * tstep;
    S.a_ready(cur);
    if constexpr (SP2) {
        PG8_STAGE(PG8_SB(0, 0), cB, voffB); PG8_STAGE(PG8_SB(0, 1), cB + hstep, voffB); PG8_STAGE(PG8_SA(0, 0), cA, voffA); PG8_STAGE(PG8_SA(0, 1), cA + hstepA, voffA1);
        if (wr == 1) PG8_BAR;
        PG8_WAIT_V(2); PG8_BAR;
        PG8_STAGE(PG8_SB(1, 0), cB + kstep, voffB); PG8_STAGE(PG8_SA(1, 0), cA + kstep, voffA); PG8_STAGE(PG8_SB(1, 1), cB + hstep + kstep, voffB);
        PG8_WAIT_V(6); PG8_BAR;
    } else {
        PG8_STAGE(PG8_SB(0, 0), cB, voffB); PG8_STAGE(PG8_SA(0, 0), cA, voffA); PG8_STAGE(PG8_SB(0, 1), cB + hstep, voffB); PG8_STAGE(PG8_SA(0, 1), cA + hstepA, voffA1);
        if (wr == 1) PG8_BAR;
        PG8_WAIT_V(4); PG8_BAR;
        PG8_STAGE(PG8_SB(1, 0), cB + kstep, voffB); PG8_STAGE(PG8_SA(1, 0), cA + kstep, voffA); PG8_STAGE(PG8_SB(1, 1), cB + hstep + kstep, voffB);
        PG8_WAIT_V(6); PG8_BAR;
    }
    for (;;) {
        const bool has_next = S.next(ui + 1, nxt);
        const char* nA = has_next ? (const char*)g.A + (size_t)nxt.pm * tstepA : cA; const char* nB = has_next ? (const char*)g.Bt + (size_t)nxt.pn * tstep : cB;
        for (int t = 0; t < nt; t += 2) {
            const bool last = (t == nt - 2);
            const char* a1 = cA + (size_t)(t + 1) * kstep;
            const char* a2 = last ? nA : cA + (size_t)(t + 2) * kstep; const char* b2 = last ? nB : cB + (size_t)(t + 2) * kstep;
            const char* a3 = a2 + kstep; const char* b3 = b2 + kstep;
            if (last && has_next) S.a_ready(nxt);
            if constexpr (SP2) {
            PG8_LDB(B0, 0, 0); PG8_LDB(B1, 0, 1); PG8_SCHED; PG8_LDA(At, 0, 0); PG8_STAGE(PG8_SA(1, 1), a1 + hstepA, voffA1);
            PG8_WAIT_V(8); PG8_WAIT_L(0); PG8_BAR; PG8_MMA(0, 0, At, B0); PG8_MMA(0, 1, At, B1); PG8_BAR; PG8_SCHED;
            PG8_LDA(At, 0, 1); PG8_STAGE(PG8_SB(0, 0), b2, voffB); PG8_STAGE(PG8_SB(0, 1), b2 + hstep, voffB); PG8_STAGE(PG8_SA(0, 0), a2, voffA);
            PG8_WAIT_V(8); PG8_WAIT_L(0); PG8_BAR; PG8_MMA(1, 0, At, B0); PG8_MMA(1, 1, At, B1); PG8_BAR; PG8_SCHED;
            PG8_LDB(B0, 1, 0); PG8_LDB(B1, 1, 1); PG8_SCHED; PG8_LDA(At, 1, 0); PG8_STAGE(PG8_SA(0, 1), a2 + hstepA, voffA1);
            PG8_WAIT_V(8); PG8_WAIT_L(0); PG8_BAR; PG8_MMA(0, 0, At, B0); PG8_MMA(0, 1, At, B1); PG8_BAR; PG8_SCHED;
            PG8_LDA(At, 1, 1); PG8_STAGE(PG8_SB(1, 0), b3, voffB); PG8_STAGE(PG8_SB(1, 1), b3 + hstep, voffB); PG8_STAGE(PG8_SA(1, 0), a3, voffA);
            PG8_WAIT_V(8); PG8_WAIT_L(0); PG8_BAR; PG8_MMA(1, 0, At, B0); PG8_MMA(1, 1, At, B1); PG8_BAR; PG8_SCHED;
            } else {
            PG8_LDB(B0, 0, 0); PG8_SCHED; PG8_LDA(At, 0, 0); PG8_STAGE(PG8_SA(1, 1), a1 + hstepA, voffA1);
            PG8_WAIT_L(8); PG8_BAR; PG8_WAIT_L(0); PG8_MMA(0, 0, At, B0); PG8_BAR; PG8_SCHED;
            PG8_LDB(B1, 0, 1); PG8_STAGE(PG8_SB(0, 0), b2, voffB);
            PG8_BAR; PG8_WAIT_L(0); PG8_MMA(0, 1, At, B1); PG8_BAR;
            PG8_LDA(At, 0, 1); PG8_STAGE(PG8_SA(0, 0), a2, voffA);
            PG8_BAR; PG8_WAIT_L(0); PG8_MMA(1, 0, At, B0); PG8_BAR; PG8_SCHED;
            PG8_STAGE(PG8_SB(0, 1), b2 + hstep, voffB);
            PG8_WAIT_V(6); PG8_BAR; PG8_MMA(1, 1, At, B1); PG8_BAR;
            PG8_LDB(B0, 1, 0); PG8_SCHED; PG8_LDA(At, 1, 0); PG8_STAGE(PG8_SA(0, 1), a2 + hstepA, voffA1);
            PG8_WAIT_L(8); PG8_BAR; PG8_WAIT_L(0); PG8_MMA(0, 0, At, B0); PG8_BAR; PG8_SCHED;
            PG8_LDB(B1, 1, 1); PG8_STAGE(PG8_SB(1, 0), b3, voffB);
            PG8_BAR; PG8_WAIT_L(0); PG8_MMA(0, 1, At, B1); PG8_BAR;
            PG8_LDA(At, 1, 1); PG8_STAGE(PG8_SA(1, 0), a3, voffA);
            PG8_BAR; PG8_WAIT_L(0); PG8_MMA(1, 0, At, B0); PG8_BAR; PG8_SCHED;
            PG8_STAGE(PG8_SB(1, 1), b3 + hstep, voffB);
            PG8_WAIT_V(6); PG8_BAR; PG8_MMA(1, 1, At, B1); PG8_BAR;
            }
        }
        if constexpr (ALIGN_EPI) { if (wr == 0) PG8_BAR; }
        if constexpr (!Epi::AFTER_DRAIN) { E(acc, cur, wr, wc, fr, fq); S.done(cur); }
        if (!has_next) break;
#pragma unroll
        for (int a = 0; a < 2; ++a)
#pragma unroll
            for (int b = 0; b < 2; ++b)
#pragma unroll
                for (int m = 0; m < 4; ++m)
#pragma unroll
                    for (int n = 0; n < 2; ++n) acc[a][b][m][n] = (f32x4){0.f, 0.f, 0.f, 0.f};
        cur = nxt; cA = nA; cB = nB; ++ui;
        if constexpr (ALIGN_EPI) { if (wr == 1) PG8_BAR; }
    }
    PG8_WAIT_V(0);
    if constexpr (!ALIGN_EPI) { if (wr == 0) PG8_BAR; }
    PG8_BAR;
    if constexpr (Epi::AFTER_DRAIN) { E.fused(acc, cur, wr, wc, fr, fq, lds, wid, lane); S.done(cur); }
#undef PG8_SA
#undef PG8_SB
#undef PG8_STAGE
#undef PG8_LDA
#undef PG8_LDB
#undef PG8_MMA
#undef PG8_WAIT_V
#undef PG8_WAIT_L
#undef PG8_BAR
#undef PG8_SCHED
}
}
namespace pg8 {
struct EpiF32 {
    static constexpr bool PERM = false, AFTER_DRAIN = false;
    float* O; int ldc;
    __device__ __forceinline__ void operator()(const f32x4 (&acc)[2][2][4][2], const Unit& u, int wr, int wc, int fr, int fq) const {
        const int row0 = u.pm * BM + wr * 64 + fr, col0 = u.pn * BM + wc * 32 + 4 * fq;
#pragma unroll
        for (int ai = 0; ai < 2; ++ai)
#pragma unroll
            for (int m = 0; m < 4; ++m) { float* rowp = O + (size_t)(row0 + ai * HALF + m * 16) * ldc + col0;
#pragma unroll
                for (int bj = 0; bj < 2; ++bj)
#pragma unroll
                    for (int n = 0; n < 2; ++n) *(f32x4*)(rowp + bj * HALF + n * 16) = acc[ai][bj][m][n]; }
    }
};
}
namespace pg8 {
struct EpiU {
    static constexpr bool PERM = true, AFTER_DRAIN = false;
    bf16_t* Ur; bf16_t* Ua;
    __device__ __forceinline__ void operator()(const f32x4 (&acc)[2][2][4][2], const Unit& u, int wr, int wc, int fr, int fq) const {
        const int row0 = u.pm * BM + wr * 64 + fr; int colt = u.pn * BM; bf16_t* base = Ur; int ld = 1792;
        if (colt >= 1792) { base = Ua; ld = 1536; colt -= 1792; }
        const int col0 = colt + wc * 32 + 8 * fq;
#pragma unroll
        for (int ai = 0; ai < 2; ++ai)
#pragma unroll
            for (int m = 0; m < 4; ++m) { bf16_t* rowp = base + (size_t)(row0 + ai * HALF + m * 16) * ld + col0;
#pragma unroll
                for (int bj = 0; bj < 2; ++bj) { const f32x4 v0 = acc[ai][bj][m][0], v1 = acc[ai][bj][m][1];
                    u32x4 w; w.x = cvt_pk_bf16(v0[0], v0[1]); w.y = cvt_pk_bf16(v0[2], v0[3]); w.z = cvt_pk_bf16(v1[0], v1[1]); w.w = cvt_pk_bf16(v1[2], v1[3]);
                    *(u32x4*)(rowp + bj * HALF) = w; } }
    }
};
}
namespace pg8 {
struct EpiB16 {
    static constexpr bool PERM = true, AFTER_DRAIN = false;
    bf16_t* O; int ldc;
    __device__ __forceinline__ void operator()(const f32x4 (&acc)[2][2][4][2], const Unit& u, int wr, int wc, int fr, int fq) const {
        const int row0 = u.pm * BM + wr * 64 + fr, col0 = u.pn * BM + wc * 32 + 8 * fq;
#pragma unroll
        for (int ai = 0; ai < 2; ++ai)
#pragma unroll
            for (int m = 0; m < 4; ++m) { bf16_t* rowp = O + (size_t)(row0 + ai * HALF + m * 16) * ldc + col0;
#pragma unroll
                for (int bj = 0; bj < 2; ++bj) { const f32x4 v0 = acc[ai][bj][m][0], v1 = acc[ai][bj][m][1];
                    u32x4 w; w.x = cvt_pk_bf16(v0[0], v0[1]); w.y = cvt_pk_bf16(v0[2], v0[3]); w.z = cvt_pk_bf16(v1[0], v1[1]); w.w = cvt_pk_bf16(v1[2], v1[3]);
                    *(u32x4*)(rowp + bj * HALF) = w; } }
    }
};
}
namespace mk {
#define GAS __attribute__((address_space(1)))
#define LAS __attribute__((address_space(3)))
typedef unsigned short bf16;
typedef unsigned v4u __attribute__((ext_vector_type(4)));
typedef unsigned v2u __attribute__((ext_vector_type(2)));
typedef float f32x4 __attribute__((ext_vector_type(4)));
typedef float f32x16 __attribute__((ext_vector_type(16)));
typedef short bf16x8 __attribute__((ext_vector_type(8)));
typedef GAS unsigned gu32;
typedef GAS unsigned long long gu64;
#define RLX_AGENT __ATOMIC_RELAXED, __HIP_MEMORY_SCOPE_AGENT
#define LDS_WAIT() asm volatile("s_waitcnt lgkmcnt(0)" ::: "memory")
#define VM_WAIT() asm volatile("s_waitcnt vmcnt(0)" ::: "memory")

constexpr int NB = 4, SEQ = 4096, NM = 16, L = 4112, LP = 4160, TP = NB * LP, D = 1024;
constexpr int NCH = LP / 64;
constexpr int UR_W = 1792, UA_W = 1536, IN_N = 3328, IN_COLS = 3144;
constexpr int NWAVES = 8, NTHR = 512;
constexpr float LN_EPS = 1e-5f, RMS_EPS = 1e-6f, GN_EPS = 64e-5f;
constexpr float DN_ALPHA = 1.189207115002721f;

typedef float f32x2_t __attribute__((ext_vector_type(2))); typedef __bf16 bf16x2_t __attribute__((ext_vector_type(2)));
__device__ __forceinline__ unsigned pk2(float lo, float hi) { f32x2_t v = {lo, hi}; bf16x2_t b = __builtin_convertvector(v, bf16x2_t); return __builtin_bit_cast(unsigned, b); }
__device__ __forceinline__ unsigned f2bf(float f) { return pk2(f, f) & 0xffffu; }
__device__ __forceinline__ float bf2f(unsigned short b) { return __uint_as_float(((unsigned)b) << 16); }
__device__ __forceinline__ float bflo(unsigned w) { return __uint_as_float(w << 16); }
__device__ __forceinline__ float bfhi(unsigned w) { return __uint_as_float(w & 0xffff0000u); }
__device__ __forceinline__ float dpp_f(float v, int ctrl_sel) {
    const int x = __float_as_int(v); int r;
    if (ctrl_sel == 0) r = __builtin_amdgcn_mov_dpp(x, 0xB1, 0xF, 0xF, true);
    else if (ctrl_sel == 1) r = __builtin_amdgcn_mov_dpp(x, 0x4E, 0xF, 0xF, true);
    else if (ctrl_sel == 2) r = __builtin_amdgcn_mov_dpp(x, 0x141, 0xF, 0xF, true);
    else r = __builtin_amdgcn_mov_dpp(x, 0x140, 0xF, 0xF, true);
    return __int_as_float(r);
}
__device__ __forceinline__ float sum_x16(float v) { auto rr = __builtin_amdgcn_permlane16_swap(__float_as_uint(v), __float_as_uint(v), false, false); return __uint_as_float(rr[0]) + __uint_as_float(rr[1]); }
__device__ __forceinline__ float sum_x32(float v) { auto rr = __builtin_amdgcn_permlane32_swap(__float_as_uint(v), __float_as_uint(v), false, false); return __uint_as_float(rr[0]) + __uint_as_float(rr[1]); }
__device__ __forceinline__ int isum_x16(int v) { auto rr = __builtin_amdgcn_permlane16_swap((unsigned)v, (unsigned)v, false, false); return (int)(rr[0] + rr[1]); }
__device__ __forceinline__ int isum_x32(int v) { auto rr = __builtin_amdgcn_permlane32_swap((unsigned)v, (unsigned)v, false, false); return (int)(rr[0] + rr[1]); }
__device__ __forceinline__ unsigned or_x16(unsigned v) { auto rr = __builtin_amdgcn_permlane16_swap(v, v, false, false); return rr[0] | rr[1]; }
__device__ __forceinline__ unsigned or_x32(unsigned v) { auto rr = __builtin_amdgcn_permlane32_swap(v, v, false, false); return rr[0] | rr[1]; }
__device__ __forceinline__ float sum8(float v) { v += dpp_f(v, 0); v += dpp_f(v, 1); v += dpp_f(v, 2); return v; }
__device__ __forceinline__ float wave_sum(float v) { v = sum8(v); v += dpp_f(v, 3); v = sum_x16(v); return sum_x32(v); }

constexpr size_t MiB = 1u << 20;
constexpr int IN_NM1 = 59;
constexpr size_t WS_CTL = 0, CTL_ZERO_BYTES = 64 * 1024;
constexpr int CW_BAR = 1024;
constexpr size_t WS_ROPEQ = 1 * MiB;
constexpr size_t WS_ROPEI = WS_ROPEQ + (size_t)LP * 32 * 8;
constexpr size_t WS_ROWSTAT = WS_ROPEI + (size_t)LP * 16 * 8;
constexpr size_t WS_WIN = 3 * MiB;
constexpr size_t WS_WOUT = WS_WIN + (size_t)IN_N * 1024 * 2;
constexpr size_t WS_WQ = WS_WOUT + (size_t)1024 * 1024 * 2;
constexpr size_t WS_WW2 = WS_WQ + (size_t)1024 * 256 * 2;
constexpr size_t WS_WA2 = WS_WW2 + (size_t)512 * 64 * 2;
constexpr size_t WS_WG2 = WS_WA2 + (size_t)512 * 64 * 2;
constexpr size_t WS_WEND = WS_WG2 + (size_t)512 * 128 * 2;
static_assert(WS_WEND <= 13 * MiB, "weights region");

constexpr int RING_BYTES = 131072;
constexpr int LDS_BYTES = 147456;
constexpr int MISC_OFF = LDS_BYTES - 16;
#define XB_TMO      128
#define XB_XCNT(j)  (256  + 64 * (j))
#define XB_XSUB(j)  (1280 + 64 * (j))
#define XB_XGEN(j)  (2304 + 64 * (j))
#define XB_TOP      3328
#define XB_TOPGEN   3392
#define XCD_BAR_WORDS 3456
#define XB_SPIN_CAP (1u << 18)

__device__ __forceinline__ unsigned xb_ld(unsigned* p)              { return __hip_atomic_load(p, __ATOMIC_RELAXED, __HIP_MEMORY_SCOPE_AGENT); }
__device__ __forceinline__ unsigned xb_add(unsigned* p, unsigned v) { return __hip_atomic_fetch_add(p, v, __ATOMIC_RELAXED, __HIP_MEMORY_SCOPE_AGENT); }
__device__ __forceinline__ unsigned xb_xcc_id() { return (unsigned)__builtin_amdgcn_s_getreg((3 << 11) | 20) & 0xFu; }
#define XB_SPIN(cond, bar) do { unsigned _sp = 0; while (cond) { __builtin_amdgcn_s_sleep(1); \
    if ((++_sp & 255u) == 0u) { if (xb_ld(&(bar)[XB_TMO])) break; if (_sp > XB_SPIN_CAP) { atomicAdd(&(bar)[XB_TMO], 1u); break; } } } } while (0)

struct XcdBarrier {
    unsigned* bar; unsigned x;
    volatile LAS unsigned* st;
};

__device__ __forceinline__ XcdBarrier xcd_barrier_post(unsigned* bar, volatile LAS unsigned* st) {
    XcdBarrier b; b.bar = bar; b.x = xb_xcc_id(); b.st = st;
    if (threadIdx.x == 0) (void)xb_add(&bar[XB_XCNT(b.x)], 1u);
    return b;
}
__device__ __forceinline__ void xcd_barrier_complete(unsigned* bar, unsigned x, unsigned& nloc, unsigned& nx) {
    const unsigned G = gridDim.x * gridDim.y * gridDim.z;
    unsigned sum, cnt, mine, sp = 0u;
    for (;;) {
        sum = 0u; cnt = 0u; mine = 0u;
#pragma unroll
        for (unsigned j = 0; j < 16; ++j) { const unsigned c = xb_ld(&bar[XB_XCNT(j)]); sum += c; cnt += (c > 0u) ? 1u : 0u; mine = (j == x) ? c : mine; }
        if (sum == G) break;
        __builtin_amdgcn_s_sleep(1);
        if ((++sp & 255u) == 0u) { if (xb_ld(&bar[XB_TMO])) break; if (sp > XB_SPIN_CAP) { atomicAdd(&bar[XB_TMO], 1u); break; } }
    }
    nloc = mine > 0u ? mine : 1u; nx = cnt > 0u ? cnt : 1u;
}

__device__ __forceinline__ bool xb_thread0(int wave) { return wave == 0 && __builtin_amdgcn_mbcnt_hi(~0u, __builtin_amdgcn_mbcnt_lo(~0u, 0u)) == 0u; }
__device__ __forceinline__ void xcd_barrier(const XcdBarrier& b, int wave) {
    asm volatile("s_waitcnt vmcnt(0)" ::: "memory");
    __syncthreads();
    if (xb_thread0(wave)) {
        unsigned* bar = b.bar;
        __builtin_amdgcn_s_waitcnt(0);
        unsigned nloc = b.st[0], nx = b.st[1];
        if (nloc == 0u) { xcd_barrier_complete(bar, b.x, nloc, nx); b.st[0] = nloc; b.st[1] = nx; }
        const unsigned old = xb_add(&bar[XB_XSUB(b.x)], 1u);
        const unsigned gen = old / nloc;
        if (old + 1u == (gen + 1u) * nloc) {
            __builtin_amdgcn_fence(__ATOMIC_RELEASE, "agent");
            asm volatile("s_waitcnt vmcnt(0)" ::: "memory");
            const unsigned og = xb_add(&bar[XB_TOP], 1u);
            const unsigned tg = og / nx;
            if (og + 1u == (tg + 1u) * nx) xb_add(&bar[XB_TOPGEN], 1u);
            else XB_SPIN(xb_ld(&bar[XB_TOPGEN]) == tg, bar);
            __builtin_amdgcn_fence(__ATOMIC_ACQUIRE, "agent");
            xb_add(&bar[XB_XGEN(b.x)], 1u);
            asm volatile("s_waitcnt vmcnt(0)" ::: "memory");
        } else {
            XB_SPIN(xb_ld(&bar[XB_TOPGEN]) == gen, bar);
            __builtin_amdgcn_fence(__ATOMIC_ACQUIRE, "agent");
            asm volatile("s_waitcnt vmcnt(0)" ::: "memory");
        }
    }
    __syncthreads();
}

constexpr int SIG_WORDS = 576;
__device__ __forceinline__ void grid_signal(int wave, const XcdBarrier& b, unsigned* sig) {
    asm volatile("s_waitcnt vmcnt(0)" ::: "memory");
    __syncthreads();
    if (xb_thread0(wave)) {
        __builtin_amdgcn_s_waitcnt(0);
        const unsigned nloc = b.st[0];
        const unsigned old = xb_add(&sig[32 * b.x], 1u);
        if (old + 1u == nloc) {
            __builtin_amdgcn_fence(__ATOMIC_RELEASE, "agent");
            asm volatile("s_waitcnt vmcnt(0)" ::: "memory");
            xb_add(&sig[512], 1u);
        }
    }
}
__device__ __forceinline__ void grid_wait(int wave, const XcdBarrier& b, unsigned* sig) {
    if (xb_thread0(wave)) {
        const unsigned nx = b.st[1];
        XB_SPIN(xb_ld(&sig[512]) < nx, b.bar);
        __builtin_amdgcn_fence(__ATOMIC_ACQUIRE, "agent");
        asm volatile("s_waitcnt vmcnt(0)" ::: "memory");
    }
    __syncthreads();
}
struct Args {
    const float* in[33]; float* out; unsigned char* ws; int ph_lo, ph_hi; int flags, pad_;
};
struct Frame {
    LAS unsigned char* lds;
    int tid, lane, wave, G, bid;
    unsigned char* ws;
};

__device__ __forceinline__ int rowmap_in(int n) {
    if (n >= 2048 && n < 2560) { const int d = (n - 2048) & 63, base = n - d; return base + (d < 32 ? 2 * d : 2 * (d - 32) + 1); }
    if (n >= 3072 && n < 3136) { const int d = n - 3072; return 3072 + (d < 16 ? 2 * d : (d < 32 ? 2 * (d - 16) + 1 : d)); }
    return n;
}
template <int MODE> __device__ __forceinline__ int rowmap(int n) {
    if (MODE == 1) return rowmap_in(n);
    if (MODE == 2) { const int d = n & 63, base = n - d; return base + (d < 32 ? 2 * d : 2 * (d - 32) + 1); }
    if (MODE == 4) return 2 * n;
    if (MODE == 3) { const int d = n & 63, base = n - d; return base + (d < 16 ? 2 * d : (d < 32 ? 2 * (d - 16) + 1 : d)); }
    return n;
}
template <int MODE> __device__ __forceinline__ void transpose_item(const float* __restrict__ W, int K, int N, bf16* WT, int row_off, LAS float* scr, int item, int nblk, int lane) {
    const int kb = item / nblk, nb = item % nblk, k0 = 64 * kb, n0 = 32 * nb;
    const int n = n0 + (lane & 31);
    float tv[32];
#pragma unroll
    for (int i = 0; i < 32; ++i) { const int kk = 2 * i + (lane >> 5); tv[i] = (n < N) ? W[(size_t)(k0 + kk) * N + n] : 0.f; }
#pragma unroll
    for (int i = 0; i < 32; ++i) { const int kk = 2 * i + (lane >> 5); scr[kk * 33 + (lane & 31)] = tv[i]; }
    LDS_WAIT(); asm volatile("" ::: "memory");
    const int c = lane & 7;
#pragma unroll
    for (int j = 0; j < 4; ++j) { const int nl = (lane >> 3) + 8 * j; const LAS float* s = scr + (8 * c) * 33 + nl;
        v4u o; o.x = pk2(s[0 * 33], s[1 * 33]); o.y = pk2(s[2 * 33], s[3 * 33]); o.z = pk2(s[4 * 33], s[5 * 33]); o.w = pk2(s[6 * 33], s[7 * 33]);
        *(v4u*)(WT + (size_t)(row_off + rowmap<MODE>(n0 + nl)) * K + k0 + 8 * c) = o; }
    LDS_WAIT(); asm volatile("" ::: "memory");
}
__device__ __forceinline__ void p0_ln_row(const Args& a, int pr, bf16* H0b, float2* rowstat, int lane) {
    const int b = pr / LP, t = pr % LP;
    unsigned long long* o8 = (unsigned long long*)(H0b + (size_t)pr * D) + lane;
    if (t >= L) {
#pragma unroll
        for (int j = 0; j < 4; ++j) o8[64 * j] = 0ull;
        if (lane == 0) rowstat[pr] = make_float2(0.f, 0.f);
        return;
    }
    const float* src = (t < NM) ? (a.in[1] + (size_t)t * D) : (a.in[0] + ((size_t)b * SEQ + (t - NM)) * D);
    const f32x4* xr = (const f32x4*)src + lane;
    f32x4 v[4]; float s = 0.f;
#pragma unroll
    for (int j = 0; j < 4; ++j) { v[j] = xr[64 * j]; s += (v[j].x + v[j].y) + (v[j].z + v[j].w); }
    const float mean = wave_sum(s) * (1.f / D); float s2 = 0.f;
#pragma unroll
    for (int j = 0; j < 4; ++j) { v[j] = v[j] - mean; s2 += (v[j].x * v[j].x + v[j].y * v[j].y) + (v[j].z * v[j].z + v[j].w * v[j].w); }
    const float rstd = 1.f / sqrtf(wave_sum(s2) * (1.f / D) + LN_EPS);
    const f32x4* gp = (const f32x4*)a.in[2] + lane; const f32x4* bp = (const f32x4*)a.in[3] + lane;
#pragma unroll
    for (int j = 0; j < 4; ++j) { const f32x4 g = gp[64 * j], bb = bp[64 * j]; const f32x4 y = v[j] * rstd * g + bb;
        o8[64 * j] = (unsigned long long)pk2(y.x, y.y) | ((unsigned long long)pk2(y.z, y.w) << 32); }
    if (lane == 0) rowstat[pr] = make_float2(mean, rstd);
}
__device__ __forceinline__ void p0_prologue(const Frame& F, const Args& a, bf16* H0b) {
    LAS float* scr = (LAS float*)(F.lds + F.wave * 16384);
    const int gw = F.bid * NWAVES + F.wave, NGW = F.G * NWAVES;
    bf16* Wt_in = (bf16*)(F.ws + WS_WIN); bf16* Wt_out = (bf16*)(F.ws + WS_WOUT); bf16* Wt_q = (bf16*)(F.ws + WS_WQ);
    bf16* Wt_w2 = (bf16*)(F.ws + WS_WW2); bf16* Wt_a2 = (bf16*)(F.ws + WS_WA2); bf16* Wt_g2 = (bf16*)(F.ws + WS_WG2);
    constexpr int I_IN = 16 * (IN_N / 32), I_OUT = 16 * 32, I_Q = 4 * 16, I_W2 = 1 * 16, I_G2 = 2 * 16;
    constexpr int NITEMS = I_IN + I_OUT + 2 * I_Q + 2 * I_W2 + I_G2;
    for (int it = gw; it < NITEMS; it += NGW) {
        int r = it;
        if (r < I_IN) { transpose_item<1>(a.in[4], 1024, IN_COLS, Wt_in, 0, scr, r, IN_N / 32, F.lane); continue; } r -= I_IN;
        if (r < I_OUT) { transpose_item<0>(a.in[21], 1024, 1024, Wt_out, 0, scr, r, 32, F.lane); continue; } r -= I_OUT;
        if (r < I_Q) { transpose_item<2>(a.in[17], 256, 512, Wt_q, 0, scr, r, 16, F.lane); continue; } r -= I_Q;
        if (r < I_Q) { transpose_item<3>(a.in[18], 256, 512, Wt_q, 512, scr, r, 16, F.lane); continue; } r -= I_Q;
        if (r < I_W2) { transpose_item<0>(a.in[7], 64, 512, Wt_w2, 0, scr, r, 16, F.lane); continue; } r -= I_W2;
        if (r < I_W2) { transpose_item<0>(a.in[9], 64, 512, Wt_a2, 0, scr, r, 16, F.lane); continue; } r -= I_W2;
        transpose_item<0>(a.in[10], 128, 512, Wt_g2, 0, scr, r, 16, F.lane);
    }
    float2* rowstat = (float2*)(F.ws + WS_ROWSTAT);
    for (int pr = gw; pr < TP; pr += NGW) p0_ln_row(a, pr, H0b, rowstat, F.lane);
    float2* rq = (float2*)(F.ws + WS_ROPEQ); float2* ri = (float2*)(F.ws + WS_ROPEI);
    const int gt = F.bid * NTHR + F.tid, NGT = F.G * NTHR;
    for (int i = gt; i < LP * 48; i += NGT) {
        if (i < LP * 32) { const int t = i >> 5, d = i & 31; const float ang = (float)t * exp2f(-(float)d * (13.287712379549449f / 32.f)); float sn, cs; sincosf(ang, &sn, &cs); rq[i] = make_float2(cs, sn); }
        else { const int j = i - LP * 32, t = j >> 4, d = j & 15; const float ang = (float)t * exp2f(-(float)d * (13.287712379549449f / 16.f)); float sn, cs; sincosf(ang, &sn, &cs); ri[j] = make_float2(cs, sn); }
    }
}
constexpr int LDM = 72;
constexpr int SLOT = 64 * LDM * 2;
constexpr int LDG = 136;
constexpr int RW_LW_OFF = 0 * SLOT;
constexpr int RW_LA_OFF = 4 * SLOT;
constexpr int RW_LG_OFF = 2 * SLOT;
static_assert(64 * LDG * 2 <= 2 * SLOT, "Lg fits in two slots");
constexpr int CS_LD = 68, G_LD = 72;
constexpr int RW_A_OFF = 8 * SLOT;
constexpr int RW_G_OFF = RW_A_OFF + 64 * CS_LD * 4;
constexpr int RW_CS_OFF = RW_G_OFF + 64 * G_LD * 2;
constexpr int RW_SEG_OFF = RW_CS_OFF + 64 * CS_LD * 4;
constexpr int RW_GC_OFF = 13 * SLOT;
static_assert(RW_SEG_OFF + 2048 <= RW_GC_OFF, "rwkv LDS map");
constexpr size_t RW_UNIT_M = 4096 * 2, RW_UNIT_N = 4096 * 4, RW_UNIT_X = 4096 * 2;
constexpr int NUNIT = NB * NCH * 8;

struct RwkvBufs { bf16* M; float* N; bf16* Q; bf16* OP; bf16* G1; bf16* G2; bf16* HC; };

__device__ __forceinline__ bf16x8 lds_frag(const LAS bf16* base, int row, int koff) { return *(const LAS bf16x8*)(base + row * LDM + koff); }
__device__ __forceinline__ int swz_col(int row, int col) { return col ^ (((row >> 4) & 3) << 3); }
template <bool SW> __device__ __forceinline__ bf16x8 lds_frag_s(const LAS bf16* base, int row, int koff) { return *(const LAS bf16x8*)(base + row * LDM + (SW ? swz_col(row, koff) : koff)); }
template <bool SX = false, bool SY = false> __device__ __forceinline__ f32x4 mm_tile(const LAS bf16* X, const LAS bf16* Y, int ta, int tb, int lane, f32x4 acc) {
    const int r = lane & 15, ko = 8 * (lane >> 4);
#pragma unroll
    for (int ks = 0; ks < 2; ++ks) {
        const bf16x8 ya = lds_frag_s<SY>(Y, 16 * tb + r, 32 * ks + ko), xb = lds_frag_s<SX>(X, 16 * ta + r, 32 * ks + ko);
        acc = __builtin_amdgcn_mfma_f32_16x16x32_bf16(ya, xb, acc, 0, 0, 0);
    }
    return acc;
}
template <bool SX = false> __device__ __forceinline__ void ld_xf(bf16x8 (&xf)[2], const LAS bf16* X, int ta, int lane) {
    const int r = lane & 15, ko = 8 * (lane >> 4);
#pragma unroll
    for (int ks = 0; ks < 2; ++ks) xf[ks] = lds_frag_s<SX>(X, 16 * ta + r, 32 * ks + ko);
}
template <bool SY = false> __device__ __forceinline__ f32x4 mm_xf(const bf16x8 (&xf)[2], const LAS bf16* Y, int tb, int lane, f32x4 acc) {
    const int r = lane & 15, ko = 8 * (lane >> 4);
#pragma unroll
    for (int ks = 0; ks < 2; ++ks) acc = __builtin_amdgcn_mfma_f32_16x16x32_bf16(lds_frag_s<SY>(Y, 16 * tb + r, 32 * ks + ko), xf[ks], acc, 0, 0, 0);
    return acc;
}
__device__ __forceinline__ void st_r(LAS bf16* dst, int a, int b0, f32x4 v) {
    v2u w; w.x = pk2(v[0], v[1]); w.y = pk2(v[2], v[3]); *(LAS v2u*)(dst + a * LDM + b0) = w;
}
__device__ __forceinline__ void st_t(LAS bf16* dst, int a, int b0, f32x4 v) {
#pragma unroll
    for (int i = 0; i < 4; ++i) dst[(b0 + i) * LDM + a] = (bf16)f2bf(v[i]);
}
__device__ __forceinline__ f32x4 ld_r(const LAS bf16* src, int a, int b0) {
    const v2u w = *(const LAS v2u*)(src + a * LDM + b0);
    return (f32x4){bflo(w.x), bfhi(w.x), bflo(w.y), bfhi(w.y)};
}
__device__ __forceinline__ void st8(LAS bf16* dst, const float (&v)[8]) {
    v4u w; w.x = pk2(v[0], v[1]); w.y = pk2(v[2], v[3]); w.z = pk2(v[4], v[5]); w.w = pk2(v[6], v[7]); *(LAS v4u*)dst = w;
}
__device__ __forceinline__ void unpack8(v4u w, float (&o)[8]) {
    o[0] = bflo(w.x); o[1] = bfhi(w.x); o[2] = bflo(w.y); o[3] = bfhi(w.y); o[4] = bflo(w.z); o[5] = bfhi(w.z); o[6] = bflo(w.w); o[7] = bfhi(w.w);
}
__device__ __forceinline__ void ld8f(const float* p, float (&o)[8]) {
    const f32x4 a = *(const f32x4*)p, b = *(const f32x4*)(p + 4);
    o[0] = a.x; o[1] = a.y; o[2] = a.z; o[3] = a.w; o[4] = b.x; o[5] = b.y; o[6] = b.z; o[7] = b.w;
}
__device__ __forceinline__ float sigmoidf_(float x) { return __builtin_amdgcn_rcpf(1.f + __expf(-x)); }
__device__ __forceinline__ float tanhf_(float x) { return 1.f - 2.f * __builtin_amdgcn_rcpf(1.f + __expf(2.f * x)); }

constexpr int RW_WG2_OFF = 13 * SLOT, RW_WB_OFF = 13 * SLOT + 64 * LDG * 2, RW_WW2_OFF = 15 * SLOT, RW_WA2_OFF = 1 * SLOT;
static_assert(RW_WB_OFF + 512 <= 15 * SLOT, "LoRA weights LDS map");
constexpr int RW_MU_OFF = 12 * SLOT;
struct RwW { v4u v[4]; float mu, bias; };
__device__ __forceinline__ void rw_w_fetch(RwW& W, const Frame& F, const Args& a, int h) {
    const bf16* W2 = (const bf16*)(F.ws + WS_WW2); const bf16* A2 = (const bf16*)(F.ws + WS_WA2); const bf16* G2w = (const bf16*)(F.ws + WS_WG2);
    const int t = F.tid;
    W.v[0] = *(const v4u*)(W2 + (size_t)(64 * h + (t >> 3)) * 64 + 8 * (t & 7));
    W.v[1] = *(const v4u*)(A2 + (size_t)(64 * h + (t >> 3)) * 64 + 8 * (t & 7));
    W.v[2] = *(const v4u*)(G2w + (size_t)(64 * h + (t >> 4)) * 128 + 8 * (t & 15));
    W.v[3] = *(const v4u*)(G2w + (size_t)(64 * h + 32 + (t >> 4)) * 128 + 8 * (t & 15));
    W.mu = (t < 192) ? a.in[5][512 * (t >> 6) + 64 * h + (t & 63)] : ((t < 448) ? a.in[5][1536 + (t - 192)] : a.in[11][64 * h + (t - 448)]);
    W.bias = (t < 64) ? a.in[6][64 * h + t] : ((t < 128) ? a.in[8][64 * h + (t - 64)] : 0.f);
}
__device__ __forceinline__ void rw_w_store(const RwW& W, const Frame& F) {
    const int t = F.tid;
    *(LAS v4u*)(F.lds + RW_WW2_OFF + ((t >> 3) * LDM + 8 * (t & 7)) * 2) = W.v[0];
    *(LAS v4u*)(F.lds + RW_WA2_OFF + ((t >> 3) * LDM + 8 * (t & 7)) * 2) = W.v[1];
    *(LAS v4u*)(F.lds + RW_WG2_OFF + ((t >> 4) * LDG + 8 * (t & 15)) * 2) = W.v[2];
    *(LAS v4u*)(F.lds + RW_WG2_OFF + ((32 + (t >> 4)) * LDG + 8 * (t & 15)) * 2) = W.v[3];
    if (t < 128) *(LAS float*)(F.lds + RW_WB_OFF + 4 * t) = W.bias;
    *(LAS float*)(F.lds + RW_MU_OFF + 4 * t) = W.mu;
}
struct RwRaw { v4u c[7], p[7]; };
__device__ __forceinline__ void rw_load_raw(RwRaw& R, const bf16* __restrict__ Ur, int uidx, int tid) {
    const int h = uidx & 7, bc = uidx >> 3, c = bc % NCH, b = bc / NCH, tau = tid >> 3, q = tid & 7;
    const size_t prow = (size_t)b * LP + (size_t)c * 64 + tau;
    const bool has_prev = (c > 0) || (tau > 0);
    const bf16* ucur = Ur + prow * UR_W; const bf16* uprv = ucur - UR_W;
    const v4u z = {0u, 0u, 0u, 0u};
#pragma unroll
    for (int j = 0; j < 7; ++j) { const int col = (j < 3) ? (512 * j + 64 * h + 8 * q) : (1536 + 64 * (j - 3) + 8 * q);
        R.c[j] = *(const v4u*)(ucur + col); R.p[j] = has_prev ? *(const v4u*)(uprv + col) : z; }
}
__device__ __forceinline__ void rwkv_unit(const Frame& F, const Args& a, const bf16* __restrict__ Ur, const RwkvBufs& RB, int uidx, RwRaw& R, int unext) {
    const int h = uidx & 7, bc = uidx >> 3, c = bc % NCH, b = bc / NCH;
    const int tid = F.tid, lane = F.lane, w = F.wave;
    LAS unsigned char* lds = F.lds;
#define MAT(i) ((LAS bf16*)(lds + (i) * SLOT))
    LAS bf16 *Rg = MAT(0), *Kg = MAT(1), *KgT = MAT(2), *Bi = MAT(3), *nBiT = MAT(4), *Ki = MAT(5), *KiT = MAT(6), *VT = MAT(7);
    LAS bf16 *Akk = MAT(8), *nArb = MAT(9), *Ark = MAT(10), *Pa = MAT(11), *PaT = MAT(12), *Pb = MAT(13), *PbT = MAT(14), *Ta = MAT(15), *Tb = MAT(1);
    LAS bf16 *AVT = MAT(3), *WuT = MAT(5), *UvT = MAT(8);
    LAS bf16* Lw = (LAS bf16*)(lds + RW_LW_OFF); LAS bf16* La = (LAS bf16*)(lds + RW_LA_OFF); LAS bf16* Lg = (LAS bf16*)(lds + RW_LG_OFF);
    LAS float* Af = (LAS float*)(lds + RW_A_OFF); LAS bf16* Gb = (LAS bf16*)(lds + RW_G_OFF); LAS float* CS = (LAS float*)(lds + RW_CS_OFF);
    LAS float* gC = (LAS float*)(lds + RW_GC_OFF); LAS float* SEG = (LAS float*)(lds + RW_SEG_OFF);
    const float* mu = a.in[5];
    const int ta = w >> 1, ar = 16 * ta + (lane & 15), ko = 8 * (lane >> 4);
    const int tau = tid >> 3, q = tid & 7;
    float r8[8], k8[8], v8[8], kk8[8];
    {
        float cu[8], pv[8], m8[8];
        const int ch0 = 64 * h + 8 * q;
        const LAS float* MUL = (const LAS float*)(lds + RW_MU_OFF);
#define RW_LD8L(p_, o_) do { const f32x4 x0_ = *(const LAS f32x4*)(p_), x1_ = *(const LAS f32x4*)((p_) + 4); o_[0] = x0_.x; o_[1] = x0_.y; o_[2] = x0_.z; o_[3] = x0_.w; o_[4] = x1_.x; o_[5] = x1_.y; o_[6] = x1_.z; o_[7] = x1_.w; } while (0)
        unpack8(R.c[0], cu); unpack8(R.p[0], pv);
        RW_LD8L(MUL + 8 * q, m8);
#pragma unroll
        for (int i = 0; i < 8; ++i) r8[i] = cu[i] + (pv[i] - cu[i]) * m8[i];
        unpack8(R.c[1], cu); unpack8(R.p[1], pv);
        RW_LD8L(MUL + 64 + 8 * q, m8);
#pragma unroll
        for (int i = 0; i < 8; ++i) k8[i] = cu[i] + (pv[i] - cu[i]) * m8[i];
        unpack8(R.c[2], cu); unpack8(R.p[2], pv);
        RW_LD8L(MUL + 128 + 8 * q, m8);
#pragma unroll
        for (int i = 0; i < 8; ++i) v8[i] = cu[i] + (pv[i] - cu[i]) * m8[i];
        float kkc[8]; RW_LD8L(MUL + 448 + 8 * q, kkc);
        float ss = 0.f;
#pragma unroll
        for (int i = 0; i < 8; ++i) { kk8[i] = k8[i] * kkc[i]; ss += kk8[i] * kk8[i]; }
        ss = sum8(ss);
        const float inv = 1.f / fmaxf(sqrtf(ss), 1e-12f);
#pragma unroll
        for (int i = 0; i < 8; ++i) kk8[i] *= inv;
#pragma unroll
        for (int i = 0; i < 4; ++i) {
            const int col = 1536 + 64 * i + 8 * q;
            unpack8(R.c[3 + i], cu); unpack8(R.p[3 + i], pv);
            RW_LD8L(MUL + 192 + 64 * i + 8 * q, m8);
            float o[8];
#pragma unroll
            for (int e = 0; e < 8; ++e) { const float x = cu[e] + (pv[e] - cu[e]) * m8[e]; o[e] = (i == 0) ? tanhf_(x) : (i == 1 ? x : sigmoidf_(x)); }
            if (i == 0) st8(Lw + tau * LDM + 8 * q, o);
            else if (i == 1) st8(La + tau * LDM + 8 * q, o);
            else st8(Lg + tau * LDG + 64 * (i - 2) + 8 * q, o);
        }
    }
    LDS_WAIT(); __syncthreads();
    {
        const LAS bf16* W2L = (const LAS bf16*)(lds + RW_WW2_OFF); const LAS bf16* A2L = (const LAS bf16*)(lds + RW_WA2_OFF); const LAS bf16* G2L = (const LAS bf16*)(lds + RW_WG2_OFF);
#pragma unroll 1
        for (int tt = 0; tt < 2; ++tt) {
            const int tb = 2 * (w & 1) + tt, b0 = 16 * tb + 4 * (lane >> 4), chl = 16 * tb + (lane & 15);
            f32x4 aw = {0.f, 0.f, 0.f, 0.f}, aa = aw, ag = aw;
#pragma unroll
            for (int ks = 0; ks < 2; ++ks) {
                const bf16x8 yw = *(const LAS bf16x8*)(W2L + chl * LDM + 32 * ks + ko), ya = *(const LAS bf16x8*)(A2L + chl * LDM + 32 * ks + ko);
                const bf16x8 xw = *(const LAS bf16x8*)(Lw + ar * LDM + 32 * ks + ko), xa = *(const LAS bf16x8*)(La + ar * LDM + 32 * ks + ko);
                aw = __builtin_amdgcn_mfma_f32_16x16x32_bf16(yw, xw, aw, 0, 0, 0);
                aa = __builtin_amdgcn_mfma_f32_16x16x32_bf16(ya, xa, aa, 0, 0, 0);
            }
#pragma unroll
            for (int ks = 0; ks < 4; ++ks) {
                const bf16x8 yg = *(const LAS bf16x8*)(G2L + chl * LDG + 32 * ks + ko);
                const bf16x8 xg = *(const LAS bf16x8*)(Lg + ar * LDG + 32 * ks + ko);
                ag = __builtin_amdgcn_mfma_f32_16x16x32_bf16(yg, xg, ag, 0, 0, 0);
            }
            const f32x4 w0v = *(const LAS f32x4*)(lds + RW_WB_OFF + 4 * b0), a0v = *(const LAS f32x4*)(lds + RW_WB_OFF + 256 + 4 * b0);
            f32x4 lw, av;
#pragma unroll
            for (int i = 0; i < 4; ++i) {
                const float xw = -(w0v[i] + aw[i]);
                const float sp = (xw > 20.f) ? xw : __logf(1.f + __expf(xw));
                lw[i] = -__expf(-sp - 0.5f);
                av[i] = sigmoidf_(a0v[i] + aa[i]);
            }
            *(LAS f32x4*)(CS + ar * CS_LD + b0) = lw;
            *(LAS f32x4*)(Af + ar * CS_LD + b0) = av;
            v2u gw; gw.x = pk2(ag[0], ag[1]); gw.y = pk2(ag[2], ag[3]); *(LAS v2u*)(Gb + ar * G_LD + b0) = gw;
        }
    }
    float kac[8], rkc[8], lng[8], lnb[8];
    { const int ch0_ = 64 * h + 8 * (tid & 7); ld8f(a.in[12] + ch0_, kac); ld8f(a.in[13] + ch0_, rkc); ld8f(a.in[14] + ch0_, lng); ld8f(a.in[15] + ch0_, lnb); }
    LDS_WAIT(); __syncthreads();
    {
        const int j = tid & 63, sg = tid >> 6;
        float run = 0.f;
#pragma unroll
        for (int i = 0; i < 8; ++i) { run += CS[(8 * sg + i) * CS_LD + j]; CS[(8 * sg + i) * CS_LD + j] = run; }
        SEG[sg * 64 + j] = run;
        LDS_WAIT(); __syncthreads();
        float off = 0.f;
#pragma unroll
        for (int s = 0; s < 7; ++s) { const float sv = SEG[s * 64 + j]; off += (s < sg) ? sv : 0.f; }
#pragma unroll
        for (int i = 0; i < 8; ++i) CS[(8 * sg + i) * CS_LD + j] += off;
    }
    LDS_WAIT(); __syncthreads();
    {
        float cs[8], csp[8], av[8], gt[8];
        { const LAS f32x4* p = (const LAS f32x4*)(CS + tau * CS_LD + 8 * q); const f32x4 x0 = p[0], x1 = p[1];
          cs[0] = x0.x; cs[1] = x0.y; cs[2] = x0.z; cs[3] = x0.w; cs[4] = x1.x; cs[5] = x1.y; cs[6] = x1.z; cs[7] = x1.w; }
        if (tau > 0) { const LAS f32x4* p = (const LAS f32x4*)(CS + (tau - 1) * CS_LD + 8 * q); const f32x4 x0 = p[0], x1 = p[1];
          csp[0] = x0.x; csp[1] = x0.y; csp[2] = x0.z; csp[3] = x0.w; csp[4] = x1.x; csp[5] = x1.y; csp[6] = x1.z; csp[7] = x1.w; }
        else {
#pragma unroll
          for (int i = 0; i < 8; ++i) csp[i] = 0.f; }
        { const LAS f32x4* p = (const LAS f32x4*)(Af + tau * CS_LD + 8 * q); const f32x4 x0 = p[0], x1 = p[1];
          av[0] = x0.x; av[1] = x0.y; av[2] = x0.z; av[3] = x0.w; av[4] = x1.x; av[5] = x1.y; av[6] = x1.z; av[7] = x1.w; }
        unpack8(*(const LAS v4u*)(Gb + tau * G_LD + 8 * q), gt);
        float o_rg[8], o_kg[8], o_bi[8], o_ki[8];
        float bon = 0.f;
#pragma unroll
        for (int i = 0; i < 8; ++i) {
            const float g = __expf(cs[i]), gi = __expf(-cs[i]), gm = __expf(csp[i]);
            o_rg[i] = r8[i] * g; o_kg[i] = kk8[i] * gm;
            const float bb = kk8[i] * av[i]; o_bi[i] = bb * gi;
            const float kt = k8[i] * (1.f + (av[i] - 1.f) * kac[i]); o_ki[i] = kt * gi;
            bon += r8[i] * kt * rkc[i];
            if (tau == 63) *(LAS float*)(Rg + (8 * q + i) * LDM + 64) = g;
        }
        bon = sum8(bon);
        st8(Rg + tau * LDM + 8 * q, o_rg); st8(Kg + tau * LDM + 8 * q, o_kg); st8(Bi + tau * LDM + 8 * q, o_bi); st8(Ki + tau * LDM + 8 * q, o_ki);
#pragma unroll
        for (int i = 0; i < 8; ++i) {
            const int j = 8 * q + i;
            const int jt = j * LDM + swz_col(j, tau);
            KgT[jt] = (bf16)f2bf(o_kg[i]); nBiT[jt] = (bf16)f2bf(-o_bi[i]); KiT[jt] = (bf16)f2bf(o_ki[i]); VT[jt] = (bf16)f2bf(v8[i]);
        }
        float g1[8], g2[8];
#pragma unroll
        for (int i = 0; i < 8; ++i) { g1[i] = lng[i] * gt[i]; g2[i] = (lnb[i] + bon * v8[i]) * gt[i]; }
        v4u w1; w1.x = pk2(g1[0], g1[1]); w1.y = pk2(g1[2], g1[3]); w1.z = pk2(g1[4], g1[5]); w1.w = pk2(g1[6], g1[7]);
        v4u w2; w2.x = pk2(g2[0], g2[1]); w2.y = pk2(g2[2], g2[3]); w2.z = pk2(g2[4], g2[5]); w2.w = pk2(g2[6], g2[7]);
        *(v4u*)(RB.G1 + (size_t)uidx * 4096 + tau * 64 + 8 * q) = w1;
        *(v4u*)(RB.G2 + (size_t)uidx * 4096 + tau * 64 + 8 * q) = w2;
    }
    LDS_WAIT(); __syncthreads();
    const f32x4 zero4 = {0.f, 0.f, 0.f, 0.f};
    bf16x8 xkg[2], xrg[2]; ld_xf(xkg, Kg, ta, lane); ld_xf(xrg, Rg, ta, lane);
#pragma unroll 1
    for (int tt = 0; tt < 2; ++tt) {
        const int tb = 2 * (w & 1) + tt, b0 = 16 * tb + 4 * (lane >> 4);
        f32x4 zkb = mm_xf(xkg, Bi, tb, lane, zero4), zkk = mm_xf(xkg, Ki, tb, lane, zero4);
        f32x4 zrb = mm_xf(xrg, Bi, tb, lane, zero4), zrk = mm_xf(xrg, Ki, tb, lane, zero4);
        f32x4 p0, t0;
#pragma unroll
        for (int i = 0; i < 4; ++i) {
            const int s = b0 + i;
            p0[i] = (s < ar) ? -zkb[i] : 0.f; t0[i] = p0[i] + ((s == ar) ? 1.f : 0.f);
            zkk[i] = (s < ar) ? zkk[i] : 0.f; zrb[i] = (s <= ar) ? -zrb[i] : 0.f; zrk[i] = (s <= ar) ? zrk[i] : 0.f;
        }
        st_r(Pa, ar, b0, p0); st_t(PaT, ar, b0, p0); st_r(Ta, ar, b0, t0); st_r(Akk, ar, b0, zkk); st_r(nArb, ar, b0, zrb); st_r(Ark, ar, b0, zrk);
    }
    LDS_WAIT(); __syncthreads();
    bf16x8 xpa[2], xvt[2]; ld_xf(xpa, Pa, ta, lane); ld_xf<true>(xvt, VT, ta, lane);
#pragma unroll 1
    for (int tt = 0; tt < 2; ++tt) {
        const int tb = 2 * (w & 1) + tt, b0 = 16 * tb + 4 * (lane >> 4);
        const f32x4 p = mm_xf(xpa, PaT, tb, lane, zero4), av = mm_xf(xvt, Akk, tb, lane, zero4);
        st_r(Pb, ar, b0, p); st_t(PbT, ar, b0, p); st_r(AVT, ar, b0, av);
    }
    LDS_WAIT(); __syncthreads();
#define RW_SQ_ACC(Pin, PinT, Pout, PoutT, Tin, Tout, DO_SQ) do { \
        const int tbA = 2 * (w & 1), b0A = 16 * tbA + 4 * (lane >> 4), b0B = b0A + 16, rA = 16 * tbA + (lane & 15); \
        bf16x8 xp[2], xt[2], ya[2], yb[2]; \
        _Pragma("unroll") for (int ks = 0; ks < 2; ++ks) { if (DO_SQ) xp[ks] = lds_frag(Pin, ar, 32 * ks + ko); xt[ks] = lds_frag(Tin, ar, 32 * ks + ko); \
            ya[ks] = lds_frag(PinT, rA, 32 * ks + ko); yb[ks] = lds_frag(PinT, rA + 16, 32 * ks + ko); } \
        f32x4 pA = zero4, pB = zero4, tA = ld_r(Tin, ar, b0A), tB = ld_r(Tin, ar, b0B); \
        _Pragma("unroll") for (int ks = 0; ks < 2; ++ks) { \
            if (DO_SQ) { pA = __builtin_amdgcn_mfma_f32_16x16x32_bf16(ya[ks], xp[ks], pA, 0, 0, 0); pB = __builtin_amdgcn_mfma_f32_16x16x32_bf16(yb[ks], xp[ks], pB, 0, 0, 0); } \
            tA = __builtin_amdgcn_mfma_f32_16x16x32_bf16(ya[ks], xt[ks], tA, 0, 0, 0); tB = __builtin_amdgcn_mfma_f32_16x16x32_bf16(yb[ks], xt[ks], tB, 0, 0, 0); } \
        if (DO_SQ) { st_r(Pout, ar, b0A, pA); st_t(PoutT, ar, b0A, pA); st_r(Pout, ar, b0B, pB); st_t(PoutT, ar, b0B, pB); } \
        st_r(Tout, ar, b0A, tA); st_r(Tout, ar, b0B, tB); \
        LDS_WAIT(); __syncthreads(); } while (0)
    RW_SQ_ACC(Pb, PbT, Pa, PaT, Ta, Tb, true);
    RW_SQ_ACC(Pa, PaT, Pb, PbT, Tb, Ta, true);
    RW_SQ_ACC(Pb, PbT, Pa, PaT, Ta, Tb, true);
    RW_SQ_ACC(Pa, PaT, Pb, PbT, Tb, Ta, true);
    RW_SQ_ACC(Pb, PbT, Pa, PaT, Ta, Tb, false);
#undef RW_SQ_ACC
    Frame F2 = F; { int t2 = tid; asm volatile("" : "+v"(t2)); F2.tid = t2; F2.lane = t2 & 63; }
    if (unext >= 0) rw_load_raw(R, Ur, unext, F2.tid);
    bf16x8 xkt[2], xav[2]; ld_xf<true>(xkt, KgT, ta, lane); ld_xf(xav, AVT, ta, lane);
#pragma unroll 1
    for (int tt = 0; tt < 2; ++tt) {
        const int tb = 2 * (w & 1) + tt, b0 = 16 * tb + 4 * (lane >> 4);
        const f32x4 wu = mm_xf(xkt, Tb, tb, lane, zero4), uv = mm_xf(xav, Tb, tb, lane, zero4);
        st_r(WuT, ar, b0, wu); st_r(UvT, ar, b0, uv);
    }
    LDS_WAIT(); __syncthreads();
    RwW Wn; if (unext >= 0) rw_w_fetch(Wn, F2, a, unext & 7);
    int uo = uidx; asm volatile("" : "+s"(uo));
    bf16x8 xnb[2], xna[2]; ld_xf<true>(xnb, nBiT, ta, lane); ld_xf(xna, nArb, ta, lane);
#pragma unroll 1
    for (int tt = 0; tt < 2; ++tt) {
        const int tb = 2 * (w & 1) + tt, b0 = 16 * tb + 4 * (lane >> 4);
        const float gj = *(const LAS float*)(Rg + ar * LDM + 64);
        { const f32x4 z = mm_xf(xnb, WuT, tb, lane, zero4);
          const int m = ar >> 5, rp = ar & 31;
          bf16* Mo = RB.M + (size_t)uo * 4096;
          float v4[4];
#pragma unroll
          for (int i = 0; i < 4; ++i) { const int jp = b0 + i; v4[i] = gj * (z[i] + ((jp == ar) ? 1.f : 0.f)); }
          { const int kb = b0 >> 5, qq = b0 & 31, s_ = qq >> 4, p = qq & 15, e0 = 4 * (p >> 3), hh = (p >> 2) & 1, ln = rp + 32 * hh;
            v2u w; w.x = pk2(v4[0], v4[1]); w.y = pk2(v4[2], v4[3]);
            *(v2u*)(Mo + ((((m * 2 + kb) * 2 + s_) * 64 + ln) << 3) + e0) = w; } }
        { f32x4 z = mm_tile<true, true>(KiT, VT, ta, tb, lane, zero4); z = mm_xf(xnb, UvT, tb, lane, z);
          const int m = ar >> 5, qq = ar & 31, hh = (qq >> 2) & 1, rg = (qq & 3) + 4 * (qq >> 3);
          float* No = RB.N + (size_t)uo * 4096;
          { const int n = b0 >> 5, cc = b0 & 31; *(f32x4*)(No + ((m * 2 + n) * 16 + rg) * 64 + cc + 32 * hh) = z * gj; } }
        { const f32x4 z = mm_xf(xna, WuT, tb, lane, ld_r(Rg, ar, b0)); v2u o; o.x = pk2(z[0], z[1]); o.y = pk2(z[2], z[3]);
          *(v2u*)(RB.Q + (size_t)uo * 4096 + ar * 64 + b0) = o; }
        { f32x4 z = mm_tile<false, true>(Ark, VT, ta, tb, lane, zero4); z = mm_xf(xna, UvT, tb, lane, z); v2u o; o.x = pk2(z[0], z[1]); o.y = pk2(z[2], z[3]);
          *(v2u*)(RB.OP + (size_t)uo * 4096 + ar * 64 + b0) = o; }
    }
    if (unext >= 0) rw_w_store(Wn, F2);
    LDS_WAIT(); __syncthreads();
#undef MAT
}

__device__ __forceinline__ void rwkv_scan(const RwkvBufs& RB, int bh, int n, int lane) {
    const int b = bh >> 3, h = bh & 7;
    f32x16 X0, X1;
#pragma unroll
    for (int r = 0; r < 16; ++r) { X0[r] = 0.f; X1[r] = 0.f; }
    const int cc = lane & 31, hh = lane >> 5;
    bf16x8 Mc[2][2][2], Mn[2][2][2]; f32x16 N0, N1, N0n, N1n;
    {
        const int uidx = ((b * NCH) << 3) + h;
        const bf16* Mi = RB.M + (size_t)uidx * 4096; const float* Ni = RB.N + (size_t)uidx * 4096;
#pragma unroll
        for (int m = 0; m < 2; ++m)
#pragma unroll
            for (int kb = 0; kb < 2; ++kb)
#pragma unroll
                for (int s = 0; s < 2; ++s) Mc[m][kb][s] = *(const bf16x8*)(Mi + ((((m * 2 + kb) * 2 + s) * 64 + lane) << 3));
#pragma unroll
        for (int r = 0; r < 16; ++r) { N0[r] = Ni[((0 * 2 + n) * 16 + r) * 64 + lane]; N1[r] = Ni[((1 * 2 + n) * 16 + r) * 64 + lane]; }
    }
#pragma unroll 1
    for (int c = 0; c < NCH; ++c) {
        const int uidx = ((b * NCH + c) << 3) + h;
        {
            const int un = ((b * NCH + min(c + 1, NCH - 1)) << 3) + h;
            const bf16* Mi = RB.M + (size_t)un * 4096; const float* Ni = RB.N + (size_t)un * 4096;
#pragma unroll
            for (int m = 0; m < 2; ++m)
#pragma unroll
                for (int kb = 0; kb < 2; ++kb)
#pragma unroll
                    for (int s = 0; s < 2; ++s) Mn[m][kb][s] = *(const bf16x8*)(Mi + ((((m * 2 + kb) * 2 + s) * 64 + lane) << 3));
#pragma unroll
            for (int r = 0; r < 16; ++r) { N0n[r] = Ni[((0 * 2 + n) * 16 + r) * 64 + lane]; N1n[r] = Ni[((1 * 2 + n) * 16 + r) * 64 + lane]; }
        }
        bf16* Ho = RB.HC + (size_t)uidx * 4096 + (size_t)(32 * n + cc) * 64;
#pragma unroll
        for (int g = 0; g < 4; ++g) {
            v2u w0; w0.x = pk2(X0[4 * g], X0[4 * g + 1]); w0.y = pk2(X0[4 * g + 2], X0[4 * g + 3]); *(v2u*)(Ho + 8 * g + 4 * hh) = w0;
            v2u w1; w1.x = pk2(X1[4 * g], X1[4 * g + 1]); w1.y = pk2(X1[4 * g + 2], X1[4 * g + 3]); *(v2u*)(Ho + 32 + 8 * g + 4 * hh) = w1;
        }
        bf16x8 bf[2][2];
#pragma unroll
        for (int s = 0; s < 2; ++s) {
            v4u t0; t0.x = pk2(X0[8 * s], X0[8 * s + 1]); t0.y = pk2(X0[8 * s + 2], X0[8 * s + 3]); t0.z = pk2(X0[8 * s + 4], X0[8 * s + 5]); t0.w = pk2(X0[8 * s + 6], X0[8 * s + 7]);
            v4u t1; t1.x = pk2(X1[8 * s], X1[8 * s + 1]); t1.y = pk2(X1[8 * s + 2], X1[8 * s + 3]); t1.z = pk2(X1[8 * s + 4], X1[8 * s + 5]); t1.w = pk2(X1[8 * s + 6], X1[8 * s + 7]);
            bf[0][s] = __builtin_bit_cast(bf16x8, t0); bf[1][s] = __builtin_bit_cast(bf16x8, t1);
        }
        f32x16 Y0 = N0, Y1 = N1;
#pragma unroll
        for (int kb = 0; kb < 2; ++kb)
#pragma unroll
            for (int s = 0; s < 2; ++s) {
                Y0 = __builtin_amdgcn_mfma_f32_32x32x16_bf16(Mc[0][kb][s], bf[kb][s], Y0, 0, 0, 0);
                Y1 = __builtin_amdgcn_mfma_f32_32x32x16_bf16(Mc[1][kb][s], bf[kb][s], Y1, 0, 0, 0);
            }
        X0 = Y0; X1 = Y1;
#pragma unroll
        for (int m = 0; m < 2; ++m)
#pragma unroll
            for (int kb = 0; kb < 2; ++kb)
#pragma unroll
                for (int s = 0; s < 2; ++s) Mc[m][kb][s] = Mn[m][kb][s];
        N0 = N0n; N1 = N1n;
    }
}

template <class OutF> __device__ __forceinline__ void rwkv_out_unit(const RwkvBufs& RB, int uidx, int lane, const OutF& outf) {
    const int h = uidx & 7, bc = uidx >> 3, c = bc % NCH, b = bc / NCH;
    const bf16* Q = RB.Q + (size_t)uidx * 4096; const bf16* HT = RB.HC + (size_t)uidx * 4096; const bf16* OP = RB.OP + (size_t)uidx * 4096;
    const bf16* G1 = RB.G1 + (size_t)uidx * 4096; const bf16* G2 = RB.G2 + (size_t)uidx * 4096;
    const int r = lane & 15, ko = 8 * (lane >> 4);
    bf16x8 yh[4][2];
#pragma unroll
    for (int tb = 0; tb < 4; ++tb)
#pragma unroll
        for (int ks = 0; ks < 2; ++ks) yh[tb][ks] = *(const bf16x8*)(HT + (16 * tb + r) * 64 + 32 * ks + ko);
    bf16x8 xqa[4][2]; v2u owa[4][4], g1a[4][4], g2a[4][4];
#pragma unroll
    for (int ta = 0; ta < 4; ++ta) {
        const int t = 16 * ta + r;
        xqa[ta][0] = *(const bf16x8*)(Q + t * 64 + ko); xqa[ta][1] = *(const bf16x8*)(Q + t * 64 + 32 + ko);
#pragma unroll
        for (int tb = 0; tb < 4; ++tb) { const int i0 = 16 * tb + 4 * (lane >> 4);
            owa[ta][tb] = *(const v2u*)(OP + t * 64 + i0); g1a[ta][tb] = *(const v2u*)(G1 + t * 64 + i0); g2a[ta][tb] = *(const v2u*)(G2 + t * 64 + i0); }
    }
#pragma unroll
    for (int ta = 0; ta < 4; ++ta) {
        const int t = 16 * ta + r;
        f32x4 o[4]; float s = 0.f;
#pragma unroll
        for (int tb = 0; tb < 4; ++tb) {
            const v2u ow = owa[ta][tb];
            f32x4 acc = {bflo(ow.x), bfhi(ow.x), bflo(ow.y), bfhi(ow.y)};
#pragma unroll
            for (int ks = 0; ks < 2; ++ks) acc = __builtin_amdgcn_mfma_f32_16x16x32_bf16(yh[tb][ks], xqa[ta][ks], acc, 0, 0, 0);
            o[tb] = acc; s += (acc[0] + acc[1]) + (acc[2] + acc[3]);
        }
        s = sum_x32(sum_x16(s));
        const float mean = s * (1.f / 64.f); float qv = 0.f;
#pragma unroll
        for (int tb = 0; tb < 4; ++tb) { o[tb] = o[tb] - mean; qv += (o[tb][0] * o[tb][0] + o[tb][1] * o[tb][1]) + (o[tb][2] * o[tb][2] + o[tb][3] * o[tb][3]); }
        qv = sum_x32(sum_x16(qv));
        const float rstd = rsqrtf(qv * (1.f / 64.f) + GN_EPS);
        const int tg = c * 64 + t;
#pragma unroll
        for (int tb = 0; tb < 4; ++tb) {
            const int i0 = 16 * tb + 4 * (lane >> 4);
            const v2u g1 = g1a[ta][tb], g2 = g2a[ta][tb];
            f32x4 y;
            y[0] = o[tb][0] * rstd * bflo(g1.x) + bflo(g2.x); y[1] = o[tb][1] * rstd * bfhi(g1.x) + bfhi(g2.x);
            y[2] = o[tb][2] * rstd * bflo(g1.y) + bflo(g2.y); y[3] = o[tb][3] * rstd * bfhi(g1.y) + bfhi(g2.y);
            if (tg < L) outf(b, tg, 64 * h + i0, y);
        }
    }
}
constexpr int MW = 264;
constexpr float QSCALE = 0.125f * 1.4426950408889634f;
struct AttBufs { bf16* Q; bf16* QI; unsigned short* MASK; bf16* KX; };
constexpr int MK_NT = MW / 4, MK_BLK = (LP + 16 + 31) / 32;
constexpr size_t MASK_BYTES = (size_t)NB * MK_BLK * MK_NT * 32 * 8;
__device__ __forceinline__ size_t mk_idx(int b, int t, int j) { return (((size_t)b * MK_BLK + ((t + 16) >> 5)) * MK_NT + j) * 32 + ((t + 16) & 31); }

constexpr int LDQ = 264;
__device__ __forceinline__ void att_prep_unit(const Frame& F, const Args& a, bf16* Ua, const AttBufs& AB, int tile) {
    const int tid = F.tid, lane = F.lane, w = F.wave;
    LAS bf16* CQ = (LAS bf16*)F.lds;
    LAS f32x2_t* RQL = (LAS f32x2_t*)(F.lds + 34816);
    LAS f32x2_t* RIL = (LAS f32x2_t*)(F.lds + 34816 + 64 * 33 * 8);
    const int tau = tid >> 3, q = tid & 7;
    const size_t prow = (size_t)tile * 64 + tau;
    const int tpos = (int)(prow % LP);
    bf16* urow = Ua + prow * UA_W;
    const float2* rq = (const float2*)(F.ws + WS_ROPEQ) + (size_t)tpos * 32;
    const float2* ri = (const float2*)(F.ws + WS_ROPEI) + (size_t)tpos * 16;
    f32x2_t tq_[4], ti_[2];
    { const int t0p = (int)(((size_t)tile * 64) % LP);
      const f32x2_t* gq = (const f32x2_t*)(F.ws + WS_ROPEQ) + (size_t)t0p * 32; const f32x2_t* gi = (const f32x2_t*)(F.ws + WS_ROPEI) + (size_t)t0p * 16;
#pragma unroll
      for (int k = 0; k < 4; ++k) tq_[k] = gq[tid + k * NTHR];
#pragma unroll
      for (int k = 0; k < 2; ++k) ti_[k] = gi[tid + k * NTHR]; }
    {
        float x[4][8]; float ss = 0.f;
#pragma unroll
        for (int i = 0; i < 4; ++i) { unpack8(*(const v4u*)(urow + 64 * i + 8 * q), x[i]);
#pragma unroll
            for (int e = 0; e < 8; ++e) ss += x[i][e] * x[i][e]; }
        ss = sum8(ss);
        const float rs = rsqrtf(ss * (1.f / 256.f) + RMS_EPS);
#pragma unroll
        for (int i = 0; i < 4; ++i) { float g8[8], o[8]; ld8f(a.in[16] + 64 * i + 8 * q, g8);
#pragma unroll
            for (int e = 0; e < 8; ++e) o[e] = x[i][e] * rs * g8[e];
            st8(CQ + tau * LDQ + 64 * i + 8 * q, o); }
    }
    v4u xin[8]; float2 cs4[4], ci4[4]; v4u xkidx; float lnw[8], lnb[8];
#pragma unroll
    for (int i = 0; i < 8; ++i) xin[i] = *(const v4u*)(urow + 256 + 8 * (q + 8 * i));
#pragma unroll
    for (int pp = 0; pp < 4; ++pp) { cs4[pp] = rq[4 * q + pp]; ci4[pp] = ri[4 * (q & 3) + pp]; }
    xkidx = *(const v4u*)(urow + 1280 + 8 * q);
#pragma unroll
    for (int e = 0; e < 8; ++e) { const int p = 8 * q + e; const int d = (p < 32) ? ((p & 1) ? 16 + (p >> 1) : (p >> 1)) : p; lnw[e] = a.in[19][d]; lnb[e] = a.in[20][d]; }
    asm volatile("" ::: "memory");
#pragma unroll
    for (int i = 0; i < 8; ++i) {
        const int col = 8 * (q + 8 * i); float x[8], o[8];
        unpack8(xin[i], x);
#pragma unroll
        for (int pp = 0; pp < 4; ++pp) { const float2 cs = cs4[pp]; o[2 * pp] = x[2 * pp] * cs.x - x[2 * pp + 1] * cs.y; o[2 * pp + 1] = x[2 * pp + 1] * cs.x + x[2 * pp] * cs.y; }
        v4u wv; wv.x = pk2(o[0], o[1]); wv.y = pk2(o[2], o[3]); wv.z = pk2(o[4], o[5]); wv.w = pk2(o[6], o[7]);
        *(v4u*)(urow + 256 + col) = wv;
    }
    {
        float x[8]; unpack8(xkidx, x);
        float s = 0.f;
#pragma unroll
        for (int e = 0; e < 8; ++e) s += x[e];
        s = sum8(s);
        const float mean = s * (1.f / 64.f); float qv = 0.f;
#pragma unroll
        for (int e = 0; e < 8; ++e) { x[e] -= mean; qv += x[e] * x[e]; }
        qv = sum8(qv);
        const float rstd = rsqrtf(qv * (1.f / 64.f) + LN_EPS);
        float y[8];
#pragma unroll
        for (int e = 0; e < 8; ++e) { const int p = 8 * q + e; const int d = (p < 32) ? ((p & 1) ? 16 + (p >> 1) : (p >> 1)) : p;
            (void)d; y[e] = x[e] * rstd * lnw[e] + lnb[e]; }
        float o[8];
        if (q < 4) {
#pragma unroll
            for (int pp = 0; pp < 4; ++pp) { const float2 cs = ci4[pp]; o[2 * pp] = y[2 * pp] * cs.x - y[2 * pp + 1] * cs.y; o[2 * pp + 1] = y[2 * pp + 1] * cs.x + y[2 * pp] * cs.y; }
        } else {
#pragma unroll
            for (int e = 0; e < 8; ++e) o[e] = y[e];
        }
        v4u wv; wv.x = pk2(o[0] * 0.125f, o[1] * 0.125f); wv.y = pk2(o[2] * 0.125f, o[3] * 0.125f); wv.z = pk2(o[4] * 0.125f, o[5] * 0.125f); wv.w = pk2(o[6] * 0.125f, o[7] * 0.125f);
        *(v4u*)(AB.KX + prow * 64 + 8 * q) = wv;
    }
#pragma unroll
    for (int k = 0; k < 4; ++k) { const int i = tid + k * NTHR; RQL[(i >> 5) * 33 + (i & 31)] = tq_[k]; }
#pragma unroll
    for (int k = 0; k < 2; ++k) { const int i = tid + k * NTHR; RIL[(i >> 4) * 17 + (i & 15)] = ti_[k]; }
    LDS_WAIT(); __syncthreads();
    {
        const bf16* Wq = (const bf16*)(F.ws + WS_WQ);
        const int r = lane & 15, ko = 8 * (lane >> 4);
        bf16x8 yfA[8], yfB[8];
#pragma unroll
        for (int ks = 0; ks < 8; ++ks) yfA[ks] = *(const bf16x8*)(Wq + (size_t)(16 * (8 * w) + r) * 256 + 32 * ks + ko);
#define ATP_TILE(YF, TBL) do { const int tb = 8 * w + (TBL), n0 = 16 * tb + 4 * (lane >> 4); \
            _Pragma("unroll 1") for (int ta = 0; ta < 4; ++ta) { \
                f32x4 acc = {0.f, 0.f, 0.f, 0.f}; \
                _Pragma("unroll") for (int ks = 0; ks < 8; ++ks) { const bf16x8 xf = *(const LAS bf16x8*)(CQ + (16 * ta + r) * LDQ + 32 * ks + ko); acc = __builtin_amdgcn_mfma_f32_16x16x32_bf16(YF[ks], xf, acc, 0, 0, 0); } \
                const size_t orow = (size_t)tile * 64 + 16 * ta + r; \
                const bool isq = (n0 < 512); const int p = n0 & 63; \
                float o0 = acc[0], o1 = acc[1], o2 = acc[2], o3 = acc[3]; \
                if (isq) { const LAS f32x2_t* rr = RQL + (16 * ta + r) * 33 + (p >> 1); const f32x2_t c0 = rr[0], c1 = rr[1]; \
                    o0 = (acc[0] * c0.x - acc[1] * c0.y) * QSCALE; o1 = (acc[1] * c0.x + acc[0] * c0.y) * QSCALE; o2 = (acc[2] * c1.x - acc[3] * c1.y) * QSCALE; o3 = (acc[3] * c1.x + acc[2] * c1.y) * QSCALE; } \
                else if (p < 32) { const LAS f32x2_t* rr = RIL + (16 * ta + r) * 17 + (p >> 1); const f32x2_t c0 = rr[0], c1 = rr[1]; \
                    o0 = acc[0] * c0.x - acc[1] * c0.y; o1 = acc[1] * c0.x + acc[0] * c0.y; o2 = acc[2] * c1.x - acc[3] * c1.y; o3 = acc[3] * c1.x + acc[2] * c1.y; } \
                v2u ov; ov.x = pk2(o0, o1); ov.y = pk2(o2, o3); \
                bf16* dst = isq ? (AB.Q + orow * 512 + n0) : (AB.QI + orow * 512 + (n0 - 512)); \
                *(v2u*)dst = ov; } } while (0)
#pragma unroll 1
        for (int tb2 = 0; tb2 < 8; tb2 += 2) {
#pragma unroll
            for (int ks = 0; ks < 8; ++ks) yfB[ks] = *(const bf16x8*)(Wq + (size_t)(16 * (8 * w + tb2 + 1) + r) * 256 + 32 * ks + ko);
            ATP_TILE(yfA, tb2);
            if (tb2 + 2 < 8) {
#pragma unroll
                for (int ks = 0; ks < 8; ++ks) yfA[ks] = *(const bf16x8*)(Wq + (size_t)(16 * (8 * w + tb2 + 2) + r) * 256 + 32 * ks + ko);
            }
            ATP_TILE(yfB, tb2 + 1);
        }
#undef ATP_TILE
    }
    LDS_WAIT(); __syncthreads();
}

__device__ __forceinline__ unsigned fkey(float f) { const unsigned u = __float_as_uint(f); return u ^ ((unsigned)((int)u >> 31) | 0x80000000u); }
__device__ __forceinline__ void cnt_ge(int& c, unsigned x, unsigned cand) {
    unsigned long long m;
    asm("v_cmp_ge_u32 %1, %2, %3\n\tv_addc_co_u32 %0, %1, 0, %0, %1" : "+v"(c), "=&s"(m) : "v"(x), "v"(cand));
}
template <int BIT> __device__ __forceinline__ void nib_ge(unsigned& nib, unsigned x, unsigned K) {
    unsigned t; asm volatile("v_cmp_ge_u32 vcc, %1, %2\n\tv_cndmask_b32 %0, 0, %3, vcc" : "=v"(t) : "v"(x), "v"(K), "v"(1u << BIT) : "vcc"); nib |= t;
}
constexpr int IDX_NT = 33, IDX_PF = 4;
__device__ __forceinline__ void idx_unit(const Frame& F, const bf16* __restrict__ Ua, const AttBufs& AB, int b, int qt, int flags) {
    const int lane = F.lane, w = F.wave, qc = lane & 15, g = lane >> 4, ko = 8 * g;
    LAS int* cntb = (LAS int*)F.lds;
    const int t0 = 16 * qt, ntile = qt + 1, tq = t0 + qc;
    const size_t qrow = (size_t)b * LP + tq;
    LAS bf16* QIL = (LAS bf16*)(F.lds + 8192);
    { const int tid = F.tid; const int rr = tid >> 5, cc = (tid & 31) * 16;
      const bf16* src = AB.QI + ((size_t)b * LP + t0 + rr) * 512 + cc;
      const v4u x0 = *(const v4u*)src, x1 = *(const v4u*)(src + 8);
      *(LAS v4u*)(QIL + rr * 520 + cc) = x0; *(LAS v4u*)(QIL + rr * 520 + cc + 8) = x1; }
    LDS_WAIT(); __syncthreads();
    float wq[8];
    { const v4u ww = *(const v4u*)(Ua + qrow * UA_W + 1344); float t8[8]; unpack8(ww, t8);
#pragma unroll
      for (int h = 0; h < 8; ++h) wq[h] = t8[h] * 0.35355339059327373f; }
    unsigned sc[IDX_NT][4];
    const bf16* kbase = AB.KX + (size_t)b * LP * 64;
    const int wlast = (ntile - 1 - w) >> 3;
    bf16x8 ra0[IDX_PF], ra1[IDX_PF];
#pragma unroll
    for (int p = 0; p < IDX_PF; ++p) { const unsigned ko_ = (unsigned)((16 * (w + 8 * max(min(p, wlast), 0)) + qc) * 64 + ko) ; const unsigned kc = (w < ntile) ? ko_ : (unsigned)(qc * 64 + ko);
        ra0[p] = *(const bf16x8*)(kbase + kc); ra1[p] = *(const bf16x8*)(kbase + kc + 32); }
#pragma unroll
    for (int i = 0; i < IDX_NT; ++i) {
        int wv = w; asm volatile("" : "+s"(wv));
        const int kt = wv + 8 * i;
        const bf16x8 a0 = ra0[i % IDX_PF], a1 = ra1[i % IDX_PF];
        { const int ip = max(min(i + IDX_PF, wlast), 0); const unsigned ko_ = (unsigned)((16 * (wv + 8 * ip) + qc) * 64 + ko); const unsigned kc = (wv < ntile) ? ko_ : (unsigned)(qc * 64 + ko);
          ra0[i % IDX_PF] = *(const bf16x8*)(kbase + kc); ra1[i % IDX_PF] = *(const bf16x8*)(kbase + kc + 32); }
        asm volatile("" ::: "memory");
        if (kt < ntile) {
            f32x4 acc = {0.f, 0.f, 0.f, 0.f};
#pragma unroll
            for (int hq = 0; hq < 2; ++hq) {
                bf16x8 qa[4], qb_[4];
#pragma unroll
                for (int h4 = 0; h4 < 4; ++h4) { qa[h4] = *(const LAS bf16x8*)(QIL + qc * 520 + 64 * (4 * hq + h4) + ko); qb_[h4] = *(const LAS bf16x8*)(QIL + qc * 520 + 64 * (4 * hq + h4) + 32 + ko); }
                __builtin_amdgcn_sched_group_barrier(0x100, 8, 0);
                f32x4 sh[4];
#pragma unroll
                for (int h4 = 0; h4 < 4; ++h4) { sh[h4] = (f32x4){0.f, 0.f, 0.f, 0.f}; sh[h4] = __builtin_amdgcn_mfma_f32_16x16x32_bf16(a0, qa[h4], sh[h4], 0, 0, 0); }
#pragma unroll
                for (int h4 = 0; h4 < 4; ++h4) sh[h4] = __builtin_amdgcn_mfma_f32_16x16x32_bf16(a1, qb_[h4], sh[h4], 0, 0, 0);
                __builtin_amdgcn_sched_group_barrier(0x008, 8, 0);
#pragma unroll
                for (int h4 = 0; h4 < 4; ++h4)
#pragma unroll
                    for (int r = 0; r < 4; ++r) { const float t_ = __builtin_amdgcn_fmed3f(sh[h4][r], 0.f, INFINITY);
                        asm("v_fma_f32 %0, %1, %2, %0" : "+v"(acc[r]) : "v"(t_), "v"(wq[4 * hq + h4])); }
                if (hq == 0) asm volatile("" ::: "memory");
            }
            if (kt == qt) {
#pragma unroll
                for (int r = 0; r < 4; ++r) sc[i][r] = (4 * g + r <= qc) ? (fkey(acc[r]) >> 1) : 0u;
            } else {
#pragma unroll
                for (int r = 0; r < 4; ++r) sc[i][r] = fkey(acc[r]) >> 1;
            }
        } else {
#pragma unroll
            for (int r = 0; r < 4; ++r) sc[i][r] = 0u;
        }
    }
    unsigned K = 0u; bool found = (tq + 1 <= 256);
    const int nwave_tiles = __builtin_amdgcn_readfirstlane(max(wlast + 1, 0));
    unsigned lo, hi;
    {
        unsigned gm[8];
#pragma unroll
        for (int j = 0; j < 8; ++j) gm[j] = 0u;
#pragma unroll
        for (int i = 0; i < IDX_NT; ++i) gm[i & 7] = max(gm[i & 7], max(max(sc[i][0], sc[i][1]), max(sc[i][2], sc[i][3])));
        unsigned mx = max(max(max(gm[0], gm[1]), max(gm[2], gm[3])), max(max(gm[4], gm[5]), max(gm[6], gm[7])));
        unsigned mn = min(min(min(gm[0], gm[1]), min(gm[2], gm[3])), min(min(gm[4], gm[5]), min(gm[6], gm[7])));
        mx = max(mx, (unsigned)__shfl_xor((int)mx, 16)); mx = max(mx, (unsigned)__shfl_xor((int)mx, 32));
        mn = min(mn, (unsigned)__shfl_xor((int)mn, 16)); mn = min(mn, (unsigned)__shfl_xor((int)mn, 32));
        LAS unsigned* brk = (LAS unsigned*)(F.lds + 1024);
        if (g == 0) { brk[w * 16 + qc] = mn; brk[128 + w * 16 + qc] = mx; }
        LDS_WAIT(); __syncthreads();
        lo = brk[qc]; hi = brk[128 + qc];
#pragma unroll
        for (int ww = 1; ww < 8; ++ww) { lo = min(lo, brk[ww * 16 + qc]); hi = max(hi, brk[128 + ww * 16 + qc]); }
        hi += 1u;
    }
    int pp = 0;
#pragma unroll 1
    for (;;) {
        if (!found && hi - lo <= 1u) { K = lo; found = true; }
        if (__all(found)) break;
        const unsigned cand = lo + ((hi - lo) >> 1);
        unsigned b0 = 0u, b1 = 0u, b2 = 0u, b3 = 0u; int lt = 0;
        int nwv = nwave_tiles; asm volatile("" : "+s"(nwv));
#pragma unroll
        for (int i = 0; i < IDX_NT; ++i) {
            if (i < nwv) {
                b0 = __builtin_amdgcn_alignbit(b0, sc[i][0] - cand, 31); b1 = __builtin_amdgcn_alignbit(b1, sc[i][1] - cand, 31);
                b2 = __builtin_amdgcn_alignbit(b2, sc[i][2] - cand, 31); b3 = __builtin_amdgcn_alignbit(b3, sc[i][3] - cand, 31);
            }
            if (i == 15 || i == 31 || i == IDX_NT - 1) { lt += __builtin_popcount(b0) + __builtin_popcount(b1) + __builtin_popcount(b2) + __builtin_popcount(b3); b0 = b1 = b2 = b3 = 0u; }
        }
        int c = 4 * nwv - lt;
        c = isum_x32(isum_x16(c));
        LAS int* cb = cntb + pp * 128; pp ^= 1;
        if (g == 0) cb[w * 16 + qc] = c;
        LDS_WAIT(); __syncthreads();
        int tot = 0;
#pragma unroll
        for (int ww = 0; ww < 8; ++ww) tot += cb[ww * 16 + qc];
        if (!found) { if (tot >= 256) lo = cand; else hi = cand; if (tot == 256) { K = cand; found = true; } }
    }
    if (tq + 1 <= 256 || K == 0u) K = 1u;
    LAS unsigned short* mlds = (LAS unsigned short*)(F.lds + 32768);
    const int kend = (qt == 0) ? 4 : min(16 * (1 + ((qt - 1) >> 4)) + 4, 260);
    LAS unsigned short* mrow_ = mlds + qc * MW + w;
#pragma unroll
    for (int i = 0; i < IDX_NT; ++i) {
        unsigned nib = 0u;
        nib_ge<0>(nib, sc[i][0], K); nib_ge<1>(nib, sc[i][1], K); nib_ge<2>(nib, sc[i][2], K); nib_ge<3>(nib, sc[i][3], K);
        unsigned v = nib << (4 * g);
        v = or_x32(or_x16(v));
        if (g == 0) mrow_[8 * i] = (unsigned short)v;
    }
    LDS_WAIT(); __syncthreads();
    {
        const int npiece = kend >> 2;
        for (int p = F.tid; p < 16 * npiece; p += NTHR) { const int q_ = p & 15, c = p >> 4;
            const v2u val = *(const LAS v2u*)(mlds + q_ * MW + 4 * c);
            ((v2u*)AB.MASK)[mk_idx(b, t0 + q_, c)] = val; }
    }
    LDS_WAIT(); __syncthreads();
}

__device__ __forceinline__ int crow(int r, int hi) { return (r & 3) + 8 * (r >> 2) + 4 * hi; }
constexpr int AT_K = 0, AT_V = 2 * 8192, AT_WS = 4 * 8192;
__device__ __forceinline__ void at_qkt(f32x16& p0, f32x16& p1, const LAS unsigned char* Kslot, const bf16x8* qr, const f32x16& negm, int r32, int hi) {
    const LAS unsigned char* kb = Kslot + hi * 1024 + r32 * 16;
    p0 = negm; p1 = negm;
#pragma unroll
    for (int d0 = 0; d0 < 4; ++d0) {
        const bf16x8 b0 = *(const LAS bf16x8*)(kb + d0 * 2048), b1 = *(const LAS bf16x8*)(kb + d0 * 2048 + 512);
        p0 = __builtin_amdgcn_mfma_f32_32x32x16_bf16(b0, qr[d0], p0, 0, 0, 0);
        p1 = __builtin_amdgcn_mfma_f32_32x32x16_bf16(b1, qr[d0], p1, 0, 0, 0);
    }
}
__device__ __forceinline__ float at_max3(float a, float b, float c) { float r; asm("v_max3_f32 %0, %1, %2, %3" : "=v"(r) : "v"(a), "v"(b), "v"(c)); return r; }
typedef short s16x4 __attribute__((ext_vector_type(4)));
__device__ __forceinline__ s16x4 at_vtr(const LAS unsigned char* p) { return __builtin_bit_cast(s16x4, __builtin_amdgcn_ds_read_tr16_b64_v4i16((LAS s16x4*)p)); }
__device__ __forceinline__ void at_pv(f32x16* o, const LAS unsigned char* vb, bf16x8 pa0, bf16x8 pa1, bf16x8 pa2, bf16x8 pa3) {
#pragma unroll
    for (int d0 = 0; d0 < 2; ++d0) {
        s16x4 lo[4], hi[4];
#pragma unroll
        for (int ks = 0; ks < 4; ++ks) { lo[ks] = at_vtr(vb + d0 * 4096 + ks * 1024); hi[ks] = at_vtr(vb + d0 * 4096 + ks * 1024 + 512); }
#define AT_PK(k) (bf16x8){lo[k][0], lo[k][1], lo[k][2], lo[k][3], hi[k][0], hi[k][1], hi[k][2], hi[k][3]}
        o[d0] = __builtin_amdgcn_mfma_f32_32x32x16_bf16(pa0, AT_PK(0), o[d0], 0, 0, 0);
        o[d0] = __builtin_amdgcn_mfma_f32_32x32x16_bf16(pa1, AT_PK(1), o[d0], 0, 0, 0);
        o[d0] = __builtin_amdgcn_mfma_f32_32x32x16_bf16(pa2, AT_PK(2), o[d0], 0, 0, 0);
        o[d0] = __builtin_amdgcn_mfma_f32_32x32x16_bf16(pa3, AT_PK(3), o[d0], 0, 0, 0);
#undef AT_PK
    }
}
template <class OutF> __device__ __forceinline__ void attn_unit(const Frame& F, const bf16* __restrict__ Ua, const AttBufs& AB, int b, int h, int qb, const OutF& outf) {
    const int lane = F.lane, wid = F.wave, r32 = lane & 31, hi = lane >> 5;
    const LAS unsigned char* lds = F.lds;
    LAS float* wsf = (LAS float*)(F.lds + AT_WS) + wid * 64;
    const size_t rowbase = (size_t)b * LP; const int q0 = (qb == 0) ? 0 : 16 + 256 * (qb - 1), qend = (qb == 0) ? 16 : q0 + 256;
    const int tq = q0 + wid * 32 + r32;
    const int NT = (qend + 63) / 64;
    bf16x8 qr[4];
    { const bf16* Qw = AB.Q + (rowbase + min(tq, LP - 1)) * 512 + 64 * h;
#pragma unroll
      for (int d0 = 0; d0 < 4; ++d0) qr[d0] = *(const bf16x8*)(Qw + 16 * d0 + 8 * hi); }
    const v2u* mrow = (const v2u*)AB.MASK + mk_idx(b, min(tq, LP - 1), 0);
    const bf16* ksrc = Ua + (rowbase + 8 * wid + (lane & 7)) * UA_W + 256 + 64 * h + 8 * (lane >> 3);
    const int ksdst = (lane >> 3) * 1024 + (8 * wid + (lane & 7)) * 16;
    const bf16* vsrc = Ua + (rowbase + 16 * (wid & 3) + (lane >> 2)) * UA_W + 768 + 64 * h + (wid >> 2) * 32 + (lane & 3) * 8;
    const int sdst = wid * 1024 + lane * 16;
    const int vb0 = ((lane >> 4) & 1) * 32 + (lane & 3) * 8 + (4 * hi + ((lane & 15) >> 2)) * 64;
    float m_run = 0.f, l_run = 0.f;
    f32x16 negm;
#pragma unroll
    for (int r = 0; r < 16; ++r) negm[r] = 0.f;
    f32x16 o[2];
#pragma unroll
    for (int r = 0; r < 16; ++r) { o[0][r] = 0.f; o[1][r] = 0.f; }
    v4u kreg = *(const v4u*)ksrc, vreg = *(const v4u*)vsrc;
    v2u mk_next = mrow[0];
    __syncthreads();
    *(LAS v4u*)(lds + AT_K + ksdst) = kreg; *(LAS v4u*)(lds + AT_V + sdst) = vreg;
    for (int j = 0; j < NT; ++j) {
        const int cur = j & 1;
        if (j + 1 < NT) { kreg = *(const v4u*)(ksrc + (size_t)(j + 1) * 64 * UA_W); vreg = *(const v4u*)(vsrc + (size_t)(j + 1) * 64 * UA_W); }
        const v2u mk = mk_next;
        if (j + 1 < NT) mk_next = mrow[32 * (j + 1)];
        LDS_WAIT(); __syncthreads();
        if (64 * j <= q0 + wid * 32 + 31 && q0 + wid * 32 < qend) {
        f32x16 p0, p1;
        at_qkt(p0, p1, lds + AT_K + cur * 8192, qr, negm, r32, hi);
        float mx;
        { float a0 = at_max3(p0[0], p0[1], p1[0]), a1 = at_max3(p0[2], p0[3], p1[1]); a0 = at_max3(a0, p1[2], p1[3]);
#pragma unroll
          for (int r = 4; r < 16; r += 4) { a0 = at_max3(a0, p0[r], p0[r + 1]); a1 = at_max3(a1, p0[r + 2], p0[r + 3]); a0 = at_max3(a0, p1[r], p1[r + 1]); a1 = at_max3(a1, p1[r + 2], p1[r + 3]); }
          mx = at_max3(a0, a1, a1); }
        { auto rr = __builtin_amdgcn_permlane32_swap(__float_as_uint(mx), __float_as_uint(mx), false, false); mx = fmaxf(__uint_as_float(rr[0]), __uint_as_float(rr[1])); }
        if (__any(mx > 4.f)) {
            const float dl = fmaxf(mx, 0.f);
            const float f = __builtin_amdgcn_exp2f(-dl);
            m_run += dl; l_run *= f;
#pragma unroll
            for (int r = 0; r < 16; ++r) { p0[r] -= dl; p1[r] -= dl; negm[r] = -m_run; }
            if (hi == 0) wsf[r32] = f;
            LDS_WAIT();
#pragma unroll
            for (int r = 0; r < 16; ++r) { const float fr = wsf[crow(r, hi)]; o[0][r] *= fr; o[1][r] *= fr; }
        }
        const int mlo = (int)(mk.x >> (4 * hi)), mhi = (int)(mk.y >> (4 * hi));
        float s = 0.f;
#pragma unroll
        for (int r = 0; r < 16; ++r) {
            int b0_, b1_;
            asm("v_bfe_i32 %0, %1, %2, 1" : "=v"(b0_) : "v"(mlo), "n"((r & 3) + 8 * (r >> 2)));
            asm("v_bfe_i32 %0, %1, %2, 1" : "=v"(b1_) : "v"(mhi), "n"((r & 3) + 8 * (r >> 2)));
            p0[r] = __uint_as_float(__float_as_uint(__builtin_amdgcn_exp2f(p0[r])) & (unsigned)b0_);
            p1[r] = __uint_as_float(__float_as_uint(__builtin_amdgcn_exp2f(p1[r])) & (unsigned)b1_);
            s += p0[r] + p1[r];
        }
        l_run += s;
        v4u pw0, pw1, pw2, pw3;
        pw0.x = pk2(p0[0], p0[1]); pw0.y = pk2(p0[2], p0[3]); pw0.z = pk2(p0[4], p0[5]); pw0.w = pk2(p0[6], p0[7]);
        pw1.x = pk2(p0[8], p0[9]); pw1.y = pk2(p0[10], p0[11]); pw1.z = pk2(p0[12], p0[13]); pw1.w = pk2(p0[14], p0[15]);
        pw2.x = pk2(p1[0], p1[1]); pw2.y = pk2(p1[2], p1[3]); pw2.z = pk2(p1[4], p1[5]); pw2.w = pk2(p1[6], p1[7]);
        pw3.x = pk2(p1[8], p1[9]); pw3.y = pk2(p1[10], p1[11]); pw3.z = pk2(p1[12], p1[13]); pw3.w = pk2(p1[14], p1[15]);
        at_pv(o, lds + AT_V + cur * 8192 + vb0, __builtin_bit_cast(bf16x8, pw0), __builtin_bit_cast(bf16x8, pw1), __builtin_bit_cast(bf16x8, pw2), __builtin_bit_cast(bf16x8, pw3));
        }
        if (j + 1 < NT) { *(LAS v4u*)(lds + AT_K + (cur ^ 1) * 8192 + ksdst) = kreg; *(LAS v4u*)(lds + AT_V + (cur ^ 1) * 8192 + sdst) = vreg; }
    }
    { auto rr = __builtin_amdgcn_permlane32_swap(__float_as_uint(l_run), __float_as_uint(l_run), false, false); l_run = __uint_as_float(rr[0]) + __uint_as_float(rr[1]); }
    LDS_WAIT();
    if (hi == 0) wsf[32 + r32] = 1.f / l_run;
    LDS_WAIT();
#pragma unroll
    for (int r = 0; r < 16; ++r) {
        const int qloc = crow(r, hi), t = q0 + wid * 32 + qloc; const float li = wsf[32 + qloc];
        if (t < qend) { outf(b, t, 512 + 64 * h + r32, o[0][r] * li); outf(b, t, 512 + 64 * h + 32 + r32, o[1][r] * li); }
    }
}
constexpr int NEXP = 32, LISTCAP = 32896;
constexpr int CW_CNT = 256;
constexpr size_t WS_LIST = 236 * MiB;
constexpr size_t WS_WT = 241 * MiB;
constexpr size_t WS_PINFO = 242 * MiB;
constexpr size_t EW_GU = (size_t)512 * 1024 * 2, EW_D = (size_t)1024 * 256 * 2;
struct MoeBufs { float* MIX; float* H1; bf16* H1b; bf16* HID; bf16* F; bf16* WGU; bf16* WD; };

__device__ __forceinline__ void convert_experts(const Frame& F, const Args& a, const MoeBufs& MB, int part, int first_wg = 0, int rank = -1, int nconv = 0) {
    LAS float* scr = (LAS float*)(F.lds + F.wave * 16384);
    if (rank < 0 && F.bid < first_wg) return;
    const int gw = (rank >= 0 ? rank : F.bid - first_wg) * NWAVES + F.wave, NGW = (rank >= 0 ? nconv : F.G - first_wg) * NWAVES;
    if (part == 0) {
        for (int it = gw; it < NEXP * 256; it += NGW) {
            const int e = it >> 8, r = it & 255;
            if (r < 128) transpose_item<4>(a.in[28] + (size_t)e * 1024 * 256, 1024, 256, MB.WGU + (size_t)e * 512 * 1024, 0, scr, r, 8, F.lane);
            else transpose_item<4>(a.in[29] + (size_t)e * 1024 * 256, 1024, 256, MB.WGU + (size_t)e * 512 * 1024, 1, scr, r - 128, 8, F.lane);
        }
    } else {
        for (int it = gw; it < NEXP * 128; it += NGW) {
            const int e = it >> 7, r = it & 127;
            transpose_item<0>(a.in[30] + (size_t)e * 256 * 1024, 256, 1024, MB.WD + (size_t)e * 1024 * 256, 0, scr, r, 32, F.lane);
        }
    }
}

constexpr int P6_LNV = 4096, P6_RGW = P6_LNV + 16384, P6_REW = P6_RGW + 16384;
static_assert(P6_REW + 65536 <= RING_BYTES, "P6 LDS map");
__device__ __forceinline__ void p6_ln1_router(const Frame& F, const Args& a, const MoeBufs& MB, const XcdBarrier& bar, unsigned* sig_mix, bool fused) {
    LAS int* lcount = (LAS int*)F.lds;
    LAS int* lbase = lcount + 32;
    LAS int* ent = lbase + 32;
    LAS float* entw = (LAS float*)(ent + 65 * 4);
    unsigned* ctl = (unsigned*)(F.ws + WS_CTL);
    const float2* rowstat = (const float2*)(F.ws + WS_ROWSTAT);
    const int lane = F.lane;
    LAS float* rbias = (LAS float*)(F.lds + 2048);
    if (F.tid < 4) rbias[F.tid] = a.in[25][F.tid]; else if (F.tid < 36) rbias[F.tid] = a.in[27][F.tid - 4];
    { f32x4 t0[2], t1[2];
#pragma unroll
      for (int u = 0; u < 2; ++u) { const int i = F.tid + u * NTHR, vs = i >> 8, q = i & 255; const float* src = (vs == 0) ? a.in[2] : (vs == 1 ? a.in[3] : (vs == 2 ? a.in[22] : a.in[23]));
          t0[u] = ((const f32x4*)src)[q]; t1[u] = *(const f32x4*)(a.in[24] + (size_t)i * 4); }
#pragma unroll
      for (int u = 0; u < 2; ++u) { const int i = F.tid + u * NTHR; *(LAS f32x4*)(F.lds + P6_LNV + i * 16) = t0[u];
          const int slot = ((i >> 8) * 4 + (i & 3)) * 64 + ((i >> 2) & 63); *(LAS f32x4*)(F.lds + P6_RGW + slot * 16) = t1[u]; } }
#pragma unroll 1
    for (int h4 = 0; h4 < 2; ++h4) {
        f32x4 wa[4], wb[4];
#pragma unroll
        for (int u = 0; u < 4; ++u) { const int i = F.tid + (4 * h4 + u) * NTHR, k = i >> 2, g = i & 3; const float* pw = a.in[26] + (size_t)k * 32 + 8 * g; wa[u] = *(const f32x4*)pw; wb[u] = *(const f32x4*)(pw + 4); }
#pragma unroll
        for (int u = 0; u < 4; ++u) { const int i = F.tid + (4 * h4 + u) * NTHR, k = i >> 2, g = i & 3; const int slot = ((k >> 8) * 4 + (k & 3)) * 64 + ((k >> 2) & 63);
            const float w8[8] = {wa[u].x, wa[u].y, wa[u].z, wa[u].w, wb[u].x, wb[u].y, wb[u].z, wb[u].w}; st8((LAS bf16*)(F.lds + P6_REW + g * 16384 + slot * 16), w8); }
    }
    if (fused) grid_wait(F.wave, bar, sig_mix);
    for (int blk = F.bid; blk < 256; blk += F.G) {
    if (F.tid < 32) lcount[F.tid] = 0;
    LDS_WAIT(); __syncthreads();
    f32x4 nx[2][4]; v2u nm[2][4]; float2 nst[2];
#define P6_LOADROW(u_, irow) do { const int ic_ = ((irow) < 64) ? (irow) : F.wave; const int o_ = 64 * blk + ic_; const int pr_ = (o_ / SEQ) * LP + NM + (o_ % SEQ), b_ = pr_ / LP, t_ = pr_ % LP; const int tc_ = (t_ < L) ? t_ : 0; \
        const float* src_ = (tc_ < NM) ? (a.in[1] + (size_t)tc_ * D) : (a.in[0] + ((size_t)b_ * SEQ + (tc_ - NM)) * D); \
        nst[u_] = rowstat[pr_]; \
        _Pragma("unroll") for (int j = 0; j < 4; ++j) { nx[u_][j] = ((const f32x4*)src_)[lane + 64 * j]; nm[u_][j] = ((const v2u*)((const bf16*)MB.MIX + (size_t)pr_ * D))[lane + 64 * j]; } } while (0)
    P6_LOADROW(0, F.wave); P6_LOADROW(1, F.wave + 8);
#pragma unroll 1
    for (int i0 = F.wave; i0 < 64; i0 += 16) {
        f32x4 v[2][4]; v2u cm[2][4];
#pragma unroll
        for (int u = 0; u < 2; ++u)
#pragma unroll
            for (int j = 0; j < 4; ++j) { v[u][j] = nx[u][j]; cm[u][j] = nm[u][j]; }
        float2 st[2] = {nst[0], nst[1]};
        if (i0 + 16 < 64) { P6_LOADROW(0, i0 + 16); P6_LOADROW(1, i0 + 24); }
        bool act[2], inb[2]; int pr[2];
#pragma unroll
        for (int u = 0; u < 2; ++u) { const int iu = i0 + 8 * u; inb[u] = iu < 64; const int o_ = 64 * blk + (inb[u] ? iu : i0); pr[u] = (o_ / SEQ) * LP + NM + (o_ % SEQ); act[u] = inb[u]; }
        float s[2] = {0.f, 0.f};
#pragma unroll
        for (int j = 0; j < 4; ++j) {
            const f32x4 g0 = *(const LAS f32x4*)(F.lds + P6_LNV + (lane + 64 * j) * 16), b0 = *(const LAS f32x4*)(F.lds + P6_LNV + 4096 + (lane + 64 * j) * 16);
#pragma unroll
            for (int u = 0; u < 2; ++u) {
                const f32x4 mxv = {bflo(cm[u][j].x), bfhi(cm[u][j].x), bflo(cm[u][j].y), bfhi(cm[u][j].y)};
                v[u][j] = ((v[u][j] - st[u].x) * st[u].y * g0 + b0) * DN_ALPHA + mxv;
                s[u] += (v[u][j].x + v[u][j].y) + (v[u][j].z + v[u][j].w);
            }
        }
        float mean[2], s2[2] = {0.f, 0.f}, rstd[2];
#pragma unroll
        for (int u = 0; u < 2; ++u) mean[u] = wave_sum(s[u]) * (1.f / D);
#pragma unroll
        for (int u = 0; u < 2; ++u)
#pragma unroll
            for (int j = 0; j < 4; ++j) { v[u][j] = v[u][j] - mean[u]; s2[u] += (v[u][j].x * v[u][j].x + v[u][j].y * v[u][j].y) + (v[u][j].z * v[u][j].z + v[u][j].w * v[u][j].w); }
#pragma unroll
        for (int u = 0; u < 2; ++u) rstd[u] = rsqrtf(wave_sum(s2[u]) * (1.f / D) + LN_EPS);
#pragma unroll
        for (int j = 0; j < 4; ++j) {
            const f32x4 g1 = *(const LAS f32x4*)(F.lds + P6_LNV + 8192 + (lane + 64 * j) * 16), b1 = *(const LAS f32x4*)(F.lds + P6_LNV + 12288 + (lane + 64 * j) * 16);
#pragma unroll
            for (int u = 0; u < 2; ++u) {
                v[u][j] = v[u][j] * rstd[u] * g1 + b1;
                if (act[u]) { v2u hb; hb.x = pk2(v[u][j].x, v[u][j].y); hb.y = pk2(v[u][j].z, v[u][j].w); ((v2u*)(MB.H1b + (size_t)pr[u] * D))[lane + 64 * j] = hb; }
            }
        }
        f32x4 ga[2] = {{0.f, 0.f, 0.f, 0.f}, {0.f, 0.f, 0.f, 0.f}};
#pragma unroll
        for (int j = 0; j < 4; ++j)
#pragma unroll
            for (int c = 0; c < 4; ++c) { const f32x4 wg = *(const LAS f32x4*)(F.lds + P6_RGW + ((4 * j + c) * 64 + lane) * 16); ga[0] = ga[0] + wg * v[0][j][c]; ga[1] = ga[1] + wg * v[1][j][c]; }
        int gs[2]; float ggate[2];
#pragma unroll
        for (int u = 0; u < 2; ++u) {
            float lgp[4];
#pragma unroll
            for (int g = 0; g < 4; ++g) lgp[g] = wave_sum(ga[u][g]) + rbias[g];
            int gsel = 0; float gm = lgp[0];
#pragma unroll
            for (int g = 1; g < 4; ++g) if (lgp[g] > gm) { gm = lgp[g]; gsel = g; }
            float den = 0.f;
#pragma unroll
            for (int g = 0; g < 4; ++g) den += __expf(lgp[g] - gm);
            gs[u] = gsel; ggate[u] = 1.f / den;
        }
        float el[2][8];
#pragma unroll
        for (int u = 0; u < 2; ++u)
#pragma unroll
            for (int q8 = 0; q8 < 8; ++q8) el[u][q8] = 0.f;
#pragma unroll
        for (int j = 0; j < 4; ++j)
#pragma unroll
            for (int c = 0; c < 4; ++c)
#pragma unroll
                for (int u = 0; u < 2; ++u) { float w8[8]; unpack8(*(const LAS v4u*)(F.lds + P6_REW + gs[u] * 16384 + ((4 * j + c) * 64 + lane) * 16), w8);
#pragma unroll
                    for (int q8 = 0; q8 < 8; ++q8) el[u][q8] = fmaf(v[u][j][c], w8[q8], el[u][q8]); }
#pragma unroll
        for (int u = 0; u < 2; ++u) {
#pragma unroll
            for (int q8 = 0; q8 < 8; ++q8) el[u][q8] = wave_sum(el[u][q8]) + rbias[4 + gs[u] * 8 + q8];
            int i1 = 0; float v1 = el[u][0];
#pragma unroll
            for (int q8 = 1; q8 < 8; ++q8) if (el[u][q8] > v1) { v1 = el[u][q8]; i1 = q8; }
            int i2 = 0; float v2 = -INFINITY;
#pragma unroll
            for (int q8 = 0; q8 < 8; ++q8) if (q8 != i1 && el[u][q8] > v2) { v2 = el[u][q8]; i2 = q8; }
            const float e2 = __expf(v2 - v1);
            const float w1 = ggate[u] / (1.f + e2), w2 = ggate[u] * e2 / (1.f + e2);
            const int i = i0 + 8 * u;
            if (lane == 0 && inb[u]) {
                if (act[u]) {
                    const int e0 = gs[u] * 8 + i1, e1 = gs[u] * 8 + i2;
                    ent[i * 4] = e0; ent[i * 4 + 1] = e1;
                    ent[i * 4 + 2] = atomicAdd((int*)(lcount + e0), 1); ent[i * 4 + 3] = atomicAdd((int*)(lcount + e1), 1);
                    entw[i * 2] = w1; entw[i * 2 + 1] = w2;
                } else ent[i * 4] = -1;
            }
        }
    }
#undef P6_LOADROW
    LDS_WAIT(); __syncthreads();
    if (F.tid < 32) lbase[F.tid] = (int)atomicAdd(ctl + CW_CNT + F.tid, (unsigned)lcount[F.tid]);
    LDS_WAIT(); __syncthreads();
    if (F.tid < 64) {
        const int i = F.tid, e0 = ent[i * 4];
        if (e0 >= 0) {
            const int o_ = 64 * blk + i; const int pr = (o_ / SEQ) * LP + NM + (o_ % SEQ), e1 = ent[i * 4 + 1];
            int* list = (int*)(F.ws + WS_LIST); float* wt = (float*)(F.ws + WS_WT);
            list[(size_t)e0 * LISTCAP + lbase[e0] + ent[i * 4 + 2]] = pr * 2;
            list[(size_t)e1 * LISTCAP + lbase[e1] + ent[i * 4 + 3]] = pr * 2 + 1;
            wt[pr * 2] = entw[i * 2]; wt[pr * 2 + 1] = entw[i * 2 + 1];
            unsigned* pinfo = (unsigned*)(F.ws + WS_PINFO);
            pinfo[pr * 2] = ((unsigned)e0 << 16) | (unsigned)(lbase[e0] + ent[i * 4 + 2]); pinfo[pr * 2 + 1] = ((unsigned)e1 << 16) | (unsigned)(lbase[e1] + ent[i * 4 + 3]);
        }
    }
    LDS_WAIT(); __syncthreads();
    }
}
}

namespace pg8 {
struct OneUnit { int pm, pn;
    __device__ __forceinline__ bool next(int i, Unit& u) const { if (i) return false; u.pm = pm; u.pn = pn; return true; }
    __device__ __forceinline__ void a_ready(const Unit&) const {}
    __device__ __forceinline__ void done(const Unit&) const {} };
struct EpiMoeUp {
    static constexpr bool PERM = true, AFTER_DRAIN = false;
    bf16_t* HID;
    __device__ __forceinline__ void operator()(const f32x4 (&acc)[2][2][4][2], const Unit& u, int wr, int wc, int fr, int fq) const {
        const int j0 = 128 * u.pn + 16 * wc + 4 * fq;
#pragma unroll
        for (int ai = 0; ai < 2; ++ai)
#pragma unroll
            for (int m = 0; m < 4; ++m) { bf16_t* rowp = HID + (size_t)(ai * HALF + wr * 64 + m * 16 + fr) * 256 + j0;
#pragma unroll
                for (int bj = 0; bj < 2; ++bj) { const f32x4 v0 = acc[ai][bj][m][0], v1 = acc[ai][bj][m][1];
                    const float h0 = v0[0] / (1.f + __expf(-v0[0])) * v0[1], h1 = v0[2] / (1.f + __expf(-v0[2])) * v0[3];
                    const float h2 = v1[0] / (1.f + __expf(-v1[0])) * v1[1], h3 = v1[2] / (1.f + __expf(-v1[2])) * v1[3];
                    unsigned w0 = cvt_pk_bf16(h0, h1), w1 = cvt_pk_bf16(h2, h3);
                    typedef unsigned u32x2_ __attribute__((ext_vector_type(2))); u32x2_ wv; wv.x = w0; wv.y = w1;
                    *(u32x2_*)(rowp + 64 * bj) = wv; } }
    }
};
struct EpiMoeDown {
    static constexpr bool PERM = true, AFTER_DRAIN = false;
    bf16_t* O;
    __device__ __forceinline__ void operator()(const f32x4 (&acc)[2][2][4][2], const Unit& u, int wr, int wc, int fr, int fq) const {
        const int col0 = (u.pn & 3) * BM + wc * 32 + 8 * fq;
#pragma unroll
        for (int ai = 0; ai < 2; ++ai)
#pragma unroll
            for (int m = 0; m < 4; ++m) { bf16_t* rowp = O + (size_t)(u.pm * BM + ai * HALF + wr * 64 + m * 16 + fr) * 1024 + col0;
#pragma unroll
                for (int bj = 0; bj < 2; ++bj) { const f32x4 v0 = acc[ai][bj][m][0], v1 = acc[ai][bj][m][1];
                    u32x4 w; w.x = cvt_pk_bf16(v0[0], v0[1]); w.y = cvt_pk_bf16(v0[2], v0[3]); w.z = cvt_pk_bf16(v1[0], v1[1]); w.w = cvt_pk_bf16(v1[2], v1[3]);
                    *(u32x4*)(rowp + bj * HALF) = w; } }
    }
};
struct ThreeUnits { int n, pm0, pn0, pm1, pn1, pm2, pn2;
    __device__ __forceinline__ bool next(int i, Unit& u) const { if (i >= n) return false; u.pm = (i == 0) ? pm0 : (i == 1 ? pm1 : pm2); u.pn = (i == 0) ? pn0 : (i == 1 ? pn1 : pn2); return true; }
    __device__ __forceinline__ void a_ready(const Unit&) const {}
    __device__ __forceinline__ void done(const Unit&) const {} };
}

namespace mk {
struct MoeTiles { int total; };
__device__ __forceinline__ int moe_find(const unsigned* cnt, int ti, int& e_out, int& i_out, int& hb_out, int& total) {
    int acc = 0, e_f = -1, i_f = 0, hb = 0;
    for (int e = 0; e < NEXP; ++e) { const int nt = ((int)cnt[e] + 255) >> 8; if (e_f < 0 && ti < acc + nt) { e_f = e; i_f = ti - acc; hb = acc; } acc += nt; }
    total = acc; e_out = e_f; i_out = i_f; hb_out = hb; return e_f;
}
constexpr int MOE_LDS_IDX = RING_BYTES;
__device__ __forceinline__ void p7_moe(const Frame& F, const Args& a, const MoeBufs& MB, const XcdBarrier& bar, unsigned* sigA, unsigned* sigB, bool do_up, bool do_down, bool fused) {
    const unsigned* cnt = (const unsigned*)(F.ws + WS_CTL) + CW_CNT;
    const int* list = (const int*)(F.ws + WS_LIST);
    LAS int* lidx = (LAS int*)(F.lds + MOE_LDS_IDX);
    const int NG = ((F.G & 7) == 0) ? 8 : 1, nslot = F.G / NG, x = F.bid % NG, y = F.bid / NG;
    int T; { int e, i, hb; moe_find(cnt, 0, e, i, hb, T); T = __builtin_amdgcn_readfirstlane(T); }
    const int tper = (T + NG - 1) / NG, t0 = x * tper, nl = max(min(tper, T - t0), 0), E = nslot >> 1;
    if (do_up) {
#pragma unroll 1
        for (int k = 0;; ++k) {
            const int o = y + k * nslot;
            if (o < 2 * nl) {
                int e, i, hb, total; moe_find(cnt, t0 + (o >> 1), e, i, hb, total);
                e = __builtin_amdgcn_readfirstlane(e); i = __builtin_amdgcn_readfirstlane(i); hb = __builtin_amdgcn_readfirstlane(hb);
                const int pn = __builtin_amdgcn_readfirstlane(o & 1), n_e = __builtin_amdgcn_readfirstlane((int)cnt[e]), base = 256 * i;
                __syncthreads();
                if (F.tid < 256) lidx[F.tid] = list[(size_t)e * LISTCAP + min(base + F.tid, n_e - 1)] >> 1;
                LDS_WAIT(); __syncthreads();
                pg8::Gemm g{MB.H1b, MB.WGU + (size_t)e * 512 * 1024, 256, 512, 1024, 1024, (const int*)(F.lds + MOE_LDS_IDX)};
                pg8::OneUnit S{0, pn};
                pg8::EpiMoeUp Ep{MB.HID + (size_t)(hb + i) * 256 * 256};
                pg8::gemm_phase<pg8::EpiMoeUp, pg8::OneUnit, true, true, true>(F.lds, g, S, Ep, F.wave);
            }
            if (k == 0) {
                if (fused) grid_signal(F.wave, bar, sigA);
            }
            if (o + nslot >= 2 * nl) break;
        }
        if (fused) grid_signal(F.wave, bar, sigB);
    }
    if (do_down) {
#pragma unroll 1
        for (int pass = 0;; ++pass) {
            int z = pass; asm volatile("" : "+s"(z));
            const int NGd = ((F.G & 7) == 0) ? 8 : 1, nsl = F.G / NGd, xd = (int)F.bid % NGd, yd = (int)F.bid / NGd;
            int Td; { int e, i, hb; moe_find(cnt, 0, e, i, hb, Td); Td = __builtin_amdgcn_readfirstlane(Td); }
            const int tperd = (Td + NGd - 1) / NGd, t0d = xd * tperd, nld = max(min(tperd, Td - t0d), 0), Ed = nsl >> 1;
            const int ne = min(Ed, nld), nlate = 4 * max(nld - Ed, 0), jb = 3 * (z - 1) * nsl + nsl - 1 - yd;
            if (z > 0 && jb >= nlate) break;
            if (fused) grid_wait(F.wave, bar, z == 0 ? sigA : sigB);
            pg8::ThreeUnits S{0, 0, 0, 0, 0, 0, 0};
            const int ns2 = max(2 * nld - nsl, 0); const bool mv = ns2 > 0 && 3 * ns2 <= nsl;
            for (int k3 = 0; k3 < 3; ++k3) {
                int tl, c; bool ok;
                if (z == 0) {
                    int od = yd + k3 * nsl; ok = k3 < 2 && !(mv && yd < ns2);
                    if (k3 == 2 && mv && yd >= ns2 && yd < 3 * ns2) { const int m = yd - ns2; od = (m % ns2) + (m / ns2) * nsl; ok = true; }
                    ok = ok && od < 4 * ne; tl = od >> 2; c = od & 3; }
                else { const int j = jb + k3 * nsl; ok = j < nlate; tl = Ed + (j >> 2); c = j & 3; }
                if (ok) { int e, i, hb, total; moe_find(cnt, t0d + tl, e, i, hb, total);
                    const int pm = __builtin_amdgcn_readfirstlane(t0d + tl), pn = __builtin_amdgcn_readfirstlane(e * 4 + c);
                    if (S.n == 0) { S.pm0 = pm; S.pn0 = pn; } else if (S.n == 1) { S.pm1 = pm; S.pn1 = pn; } else { S.pm2 = pm; S.pn2 = pn; } S.n = S.n + 1; }
            }
            pg8::Gemm g{MB.HID, MB.WD, 256, 1024, 256, 256, nullptr};
            pg8::EpiMoeDown Ed_{MB.F};
            pg8::gemm_phase<pg8::EpiMoeDown, pg8::ThreeUnits, true, false, false>(F.lds, g, S, Ed_, F.wave);
        }
    }
}
__device__ __forceinline__ int moe_total_tiles(const unsigned* cnt) { int acc = 0; for (int e = 0; e < NEXP; ++e) acc += ((int)cnt[e] + 255) >> 8; return acc; }
__device__ __forceinline__ void p8_final(const Frame& F, const Args& a, const MoeBufs& MB) {
    const int gw = F.bid * NWAVES + F.wave, NGW = F.G * NWAVES, lane = F.lane;
    const unsigned* cnt = (const unsigned*)(F.ws + WS_CTL) + CW_CNT;
    const unsigned* pinfo = (const unsigned*)(F.ws + WS_PINFO); const float* wt = (const float*)(F.ws + WS_WT);
    int tb = 0;
    { const int nt = (lane < NEXP) ? (((int)cnt[lane & 31] + 255) >> 8) : 0; int inc = nt;
#pragma unroll
      for (int o = 1; o < 32; o <<= 1) { const int t = __shfl_up(inc, o); if ((lane & 31) >= o) inc += t; }
      tb = inc - nt; }
    const int NR = NB * SEQ;
    f32x4 g2[4], b2[4];
#pragma unroll
    for (int j = 0; j < 4; ++j) { g2[j] = ((const f32x4*)a.in[31])[lane + 64 * j]; b2[j] = ((const f32x4*)a.in[32])[lane + 64 * j]; }
    for (int orow = gw; orow < NR; orow += 2 * NGW) {
        v2u hv[2][4], fa[2][4], fb[2][4]; float w0[2], w1[2]; bool ok[2];
#pragma unroll
        for (int u = 0; u < 2; ++u) {
            const int o = orow + u * NGW; ok[u] = o < NR; const int oc = ok[u] ? o : orow;
            const size_t pr = (size_t)(oc / SEQ) * LP + NM + (oc % SEQ);
            const unsigned p0 = pinfo[pr * 2], p1 = pinfo[pr * 2 + 1]; w0[u] = wt[pr * 2]; w1[u] = wt[pr * 2 + 1];
            const size_t r0 = (size_t)__shfl(tb, (int)(p0 >> 16)) * 256 + (p0 & 0xffffu), r1 = (size_t)__shfl(tb, (int)(p1 >> 16)) * 256 + (p1 & 0xffffu);
#pragma unroll
            for (int j = 0; j < 4; ++j) { hv[u][j] = ((const v2u*)(MB.H1b + pr * D))[lane + 64 * j]; fa[u][j] = ((const v2u*)(MB.F + r0 * D))[lane + 64 * j]; fb[u][j] = ((const v2u*)(MB.F + r1 * D))[lane + 64 * j]; }
        }
#pragma unroll
        for (int u = 0; u < 2; ++u) {
            f32x4 v[4]; float sm = 0.f;
#pragma unroll
            for (int j = 0; j < 4; ++j) {
                const f32x4 h = {bflo(hv[u][j].x), bfhi(hv[u][j].x), bflo(hv[u][j].y), bfhi(hv[u][j].y)}; const v2u f0 = fa[u][j], f1 = fb[u][j];
                v[j].x = DN_ALPHA * h.x + w0[u] * bflo(f0.x) + w1[u] * bflo(f1.x); v[j].y = DN_ALPHA * h.y + w0[u] * bfhi(f0.x) + w1[u] * bfhi(f1.x);
                v[j].z = DN_ALPHA * h.z + w0[u] * bflo(f0.y) + w1[u] * bflo(f1.y); v[j].w = DN_ALPHA * h.w + w0[u] * bfhi(f0.y) + w1[u] * bfhi(f1.y);
                sm += (v[j].x + v[j].y) + (v[j].z + v[j].w);
            }
            const float mean = wave_sum(sm) * (1.f / D); float s2 = 0.f;
#pragma unroll
            for (int j = 0; j < 4; ++j) { v[j] = v[j] - mean; s2 += (v[j].x * v[j].x + v[j].y * v[j].y) + (v[j].z * v[j].z + v[j].w * v[j].w); }
            const float rstd = rsqrtf(wave_sum(s2) * (1.f / D) + LN_EPS);
            if (ok[u]) {
                const int o = orow + u * NGW;
#pragma unroll
                for (int j = 0; j < 4; ++j) ((f32x4*)(a.out + (size_t)o * D))[lane + 64 * j] = v[j] * rstd * g2[j] + b2[j];
            }
        }
    }
}
struct OutY {
    bf16* Ur;
    __device__ __forceinline__ void operator()(int b, int t, int col, f32x4 y) const { v2u o; o.x = pk2(y[0], y[1]); o.y = pk2(y[2], y[3]); *(v2u*)(Ur + ((size_t)b * LP + t) * UR_W + col) = o; }
    __device__ __forceinline__ void operator()(int b, int t, int col, float y) const { Ur[((size_t)b * LP + t) * UR_W + col] = (bf16)f2bf(y); }
};
constexpr int CW_W3 = 16, CW_W4 = 80;
constexpr int CW_SIG0 = 4608;
constexpr int CW_SIG_IN1 = CW_SIG0, CW_SIG_IN2 = CW_SIG0 + SIG_WORDS;
constexpr int CW_SIG_ATT = CW_SIG0 + 2 * SIG_WORDS, CW_SIG_UNITS = CW_SIG0 + 3 * SIG_WORDS;
constexpr int CW_SIG_SCAN = CW_SIG0 + 4 * SIG_WORDS, CW_SIG_IDX = CW_SIG0 + 5 * SIG_WORDS;
constexpr int CW_SIG_UPA = CW_SIG0 + 6 * SIG_WORDS, CW_SIG_UPB = CW_SIG0 + 7 * SIG_WORDS;
constexpr int CW_SIG_MIX = CW_SIG0 + 8 * SIG_WORDS, CW_SIG_ATTN = CW_SIG0 + 9 * SIG_WORDS;
constexpr int CW_SIG_IDXH = CW_SIG0 + 10 * SIG_WORDS;
constexpr int IDX_N1 = 512, ATT_N1 = 256;
static_assert((CW_SIG0 + 11 * SIG_WORDS) * 4 <= (int)CTL_ZERO_BYTES && CW_BAR + XCD_BAR_WORDS <= CW_SIG0, "control words");
constexpr int TICKET_OFF = 15 * 9216 + 62 * 144 + 128;
__device__ __forceinline__ int next_ticket(const Frame& F, unsigned* ctr) {
    LAS int* slot = (LAS int*)(F.lds + TICKET_OFF);
    if (F.tid == 0) *slot = (int)atomicAdd(ctr, 1u);
    LDS_WAIT(); __syncthreads();
    const int t = *slot;
    LDS_WAIT(); __syncthreads();
    return t;
}
__device__ __forceinline__ int bcast_ticket(const Frame& F, int mine) {
    LAS int* slot = (LAS int*)(F.lds + TICKET_OFF);
    if (F.tid == 0) *slot = mine;
    LDS_WAIT(); __syncthreads();
    const int t = *slot;
    LDS_WAIT(); __syncthreads();
    return t;
}
constexpr size_t W_UR = 16 * MiB;
constexpr size_t W_UA = W_UR + (size_t)TP * UR_W * 2;
constexpr size_t W_RW = W_UA + (size_t)TP * UA_W * 2;
constexpr size_t W_H0B = W_RW;
constexpr size_t W_RW_M = W_RW, W_RW_N = W_RW_M + (size_t)NUNIT * 8192, W_RW_Q = W_RW_N + (size_t)NUNIT * 16384, W_RW_OP = W_RW_Q + (size_t)NUNIT * 8192,
                 W_RW_G1 = W_RW_OP + (size_t)NUNIT * 8192, W_RW_G2 = W_RW_G1 + (size_t)NUNIT * 8192, W_RW_END = W_RW_G2 + (size_t)NUNIT * 8192;
static_assert(W_RW_END <= WS_LIST, "RWKV data below the token lists");
constexpr size_t W_MIX = W_UA;
constexpr size_t W_WGU = W_RW;
constexpr size_t W_F = W_UR;
constexpr size_t W_H1B = W_RW + 81 * MiB;
constexpr size_t W_H1 = W_UR;
constexpr size_t W_HID = W_RW_Q;
static_assert(W_MIX + (size_t)TP * 2048 <= W_RW && W_WGU + (size_t)NEXP * EW_GU <= W_RW_Q && W_HID + (size_t)41216 * 512 <= W_H1B && W_H1B + (size_t)TP * 2048 <= WS_LIST
              && W_F + (size_t)41216 * 2048 <= W_RW, "late-phase overlays");
constexpr size_t O_Q = 0, O_QI = O_Q + (size_t)TP * 1024, O_HC = O_QI + (size_t)TP * 1024, O_MASK = O_HC + (size_t)NUNIT * 8192, O_KX = O_MASK + MASK_BYTES, O_END = O_KX + (size_t)TP * 128;
constexpr size_t O_WD = O_QI;
static_assert(O_END <= 64 * MiB && O_WD + (size_t)NEXP * EW_D <= O_HC, "d_out scratch");

__global__ void __launch_bounds__(NTHR, 2) mega(Args a) {
    unsigned char* const wsb_ = a.ws; unsigned char* const ob_ = (unsigned char*)a.out;
    bf16* const H0b = (bf16*)(wsb_ + W_H0B); bf16* const Ur = (bf16*)(wsb_ + W_UR); bf16* const Ua = (bf16*)(wsb_ + W_UA);
    const RwkvBufs RB{(bf16*)(wsb_ + W_RW_M), (float*)(wsb_ + W_RW_N), (bf16*)(wsb_ + W_RW_Q), (bf16*)(wsb_ + W_RW_OP), (bf16*)(wsb_ + W_RW_G1), (bf16*)(wsb_ + W_RW_G2), (bf16*)(ob_ + O_HC)};
    const AttBufs AB{(bf16*)(ob_ + O_Q), (bf16*)(ob_ + O_QI), (unsigned short*)(ob_ + O_MASK), (bf16*)(ob_ + O_KX)};
    const MoeBufs MB{(float*)(wsb_ + W_MIX), (float*)(wsb_ + W_H1), (bf16*)(wsb_ + W_H1B), (bf16*)(wsb_ + W_HID), (bf16*)(wsb_ + W_F), (bf16*)(wsb_ + W_WGU), (bf16*)(ob_ + O_WD)};
    extern __shared__ __attribute__((aligned(16))) unsigned char lds[];
    Frame F;
    F.lds = (LAS unsigned char*)lds;
    F.tid = threadIdx.x; F.lane = 0; F.wave = __builtin_amdgcn_readfirstlane(F.tid >> 6);
    F.G = gridDim.x; F.bid = blockIdx.x; F.ws = a.ws;
    unsigned* ctl = (unsigned*)(a.ws + WS_CTL);
    const int lo = a.ph_lo, hi = a.ph_hi;
    volatile LAS unsigned* MISC = (volatile LAS unsigned*)(F.lds + MISC_OFF);
    if (F.tid < 4) MISC[F.tid] = 0u;
    LDS_WAIT(); __syncthreads();
    const Frame& Fo = F;
#define PHASE_FRAME Frame F = Fo; { int t_ = Fo.wave * 64 + (int)__builtin_amdgcn_mbcnt_hi(~0u, __builtin_amdgcn_mbcnt_lo(~0u, 0u)); asm volatile("" : "+v"(t_)); F.tid = t_; F.lane = t_ & 63; }
    XcdBarrier bar; bar.bar = ctl + CW_BAR; bar.x = 0; bar.st = MISC;
    if (hi - lo > 1) bar = xcd_barrier_post(ctl + CW_BAR, MISC);
#define SEAM(k) do { if (IN(k) && IN((k) + 1)) xcd_barrier(bar, F.wave); } while (0)
#define IN(k) (lo <= (k) && (k) < hi)
    if (IN(0)) { PHASE_FRAME p0_prologue(F, a, H0b); }
    SEAM(0);
    const bool fuse12 = IN(1) && IN(2);
    if (IN(1)) {
        pg8::Gemm g{H0b, (const bf16*)(F.ws + WS_WIN), TP, IN_N, 1024, 1024, nullptr};
        pg8::StaticOrder S; S.init(IN_NM1 * 256, IN_N, F.G, (int)blockIdx.x);
        pg8::EpiU E{Ur, Ua};
        pg8::gemm_phase<pg8::EpiU, pg8::StaticOrder, true, true>(F.lds, g, S, E, F.wave);
        if (fuse12) grid_signal(F.wave, bar, ctl + CW_SIG_IN1);
#pragma unroll 1
        for (int j = F.bid; j < (TP / 256 - IN_NM1) * (IN_N / 256); j += F.G) {
            pg8::OneUnit S2{IN_NM1 + j / (IN_N / 256), j % (IN_N / 256)};
            pg8::gemm_phase<pg8::EpiU, pg8::OneUnit, true, true>(F.lds, g, S2, E, F.wave);
        }
        if (fuse12) grid_signal(F.wave, bar, ctl + CW_SIG_IN2);
    }
    if (!fuse12) SEAM(1);
    const bool fuse23 = IN(2) && IN(3), fuse34 = IN(3) && IN(4), fuse45 = IN(4) && IN(5), fuse56 = IN(5) && IN(6);
    if (IN(2)) {
        PHASE_FRAME
        {
            if (F.G == 256) {
                if (fuse12) { grid_wait(F.wave, bar, ctl + CW_SIG_IN1); if (F.bid >= 4 * IN_NM1) grid_wait(F.wave, bar, ctl + CW_SIG_IN2); }
                att_prep_unit(F, a, Ua, AB, F.bid);
                if (F.bid >= 32 && F.bid < 36) { if (fuse12) grid_wait(F.wave, bar, ctl + CW_SIG_IN2); att_prep_unit(F, a, Ua, AB, 256 + F.bid - 32); } }
            else { if (fuse12) grid_wait(F.wave, bar, ctl + CW_SIG_IN2); for (int u = F.bid; u < TP / 64; u += F.G) att_prep_unit(F, a, Ua, AB, u); }
        }
        if (fuse23) grid_signal(F.wave, bar, ctl + CW_SIG_ATT);
        {
            if (F.G == 256) {
                constexpr int XB = (TP / 256 - IN_NM1) * (IN_N / 256);
                const bool xtra = F.bid >= XB && F.bid < XB + 32;
                const int nk = (F.bid >= 32 && F.bid < 36) ? 7 : ((xtra || (F.bid >= 36 && F.bid < 40)) ? 9 : 8);
#define PB(x) (32 * ((x) & 7) + ((x) >> 3))
                RwRaw R; rw_load_raw(R, Ur, PB(F.bid), F.tid);
                { RwW W0; rw_w_fetch(W0, F, a, PB(F.bid) & 7); __syncthreads(); rw_w_store(W0, F); LDS_WAIT(); __syncthreads(); }
#pragma unroll 1
                for (int kq = 0; kq < nk; ++kq) {
                    if (kq == 2 && fuse12) grid_wait(F.wave, bar, ctl + CW_SIG_IN2);
                    const int u = (kq < 8) ? PB(F.bid) + 256 * kq : (xtra ? 2048 + (F.bid - XB) : PB(F.bid - 4) + 256 * 7);
                    const int kn = kq + 1; const int un = (kn >= nk) ? -1 : ((kn < 8) ? PB(F.bid) + 256 * kn : (xtra ? 2048 + (F.bid - XB) : PB(F.bid - 4) + 256 * 7));
                    rwkv_unit(F, a, Ur, RB, u, R, un);
                }
            } else { RwRaw R; for (int u = F.bid; u < NUNIT; u += F.G) { rw_load_raw(R, Ur, u, F.tid); { RwW W0; rw_w_fetch(W0, F, a, u & 7); __syncthreads(); rw_w_store(W0, F); LDS_WAIT(); __syncthreads(); } rwkv_unit(F, a, Ur, RB, u, R, -1); } }
        }
        if (fuse23) grid_signal(F.wave, bar, ctl + CW_SIG_UNITS);
    }
    if (IN(3)) {
        PHASE_FRAME
        if (fuse23) grid_wait(F.wave, bar, ctl + CW_SIG_ATT);
        if (F.bid < 16) { if (fuse23) grid_wait(F.wave, bar, ctl + CW_SIG_UNITS); if (F.wave < 4) rwkv_scan(RB, 2 * F.bid + (F.wave >> 1), F.wave & 1, F.lane); }
        if (fuse34) grid_signal(F.wave, bar, ctl + CW_SIG_SCAN);
        { bool hs = false;
          for (int i = next_ticket(F, ctl + CW_W3);;) {
            if (fuse34 && !hs && i >= IDX_N1) { grid_signal(F.wave, bar, ctl + CW_SIG_IDXH); hs = true; }
            if (i >= 4 * 257) break;
            idx_unit(F, Ua, AB, i & 3, 256 - (i >> 2), a.flags);
            i = next_ticket(F, ctl + CW_W3);
          } }
        if (fuse34) grid_signal(F.wave, bar, ctl + CW_SIG_IDX);
    }
    if (IN(4)) {
        PHASE_FRAME
        const OutY of{Ur};
        if (fuse34) grid_wait(F.wave, bar, ctl + CW_SIG_SCAN);
        for (int u = F.bid * NWAVES + F.wave; u < NUNIT; u += F.G * NWAVES) rwkv_out_unit(RB, u, F.lane, of);
        if (fuse34) grid_wait(F.wave, bar, ctl + CW_SIG_IDXH);
        { bool all = false;
          for (int i = next_ticket(F, ctl + CW_W4); i < 17 * 32;) {
            if (fuse34 && !all && i >= ATT_N1) { grid_wait(F.wave, bar, ctl + CW_SIG_IDX); all = true; }
            attn_unit(F, Ua, AB, (i & 31) >> 3, i & 7, 16 - (i >> 5), of);
            i = next_ticket(F, ctl + CW_W4);
          } }
    }
    if (IN(4) && fuse45) grid_signal(F.wave, bar, ctl + CW_SIG_ATTN);
    if (IN(5)) {
        PHASE_FRAME
        convert_experts(F, a, MB, 0, 0);
        if (fuse34) grid_wait(F.wave, bar, ctl + CW_SIG_IDX);
        convert_experts(F, a, MB, 1, 0);
        if (fuse45) grid_wait(F.wave, bar, ctl + CW_SIG_ATTN);
        for (int v = F.bid; v < 256; v += F.G) {
            const int y = v >> 3, pmc = (v & 7) * 8 + (y >> 2), pn = y & 3;
            const size_t row0 = (size_t)(pmc >> 4) * LP + NM + 256 * (pmc & 15);
            pg8::Gemm g{Ur + row0 * UR_W, (const bf16*)(F.ws + WS_WOUT), 256, 1024, 1024, UR_W, nullptr};
            pg8::OneUnit S{0, pn};
            pg8::EpiB16 E{(bf16*)MB.MIX + row0 * 1024, 1024};
            pg8::gemm_phase<pg8::EpiB16, pg8::OneUnit, true, true>(F.lds, g, S, E, F.wave);
        }
        if (fuse56) grid_signal(F.wave, bar, ctl + CW_SIG_MIX);
    }
    if (IN(6)) { PHASE_FRAME p6_ln1_router(F, a, MB, bar, ctl + CW_SIG_MIX, fuse56); }
    SEAM(6);
    if (IN(7) || IN(8)) { Frame F8 = F; { int t = F.wave * 64 + (int)__builtin_amdgcn_mbcnt_hi(~0u, __builtin_amdgcn_mbcnt_lo(~0u, 0u)); asm volatile("" : "+v"(t)); F8.tid = t; F8.lane = t & 63; }
        p7_moe(F8, a, MB, bar, ctl + CW_SIG_UPA, ctl + CW_SIG_UPB, IN(7), IN(8), IN(7) && IN(8)); }
    SEAM(8);
    if (IN(9)) { Frame F9 = F; { int t = F.wave * 64 + (int)__builtin_amdgcn_mbcnt_hi(~0u, __builtin_amdgcn_mbcnt_lo(~0u, 0u)); asm volatile("" : "+v"(t)); F9.tid = t; F9.lane = t & 63; } p8_final(F9, a, MB); }
#undef PHASE_FRAME
#undef IN
#undef SEAM
}

}
extern "C" void kernel_launch(void* const* d_in, const int* in_sizes, int n_in, void* d_out, int out_size, void* d_ws, size_t ws_size, hipStream_t stream) {
    static int inited = 0;
    if (!inited) { (void)hipFuncSetAttribute((const void*)mk::mega, hipFuncAttributeMaxDynamicSharedMemorySize, mk::LDS_BYTES); inited = 1; }
    unsigned char* wsb = (unsigned char*)d_ws;
    (void)hipMemsetAsync(wsb + mk::WS_CTL, 0, mk::CTL_ZERO_BYTES, stream);
    mk::Args a{};
    for (int i = 0; i < 33; ++i) a.in[i] = (const float*)d_in[i];
    a.out = (float*)d_out; a.ws = wsb;
    static int grid = 0;
    if (!grid) { int dev = 0, cus = 0, per_cu = 0; (void)hipGetDevice(&dev); (void)hipDeviceGetAttribute(&cus, hipDeviceAttributeMultiprocessorCount, dev);
        (void)hipOccupancyMaxActiveBlocksPerMultiprocessor(&per_cu, (const void*)mk::mega, mk::NTHR, mk::LDS_BYTES); (void)hipGetLastError();
        if (per_cu < 1) per_cu = 1; if (cus < 1) cus = 256; grid = cus * per_cu; if (grid > 256) grid = 256; }
    a.ph_lo = 0; a.ph_hi = 10;
    { void* kargs[] = {(void*)&a};
      if (hipLaunchCooperativeKernel((const void*)mk::mega, dim3(grid), dim3(mk::NTHR), kargs, mk::LDS_BYTES, stream) != hipSuccess) {
          (void)hipGetLastError();
          hipLaunchKernelGGL(mk::mega, dim3(grid), dim3(mk::NTHR), mk::LDS_BYTES, stream, a);
      } }
}
```
